# Optimizing an MI355X kernel written in HIP

```python
import jax
import jax.numpy as jnp
from jax import lax
import numpy as np

D_MODEL = 1024
BATCH = 16
SEQ = 2048
DEPTH = 4

GRID_W = 64
CTX_LEN = 256
NORM_EPS = 1e-6

ATT_HEADS = 8
ATT_KV_HEADS = 2
ATT_HEAD_DIM = 64
ATT_GROUP = ATT_HEADS // ATT_KV_HEADS
ATT_WIDTH = ATT_HEADS * ATT_HEAD_DIM
ATT_KV_WIDTH = ATT_KV_HEADS * ATT_HEAD_DIM
ROPE_THETA = 10000.0
Q_BLOCK = 128

RWKV_HEADS = 8
RWKV_HEAD_DIM = 64
RWKV_WIDTH = RWKV_HEADS * RWKV_HEAD_DIM
DECAY_RANK = 64
ICLR_RANK = 64
GATE_RANK = 128
RWKV_GN_EPS = 64e-5

CONV_WIDTH = 512
CONV_K = 3

N_BRANCHES = 3

N_EXPERTS = 16
EXPERT_FF = 1024
CAPACITY_FACTOR = 2

ATT_SPLITS = [ATT_WIDTH, ATT_KV_WIDTH, ATT_KV_WIDTH]
RWKV_SPLITS = [RWKV_WIDTH, RWKV_WIDTH, RWKV_WIDTH, 2 * DECAY_RANK, 2 * ICLR_RANK, GATE_RANK]
CONV_SPLITS = [CONV_WIDTH, CONV_WIDTH, CONV_WIDTH]
GROUP_SPLITS = [sum(ATT_SPLITS), sum(RWKV_SPLITS), sum(CONV_SPLITS), N_BRANCHES * D_MODEL]
RWKV_SEG = sum(RWKV_SPLITS)
IN_WIDTH = sum(GROUP_SPLITS)

kernel_name = 'hybrid_flow_rwkv_gqa_conv_ecmoe'


def _split(x, sizes):
    return jnp.split(x, np.cumsum(sizes)[:-1].tolist(), axis=-1)


def _rms_norm(x, gain):
    xf = x.astype(jnp.float32)
    y = xf * lax.rsqrt(jnp.mean(xf * xf, axis=-1, keepdims=True) + NORM_EPS)
    return (y * gain.astype(jnp.float32)).astype(x.dtype)


def _modulate(x, gain, shift, scale):
    return _rms_norm(x, gain) * (1 + scale) + shift


def _neighbours(u):
    up = jnp.pad(u, ((0, 0), (1, 1), (0, 0)))
    return up[:, :-2], up[:, 2:]


def _axial_rope_tables(n_tokens, dtype):
    rows = n_tokens // GRID_W
    row = jnp.repeat(jnp.arange(rows, dtype=jnp.float32), GRID_W)
    col = jnp.tile(jnp.arange(GRID_W, dtype=jnp.float32), rows)
    axis_dim = ATT_HEAD_DIM // 2
    inv_freq = ROPE_THETA ** (-jnp.arange(0, axis_dim, 2, dtype=jnp.float32) / axis_dim)
    ang_r = row[:, None] * inv_freq[None, :]
    ang_c = col[:, None] * inv_freq[None, :]
    return (jnp.cos(ang_r).astype(dtype), jnp.sin(ang_r).astype(dtype),
            jnp.cos(ang_c).astype(dtype), jnp.sin(ang_c).astype(dtype))


def _rotate_half(x, cos, sin):
    x1, x2 = jnp.split(x, 2, axis=-1)
    cos = cos[:, None, :]
    sin = sin[:, None, :]
    return jnp.concatenate([x1 * cos - x2 * sin, x1 * sin + x2 * cos], axis=-1)


def _axial_rotary(x, tables):
    cos_r, sin_r, cos_c, sin_c = tables
    x_row, x_col = jnp.split(x, 2, axis=-1)
    return jnp.concatenate([_rotate_half(x_row, cos_r, sin_r), _rotate_half(x_col, cos_c, sin_c)], axis=-1)


def _attend(q, k, v):
    s = jnp.einsum('bqkgd,bskd->bkgqs', q, k).astype(jnp.float32) * (ATT_HEAD_DIM ** -0.5)
    p = jax.nn.softmax(s, axis=-1).astype(v.dtype)
    return jnp.einsum('bkgqs,bskd->bqkgd', p, v)


def _latent_attention(q, k_all, v_all):
    b, t = q.shape[:2]
    n_blocks = t // Q_BLOCK
    q_blocks = jnp.moveaxis(q.reshape(b, n_blocks, Q_BLOCK, ATT_KV_HEADS, ATT_GROUP, ATT_HEAD_DIM), 1, 0)
    o = lax.map(lambda q_blk: _attend(q_blk, k_all, v_all), q_blocks)
    return jnp.moveaxis(o, 0, 1).reshape(b, t, ATT_WIDTH)


def _attention_branch(att_lat, att_ctx, q_gain, k_gain, need_ctx):
    def heads(seg):
        b, t = seg.shape[:2]
        q, k, v = _split(seg, ATT_SPLITS)
        q = _rms_norm(q.reshape(b, t, ATT_HEADS, ATT_HEAD_DIM), q_gain)
        k = _rms_norm(k.reshape(b, t, ATT_KV_HEADS, ATT_HEAD_DIM), k_gain)
        return q, k, v.reshape(b, t, ATT_KV_HEADS, ATT_HEAD_DIM)

    b, t = att_lat.shape[:2]
    q_l, k_l, v_l = heads(att_lat)
    q_c, k_c, v_c = heads(att_ctx)
    tables = _axial_rope_tables(t, q_l.dtype)
    q_l = _axial_rotary(q_l, tables).reshape(b, t, ATT_KV_HEADS, ATT_GROUP, ATT_HEAD_DIM)
    k_l = _axial_rotary(k_l, tables)
    k_all = jnp.concatenate([k_c, k_l], axis=1)
    v_all = jnp.concatenate([v_c, v_l], axis=1)
    o_lat = _latent_attention(q_l, k_all, v_all)
    if not need_ctx:
        return o_lat, None
    n_ctx = att_ctx.shape[1]
    q_c = q_c.reshape(b, n_ctx, ATT_KV_HEADS, ATT_GROUP, ATT_HEAD_DIM)
    o_ctx = _attend(q_c, k_c, v_c).reshape(b, n_ctx, ATT_WIDTH)
    return o_lat, o_ctx


def _to_heads(u):
    return u.reshape(u.shape[:-1] + (RWKV_HEADS, RWKV_HEAD_DIM))


def _l2_heads(u):
    uf = u.astype(jnp.float32)
    return (uf * lax.rsqrt(jnp.sum(uf * uf, axis=-1, keepdims=True) + 1e-12)).astype(u.dtype)


def _rwkv_prepare(seg, mu, decay_w0, decay_w2, iclr_a0, iclr_a2, gate_g2, k_k, k_a):
    b, t, _ = seg.shape
    prev, nxt = _neighbours(seg)
    seg = seg + mu * (0.5 * (prev + nxt) - seg)
    r, k, v, w_lo, a_lo, g_lo = _split(seg, RWKV_SPLITS)
    w_pre = decay_w0 + jnp.einsum('btdr,drc->btdc', jnp.tanh(w_lo.reshape(b, t, 2, DECAY_RANK)), decay_w2)
    decay = jnp.exp(-jnp.exp(-jax.nn.softplus(-w_pre) - 0.5))
    a = jax.nn.sigmoid(iclr_a0 + jnp.einsum('btdr,drc->btdc', a_lo.reshape(b, t, 2, ICLR_RANK), iclr_a2))
    g = jax.nn.sigmoid(g_lo) @ gate_g2
    kk = _l2_heads(_to_heads(k * k_k))
    k_dir = k[:, :, None, :] * (1 + (a - 1) * k_a)
    return (_to_heads(r), _to_heads(k), _to_heads(v), g, _to_heads(decay), _to_heads(k_dir), kk, _to_heads(a))


def _time_major(x_fwd, x_bwd):
    return jnp.moveaxis(jnp.stack([x_fwd, jnp.flip(x_bwd, axis=1)], axis=0), 2, 0)


def _rwkv_bidir_scan(r, v, decay, k_dir, kk, a, s0):
    b_vec = kk[:, :, None] * a
    xs = (_time_major(r, r), _time_major(decay[:, :, 0], decay[:, :, 1]),
          _time_major(k_dir[:, :, 0], k_dir[:, :, 1]), _time_major(v, v),
          _time_major(-kk, -kk), _time_major(b_vec[:, :, 0], b_vec[:, :, 1]))

    def step(state, inp):
        r_t, w_t, k_t, v_t, a_t, b_t = inp
        sa = jnp.einsum('dbhvk,dbhk->dbhv', state, a_t)
        state = state * w_t[..., None, :] + sa[..., :, None] * b_t[..., None, :] + v_t[..., :, None] * k_t[..., None, :]
        return state, jnp.einsum('dbhvk,dbhk->dbhv', state, r_t)

    s_final, ys = lax.scan(step, s0, xs)
    y = ys[:, 0] + jnp.flip(ys[:, 1], axis=0)
    return jnp.moveaxis(y, 0, 1), s_final


def _rwkv_readout(y, r, k, v, g, r_k, gn_w, gn_b):
    b, t = y.shape[:2]
    yf = y.astype(jnp.float32)
    mean = jnp.mean(yf, axis=-1, keepdims=True)
    var = jnp.mean(jnp.square(yf - mean), axis=-1, keepdims=True)
    yn = ((yf - mean) * lax.rsqrt(var + RWKV_GN_EPS)).astype(y.dtype).reshape(b, t, RWKV_WIDTH)
    bonus = jnp.sum(r * k * _to_heads(r_k), axis=-1, keepdims=True) * v
    return (yn * gn_w + gn_b + bonus.reshape(b, t, RWKV_WIDTH)) * g


def _rwkv_branch(seg_lat, seg_ctx, need_ctx, mu, decay_w0, decay_w2, iclr_a0, iclr_a2, gate_g2, k_k, k_a, r_k, gn_w, gn_b):
    r_c, k_c, v_c, g_c, w_c, kd_c, kk_c, a_c = _rwkv_prepare(seg_ctx, mu, decay_w0, decay_w2, iclr_a0, iclr_a2, gate_g2, k_k, k_a)
    s0 = jnp.zeros((2, seg_ctx.shape[0], RWKV_HEADS, RWKV_HEAD_DIM, RWKV_HEAD_DIM), r_c.dtype)
    y_c, s_ctx = _rwkv_bidir_scan(r_c, v_c, w_c, kd_c, kk_c, a_c, s0)
    r_l, k_l, v_l, g_l, w_l, kd_l, kk_l, a_l = _rwkv_prepare(seg_lat, mu, decay_w0, decay_w2, iclr_a0, iclr_a2, gate_g2, k_k, k_a)
    y_l, _ = _rwkv_bidir_scan(r_l, v_l, w_l, kd_l, kk_l, a_l, s_ctx)
    o_lat = _rwkv_readout(y_l, r_l, k_l, v_l, g_l, r_k, gn_w, gn_b)
    if not need_ctx:
        return o_lat, None
    return o_lat, _rwkv_readout(y_c, r_c, k_c, v_c, g_c, r_k, gn_w, gn_b)


def _short_conv(seg, conv_w):
    b_gate, c_gate, u = _split(seg, CONV_SPLITS)
    z = c_gate * u
    z_prev, z_next = _neighbours(z)
    return b_gate * (conv_w[0] * z_prev + conv_w[1] * z + conv_w[2] * z_next)


def _mixer(h_lat, h_ctx, need_ctx, w_in, q_gain, k_gain, shift_mu, decay_w0, decay_w2, iclr_a0, iclr_a2,
           gate_g2, rwkv_kk, rwkv_ka, rwkv_rk, rwkv_gn_w, rwkv_gn_b, conv_w, w_br_att, w_br_rwkv, w_br_conv, w_out):
    att_l, rw_l, cv_l, gt_l = _split(h_lat @ w_in, GROUP_SPLITS)
    att_c, rw_c, cv_c, gt_c = _split(h_ctx @ w_in, GROUP_SPLITS)
    o_att_l, o_att_c = _attention_branch(att_l, att_c, q_gain, k_gain, need_ctx)
    o_rw_l, o_rw_c = _rwkv_branch(rw_l, rw_c, need_ctx, shift_mu, decay_w0, decay_w2, iclr_a0, iclr_a2,
                                  gate_g2, rwkv_kk, rwkv_ka, rwkv_rk, rwkv_gn_w, rwkv_gn_b)

    def merge(gates, o_att, o_rwkv, o_conv):
        g_att, g_rwkv, g_conv = jnp.split(jax.nn.sigmoid(gates), N_BRANCHES, axis=-1)
        m = g_att * (o_att @ w_br_att) + g_rwkv * (o_rwkv @ w_br_rwkv) + g_conv * (o_conv @ w_br_conv)
        return m @ w_out

    y_lat = merge(gt_l, o_att_l, o_rw_l, _short_conv(cv_l, conv_w))
    if not need_ctx:
        return y_lat, None
    return y_lat, merge(gt_c, o_att_c, o_rw_c, _short_conv(cv_c, conv_w))


def _expert_choice_ffn(h, w_router, w_gate, w_up, w_down):
    b, n, d = h.shape
    cap = CAPACITY_FACTOR * n // N_EXPERTS
    aff = jax.nn.softmax(jnp.einsum('bnd,de->bne', h, w_router).astype(jnp.float32), axis=-1)
    gate, idx = lax.top_k(jnp.swapaxes(aff, 1, 2), cap)
    batch_idx = jnp.arange(b)[:, None, None]
    xe = h[batch_idx, idx]
    hid = jax.nn.silu(jnp.einsum('becd,edf->becf', xe, w_gate)) * jnp.einsum('becd,edf->becf', xe, w_up)
    ye = jnp.einsum('becf,efd->becd', hid, w_down) * gate[..., None].astype(h.dtype)
    flat = (batch_idx * n + idx).reshape(-1)
    out = jnp.zeros((b * n, d), h.dtype).at[flat].add(ye.reshape(-1, d))
    return out.reshape(b, n, d)


def setup_inputs(seed: int = 0) -> dict:
    key = jax.random.key(seed)
    ks = jax.random.split(key, 40)
    f32 = jnp.float32
    L = DEPTH
    D = D_MODEL

    def nrm(k, shape, scale):
        return jax.random.normal(k, shape, f32) * scale

    def gain(k, shape, base=1.0):
        return base + 0.05 * jax.random.normal(k, shape, f32)

    return {
        'x': nrm(ks[0], (BATCH, SEQ, D), 1.0),
        'c': nrm(ks[1], (BATCH, D), 1.0),
        'ctx': nrm(ks[2], (BATCH, CTX_LEN, D), 1.0),
        'c_ctx': nrm(ks[3], (D,), 1.0),
        'ada_w': nrm(ks[4], (L, D, 6 * D), 0.5 * D ** -0.5),
        'ada_b': nrm(ks[5], (L, 6 * D), 0.02),
        'norm1': gain(ks[6], (L, D)),
        'w_in': nrm(ks[7], (L, D, IN_WIDTH), D ** -0.5),
        'q_gain': gain(ks[8], (L, ATT_HEAD_DIM)),
        'k_gain': gain(ks[9], (L, ATT_HEAD_DIM)),
        'shift_mu': jax.random.uniform(ks[10], (L, RWKV_SEG), f32),
        'decay_w0': jax.random.uniform(ks[11], (L, 2, RWKV_WIDTH), f32, -4.0, 1.0),
        'decay_w2': nrm(ks[12], (L, 2, DECAY_RANK, RWKV_WIDTH), 0.1 * DECAY_RANK ** -0.5),
        'iclr_a0': nrm(ks[13], (L, 2, RWKV_WIDTH), 0.5),
        'iclr_a2': nrm(ks[14], (L, 2, ICLR_RANK, RWKV_WIDTH), 0.5 * ICLR_RANK ** -0.5),
        'gate_g2': nrm(ks[15], (L, GATE_RANK, RWKV_WIDTH), GATE_RANK ** -0.5),
        'rwkv_kk': gain(ks[16], (L, RWKV_WIDTH), 0.85),
        'rwkv_ka': gain(ks[17], (L, RWKV_WIDTH)),
        'rwkv_rk': nrm(ks[18], (L, RWKV_WIDTH), 0.1),
        'rwkv_gn_w': gain(ks[19], (L, RWKV_WIDTH)),
        'rwkv_gn_b': nrm(ks[20], (L, RWKV_WIDTH), 0.02),
        'conv_w': nrm(ks[21], (L, CONV_K, CONV_WIDTH), CONV_K ** -0.5),
        'w_br_att': nrm(ks[22], (L, ATT_WIDTH, D), ATT_WIDTH ** -0.5),
        'w_br_rwkv': nrm(ks[23], (L, RWKV_WIDTH, D), RWKV_WIDTH ** -0.5),
        'w_br_conv': nrm(ks[24], (L, CONV_WIDTH, D), CONV_WIDTH ** -0.5),
        'w_out': nrm(ks[25], (L, D, D), D ** -0.5),
        'norm2': gain(ks[26], (L, D)),
        'w_router': nrm(ks[27], (L, D, N_EXPERTS), D ** -0.5),
        'exp_gate': nrm(ks[28], (L, N_EXPERTS, D, EXPERT_FF), D ** -0.5),
        'exp_up': nrm(ks[29], (L, N_EXPERTS, D, EXPERT_FF), D ** -0.5),
        'exp_down': nrm(ks[30], (L, N_EXPERTS, EXPERT_FF, D), EXPERT_FF ** -0.5),
        'final_norm': gain(ks[31], (D,)),
    }


def reference(x, c, ctx, c_ctx, ada_w, ada_b, norm1, w_in, q_gain, k_gain, shift_mu, decay_w0, decay_w2,
              iclr_a0, iclr_a2, gate_g2, rwkv_kk, rwkv_ka, rwkv_rk, rwkv_gn_w, rwkv_gn_b, conv_w,
              w_br_att, w_br_rwkv, w_br_conv, w_out, norm2, w_router, exp_gate, exp_up, exp_down, final_norm):
    silu_c = jax.nn.silu(c)
    silu_cc = jax.nn.silu(c_ctx)
    for layer in range(DEPTH):
        need_ctx = layer < DEPTH - 1
        mod_l = (silu_c @ ada_w[layer] + ada_b[layer])[:, None, :]
        mod_c = silu_cc @ ada_w[layer] + ada_b[layer]
        sh1, sc1, g1, sh2, sc2, g2 = jnp.split(mod_l, 6, axis=-1)
        sh1c, sc1c, g1c, sh2c, sc2c, g2c = jnp.split(mod_c, 6, axis=-1)

        h_l = _modulate(x, norm1[layer], sh1, sc1)
        h_c = _modulate(ctx, norm1[layer], sh1c, sc1c)
        y_l, y_c = _mixer(h_l, h_c, need_ctx, w_in[layer], q_gain[layer], k_gain[layer], shift_mu[layer],
                          decay_w0[layer], decay_w2[layer], iclr_a0[layer], iclr_a2[layer], gate_g2[layer],
                          rwkv_kk[layer], rwkv_ka[layer], rwkv_rk[layer], rwkv_gn_w[layer], rwkv_gn_b[layer],
                          conv_w[layer], w_br_att[layer], w_br_rwkv[layer], w_br_conv[layer], w_out[layer])
        x = x + g1 * y_l
        h_l = _modulate(x, norm2[layer], sh2, sc2)
        x = x + g2 * _expert_choice_ffn(h_l, w_router[layer], exp_gate[layer], exp_up[layer], exp_down[layer])

        if need_ctx:
            ctx = ctx + g1c * y_c
            h_c = _modulate(ctx, norm2[layer], sh2c, sc2c)
            ctx = ctx + g2c * _expert_choice_ffn(h_c, w_router[layer], exp_gate[layer], exp_up[layer], exp_down[layer])
    return _rms_norm(x, final_norm)
```

```cpp
#include <hip/hip_runtime.h>
#include <hip/hip_bf16.h>
#include <cstdio>
#include <cstdint>
#include <cmath>

#define LAS __attribute__((address_space(3)))
typedef unsigned short bf16_t;
typedef short bf16x8 __attribute__((ext_vector_type(8)));
typedef float f32x4 __attribute__((ext_vector_type(4)));
typedef float f32x2 __attribute__((ext_vector_type(2)));
typedef unsigned u32x4 __attribute__((ext_vector_type(4)));
typedef unsigned u32x2 __attribute__((ext_vector_type(2)));

constexpr int DM = 1024, NB = 16, SEQ = 2048, NL = 4, CTXL = 256;
constexpr int NLAT = NB * SEQ;
constexpr int NCTX = NB * CTXL;
constexpr int NTOK = NLAT + NCTX;
constexpr int PW = 7296;
constexpr int PWP = 7424;
constexpr int C_Q = 0, C_K = 512, C_V = 640, C_RW = 768, C_R = 768, C_RK = 1280, C_RV = 1792, C_WLO = 2304, C_ALO = 2432, C_GLO = 2560;
constexpr int C_BG = 2688, C_CG = 3200, C_U = 3712, C_GT = 4224;
constexpr int C_OATT = 0, C_OCONV = 2688, C_ORWKV = 3200;
constexpr int WAGW = 2560;
constexpr int LRAW = 384;
constexpr int NEXP = 16, EFF = 1024, CAPL = 256, CAPC = 32, PAIRS_E = 4608;
constexpr float NORM_EPS = 1e-6f, GN_EPS = 64e-5f;
constexpr float QSCALE = 0.125f * 1.4426950408889634f;

constexpr size_t MiB = 1u << 20;
constexpr size_t WS_CTL = 0, CTL_ZERO_BYTES = 1 * MiB;
constexpr size_t WS_MOD = 1 * MiB;
constexpr size_t WS_ROPE = 3 * MiB;
constexpr size_t WS_LIST = 4 * MiB;
constexpr size_t WS_SLOT = 5 * MiB;
constexpr size_t WS_AFF = 8 * MiB;
constexpr size_t WS_XC = 11 * MiB;
constexpr size_t WS_WIN = 27 * MiB;
constexpr size_t WS_WBR = 85 * MiB;
constexpr size_t WS_WOUT = 97 * MiB;
constexpr size_t WS_WLR = 105 * MiB;
constexpr size_t WS_WUP = 113 * MiB;
constexpr size_t WS_WDN = 177 * MiB;
constexpr size_t WS_H = 209 * MiB;
constexpr size_t WS_PROJ = 281 * MiB;
constexpr size_t WS_HID = WS_PROJ;
constexpr size_t WS_YE = WS_PROJ + 144 * MiB;
constexpr size_t WS_WAG = 794 * MiB;
constexpr size_t WS_LRA = 974 * MiB;
constexpr size_t WS_YF = 1001 * MiB;
constexpr size_t WS_YB = 1037 * MiB;
constexpr size_t WS_END = 1073 * MiB;
static_assert(WS_WIN + (size_t)NL * PWP * DM * 2 <= WS_WBR && WS_PROJ + (size_t)NTOK * PW * 2 <= WS_WAG && WS_WAG + (size_t)NTOK * WAGW * 2 <= WS_LRA && WS_LRA + (size_t)NTOK * LRAW * 2 <= WS_YF, "ws map");
static_assert(WS_YE + (size_t)NEXP * PAIRS_E * DM * 2 <= WS_WAG && WS_H + (size_t)NTOK * DM * 2 <= WS_PROJ, "ws map 2");
constexpr int CW_BAR = 4096;
constexpr int CW_DBG = 32768;

constexpr int RING_BYTES = 131072;
constexpr int XTRA_OFF = RING_BYTES;
constexpr int XTRA_BYTES = 12288;
constexpr int MISC_OFF = XTRA_OFF + XTRA_BYTES;
constexpr int LDS_BYTES = 147456;
static_assert(MISC_OFF + 256 <= LDS_BYTES, "lds map");
constexpr int NWAVES = 8, NTHR = 512;

__device__ __forceinline__ unsigned f2bf(float f) { unsigned u = __builtin_bit_cast(unsigned, f); return (u + 0x7fffu + ((u >> 16) & 1u)) >> 16; }
__device__ __forceinline__ unsigned pk2(float lo, float hi) { return f2bf(lo) | (f2bf(hi) << 16); }
__device__ __forceinline__ float bflo(unsigned w) { return __builtin_bit_cast(float, w << 16); }
__device__ __forceinline__ float bfhi(unsigned w) { return __builtin_bit_cast(float, w & 0xffff0000u); }
__device__ __forceinline__ void unpack8(const u32x4 w, float (&f)[8]) { f[0] = bflo(w.x); f[1] = bfhi(w.x); f[2] = bflo(w.y); f[3] = bfhi(w.y); f[4] = bflo(w.z); f[5] = bfhi(w.z); f[6] = bflo(w.w); f[7] = bfhi(w.w); }
__device__ __forceinline__ u32x4 pack8(const float (&f)[8]) { u32x4 w; w.x = pk2(f[0], f[1]); w.y = pk2(f[2], f[3]); w.z = pk2(f[4], f[5]); w.w = pk2(f[6], f[7]); return w; }
__device__ __forceinline__ void ld8(const bf16_t* p, float (&f)[8]) { unpack8(*(const u32x4*)p, f); }
__device__ __forceinline__ void st8(bf16_t* p, const float (&f)[8]) { *(u32x4*)p = pack8(f); }
__device__ __forceinline__ float sigmoidf_(float x) { return 1.0f / (1.0f + __expf(-x)); }
__device__ __forceinline__ float wave_sum(float v) {
#pragma unroll
    for (int o = 1; o < 64; o <<= 1) v += __shfl_xor(v, o);
    return v;
}
__device__ __forceinline__ float dpp_f(float x, const int ctrl_sel) {
    const int xi = __builtin_bit_cast(int, x); int r;
    if (ctrl_sel == 0) r = __builtin_amdgcn_update_dpp(xi, xi, 0xB1, 0xF, 0xF, false);
    else if (ctrl_sel == 1) r = __builtin_amdgcn_update_dpp(xi, xi, 0x4E, 0xF, 0xF, false);
    else r = __builtin_amdgcn_update_dpp(xi, xi, 0x141, 0xF, 0xF, false);
    return __builtin_bit_cast(float, r);
}
__device__ __forceinline__ float sum8(float x) { x += dpp_f(x, 0); x += dpp_f(x, 1); x += dpp_f(x, 2); return x; }
namespace pg8 {
constexpr int BM = 256, BK = 64, HALF = 128, HTB = HALF * BK * 2, STAGE_BYTES = 8 * HTB;
__host__ __device__ __forceinline__ int lds_byte(int r, int c) { const int st = (r >> 4) * 2 + (c >> 5), rr = r & 15, cc = c & 31, ob = rr * 64 + cc * 2; return st * 1024 + (ob ^ (((ob >> 9) & 1) << 5)); }
__host__ __device__ __forceinline__ void stage_rc(int b, int& R, int& C) { const int st = b / 1024, sb = b % 1024, swz = sb ^ (((sb >> 9) & 1) << 5); R = (st >> 1) * 16 + swz / 64; C = (st & 1) * 32 + (swz % 64) / 2; }
__host__ __device__ __forceinline__ int perm32(int rho) { const int n = rho >> 4, i = rho & 15; return 8 * (i >> 2) + 4 * n + (i & 3); }
__device__ __forceinline__ unsigned cvt_pk_bf16(float lo, float hi) { unsigned r; asm volatile("v_cvt_pk_bf16_f32 %0, %1, %2" : "=v"(r) : "v"(lo), "v"(hi)); return r; }

struct GUnit { const char* A; const char* B; int pm, pn, x0, x1; };

template <class Epi, class Sched, bool GATHER>
__device__ __forceinline__ void gemm_phase(LAS unsigned char* lds, const int K, const int lda, const int ldb, const Sched& S, const Epi& E) {
    int tid_ = threadIdx.x; asm volatile("" : "+v"(tid_));
    const int tid = tid_, wid = __builtin_amdgcn_readfirstlane(tid >> 6), lane = tid & 63, wr = wid >> 2, wc = wid & 3, fr = lane & 15, fq = lane >> 4;
    const int nt = K / BK;
    int sR[2], sC[2];
    unsigned voffA[2][2], voffB[2], voffAn[2][2];
#pragma unroll
    for (int i = 0; i < 2; ++i) { int R, C; stage_rc(tid * 16 + i * 8192, R, C); sR[i] = R; sC[i] = C; const int Rb = Epi::PERM ? ((R & ~31) + perm32(R & 31)) : R;
        voffB[i] = (unsigned)(Rb * ldb + C) * 2u;
#pragma unroll
        for (int h = 0; h < 2; ++h) { voffA[h][i] = (unsigned)((h * HALF + R) * lda + C) * 2u; voffAn[h][i] = voffA[h][i]; } }
    const size_t kstep = (size_t)(BK * 2);
    const size_t hstepB = (size_t)HALF * ldb * 2;
    const unsigned ldsw = (unsigned)wid * 1024u;
    const int aoff = lds_byte(wr * 64 + fr, fq * 8), boff = lds_byte(wc * 32 + fr, fq * 8);
#define PG8_SA(b, h) (((b) * 2 + (h)) * HTB)
#define PG8_SB(b, h) ((4 + (b) * 2 + (h)) * HTB)
#define PG8_STAGE(bufoff, gbase, voff) do { _Pragma("unroll") for (int _i = 0; _i < 2; ++_i) \
        __builtin_amdgcn_global_load_lds((const unsigned*)((const char*)(gbase) + (voff)[_i]), (LAS unsigned*)(lds + (bufoff) + ldsw + _i * 8192), 16, 0, 0); } while (0)
#define PG8_LDA(dst, b, h) do { _Pragma("unroll") for (int m = 0; m < 4; ++m) _Pragma("unroll") for (int k = 0; k < 2; ++k) dst[m][k] = *(const LAS bf16x8*)(lds + PG8_SA(b, h) + aoff + m * 2048 + k * 1024); } while (0)
#define PG8_LDB(dst, b, h) do { _Pragma("unroll") for (int n = 0; n < 2; ++n) _Pragma("unroll") for (int k = 0; k < 2; ++k) dst[n][k] = *(const LAS bf16x8*)(lds + PG8_SB(b, h) + boff + n * 2048 + k * 1024); } while (0)
#define PG8_MMA(ai, bj, At, Bt) do { __builtin_amdgcn_s_setprio(1); _Pragma("unroll") for (int m = 0; m < 4; ++m) _Pragma("unroll") for (int n = 0; n < 2; ++n) _Pragma("unroll") for (int k = 0; k < 2; ++k) \
        acc[ai][bj][m][n] = __builtin_amdgcn_mfma_f32_16x16x32_bf16(Bt[n][k], At[m][k], acc[ai][bj][m][n], 0, 0, 0); __builtin_amdgcn_s_setprio(0); } while (0)
#define PG8_WAIT_V(n) asm volatile("s_waitcnt vmcnt(" #n ")" ::: "memory")
#define PG8_WAIT_L(n) asm volatile("s_waitcnt lgkmcnt(" #n ")" ::: "memory")
#define PG8_BAR __builtin_amdgcn_s_barrier()
#define PG8_SCHED __builtin_amdgcn_sched_barrier(0)
    GUnit cur, nxt; int ui = 0;
    if (!S.next(0, cur)) return;
    if constexpr (GATHER) {
#pragma unroll
        for (int i = 0; i < 2; ++i)
#pragma unroll
            for (int h = 0; h < 2; ++h) voffA[h][i] = (S.arow(0, h * HALF + sR[i]) * (unsigned)lda + (unsigned)sC[i]) * 2u;
    }
    f32x4 acc[2][2][4][2];
#pragma unroll
    for (int a = 0; a < 2; ++a)
#pragma unroll
        for (int b = 0; b < 2; ++b)
#pragma unroll
            for (int m = 0; m < 4; ++m)
#pragma unroll
                for (int n = 0; n < 2; ++n) acc[a][b][m][n] = (f32x4){0.f, 0.f, 0.f, 0.f};
    bf16x8 At[4][2], B0[2][2], B1[2][2];
    const char* cA = cur.A; const char* cB = cur.B;
    PG8_STAGE(PG8_SB(0, 0), cB, voffB); PG8_STAGE(PG8_SB(0, 1), cB + hstepB, voffB); PG8_STAGE(PG8_SA(0, 0), cA, voffA[0]); PG8_STAGE(PG8_SA(0, 1), cA, voffA[1]);
    if (wr == 1) PG8_BAR;
    PG8_WAIT_V(2); PG8_BAR;
    PG8_STAGE(PG8_SB(1, 0), cB + kstep, voffB); PG8_STAGE(PG8_SA(1, 0), cA + kstep, voffA[0]); PG8_STAGE(PG8_SB(1, 1), cB + hstepB + kstep, voffB);
    PG8_WAIT_V(6); PG8_BAR;
    for (;;) {
        const bool has_next = S.next(ui + 1, nxt);
        const char* nA = has_next ? nxt.A : cA; const char* nB = has_next ? nxt.B : cB;
        if constexpr (GATHER) {
#pragma unroll
            for (int i = 0; i < 2; ++i)
#pragma unroll
                for (int h = 0; h < 2; ++h) voffAn[h][i] = has_next ? (S.arow(ui + 1, h * HALF + sR[i]) * (unsigned)lda + (unsigned)sC[i]) * 2u : voffA[h][i];
        }
#pragma unroll 1
        for (int t = 0; t < nt; t += 2) {
            const bool last = (t == nt - 2);
            const char* a1 = cA + (size_t)(t + 1) * kstep;
            const char* a2 = last ? nA : cA + (size_t)(t + 2) * kstep; const char* b2 = last ? nB : cB + (size_t)(t + 2) * kstep;
            const char* a3 = a2 + kstep; const char* b3 = b2 + kstep;
            unsigned v2[2][2];
#pragma unroll
            for (int i = 0; i < 2; ++i)
#pragma unroll
                for (int h = 0; h < 2; ++h) v2[h][i] = GATHER ? (last ? voffAn[h][i] : voffA[h][i]) : voffA[h][i];
            PG8_LDB(B0, 0, 0); PG8_LDB(B1, 0, 1); PG8_SCHED; PG8_LDA(At, 0, 0); PG8_STAGE(PG8_SA(1, 1), a1, voffA[1]);
            PG8_WAIT_V(8); PG8_WAIT_L(0); PG8_BAR; PG8_MMA(0, 0, At, B0); PG8_MMA(0, 1, At, B1); PG8_BAR; PG8_SCHED;
            PG8_LDA(At, 0, 1); PG8_STAGE(PG8_SB(0, 0), b2, voffB); PG8_STAGE(PG8_SB(0, 1), b2 + hstepB, voffB); PG8_STAGE(PG8_SA(0, 0), a2, v2[0]);
            PG8_WAIT_V(8); PG8_WAIT_L(0); PG8_BAR; PG8_MMA(1, 0, At, B0); PG8_MMA(1, 1, At, B1); PG8_BAR; PG8_SCHED;
            PG8_LDB(B0, 1, 0); PG8_LDB(B1, 1, 1); PG8_SCHED; PG8_LDA(At, 1, 0); PG8_STAGE(PG8_SA(0, 1), a2, v2[1]);
            PG8_WAIT_V(8); PG8_WAIT_L(0); PG8_BAR; PG8_MMA(0, 0, At, B0); PG8_MMA(0, 1, At, B1); PG8_BAR; PG8_SCHED;
            PG8_LDA(At, 1, 1); PG8_STAGE(PG8_SB(1, 0), b3, voffB); PG8_STAGE(PG8_SB(1, 1), b3 + hstepB, voffB); PG8_STAGE(PG8_SA(1, 0), a3, v2[0]);
            PG8_WAIT_V(8); PG8_WAIT_L(0); PG8_BAR; PG8_MMA(1, 0, At, B0); PG8_MMA(1, 1, At, B1); PG8_BAR; PG8_SCHED;
        }
        if (wr == 0) PG8_BAR;
        E(acc, cur, wr, wc, fr, fq);
        if (!has_next) break;
#pragma unroll
        for (int a = 0; a < 2; ++a)
#pragma unroll
            for (int b = 0; b < 2; ++b)
#pragma unroll
                for (int m = 0; m < 4; ++m)
#pragma unroll
                    for (int n = 0; n < 2; ++n) acc[a][b][m][n] = (f32x4){0.f, 0.f, 0.f, 0.f};
        cur = nxt; cA = nA; cB = nB; ++ui;
        if constexpr (GATHER) {
#pragma unroll
            for (int i = 0; i < 2; ++i)
#pragma unroll
                for (int h = 0; h < 2; ++h) voffA[h][i] = voffAn[h][i];
        }
        if (wr == 1) PG8_BAR;
    }
    PG8_WAIT_V(0);
    PG8_BAR;
#undef PG8_SA
#undef PG8_SB
#undef PG8_STAGE
#undef PG8_LDA
#undef PG8_LDB
#undef PG8_MMA
#undef PG8_WAIT_V
#undef PG8_WAIT_L
#undef PG8_BAR
#undef PG8_SCHED
}
}
namespace pg8 {
struct EpiProj {
    static constexpr bool PERM = true;
    bf16_t* P;
    __device__ __forceinline__ void operator()(const f32x4 (&acc)[2][2][4][2], const GUnit& u, int wr, int wc, int fr, int fq) const {
        const int row0 = u.pm * BM + wr * 64 + fr;
#pragma unroll
        for (int bj = 0; bj < 2; ++bj) {
            const int ct = u.pn * BM + bj * HALF;
            if (ct >= PW) continue;
            const bool sig = ct >= C_GT;
            const int col0 = ct + wc * 32 + 8 * fq;
#pragma unroll
            for (int ai = 0; ai < 2; ++ai)
#pragma unroll
                for (int m = 0; m < 4; ++m) {
                    f32x4 v0 = acc[ai][bj][m][0], v1 = acc[ai][bj][m][1];
                    if (sig) {
#pragma unroll
                        for (int j = 0; j < 4; ++j) { v0[j] = sigmoidf_(v0[j]); v1[j] = sigmoidf_(v1[j]); }
                    }
                    u32x4 w; w.x = cvt_pk_bf16(v0[0], v0[1]); w.y = cvt_pk_bf16(v0[2], v0[3]); w.z = cvt_pk_bf16(v1[0], v1[1]); w.w = cvt_pk_bf16(v1[2], v1[3]);
                    *(u32x4*)(P + (size_t)(row0 + ai * HALF + m * 16) * PW + col0) = w;
                }
        }
    }
};
struct EpiLowRank {
    static constexpr bool PERM = true;
    bf16_t* W; const float* w0; const float* a0;
    __device__ __forceinline__ void operator()(const f32x4 (&acc)[2][2][4][2], const GUnit& u, int wr, int wc, int fr, int fq) const {
        const int row0 = u.pm * BM + wr * 64 + fr;
#pragma unroll
        for (int bj = 0; bj < 2; ++bj) {
            const int ct = u.pn * BM + bj * HALF;
            const int col0 = ct + wc * 32 + 8 * fq;
            const int mode = ct < 1024 ? 0 : (ct < 2048 ? 1 : 2);
            float bias[8];
#pragma unroll
            for (int j = 0; j < 8; ++j) bias[j] = mode == 0 ? w0[col0 + j] : (mode == 1 ? a0[col0 - 1024 + j] : 0.f);
#pragma unroll
            for (int ai = 0; ai < 2; ++ai)
#pragma unroll
                for (int m = 0; m < 4; ++m) {
                    float v[8];
#pragma unroll
                    for (int j = 0; j < 4; ++j) { v[j] = acc[ai][bj][m][0][j] + bias[j]; v[4 + j] = acc[ai][bj][m][1][j] + bias[4 + j]; }
                    if (mode == 0) {
#pragma unroll
                        for (int j = 0; j < 8; ++j) v[j] = 0.60653066f * sigmoidf_(v[j]);
                    } else if (mode == 1) {
#pragma unroll
                        for (int j = 0; j < 8; ++j) v[j] = sigmoidf_(v[j]);
                    }
                    u32x4 w; w.x = cvt_pk_bf16(v[0], v[1]); w.y = cvt_pk_bf16(v[2], v[3]); w.z = cvt_pk_bf16(v[4], v[5]); w.w = cvt_pk_bf16(v[6], v[7]);
                    *(u32x4*)(W + (size_t)(row0 + ai * HALF + m * 16) * WAGW + col0) = w;
                    asm volatile("" ::: "memory");
                }
        }
    }
};
struct EpiMerge {
    static constexpr bool PERM = true;
    const bf16_t* P; bf16_t* M;
    __device__ __forceinline__ void operator()(const f32x4 (&acc)[2][2][4][2], const GUnit& u, int wr, int wc, int fr, int fq) const {
        const int row0 = u.pm * BM + wr * 64 + fr; const int br = u.x0;
#pragma unroll
        for (int bj = 0; bj < 2; ++bj) {
            const int col0 = u.pn * BM + bj * HALF + wc * 32 + 8 * fq;
#pragma unroll
            for (int ai = 0; ai < 2; ++ai)
#pragma unroll
                for (int m = 0; m < 4; ++m) {
                    const size_t row = (size_t)(row0 + ai * HALF + m * 16);
                    float g[8], o[8];
                    ld8(P + row * PW + C_GT + br * 1024 + col0, g);
                    if (br > 0) ld8(M + row * DM + col0, o);
                    else {
#pragma unroll
                        for (int j = 0; j < 8; ++j) o[j] = 0.f;
                    }
#pragma unroll
                    for (int j = 0; j < 4; ++j) { o[j] += g[j] * acc[ai][bj][m][0][j]; o[4 + j] += g[4 + j] * acc[ai][bj][m][1][j]; }
                    st8(M + row * DM + col0, o);
                }
        }
    }
};
struct EpiOut {
    static constexpr bool PERM = false;
    float* XR; float* XC; const float* mod;
    __device__ __forceinline__ void operator()(const f32x4 (&acc)[2][2][4][2], const GUnit& u, int wr, int wc, int fr, int fq) const {
        const int rt = u.pm * BM; const bool lat = rt < NLAT;
        const int modrow = lat ? (rt >> 11) : 16;
        float* X = lat ? XR + (size_t)rt * DM : XC + (size_t)(rt - NLAT) * DM;
        const float* g1 = mod + (size_t)modrow * 6144 + 2048;
        const int r0 = wr * 64 + fr;
#pragma unroll
        for (int bj = 0; bj < 2; ++bj)
#pragma unroll
            for (int n = 0; n < 2; ++n) {
                const int col = u.pn * BM + bj * HALF + wc * 32 + 16 * n + 4 * fq;
                const f32x4 gv = *(const f32x4*)(g1 + col);
#pragma unroll
                for (int ai = 0; ai < 2; ++ai)
#pragma unroll
                    for (int m = 0; m < 4; ++m) {
                        float* xp = X + (size_t)(r0 + ai * HALF + m * 16) * DM + col;
                        f32x4 xv = *(const f32x4*)xp;
                        xv += gv * acc[ai][bj][m][n];
                        *(f32x4*)xp = xv;
                    }
            }
    }
};
struct EpiUp {
    static constexpr bool PERM = true;
    bf16_t* HID;
    __device__ __forceinline__ void operator()(const f32x4 (&acc)[2][2][4][2], const GUnit& u, int wr, int wc, int fr, int fq) const {
        const int row0 = u.x0 * PAIRS_E + u.pm * BM + wr * 64 + fr;
        const int col0 = u.pn * HALF + wc * 32 + 8 * fq;
#pragma unroll
        for (int ai = 0; ai < 2; ++ai)
#pragma unroll
            for (int m = 0; m < 4; ++m) {
                float v[8];
#pragma unroll
                for (int j = 0; j < 4; ++j) {
                    const float g0 = acc[ai][0][m][0][j], g1 = acc[ai][0][m][1][j];
                    v[j] = g0 * sigmoidf_(g0) * acc[ai][1][m][0][j]; v[4 + j] = g1 * sigmoidf_(g1) * acc[ai][1][m][1][j];
                }
                u32x4 w; w.x = cvt_pk_bf16(v[0], v[1]); w.y = cvt_pk_bf16(v[2], v[3]); w.z = cvt_pk_bf16(v[4], v[5]); w.w = cvt_pk_bf16(v[6], v[7]);
                *(u32x4*)(HID + (size_t)(row0 + ai * HALF + m * 16) * EFF + col0) = w;
            }
    }
};
struct EpiDown {
    static constexpr bool PERM = true;
    bf16_t* YE;
    __device__ __forceinline__ void operator()(const f32x4 (&acc)[2][2][4][2], const GUnit& u, int wr, int wc, int fr, int fq) const {
        const int row0 = u.x0 * PAIRS_E + u.pm * BM + wr * 64 + fr;
#pragma unroll
        for (int bj = 0; bj < 2; ++bj) {
            const int col0 = u.pn * BM + bj * HALF + wc * 32 + 8 * fq;
#pragma unroll
            for (int ai = 0; ai < 2; ++ai)
#pragma unroll
                for (int m = 0; m < 4; ++m) {
                    const f32x4 v0 = acc[ai][bj][m][0], v1 = acc[ai][bj][m][1];
                    u32x4 w; w.x = cvt_pk_bf16(v0[0], v0[1]); w.y = cvt_pk_bf16(v0[2], v0[3]); w.z = cvt_pk_bf16(v1[0], v1[1]); w.w = cvt_pk_bf16(v1[2], v1[3]);
                    *(u32x4*)(YE + (size_t)(row0 + ai * HALF + m * 16) * DM + col0) = w;
                }
        }
    }
};

struct PlainOrder {
    const char* A; const char* B; int nM, nN, nwg, G, c; size_t astep, bstep;
    __device__ __forceinline__ void init(const void* A_, const void* B_, int M, int N, int lda, int ldb, int G_, int c_) { A = (const char*)A_; B = (const char*)B_; nM = M / BM; nN = N / BM; nwg = nM * nN; G = G_; c = c_; astep = (size_t)BM * lda * 2; bstep = (size_t)BM * ldb * 2; }
    __device__ __forceinline__ bool next(int i, GUnit& u) const {
        const long L = (long)i * G + c; if (L >= nwg) return false;
        int wgid = (int)L; { const int q = nwg / 8, r = nwg % 8, xcd = wgid % 8, off = wgid / 8; wgid = (xcd < r ? xcd * (q + 1) : r * (q + 1) + (xcd - r) * q) + off; }
        const int nig = 8 * nN, gid = wgid / nig, fm = gid * 8, gsz = (nM - fm) < 8 ? (nM - fm) : 8;
        u.pm = fm + ((wgid % nig) % gsz); u.pn = (wgid % nig) / gsz; u.x0 = 0; u.x1 = 0;
        u.A = A + (size_t)u.pm * astep; u.B = B + (size_t)u.pn * bstep; return true;
    }
    __device__ __forceinline__ unsigned arow(int, int) const { return 0u; }
};
struct MergeOrder {
    const char* P; const char* W; int nM, G, c;
    __device__ __forceinline__ bool next(int i, GUnit& u) const {
        const long tl = (long)(i / 3) * G + c; if (tl >= (long)nM * 4) return false;
        const int tile = (int)tl, br = i % 3;
        u.pm = tile >> 2; u.pn = tile & 3; u.x0 = br; u.x1 = 0;
        const int acol = br == 0 ? C_OATT : (br == 1 ? C_ORWKV : C_OCONV);
        u.A = P + ((size_t)u.pm * BM * PW + acol) * 2; u.B = W + ((size_t)br * 1024 * 512 + (size_t)u.pn * BM * 512) * 2; return true;
    }
    __device__ __forceinline__ unsigned arow(int, int) const { return 0u; }
};
struct MoeOrder {
    const char* A; const char* W; const LAS int* rows; int mt_per, npn, G, c; size_t wexp;
    __device__ __forceinline__ bool decode(long L, int& e, int& mt, int& pn) const {
        const int per_e = mt_per * npn; if (L >= (long)NEXP * per_e) return false;
        e = (int)(L / per_e); const int r = (int)(L % per_e); pn = r / mt_per; mt = r % mt_per; return true;
    }
    __device__ __forceinline__ bool next(int i, GUnit& u) const {
        int e, mt, pn; if (!decode((long)i * G + c, e, mt, pn)) return false;
        u.pm = mt; u.pn = pn; u.x0 = e; u.x1 = 0;
        u.A = A; u.B = W + (size_t)e * wexp + (size_t)pn * BM * 1024 * 2; return true;
    }
    __device__ __forceinline__ unsigned arow(int i, int r) const { return (unsigned)rows[i * 256 + r]; }
};
struct MoeDownOrder {
    const char* A; const char* W; int mt_per, G, c;
    __device__ __forceinline__ bool next(int i, GUnit& u) const {
        const long L = (long)i * G + c; const int per_e = mt_per * 4; if (L >= (long)NEXP * per_e) return false;
        const int e = (int)(L / per_e), r = (int)(L % per_e); u.pn = r / mt_per; u.pm = r % mt_per; u.x0 = e; u.x1 = 0;
        u.A = A + ((size_t)e * PAIRS_E + (size_t)u.pm * BM) * EFF * 2; u.B = W + ((size_t)e * 1024 + (size_t)u.pn * BM) * 1024 * 2; return true;
    }
    __device__ __forceinline__ unsigned arow(int, int) const { return 0u; }
};
}
namespace attn_body {
using bf16=__hip_bfloat16;
using bf16x8=__attribute__((ext_vector_type(8)))short;
using s16x4=__attribute__((ext_vector_type(4)))short;
using f32x16=__attribute__((ext_vector_type(16)))float;
using u32x4=__attribute__((ext_vector_type(4)))unsigned;
constexpr int D=64,DM=7296;
constexpr int NW=8,QBLK=32,QB=QBLK*NW,KVBLK=64;
constexpr int ATTN_PITCH=DM, ATTN_UNIT_ROWS=QB;
__device__ __forceinline__ int crow(int r,int hi){return (r&3)+8*(r>>2)+4*hi;}
#define SBAR() __builtin_amdgcn_sched_barrier(0)
__device__ __forceinline__ void cmask(f32x16&p0,f32x16&p1,int jb,int qrel,int hi){
  const float NEG=-INFINITY; int kb=64*jb+4*hi;
  #pragma unroll
  for(int r=0;r<16;++r){int kv=kb+(r&3)+8*(r>>2); if(kv>qrel)p0[r]=NEG; if(kv+32>qrel)p1[r]=NEG;}
}

constexpr int NSLOT=3, SLOTB=8192;
constexpr int LDS_K=0, LDS_V=NSLOT*SLOTB, LDS_WS=2*NSLOT*SLOTB, LDS_OST=LDS_WS+NW*64*4, LDS_BYTES=LDS_OST+NW*4096;
constexpr float C2=0.125f*1.4426950408889634f;
__device__ __forceinline__ void glds16(const void*gsrc,unsigned lds_dst){unsigned keep;
  asm volatile("s_mov_b32 %0, m0\n\ts_mov_b32 m0, %2\n\ts_nop 0\n\tglobal_load_lds_dwordx4 %1, off\n\ts_mov_b32 m0, %0":"=&s"(keep):"v"(gsrc),"s"(lds_dst):"memory");}
__device__ __forceinline__ float max3f(float a,float b,float c){float r;asm("v_max3_f32 %0, %1, %2, %3":"=v"(r):"v"(a),"v"(b),"v"(c));return r;}
__device__ __forceinline__ float max2f(float a,float b){float r;asm("v_max_f32_e32 %0, %1, %2":"=v"(r):"v"(a),"v"(b));return r;}
__device__ __forceinline__ float fadd_s(float a,float b){float r;asm("v_add_f32_e32 %0, %1, %2":"=v"(r):"v"(a),"v"(b));return r;}
__device__ __forceinline__ float fsub_s(float a,float b){float r;asm("v_sub_f32_e32 %0, %1, %2":"=v"(r):"v"(a),"v"(b));return r;}
typedef float f32x2_t __attribute__((ext_vector_type(2))); typedef __bf16 bf16x2_t __attribute__((ext_vector_type(2)));
__device__ __forceinline__ unsigned cvtpk_s(float lo,float hi){f32x2_t v={lo,hi};bf16x2_t b=__builtin_convertvector(v,bf16x2_t);return __builtin_bit_cast(unsigned,b);}
#define WAIT_BAR(N) asm volatile("s_waitcnt vmcnt(" #N ") lgkmcnt(0)\n\ts_barrier":::"memory")

__device__ __forceinline__ void qkt(f32x16&p0,f32x16&p1,const char*Kslot,const bf16x8*qr,const f32x16&negm,int r32,int hi){
  const char*kb=Kslot+hi*1024+r32*16;
  #pragma unroll
  for(int d0=0;d0<4;++d0){
    const bf16x8 b0=*reinterpret_cast<const bf16x8*>(kb+d0*2048);
    const bf16x8 b1=*reinterpret_cast<const bf16x8*>(kb+d0*2048+512);
    if(d0==0){p0=__builtin_amdgcn_mfma_f32_32x32x16_bf16(b0,qr[0],negm,0,0,0);p1=__builtin_amdgcn_mfma_f32_32x32x16_bf16(b1,qr[0],negm,0,0,0);}
    else{p0=__builtin_amdgcn_mfma_f32_32x32x16_bf16(b0,qr[d0],p0,0,0,0);p1=__builtin_amdgcn_mfma_f32_32x32x16_bf16(b1,qr[d0],p1,0,0,0);}}
}
typedef __attribute__((address_space(3))) const char* lds_cptr;
typedef short v4i16_t __attribute__((ext_vector_type(4)));
__device__ __forceinline__ void kload8(bf16x8*kf,lds_cptr kp){
  kf[0]=*(const __attribute__((address_space(3))) bf16x8*)(kp);      kf[1]=*(const __attribute__((address_space(3))) bf16x8*)(kp+512);
  kf[2]=*(const __attribute__((address_space(3))) bf16x8*)(kp+2048); kf[3]=*(const __attribute__((address_space(3))) bf16x8*)(kp+2560);
  kf[4]=*(const __attribute__((address_space(3))) bf16x8*)(kp+4096); kf[5]=*(const __attribute__((address_space(3))) bf16x8*)(kp+4608);
  kf[6]=*(const __attribute__((address_space(3))) bf16x8*)(kp+6144); kf[7]=*(const __attribute__((address_space(3))) bf16x8*)(kp+6656);
}
__device__ __forceinline__ void kload2(bf16x8*kf,lds_cptr kp,int j){ kf[2*j]=*(const __attribute__((address_space(3))) bf16x8*)(kp+j*2048); kf[2*j+1]=*(const __attribute__((address_space(3))) bf16x8*)(kp+j*2048+512); }
__device__ __forceinline__ s16x4 vtr(lds_cptr p){ return __builtin_bit_cast(s16x4,__builtin_amdgcn_ds_read_tr16_b64_v4i16((__attribute__((address_space(3))) v4i16_t*)p)); }
__device__ __forceinline__ float rowmax(const f32x16&p0,const f32x16&p1){
  float a=max3f(p0[0],p0[1],p1[0]),b=max3f(p0[2],p0[3],p1[1]);a=max3f(a,p1[2],p1[3]);
  #pragma unroll
  for(int r=4;r<16;r+=4){a=max3f(a,p0[r],p0[r+1]);b=max3f(b,p0[r+2],p0[r+3]);a=max3f(a,p1[r],p1[r+1]);b=max3f(b,p1[r+2],p1[r+3]);}
  const float m=max2f(a,b);
  auto rr=__builtin_amdgcn_permlane32_swap(__float_as_uint(m),__float_as_uint(m),false,false);
  return max2f(__uint_as_float(rr[0]),__uint_as_float(rr[1]));
}
__device__ __forceinline__ void pv(f32x16*o,int vb,bf16x8 pa0,bf16x8 pa1,bf16x8 pa2,bf16x8 pa3){
  #pragma unroll
  for(int d0=0;d0<2;++d0){s16x4 lo[4],hi[4];
    #pragma unroll
    for(int ks=0;ks<4;++ks){
      asm volatile("ds_read_b64_tr_b16 %0,%1 offset:%c2":"=&v"(lo[ks]):"v"(vb),"i"(d0*4096+ks*1024):"memory");
      asm volatile("ds_read_b64_tr_b16 %0,%1 offset:%c2":"=&v"(hi[ks]):"v"(vb),"i"(d0*4096+ks*1024+512):"memory");}
    asm volatile("s_waitcnt lgkmcnt(0)":::"memory");SBAR();
    #define PK(k) (bf16x8){lo[k][0],lo[k][1],lo[k][2],lo[k][3],hi[k][0],hi[k][1],hi[k][2],hi[k][3]}
    o[d0]=__builtin_amdgcn_mfma_f32_32x32x16_bf16(pa0,PK(0),o[d0],0,0,0);
    o[d0]=__builtin_amdgcn_mfma_f32_32x32x16_bf16(pa1,PK(1),o[d0],0,0,0);
    o[d0]=__builtin_amdgcn_mfma_f32_32x32x16_bf16(pa2,PK(2),o[d0],0,0,0);
    o[d0]=__builtin_amdgcn_mfma_f32_32x32x16_bf16(pa3,PK(3),o[d0],0,0,0);
    #undef PK
  }
}

#ifndef ATTN_STORE16
#define ATTN_STORE16(p,v) (*(u32x4*)(p)=(v))
#endif
template<int THRL> __device__ __forceinline__ void attn_unit(const bf16*Qu,bf16*Ou,const bf16*KV0,const int crow0,const int lrow0,const int NT,const int nct,char*shm){
  constexpr int VOFF=128;
  int tid_=threadIdx.x; asm volatile("":"+v"(tid_)); const int tid=tid_,lane=tid&63,r32=lane&31,hi=lane>>5; const int wid=__builtin_amdgcn_readfirstlane(tid>>6);
  const bf16*Qw=Qu+(long)(wid*QBLK)*DM;
  const unsigned lds0=(unsigned)(uintptr_t)shm;
  float*wsf=(float*)(shm+LDS_WS)+wid*64;
  const long klane=(long)lane*DM+wid*8;
  const long vlane=(long)(16*(wid&3)+(lane>>2))*DM+(wid>>2)*32+(lane&3)*8;
  const unsigned kdst=lds0+LDS_K+wid*1024, vdst=lds0+LDS_V+wid*1024;
  #define KTILE(t) (KV0+(long)(((t)<nct)?(crow0+(t)*KVBLK):(lrow0+((t)-nct)*KVBLK))*DM)
  #define VTILE(t) (KTILE(t)+VOFF)
  #define DMA_K(t,slot) glds16(KTILE(t)+klane,(unsigned)__builtin_amdgcn_readfirstlane(kdst+(slot)))
  #define DMA_V(t,slot) glds16(VTILE(t)+vlane,(unsigned)__builtin_amdgcn_readfirstlane(vdst+(slot)))
  const int vb0=(int)(lds0+LDS_V)+((lane>>4)&1)*32+(lane&3)*8+(4*hi+((lane&15)>>2))*64;
  const char*Kbase=shm+LDS_K; bf16x8 kf[8];
  const lds_cptr shm3=(lds_cptr)shm; const lds_cptr kp0=shm3+LDS_K+hi*1024+r32*16; const lds_cptr vp0=shm3+LDS_V+((lane>>4)&1)*32+(lane&3)*8+(4*hi+((lane&15)>>2))*64;
  DMA_K(0,0);DMA_V(0,0);DMA_K(1,SLOTB);
  bf16x8 qr[4];
  #pragma unroll
  for(int d0=0;d0<4;++d0)qr[d0]=*reinterpret_cast<const bf16x8*>(&Qw[(long)r32*DM+d0*16+hi*8]);
  float mhat=0.f,l_reg=0.f;f32x16 o[2];o[0]=f32x16{};o[1]=f32x16{};f32x16 negm=f32x16{};asm volatile("":"+v"(negm));
  #define CMASK(P0,P1,t) do{}while(0)
  bool resc=false;
  #define START(P0,P1) do{ const float rm=rowmax(P0,P1); resc=false; \
    { const float dl=rm; mhat=fadd_s(mhat,dl); \
      _Pragma("unroll") for(int r=0;r<16;++r){P0[r]=fsub_s(P0[r],dl);P1[r]=fsub_s(P1[r],dl);} \
      _Pragma("unroll") for(int r=0;r<16;++r)negm[r]=-mhat; asm volatile("":"+v"(negm)); } \
    _Pragma("unroll") for(int r=0;r<16;++r)P0[r]=__builtin_amdgcn_exp2f(P0[r]); }while(0)
  #define RESC() do{ if(resc){ asm volatile("s_waitcnt lgkmcnt(0)":::"memory"); \
      _Pragma("unroll") for(int d_=0;d_<2;++d_) _Pragma("unroll") for(int r=0;r<16;++r)o[d_][r]*=wsf[crow(r,hi)]; } }while(0)
  f32x16 pA0,pA1,pB0,pB1;
  int sl_prev=0,sl_cur=0,sl_next=SLOTB;
  #define ROT() do{sl_prev=sl_cur;sl_cur=sl_next;sl_next=(sl_next==(NSLOT-1)*SLOTB)?0:sl_next+SLOTB;}while(0)
  DMA_K(2,2*SLOTB);
  WAIT_BAR(3);
  qkt(pA0,pA1,Kbase,qr,negm,r32,hi);asm volatile("s_nop 15\n\ts_nop 7":"+v"(pA0),"+v"(pA1));CMASK(pA0,pA1,0);
  START(pA0,pA1);
  _Pragma("unroll") for(int r=0;r<16;++r)pA1[r]=__builtin_amdgcn_exp2f(pA1[r]);
  WAIT_BAR(0);
  DMA_K(3,0);DMA_V(1,SLOTB);
  ROT();
  kload8(kf,kp0+sl_cur);
  WAIT_BAR(2);
  s16x4 vlo[8],vhi[8]; u32x4 pw0,pw1,pw2,pw3;
  #define PKW(P,B) cvtpk_s(P[B],P[B+1])
  #define PAF(k) __builtin_bit_cast(bf16x8,pw##k)
  #define VFR(i) (bf16x8){vlo[i][0],vlo[i][1],vlo[i][2],vlo[i][3],vhi[i][0],vhi[i][1],vhi[i][2],vhi[i][3]}
  #define PIN(x) asm volatile("":"+v"(x))
  #define MX3(a,b,c) __builtin_fmaxf(__builtin_fmaxf((a),(b)),(c))
  #define GAPA(MF,A0,A1,A2,A3,W0,W1,PW) do{ MF; sacc+=A0; sacc+=A1; sacc+=A2; sacc+=A3; PIN(sacc); W0; W1; PIN(PW); SBAR(); }while(0)
  #define EX(v) __builtin_amdgcn_exp2f(v)
  #define GAPB(MF,X,B) do{ MF; X[B]=EX(X[B]); X[B+1]=EX(X[B+1]); X[B+2]=EX(X[B+2]); X[B+3]=EX(X[B+3]); PIN(X); SBAR(); }while(0)
  #define VRD(i) do{ vlo[i]=vtr(vp_+(((i)>>2)*4096+((i)&3)*1024)); vhi[i]=vtr(vp_+(((i)>>2)*4096+((i)&3)*1024+512)); }while(0)
  #define KRD(G,j) do{ if(G){ kload2(kf,kp0+sl_next,j); SBAR(); } }while(0)
  #define STEP(C0,C1,P0,P1,t,GK,GV,GL) do{ SBAR(); \
    const lds_cptr vp_=vp0+sl_prev; \
    VRD(0); SBAR(); float sacc=(P0[0]+P0[1]); \
    GAPA(C0=__builtin_amdgcn_mfma_f32_32x32x16_bf16(kf[0],qr[0],negm,0,0,0), P0[2],P0[3],P0[4],P0[5],     pw0[0]=PKW(P0,0), pw0[1]=PKW(P0,2), pw0); \
    VRD(4); SBAR(); GAPA(C1=__builtin_amdgcn_mfma_f32_32x32x16_bf16(kf[1],qr[0],negm,0,0,0), P0[6],P0[7],P0[8],P0[9],     pw0[2]=PKW(P0,4), pw0[3]=PKW(P0,6), pw0); \
    VRD(1); SBAR(); GAPA(C0=__builtin_amdgcn_mfma_f32_32x32x16_bf16(kf[2],qr[1],C0,0,0,0),   P0[10],P0[11],P0[12],P0[13], pw1[0]=PKW(P0,8), pw1[1]=PKW(P0,10), pw1); \
    VRD(5); SBAR(); GAPA(C1=__builtin_amdgcn_mfma_f32_32x32x16_bf16(kf[3],qr[1],C1,0,0,0),   P0[14],P0[15],P1[0],P1[1],   pw1[2]=PKW(P0,12),pw1[3]=PKW(P0,14), pw1); \
    VRD(2); SBAR(); GAPA(C0=__builtin_amdgcn_mfma_f32_32x32x16_bf16(kf[4],qr[2],C0,0,0,0),   P1[2],P1[3],P1[4],P1[5],     pw2[0]=PKW(P1,0), pw2[1]=PKW(P1,2), pw2); \
    VRD(6); SBAR(); GAPA(C1=__builtin_amdgcn_mfma_f32_32x32x16_bf16(kf[5],qr[2],C1,0,0,0),   P1[6],P1[7],P1[8],P1[9],     pw2[2]=PKW(P1,4), pw2[3]=PKW(P1,6), pw2); \
    VRD(3); SBAR(); GAPA(C0=__builtin_amdgcn_mfma_f32_32x32x16_bf16(kf[6],qr[3],C0,0,0,0),   P1[10],P1[11],P1[12],P1[13], pw3[0]=PKW(P1,8), pw3[1]=PKW(P1,10), pw3); \
    VRD(7); SBAR(); GAPA(C1=__builtin_amdgcn_mfma_f32_32x32x16_bf16(kf[7],qr[3],C1,0,0,0),   P1[14],P1[15],0.f,0.f,       pw3[2]=PKW(P1,12),pw3[3]=PKW(P1,14), pw3); \
    l_reg+=sacc; \
    if(GK){DMA_K((t)+3,sl_cur);} if(GV){DMA_V((t)+1,sl_next);} \
    CMASK(C0,C1,t); \
    { float a=MX3(C0[0],C0[1],C1[0]),b=MX3(C0[2],C0[3],C1[1]); a=MX3(a,C1[2],C1[3]); \
      _Pragma("unroll") for(int r=4;r<16;r+=4){a=MX3(a,C0[r],C0[r+1]);b=MX3(b,C0[r+2],C0[r+3]);a=MX3(a,C1[r],C1[r+1]);b=MX3(b,C1[r+2],C1[r+3]);} \
      float rm=__builtin_fmaxf(a,b); { auto rr=__builtin_amdgcn_permlane32_swap(__float_as_uint(rm),__float_as_uint(rm),false,false); rm=__builtin_fmaxf(__uint_as_float(rr[0]),__uint_as_float(rr[1])); } \
      resc=false; \
      if(__builtin_expect(__any(rm>(float)THRL),0)){ const float dl=__builtin_fmaxf(rm,0.f); mhat+=dl; \
        _Pragma("unroll") for(int r=0;r<16;++r){C0[r]-=dl;C1[r]-=dl;} \
        _Pragma("unroll") for(int r=0;r<16;++r)negm[r]=-mhat; asm volatile("":"+v"(negm)); \
        const float f=__builtin_amdgcn_exp2f(-dl); l_reg*=f; if(hi==0)wsf[r32]=f; resc=true; } } \
    SBAR(); \
    GAPB(o[0]=__builtin_amdgcn_mfma_f32_32x32x16_bf16(PAF(0),VFR(0),o[0],0,0,0), C0,0); \
    GAPB(o[1]=__builtin_amdgcn_mfma_f32_32x32x16_bf16(PAF(0),VFR(4),o[1],0,0,0), C0,4); \
    KRD(GL,0); GAPB(o[0]=__builtin_amdgcn_mfma_f32_32x32x16_bf16(PAF(1),VFR(1),o[0],0,0,0), C0,8); \
    KRD(GL,1); GAPB(o[1]=__builtin_amdgcn_mfma_f32_32x32x16_bf16(PAF(1),VFR(5),o[1],0,0,0), C0,12); \
    KRD(GL,2); GAPB(o[0]=__builtin_amdgcn_mfma_f32_32x32x16_bf16(PAF(2),VFR(2),o[0],0,0,0), C1,0); \
    KRD(GL,3); GAPB(o[1]=__builtin_amdgcn_mfma_f32_32x32x16_bf16(PAF(2),VFR(6),o[1],0,0,0), C1,4); \
    GAPB(o[0]=__builtin_amdgcn_mfma_f32_32x32x16_bf16(PAF(3),VFR(3),o[0],0,0,0), C1,8); \
    GAPB(o[1]=__builtin_amdgcn_mfma_f32_32x32x16_bf16(PAF(3),VFR(7),o[1],0,0,0), C1,12); \
    }while(0)
  int t=1;
  #undef CMASK
  #define CMASK(P0,P1,t) do{}while(0)
  for(;t+5<NT;t+=2){
    STEP(pB0,pB1,pA0,pA1,t,true,true,true);     WAIT_BAR(2); RESC(); ROT();
    STEP(pA0,pA1,pB0,pB1,t+1,true,true,true);   WAIT_BAR(2); RESC(); ROT();
  }
  #undef CMASK
  #define CMASK(P0,P1,t) do{}while(0)
  #define ENDW(tt) do{ if((tt)+3<NT){WAIT_BAR(2);} else if((tt)+2<NT){WAIT_BAR(1);} else {WAIT_BAR(0);} }while(0)
  for(;t+1<NT;t+=2){
    STEP(pB0,pB1,pA0,pA1,t,(t+3<NT),(t+1<NT),(t+1<NT));       ENDW(t);   RESC(); ROT();
    STEP(pA0,pA1,pB0,pB1,t+1,(t+4<NT),(t+2<NT),(t+2<NT));     ENDW(t+1); RESC(); ROT();
  }
  STEP(pB0,pB1,pA0,pA1,NT-1,false,false,false); RESC();
  { float sacc=pB0[0]+pB0[1]; _Pragma("unroll") for(int r=2;r<16;++r)sacc+=pB0[r]; _Pragma("unroll") for(int r=0;r<16;++r)sacc+=pB1[r]; l_reg+=sacc;
    pw0=(u32x4){PKW(pB0,0),PKW(pB0,2),PKW(pB0,4),PKW(pB0,6)};pw1=(u32x4){PKW(pB0,8),PKW(pB0,10),PKW(pB0,12),PKW(pB0,14)};pw2=(u32x4){PKW(pB1,0),PKW(pB1,2),PKW(pB1,4),PKW(pB1,6)};pw3=(u32x4){PKW(pB1,8),PKW(pB1,10),PKW(pB1,12),PKW(pB1,14)};
    SBAR(); pv(o,vb0+sl_cur,PAF(0),PAF(1),PAF(2),PAF(3)); }
  #undef PKW
  #undef PAF
  #undef VFR
  #undef PIN
  #undef MX3
  #undef GAPA
  #undef GAPB
  #undef EX
  #undef VRD
  #undef KRD
  #undef STEP
  #undef ENDW
  {auto rr=__builtin_amdgcn_permlane32_swap(__float_as_uint(l_reg),__float_as_uint(l_reg),false,false);l_reg=__uint_as_float(rr[0])+__uint_as_float(rr[1]);}
  if(hi==0)wsf[32+r32]=l_reg;asm volatile("s_waitcnt lgkmcnt(0)":::"memory");
  float rli[16];
  #pragma unroll
  for(int r=0;r<16;++r)rli[r]=__builtin_amdgcn_rcpf(wsf[32+crow(r,hi)]);
  bf16*Ow=Ou+(long)(wid*QBLK)*DM;
  { bf16*stg=(bf16*)(shm+LDS_OST)+wid*2048;
    #pragma unroll
    for(int r=0;r<16;++r){const int orow=crow(r,hi);
      #pragma unroll
      for(int d0=0;d0<2;++d0)stg[orow*64+d0*32+r32]=__float2bfloat16(o[d0][r]*rli[r]);}
    asm volatile("s_waitcnt lgkmcnt(0)":::"memory");
    #pragma unroll
    for(int i=0;i<4;++i){const int row=i*8+(lane>>3),ch=lane&7; const u32x4 v=*(const u32x4*)(stg+row*64+ch*8); ATTN_STORE16(Ow+(long)row*DM+ch*8,v);} }
  asm volatile("s_waitcnt lgkmcnt(0)\n\ts_barrier":::"memory");
  #undef DMA_K
  #undef KTILE
  #undef VTILE
  #undef DMA_V
  #undef CMASK
  #undef START
  #undef RESC
  #undef ROT
}
constexpr int ATTN_LDS_BYTES=LDS_BYTES;
#undef SBAR
#undef WAIT_BAR
}
#define XB_TMO      128
#define XB_XCNT(j)  (256  + 64 * (j))
#define XB_XSUB(j)  (1280 + 64 * (j))
#define XB_XGEN(j)  (2304 + 64 * (j))
#define XB_TOP      3328
#define XB_TOPGEN   3392
#define XCD_BAR_WORDS 3456
#define XB_SPIN_CAP (1u << 18)
__device__ __forceinline__ unsigned xb_ld(unsigned* p)              { return __hip_atomic_load(p, __ATOMIC_RELAXED, __HIP_MEMORY_SCOPE_AGENT); }
__device__ __forceinline__ unsigned xb_add(unsigned* p, unsigned v) { return __hip_atomic_fetch_add(p, v, __ATOMIC_RELAXED, __HIP_MEMORY_SCOPE_AGENT); }
__device__ __forceinline__ unsigned xb_xcc_id() { return (unsigned)__builtin_amdgcn_s_getreg((3 << 11) | 20) & 0xFu; }
#define XB_SPIN(cond, bar) do { unsigned _sp = 0; while (cond) { __builtin_amdgcn_s_sleep(1); \
    if ((++_sp & 255u) == 0u) { if (xb_ld(&(bar)[XB_TMO])) break; if (_sp > XB_SPIN_CAP) { atomicAdd(&(bar)[XB_TMO], 1u); break; } } } } while (0)
struct XcdBarrier { unsigned* bar; unsigned x; volatile LAS unsigned* st; };
__device__ __forceinline__ XcdBarrier xcd_barrier_post(unsigned* bar, volatile LAS unsigned* st) {
    XcdBarrier b; b.bar = bar; b.x = xb_xcc_id(); b.st = st;
    if (threadIdx.x == 0) (void)xb_add(&bar[XB_XCNT(b.x)], 1u);
    return b;
}
__device__ __forceinline__ void xcd_barrier_complete(unsigned* bar, unsigned x, unsigned& nloc, unsigned& nx) {
    const unsigned G = gridDim.x * gridDim.y * gridDim.z;
    unsigned sum, cnt, mine, sp = 0u;
    for (;;) {
        sum = 0u; cnt = 0u; mine = 0u;
#pragma unroll
        for (unsigned j = 0; j < 16; ++j) { const unsigned c = xb_ld(&bar[XB_XCNT(j)]); sum += c; cnt += (c > 0u) ? 1u : 0u; mine = (j == x) ? c : mine; }
        if (sum == G) break;
        __builtin_amdgcn_s_sleep(1);
        if ((++sp & 255u) == 0u) { if (xb_ld(&bar[XB_TMO])) break; if (sp > XB_SPIN_CAP) { atomicAdd(&bar[XB_TMO], 1u); break; } }
    }
    nloc = mine > 0u ? mine : 1u; nx = cnt > 0u ? cnt : 1u;
}
__device__ __forceinline__ void xcd_barrier(const XcdBarrier& b) {
    asm volatile("s_waitcnt vmcnt(0)" ::: "memory");
    __syncthreads();
    if (threadIdx.x == 0) {
        unsigned long long bar_i = (unsigned long long)b.bar; unsigned bx_ = b.x; asm volatile("" : "+s"(bar_i), "+s"(bx_));
        unsigned* bar = (unsigned*)(__attribute__((address_space(1))) unsigned*)bar_i;
        __builtin_amdgcn_s_waitcnt(0);
        unsigned nloc = b.st[0], nx = b.st[1];
        if (nloc == 0u) { xcd_barrier_complete(bar, bx_, nloc, nx); b.st[0] = nloc; b.st[1] = nx; }
        const unsigned old = xb_add(&bar[XB_XSUB(bx_)], 1u);
        const unsigned gen = old / nloc;
        if (old + 1u == (gen + 1u) * nloc) {
            __builtin_amdgcn_fence(__ATOMIC_RELEASE, "agent");
            asm volatile("s_waitcnt vmcnt(0)" ::: "memory");
            const unsigned og = xb_add(&bar[XB_TOP], 1u);
            const unsigned tg = og / nx;
            if (og + 1u == (tg + 1u) * nx) xb_add(&bar[XB_TOPGEN], 1u);
            else XB_SPIN(xb_ld(&bar[XB_TOPGEN]) == tg, bar);
            __builtin_amdgcn_fence(__ATOMIC_ACQUIRE, "agent");
            xb_add(&bar[XB_XGEN(bx_)], 1u);
            asm volatile("s_waitcnt vmcnt(0)" ::: "memory");
        } else {
            XB_SPIN(xb_ld(&bar[XB_XGEN(bx_)]) == gen, bar);
            __builtin_amdgcn_fence(__ATOMIC_ACQUIRE, "agent");
            asm volatile("s_waitcnt vmcnt(0)" ::: "memory");
        }
    }
    __syncthreads();
}

struct Frame {
    LAS unsigned char* lds;
    int tid, lane, wave, vcu, G, gw, NGW, bid;
    float* out; unsigned char* ws;
};
__device__ __forceinline__ void relaunder(Frame& F) {
    unsigned long long w = (unsigned long long)F.ws, o = (unsigned long long)F.out;
    int vcu = F.vcu, G = F.G, wave = F.wave, tid = F.tid, bid = F.bid;
    asm volatile("" : "+s"(w), "+s"(o), "+s"(vcu), "+s"(G), "+s"(wave), "+s"(bid), "+v"(tid));
    F.ws = (unsigned char*)(__attribute__((address_space(1))) unsigned char*)w; F.out = (float*)(__attribute__((address_space(1))) float*)o;
    F.vcu = vcu; F.G = G; F.wave = wave; F.tid = tid; F.lane = tid & 63; F.bid = bid; F.gw = vcu * NWAVES + wave; F.NGW = G * NWAVES;
}
#define LDS_WAIT() asm volatile("s_waitcnt lgkmcnt(0)" ::: "memory")

__device__ __forceinline__ void transpose_item(const float* W, int N, int k0, int n0, bf16_t* dst, int ldk, LAS float* scr, int lane) {
#pragma unroll 8
    for (int i = 0; i < 32; ++i) { const int kk = 2 * i + (lane >> 5); scr[kk * 33 + (lane & 31)] = W[(size_t)(k0 + kk) * N + n0 + (lane & 31)]; }
    LDS_WAIT(); asm volatile("" ::: "memory");
    const int c = lane & 7;
#pragma unroll
    for (int j = 0; j < 4; ++j) { const int n = (lane >> 3) + 8 * j; const LAS float* s = scr + (8 * c) * 33 + n;
        u32x4 o; o.x = pk2(s[0 * 33], s[1 * 33]); o.y = pk2(s[2 * 33], s[3 * 33]); o.z = pk2(s[4 * 33], s[5 * 33]); o.w = pk2(s[6 * 33], s[7 * 33]);
        *(u32x4*)(dst + (size_t)n * ldk + 8 * c) = o; }
    LDS_WAIT(); asm volatile("" ::: "memory");
}

__device__ __forceinline__ void phase_prologue(Frame& F, const float* c_in, const float* cctx_in, const float* ada_w, const float* ada_b, const float* w_in, const float* decay_w2, const float* iclr_a2, const float* gate_g2,
                                               const float* w_br_att, const float* w_br_rwkv, const float* w_br_conv, const float* w_out) {
    LAS float* scr = (LAS float*)(F.lds + F.wave * 16384);
    bf16_t* Win = (bf16_t*)(F.ws + WS_WIN); bf16_t* Wbr = (bf16_t*)(F.ws + WS_WBR); bf16_t* Wout = (bf16_t*)(F.ws + WS_WOUT); bf16_t* Wlr = (bf16_t*)(F.ws + WS_WLR);
    constexpr int I_IN = 16 * 228, I_BR = 8 * 32, I_OUT = 16 * 32;
    constexpr int PER_L = I_IN + 3 * I_BR + I_OUT;
    for (int it = F.gw; it < NL * PER_L; it += F.NGW) {
        const int l = it / PER_L; int r = it % PER_L;
        if (r < I_IN) { const int kb = r / 228, nb = r % 228; transpose_item(w_in + (size_t)l * DM * PW, PW, kb * 64, nb * 32, Win + ((size_t)l * PWP + nb * 32) * DM + kb * 64, DM, scr, F.lane); continue; }
        r -= I_IN;
        if (r < 3 * I_BR) { const int br = r / I_BR, q = r % I_BR, kb = q / 32, nb = q % 32;
            const float* W = (br == 0 ? w_br_att : (br == 1 ? w_br_rwkv : w_br_conv)) + (size_t)l * 512 * DM;
            transpose_item(W, DM, kb * 64, nb * 32, Wbr + (((size_t)l * 3 + br) * 1024 + nb * 32) * 512 + kb * 64, 512, scr, F.lane); continue; }
        r -= 3 * I_BR;
        { const int kb = r / 32, nb = r % 32; transpose_item(w_out + (size_t)l * DM * DM, DM, kb * 64, nb * 32, Wout + ((size_t)l * 1024 + nb * 32) * DM + kb * 64, DM, scr, F.lane); }
    }
    for (int i = F.gw * 64 + F.lane; i < NL * (PWP - PW) * DM / 8; i += F.NGW * 64) {
        const int l = i / ((PWP - PW) * DM / 8), r = i % ((PWP - PW) * DM / 8);
        *(u32x4*)(Win + ((size_t)l * PWP + PW) * DM + (size_t)r * 8) = (u32x4){0u, 0u, 0u, 0u};
    }
    for (int i = F.gw * 64 + F.lane; i < NL * WAGW * LRAW; i += F.NGW * 64) {
        const int l = i / (WAGW * LRAW), r = i % (WAGW * LRAW), n = r / LRAW, k = r % LRAW;
        float v = 0.f;
        if (n < 512) { if (k < 64) v = decay_w2[(((size_t)l * 2 + 0) * 64 + k) * 512 + n]; }
        else if (n < 1024) { if (k >= 64 && k < 128) v = decay_w2[(((size_t)l * 2 + 1) * 64 + (k - 64)) * 512 + (n - 512)]; }
        else if (n < 1536) { if (k >= 128 && k < 192) v = iclr_a2[(((size_t)l * 2 + 0) * 64 + (k - 128)) * 512 + (n - 1024)]; }
        else if (n < 2048) { if (k >= 192 && k < 256) v = iclr_a2[(((size_t)l * 2 + 1) * 64 + (k - 192)) * 512 + (n - 1536)]; }
        else { if (k >= 256) v = gate_g2[((size_t)l * 128 + (k - 256)) * 512 + (n - 2048)]; }
        Wlr[i] = (bf16_t)f2bf(v);
    }
    if (blockIdx.x == 0) {
        float* rope = (float*)(F.ws + WS_ROPE);
        for (int i = F.tid; i < 64 * 16; i += NTHR) { const int pos = i >> 4, fi = i & 15;
            const float inv = powf(10000.0f, -(float)(2 * fi) / 32.0f); const float ang = (float)pos * inv;
            rope[2 * i] = cosf(ang); rope[2 * i + 1] = sinf(ang); }
    }
    __syncthreads();
    LAS float* sc = (LAS float*)F.lds;
    LAS float* part = (LAS float*)(F.lds + 17 * 1024 * 4);
    for (int i = F.tid; i < 17 * 1024; i += NTHR) { const float v = (i < 16 * 1024) ? c_in[i] : cctx_in[i - 16 * 1024]; sc[i] = v / (1.0f + __expf(-v)); }
    __syncthreads();
    float* MOD = (float*)(F.ws + WS_MOD);
    for (int item = F.vcu; item < NL * 96; item += F.G) {
        const int l = item / 96, n0 = (item % 96) * 64;
        float acc[17];
#pragma unroll
        for (int r = 0; r < 17; ++r) acc[r] = 0.f;
        const float* wp = ada_w + ((size_t)l * DM + F.wave * 128) * 6144 + n0 + F.lane;
        for (int kk = 0; kk < 128; ++kk) {
            const float w = wp[(size_t)kk * 6144];
            const int k = F.wave * 128 + kk;
#pragma unroll
            for (int r = 0; r < 17; ++r) acc[r] += sc[r * 1024 + k] * w;
        }
#pragma unroll
        for (int r = 0; r < 17; ++r) part[(F.wave * 17 + r) * 64 + F.lane] = acc[r];
        __syncthreads();
        for (int idx = F.tid; idx < 17 * 64; idx += NTHR) { const int r = idx >> 6, j = idx & 63; float s = 0.f;
#pragma unroll
            for (int w = 0; w < 8; ++w) s += part[(w * 17 + r) * 64 + j];
            MOD[((size_t)l * 17 + r) * 6144 + n0 + j] = s + ada_b[(size_t)l * 6144 + n0 + j]; }
        __syncthreads();
    }
}

__device__ __forceinline__ void convert_experts(Frame& F, int l, const float* exp_gate, const float* exp_up, const float* exp_down) {
    LAS float* scr = (LAS float*)(F.lds + F.wave * 16384);
    bf16_t* Wup = (bf16_t*)(F.ws + WS_WUP); bf16_t* Wdn = (bf16_t*)(F.ws + WS_WDN);
    constexpr int I_M = 16 * 32;
    for (int it = F.gw; it < 3 * NEXP * I_M; it += F.NGW) {
        const int which = it / (NEXP * I_M), r = it % (NEXP * I_M), e = r / I_M, q = r % I_M, kb = q / 32, nb = q % 32, n0 = nb * 32;
        const float* W = (which == 0 ? exp_gate : (which == 1 ? exp_up : exp_down)) + ((size_t)l * NEXP + e) * DM * EFF;
        if (which < 2) { const int drow = 256 * (n0 >> 7) + 128 * which + (n0 & 127);
            transpose_item(W, EFF, kb * 64, n0, Wup + ((size_t)e * 2048 + drow) * DM + kb * 64, DM, scr, F.lane); }
        else transpose_item(W, DM, kb * 64, n0, Wdn + ((size_t)e * 1024 + n0) * EFF + kb * 64, EFF, scr, F.lane);
    }
}

__device__ __forceinline__ void phase_norm1(Frame& F, int l, const float* x_in, const float* ctx_in, const float* norm1, const float* final_norm) {
    const bool fin = (l == NL);
    const int nrows = fin ? NLAT : NTOK;
    float* XR = F.out; float* XC = (float*)(F.ws + WS_XC);
    const float* MOD = (const float*)(F.ws + WS_MOD);
    const int* SLOT = (const int*)(F.ws + WS_SLOT); const float* AFF = (const float*)(F.ws + WS_AFF);
    const bf16_t* YE = (const bf16_t*)(F.ws + WS_YE); bf16_t* H = (bf16_t*)(F.ws + WS_H);
    for (int row = F.gw; row < nrows; row += F.NGW) {
        const bool lat = row < NLAT; const int b = lat ? (row >> 11) : ((row - NLAT) >> 8); const int modrow = lat ? b : 16;
        float* xw = lat ? XR + (size_t)row * DM : XC + (size_t)(row - NLAT) * DM;
        const float* xs = (l == 0) ? (lat ? x_in + (size_t)row * DM : ctx_in + (size_t)(row - NLAT) * DM) : xw;
        f32x4 v[4];
#pragma unroll
        for (int j = 0; j < 4; ++j) v[j] = *(const f32x4*)(xs + 4 * F.lane + 256 * j);
        if (l > 0) {
            f32x4 a[4];
#pragma unroll
            for (int j = 0; j < 4; ++j) a[j] = (f32x4){0.f, 0.f, 0.f, 0.f};
            for (int e = 0; e < NEXP; ++e) {
                const int s = __builtin_amdgcn_readfirstlane(SLOT[(size_t)row * 16 + e]);
                if (s >= 0) {
                    const float gate = AFF[(size_t)row * 16 + e];
                    const size_t pr = (size_t)e * PAIRS_E + (lat ? b * CAPL : NB * CAPL + b * CAPC) + s;
                    const bf16_t* yp = YE + pr * DM + 4 * F.lane;
#pragma unroll
                    for (int j = 0; j < 4; ++j) { const u32x2 w = *(const u32x2*)(yp + 256 * j);
                        a[j][0] += gate * bflo(w.x); a[j][1] += gate * bfhi(w.x); a[j][2] += gate * bflo(w.y); a[j][3] += gate * bfhi(w.y); }
                }
            }
            const float* g2 = MOD + ((size_t)(l - 1) * 17 + modrow) * 6144 + 5 * 1024 + 4 * F.lane;
#pragma unroll
            for (int j = 0; j < 4; ++j) v[j] += *(const f32x4*)(g2 + 256 * j) * a[j];
        }
        if (!fin) {
#pragma unroll
            for (int j = 0; j < 4; ++j) *(f32x4*)(xw + 4 * F.lane + 256 * j) = v[j];
        }
        float ss = 0.f;
#pragma unroll
        for (int j = 0; j < 4; ++j) ss += (v[j][0] * v[j][0] + v[j][1] * v[j][1]) + (v[j][2] * v[j][2] + v[j][3] * v[j][3]);
        const float rstd = 1.0f / sqrtf(wave_sum(ss) * (1.0f / DM) + NORM_EPS);
        if (fin) {
            const float* gn = final_norm + 4 * F.lane;
#pragma unroll
            for (int j = 0; j < 4; ++j) *(f32x4*)(xw + 4 * F.lane + 256 * j) = v[j] * rstd * *(const f32x4*)(gn + 256 * j);
        } else {
            const float* gn = norm1 + (size_t)l * DM + 4 * F.lane;
            const float* md = MOD + ((size_t)l * 17 + modrow) * 6144 + 4 * F.lane;
#pragma unroll
            for (int j = 0; j < 4; ++j) {
                const f32x4 h = v[j] * rstd * *(const f32x4*)(gn + 256 * j) * (*(const f32x4*)(md + 1024 + 256 * j) + 1.0f) + *(const f32x4*)(md + 256 * j);
                u32x2 w; w.x = pk2(h[0], h[1]); w.y = pk2(h[2], h[3]);
                *(u32x2*)(H + (size_t)row * DM + 4 * F.lane + 256 * j) = w;
            }
        }
    }
}

__device__ __forceinline__ void phase_prep(Frame& F, int l, const float* q_gain, const float* k_gain, const float* conv_w, const float* shift_mu) {
    bf16_t* P = (bf16_t*)(F.ws + WS_PROJ); bf16_t* LRA = (bf16_t*)(F.ws + WS_LRA);
    LAS float* rope = (LAS float*)F.lds;
    for (int i = F.tid; i < 64 * 16 * 2; i += NTHR) rope[i] = ((const float*)(F.ws + WS_ROPE))[i];
    __syncthreads();
    const int lane = F.lane, s8 = lane & 7;
    float qg[8], kg[8], cw0[8], cw1[8], cw2[8], mu[8];
#pragma unroll
    for (int i = 0; i < 8; ++i) { qg[i] = q_gain[l * 64 + s8 * 8 + i]; kg[i] = k_gain[l * 64 + s8 * 8 + i];
        cw0[i] = conv_w[((size_t)l * 3 + 0) * 512 + 8 * lane + i]; cw1[i] = conv_w[((size_t)l * 3 + 1) * 512 + 8 * lane + i]; cw2[i] = conv_w[((size_t)l * 3 + 2) * 512 + 8 * lane + i];
        mu[i] = (lane < 48) ? shift_mu[(size_t)l * 1920 + (C_WLO - C_RW) + 8 * lane + i] : 0.f; }
    for (int row = F.gw; row < NTOK; row += F.NGW) {
        const bool lat = row < NLAT; const int t = lat ? (row & 2047) : ((row - NLAT) & 255); const int slen = lat ? SEQ : CTXL;
        bf16_t* pr = P + (size_t)row * PW;
        const bool hp = t > 0, hn = t + 1 < slen;
#pragma unroll
        for (int which = 0; which < 2; ++which) {
            const int li = which == 0 ? lane : (lane & 15);
            bf16_t* ptr = pr + (which == 0 ? C_Q : C_K) + 8 * li;
            float x[8]; ld8(ptr, x);
            float ss = 0.f;
#pragma unroll
            for (int i = 0; i < 8; ++i) ss += x[i] * x[i];
            ss = sum8(ss);
            const float rstd = 1.0f / sqrtf(ss * (1.0f / 64.0f) + NORM_EPS);
#pragma unroll
            for (int i = 0; i < 8; ++i) x[i] = x[i] * rstd * (which == 0 ? qg[i] : kg[i]);
            if (lat) {
                const int pos = (s8 < 4) ? (t >> 6) : (t & 63);
                float o[8];
#pragma unroll
                for (int i = 0; i < 8; ++i) {
                    const float partner = __shfl_xor(x[i], 2);
                    const int fi = (s8 & 1) * 8 + i;
                    const float c = rope[(pos * 16 + fi) * 2], sn = rope[(pos * 16 + fi) * 2 + 1];
                    o[i] = (s8 & 2) ? (partner * sn + x[i] * c) : (x[i] * c - partner * sn);
                }
#pragma unroll
                for (int i = 0; i < 8; ++i) x[i] = o[i];
            }
            if (which == 0) {
#pragma unroll
                for (int i = 0; i < 8; ++i) x[i] *= QSCALE;
                st8(ptr, x);
            } else if (lane < 16) st8(ptr, x);
        }
        {
            float bg[8], c0[8], u0[8], z[8], zp[8], zn[8];
            ld8(pr + C_BG + 8 * lane, bg); ld8(pr + C_CG + 8 * lane, c0); ld8(pr + C_U + 8 * lane, u0);
#pragma unroll
            for (int i = 0; i < 8; ++i) { z[i] = c0[i] * u0[i]; zp[i] = 0.f; zn[i] = 0.f; }
            if (hp) { ld8(pr - PW + C_CG + 8 * lane, c0); ld8(pr - PW + C_U + 8 * lane, u0);
#pragma unroll
                for (int i = 0; i < 8; ++i) zp[i] = c0[i] * u0[i]; }
            if (hn) { ld8(pr + PW + C_CG + 8 * lane, c0); ld8(pr + PW + C_U + 8 * lane, u0);
#pragma unroll
                for (int i = 0; i < 8; ++i) zn[i] = c0[i] * u0[i]; }
            float o[8];
#pragma unroll
            for (int i = 0; i < 8; ++i) o[i] = bg[i] * (cw0[i] * zp[i] + cw1[i] * z[i] + cw2[i] * zn[i]);
            st8(pr + C_OCONV + 8 * lane, o);
        }
        if (lane < 48) {
            float x[8], xp[8], xn[8];
            ld8(pr + C_WLO + 8 * lane, x);
#pragma unroll
            for (int i = 0; i < 8; ++i) { xp[i] = 0.f; xn[i] = 0.f; }
            if (hp) ld8(pr - PW + C_WLO + 8 * lane, xp);
            if (hn) ld8(pr + PW + C_WLO + 8 * lane, xn);
            float o[8];
#pragma unroll
            for (int i = 0; i < 8; ++i) { const float sft = x[i] + mu[i] * (0.5f * (xp[i] + xn[i]) - x[i]);
                o[i] = lane < 16 ? tanhf(sft) : (lane < 32 ? sft : sigmoidf_(sft)); }
            st8(LRA + (size_t)row * LRAW + 8 * lane, o);
        }
    }
}
__device__ __forceinline__ void phase_norm2_router(Frame& F, int l, int nrows, const float* norm2, const float* w_router) {
    LAS float* wrT = (LAS float*)F.lds;
    for (int i = F.tid; i < 16 * 1024; i += NTHR) { const int c = i >> 4, e = i & 15; wrT[e * 1024 + c] = w_router[(size_t)l * DM * 16 + i]; }
    __syncthreads();
    const float* XR = F.out; const float* XC = (const float*)(F.ws + WS_XC);
    const float* MOD = (const float*)(F.ws + WS_MOD);
    float* AFF = (float*)(F.ws + WS_AFF); bf16_t* H = (bf16_t*)(F.ws + WS_H);
    for (int row = F.gw; row < nrows; row += F.NGW) {
        const bool lat = row < NLAT; const int b = lat ? (row >> 11) : ((row - NLAT) >> 8); const int modrow = lat ? b : 16;
        const float* xs = lat ? XR + (size_t)row * DM : XC + (size_t)(row - NLAT) * DM;
        f32x4 v[4];
#pragma unroll
        for (int j = 0; j < 4; ++j) v[j] = *(const f32x4*)(xs + 4 * F.lane + 256 * j);
        float ss = 0.f;
#pragma unroll
        for (int j = 0; j < 4; ++j) ss += (v[j][0] * v[j][0] + v[j][1] * v[j][1]) + (v[j][2] * v[j][2] + v[j][3] * v[j][3]);
        const float rstd = 1.0f / sqrtf(wave_sum(ss) * (1.0f / DM) + NORM_EPS);
        const float* gn = norm2 + (size_t)l * DM + 4 * F.lane;
        const float* md = MOD + ((size_t)l * 17 + modrow) * 6144 + 3 * 1024 + 4 * F.lane;
#pragma unroll
        for (int j = 0; j < 4; ++j) {
            v[j] = v[j] * rstd * *(const f32x4*)(gn + 256 * j) * (*(const f32x4*)(md + 1024 + 256 * j) + 1.0f) + *(const f32x4*)(md + 256 * j);
            u32x2 w; w.x = pk2(v[j][0], v[j][1]); w.y = pk2(v[j][2], v[j][3]);
            *(u32x2*)(H + (size_t)row * DM + 4 * F.lane + 256 * j) = w;
        }
        float lg[16];
#pragma unroll
        for (int e = 0; e < 16; ++e) {
            float s = 0.f;
#pragma unroll
            for (int j = 0; j < 4; ++j) { const f32x4 w = *(const LAS f32x4*)(wrT + e * 1024 + 4 * F.lane + 256 * j); s += (v[j][0] * w[0] + v[j][1] * w[1]) + (v[j][2] * w[2] + v[j][3] * w[3]); }
            lg[e] = wave_sum(s);
            __builtin_amdgcn_sched_barrier(0);
        }
        float mx = lg[0];
#pragma unroll
        for (int e = 1; e < 16; ++e) mx = fmaxf(mx, lg[e]);
        float den = 0.f;
#pragma unroll
        for (int e = 0; e < 16; ++e) { lg[e] = __expf(lg[e] - mx); den += lg[e]; }
        const float inv = 1.0f / den;
        float mine = 0.f;
#pragma unroll
        for (int e = 0; e < 16; ++e) mine = (F.lane == e) ? lg[e] * inv : mine;
        if (F.lane < 16) AFF[(size_t)row * 16 + F.lane] = mine;
    }
}

__device__ __forceinline__ int block_sum_i(LAS int* red, int& par, int wave_val, int wave, int lane) {
    if (lane == 0) red[par * 8 + wave] = wave_val;
    __syncthreads();
    int s = 0;
#pragma unroll
    for (int w = 0; w < 8; ++w) s += red[par * 8 + w];
    par ^= 1;
    return s;
}
__device__ __forceinline__ int block_exscan_i(LAS int* red, int& par, int val, int wave, int lane) {
    int inc = val;
#pragma unroll
    for (int o = 1; o < 64; o <<= 1) { const int t = __shfl_up(inc, o); if (lane >= o) inc += t; }
    if (lane == 63) red[par * 8 + wave] = inc;
    __syncthreads();
    int base = 0;
#pragma unroll
    for (int w = 0; w < 8; ++w) base += (w < wave) ? red[par * 8 + w] : 0;
    par ^= 1;
    return base + inc - val;
}
__device__ __forceinline__ void topk_set(Frame& F, LAS int* red, int& par, int n, int cap, int rowbase, int e, int listbase) {
    const float* AFF = (const float*)(F.ws + WS_AFF); int* LIST = (int*)(F.ws + WS_LIST); int* SLOT = (int*)(F.ws + WS_SLOT);
    unsigned key[4];
#pragma unroll
    for (int j = 0; j < 4; ++j) { const int tok = 4 * F.tid + j; key[j] = (tok < n) ? __builtin_bit_cast(unsigned, AFF[(size_t)(rowbase + tok) * 16 + e]) : 0u; }
    unsigned T = 0u;
    for (int bit = 30; bit >= 0; --bit) {
        const unsigned cand = T | (1u << bit);
        int c = 0;
#pragma unroll
        for (int j = 0; j < 4; ++j) c += __popcll(__ballot(key[j] >= cand));
        if (block_sum_i(red, par, c, F.wave, F.lane) >= cap) T = cand;
    }
    int cgt = 0, ceq = 0;
#pragma unroll
    for (int j = 0; j < 4; ++j) { cgt += __popcll(__ballot(key[j] > T)); ceq += (key[j] == T) ? 1 : 0; }
    const int n_gt = block_sum_i(red, par, cgt, F.wave, F.lane);
    const int need_eq = cap - n_gt;
    int eqrank = block_exscan_i(red, par, ceq, F.wave, F.lane);
    int sel[4], csel = 0;
#pragma unroll
    for (int j = 0; j < 4; ++j) { const bool eq = key[j] == T; sel[j] = (key[j] > T || (eq && eqrank < need_eq)) ? 1 : 0; eqrank += eq ? 1 : 0; csel += sel[j]; }
    int slot = block_exscan_i(red, par, csel, F.wave, F.lane);
#pragma unroll
    for (int j = 0; j < 4; ++j) { const int tok = 4 * F.tid + j;
        if (tok < n) { SLOT[(size_t)(rowbase + tok) * 16 + e] = sel[j] ? slot : -1; if (sel[j]) { LIST[listbase + slot] = rowbase + tok; ++slot; } } }
}
__device__ __forceinline__ void phase_topk(Frame& F, bool need_ctx) {
    LAS int* red = (LAS int*)F.lds; int par = 0;
    for (int pair = F.vcu; pair < NB * NEXP; pair += F.G) {
        const int b = pair >> 4, e = pair & 15;
        topk_set(F, red, par, SEQ, CAPL, b * SEQ, e, e * PAIRS_E + b * CAPL);
        if (need_ctx) topk_set(F, red, par, CTXL, CAPC, NLAT + b * CTXL, e, e * PAIRS_E + NB * CAPL + b * CAPC);
    }
}

__device__ __forceinline__ void phase_scan(Frame& F, int l, const float* shift_mu, const float* rwkv_kk, const float* rwkv_ka) {
    const bf16_t* P = (const bf16_t*)(F.ws + WS_PROJ); const bf16_t* WAG = (const bf16_t*)(F.ws + WS_WAG);
    LAS float* VA = (LAS float*)F.lds;
    LAS float* VW = VA + 4096;
    LAS float* VB = VW + 4096;
    LAS float* VK = VB + 4096;
    LAS float* VR = VK + 4096;
    LAS float* VV = VR + 4096;
    LAS float* YO = VV + 4096;
    const int tid = F.tid, s = tid >> 3, cg = tid & 7;
    for (int chain = F.vcu; chain < 2 * NB * 8; chain += F.G) {
        const int d = chain >> 7, b = (chain >> 3) & 15, h = chain & 7;
        bf16_t* Y = (bf16_t*)(F.ws + (d == 0 ? WS_YF : WS_YB));
        const int hc = h * 64 + 8 * cg;
        float mur[8], muk[8], muv[8], kkw[8], kaw[8];
#pragma unroll
        for (int i = 0; i < 8; ++i) { mur[i] = shift_mu[(size_t)l * 1920 + hc + i]; muk[i] = shift_mu[(size_t)l * 1920 + 512 + hc + i]; muv[i] = shift_mu[(size_t)l * 1920 + 1024 + hc + i];
            kkw[i] = rwkv_kk[(size_t)l * 512 + hc + i]; kaw[i] = rwkv_ka[(size_t)l * 512 + hc + i]; }
        float S[8];
#pragma unroll
        for (int j = 0; j < 8; ++j) S[j] = 0.f;
        for (int seg = 0; seg < 2; ++seg) {
            const int slen = seg == 0 ? CTXL : SEQ; const int rowbase = seg == 0 ? NLAT + b * CTXL : b * SEQ;
            for (int c0 = 0; c0 < slen; c0 += 64) {
                const int t = d == 0 ? (c0 + s) : (slen - 1 - (c0 + s));
                const size_t row = (size_t)(rowbase + t);
                {
                    const bf16_t* pr = P + row * PW + C_RW + hc;
                    const bool hp = t > 0, hn = t + 1 < slen;
                    float x[8], xp[8], xn[8], r[8], k[8], vv[8];
#pragma unroll
                    for (int q = 0; q < 3; ++q) {
                        ld8(pr + 512 * q, x);
#pragma unroll
                        for (int i = 0; i < 8; ++i) { xp[i] = 0.f; xn[i] = 0.f; }
                        if (hp) ld8(pr - PW + 512 * q, xp);
                        if (hn) ld8(pr + PW + 512 * q, xn);
#pragma unroll
                        for (int i = 0; i < 8; ++i) { const float m = q == 0 ? mur[i] : (q == 1 ? muk[i] : muv[i]); const float sft = x[i] + m * (0.5f * (xp[i] + xn[i]) - x[i]);
                            if (q == 0) r[i] = sft; else if (q == 1) k[i] = sft; else vv[i] = sft; }
                    }
                    float u[8], ag[8];
                    ld8(WAG + row * WAGW + d * 512 + hc, u);
                    ld8(WAG + row * WAGW + 1024 + d * 512 + hc, ag);
                    float kks[8], n2 = 0.f;
#pragma unroll
                    for (int i = 0; i < 8; ++i) { kks[i] = k[i] * kkw[i]; n2 += kks[i] * kks[i]; }
                    n2 = sum8(n2);
                    const float rn = 1.0f / sqrtf(n2 + 1e-12f);
                    LAS float* dst = VA + s * 64 + 8 * cg;
#pragma unroll
                    for (int i = 0; i < 8; ++i) {
                        const float kk = kks[i] * rn;
                        dst[i] = -kk;
                        dst[4096 + i] = __expf(-u[i]);
                        dst[2 * 4096 + i] = kk * ag[i];
                        dst[3 * 4096 + i] = k[i] * (1.0f + (ag[i] - 1.0f) * kaw[i]);
                        dst[4 * 4096 + i] = r[i];
                        dst[5 * 4096 + i] = vv[i];
                    }
                }
                __syncthreads();
                for (int st = 0; st < 64; ++st) {
                    const LAS float* base = VA + st * 64 + 8 * cg;
                    float a8[8], w8[8], b8[8], k8[8], r8[8];
                    { const f32x4 t0 = *(const LAS f32x4*)(base), t1 = *(const LAS f32x4*)(base + 4);
#pragma unroll
                      for (int j = 0; j < 4; ++j) { a8[j] = t0[j]; a8[4 + j] = t1[j]; } }
                    { const f32x4 t0 = *(const LAS f32x4*)(base + 4096), t1 = *(const LAS f32x4*)(base + 4096 + 4);
#pragma unroll
                      for (int j = 0; j < 4; ++j) { w8[j] = t0[j]; w8[4 + j] = t1[j]; } }
                    { const f32x4 t0 = *(const LAS f32x4*)(base + 2 * 4096), t1 = *(const LAS f32x4*)(base + 2 * 4096 + 4);
#pragma unroll
                      for (int j = 0; j < 4; ++j) { b8[j] = t0[j]; b8[4 + j] = t1[j]; } }
                    { const f32x4 t0 = *(const LAS f32x4*)(base + 3 * 4096), t1 = *(const LAS f32x4*)(base + 3 * 4096 + 4);
#pragma unroll
                      for (int j = 0; j < 4; ++j) { k8[j] = t0[j]; k8[4 + j] = t1[j]; } }
                    { const f32x4 t0 = *(const LAS f32x4*)(base + 4 * 4096), t1 = *(const LAS f32x4*)(base + 4 * 4096 + 4);
#pragma unroll
                      for (int j = 0; j < 4; ++j) { r8[j] = t0[j]; r8[4 + j] = t1[j]; } }
                    const float vs = VV[st * 64 + s];
                    float sa = 0.f;
#pragma unroll
                    for (int j = 0; j < 8; ++j) sa += S[j] * a8[j];
                    sa = sum8(sa);
                    float y = 0.f;
#pragma unroll
                    for (int j = 0; j < 8; ++j) { S[j] = S[j] * w8[j] + (sa * b8[j] + vs * k8[j]); y += S[j] * r8[j]; }
                    y = sum8(y);
                    if (cg == 0) YO[st * 64 + s] = y;
                }
                __syncthreads();
                {
                    float o[8];
#pragma unroll
                    for (int i = 0; i < 8; ++i) o[i] = YO[s * 64 + 8 * cg + i];
                    st8(Y + row * 512 + hc, o);
                }
            }
        }
        __syncthreads();
    }
}

__device__ __forceinline__ void phase_readout(Frame& F, int l, int nrows, const float* shift_mu, const float* rwkv_rk, const float* gn_w, const float* gn_b) {
    bf16_t* P = (bf16_t*)(F.ws + WS_PROJ); const bf16_t* WAG = (const bf16_t*)(F.ws + WS_WAG);
    const bf16_t* YF = (const bf16_t*)(F.ws + WS_YF); const bf16_t* YB = (const bf16_t*)(F.ws + WS_YB);
    const int lane = F.lane;
    float mur[8], muk[8], muv[8], rkw[8], gw[8], gb[8];
#pragma unroll
    for (int i = 0; i < 8; ++i) { mur[i] = shift_mu[(size_t)l * 1920 + 8 * lane + i]; muk[i] = shift_mu[(size_t)l * 1920 + 512 + 8 * lane + i]; muv[i] = shift_mu[(size_t)l * 1920 + 1024 + 8 * lane + i];
        rkw[i] = rwkv_rk[(size_t)l * 512 + 8 * lane + i]; gw[i] = gn_w[(size_t)l * 512 + 8 * lane + i]; gb[i] = gn_b[(size_t)l * 512 + 8 * lane + i]; }
    for (int row = F.gw; row < nrows; row += F.NGW) {
        const bool lat = row < NLAT; const int t = lat ? (row & 2047) : ((row - NLAT) & 255); const int slen = lat ? SEQ : CTXL;
        const bool hp = t > 0, hn = t + 1 < slen;
        bf16_t* pr = P + (size_t)row * PW;
        float yf[8], yb[8], y[8];
        ld8(YF + (size_t)row * 512 + 8 * lane, yf); ld8(YB + (size_t)row * 512 + 8 * lane, yb);
        float sm = 0.f;
#pragma unroll
        for (int i = 0; i < 8; ++i) { y[i] = yf[i] + yb[i]; sm += y[i]; }
        const float mean = sum8(sm) * (1.0f / 64.0f);
        float sq = 0.f;
#pragma unroll
        for (int i = 0; i < 8; ++i) { y[i] -= mean; sq += y[i] * y[i]; }
        const float rstd = 1.0f / sqrtf(sum8(sq) * (1.0f / 64.0f) + GN_EPS);
        float x[8], xp[8], xn[8], r[8], k[8], vv[8];
#pragma unroll
        for (int q = 0; q < 3; ++q) {
            ld8(pr + C_RW + 512 * q + 8 * lane, x);
#pragma unroll
            for (int i = 0; i < 8; ++i) { xp[i] = 0.f; xn[i] = 0.f; }
            if (hp) ld8(pr - PW + C_RW + 512 * q + 8 * lane, xp);
            if (hn) ld8(pr + PW + C_RW + 512 * q + 8 * lane, xn);
#pragma unroll
            for (int i = 0; i < 8; ++i) { const float m = q == 0 ? mur[i] : (q == 1 ? muk[i] : muv[i]); const float sft = x[i] + m * (0.5f * (xp[i] + xn[i]) - x[i]);
                if (q == 0) r[i] = sft; else if (q == 1) k[i] = sft; else vv[i] = sft; }
        }
        float bs = 0.f;
#pragma unroll
        for (int i = 0; i < 8; ++i) bs += r[i] * k[i] * rkw[i];
        bs = sum8(bs);
        float g[8], o[8];
        ld8(WAG + (size_t)row * WAGW + 2048 + 8 * lane, g);
#pragma unroll
        for (int i = 0; i < 8; ++i) o[i] = (y[i] * rstd * gw[i] + gb[i] + bs * vv[i]) * g[i];
        st8(pr + C_ORWKV + 8 * lane, o);
    }
}
__device__ __forceinline__ void phase_attention(Frame& F, bool need_ctx, char* lds_generic) {
    typedef attn_body::bf16 abf;
    abf* P = (abf*)(F.ws + WS_PROJ);
    const int nu = (need_ctx && F.vcu < NB * 8) ? 5 : 4;
    for (int i = 0; i < nu; ++i) {
        int b, h, qrow, NT;
        if (i < 4) { const int u = F.vcu * 4 + i; b = u >> 6; h = (u >> 3) & 7; qrow = b * SEQ + (u & 7) * 256; NT = (CTXL + SEQ) / 64; }
        else { b = F.vcu >> 3; h = F.vcu & 7; qrow = NLAT + b * CTXL; NT = CTXL / 64; }
        abf* Qu = P + (size_t)qrow * PW + C_Q + h * 64;
        attn_body::attn_unit<8>(Qu, Qu, P + C_K + (h >> 2) * 64, NLAT + b * CTXL, b * SEQ, NT, CTXL / 64, lds_generic);
    }
}

struct Args { const float* in[32]; float* out; unsigned char* ws; int ph_lo, ph_hi; };
constexpr int PH_PER_LAYER = 12, PH_FINAL = 1 + NL * PH_PER_LAYER, PH_END = PH_FINAL + 1;

__global__ void __launch_bounds__(NTHR, 2) mega_fwd(Args args) {
    extern __shared__ __attribute__((aligned(16))) unsigned char lds[];
    Frame F;
    F.lds = (LAS unsigned char*)lds;
    F.tid = threadIdx.x; F.lane = F.tid & 63; F.wave = __builtin_amdgcn_readfirstlane(F.tid >> 6);
    F.G = gridDim.x; { const int bx = blockIdx.x; F.vcu = (F.G % 8 == 0) ? (bx % 8) * (F.G / 8) + bx / 8 : bx; }
    F.gw = F.vcu * NWAVES + F.wave; F.NGW = F.G * NWAVES; F.bid = blockIdx.x;
    F.out = args.out; F.ws = args.ws;
    volatile LAS unsigned* MISC = (volatile LAS unsigned*)(F.lds + MISC_OFF);
    for (int u = F.tid; u < (LDS_BYTES - MISC_OFF) / 4; u += NTHR) MISC[u] = 0u;
    __syncthreads();
    unsigned* ctl = (unsigned*)(F.ws + WS_CTL);
    XcdBarrier bar = xcd_barrier_post(ctl + CW_BAR, MISC + 8);
    const int lo = args.ph_lo, hi = args.ph_hi;
    typedef const __attribute__((address_space(1))) float* cfp_t;
#define KP(k) ((const float*)KIN[k])
#define KIN_DECL const __attribute__((address_space(4))) cfp_t* KIN = (const __attribute__((address_space(4))) cfp_t*)__builtin_amdgcn_kernarg_segment_ptr(); asm volatile("" : "+s"(KIN))
#ifndef PHMASK
#define PHMASK 0xFFFFFFFFu
#endif
#define IN(k) (lo <= (k) && (k) < hi)
#define EN(j) ((PHMASK >> (j)) & 1u)
#define SEAM(k) do { if ((k) + 1 < hi) xcd_barrier(bar); } while (0)

    if (EN(0) && IN(0)) { relaunder(F); KIN_DECL; phase_prologue(F, KP(1), KP(3), KP(4), KP(5), KP(7), KP(12), KP(14), KP(15), KP(22), KP(23), KP(24), KP(25)); SEAM(0); }

    for (int l = 0; l < NL; ++l) {
        const int pb = 1 + l * PH_PER_LAYER;
        const bool need_ctx = l < NL - 1;
        const int nrows = need_ctx ? NTOK : NLAT;
        if (EN(1) && IN(pb + 0)) { relaunder(F); KIN_DECL; convert_experts(F, l, KP(28), KP(29), KP(30)); phase_norm1(F, l, KP(0), KP(2), KP(6), KP(31)); SEAM(pb + 0); }
        if (EN(2) && IN(pb + 1)) { relaunder(F);
            pg8::PlainOrder S; S.init(F.ws + WS_H, F.ws + WS_WIN + (size_t)l * PWP * DM * 2, NTOK, PWP, DM, DM, F.G, F.bid);
            pg8::EpiProj E{(bf16_t*)(F.ws + WS_PROJ)};
            pg8::gemm_phase<pg8::EpiProj, pg8::PlainOrder, false>(F.lds, DM, DM, DM, S, E);
            SEAM(pb + 1);
        }
        if (EN(3) && IN(pb + 2)) { relaunder(F); KIN_DECL; phase_prep(F, l, KP(8), KP(9), KP(21), KP(10)); SEAM(pb + 2); }
        if (EN(4) && IN(pb + 3)) { relaunder(F);
            pg8::PlainOrder S; S.init(F.ws + WS_LRA, F.ws + WS_WLR + (size_t)l * WAGW * LRAW * 2, NTOK, WAGW, LRAW, LRAW, F.G, F.bid);
            KIN_DECL; pg8::EpiLowRank E{(bf16_t*)(F.ws + WS_WAG), KP(11) + (size_t)l * 1024, KP(13) + (size_t)l * 1024};
            pg8::gemm_phase<pg8::EpiLowRank, pg8::PlainOrder, false>(F.lds, LRAW, LRAW, LRAW, S, E);
            phase_attention(F, need_ctx, (char*)lds);
            SEAM(pb + 3);
        }
        if (EN(5) && IN(pb + 4)) { relaunder(F); KIN_DECL; phase_scan(F, l, KP(10), KP(16), KP(17)); SEAM(pb + 4); }
        if (EN(6) && IN(pb + 5)) { relaunder(F); KIN_DECL; phase_readout(F, l, nrows, KP(10), KP(18), KP(19), KP(20)); SEAM(pb + 5); }
        if (EN(7) && IN(pb + 6)) { relaunder(F);
            pg8::MergeOrder S{(const char*)(F.ws + WS_PROJ), (const char*)(F.ws + WS_WBR + (size_t)l * 3 * 1024 * 512 * 2), nrows / 256, F.G, F.bid};
            pg8::EpiMerge E{(const bf16_t*)(F.ws + WS_PROJ), (bf16_t*)(F.ws + WS_H)};
            pg8::gemm_phase<pg8::EpiMerge, pg8::MergeOrder, false>(F.lds, 512, PW, 512, S, E);
            SEAM(pb + 6);
        }
        if (EN(8) && IN(pb + 7)) { relaunder(F);
            pg8::PlainOrder S; S.init(F.ws + WS_H, F.ws + WS_WOUT + (size_t)l * DM * DM * 2, nrows, DM, DM, DM, F.G, F.bid);
            pg8::EpiOut E{F.out, (float*)(F.ws + WS_XC), (const float*)(F.ws + WS_MOD) + (size_t)l * 17 * 6144};
            pg8::gemm_phase<pg8::EpiOut, pg8::PlainOrder, false>(F.lds, DM, DM, DM, S, E);
            SEAM(pb + 7);
        }
        if (EN(9) && IN(pb + 8)) { relaunder(F); KIN_DECL; phase_norm2_router(F, l, nrows, KP(26), KP(27)); SEAM(pb + 8); }
        if (EN(10) && IN(pb + 9)) { relaunder(F); phase_topk(F, need_ctx); SEAM(pb + 9); }
        if (EN(11) && IN(pb + 10)) { relaunder(F);
            const int mt_per = need_ctx ? 18 : 16;
            LAS int* rows = (LAS int*)(F.lds + XTRA_OFF);
            pg8::MoeOrder S{(const char*)(F.ws + WS_H), (const char*)(F.ws + WS_WUP), rows, mt_per, 8, F.G, F.bid, (size_t)2048 * 1024 * 2};
            const int* LIST = (const int*)(F.ws + WS_LIST);
            for (int i = 0; i < XTRA_BYTES / 1024; ++i) { int e, mt, pn; if (!S.decode((long)i * F.G + F.bid, e, mt, pn)) break;
                if (F.tid < 256) rows[i * 256 + F.tid] = LIST[e * PAIRS_E + mt * 256 + F.tid]; }
            __syncthreads();
            pg8::EpiUp E{(bf16_t*)(F.ws + WS_HID)};
            pg8::gemm_phase<pg8::EpiUp, pg8::MoeOrder, true>(F.lds, DM, DM, DM, S, E);
            SEAM(pb + 10);
        }
        if (EN(12) && IN(pb + 11)) { relaunder(F);
            const int mt_per = need_ctx ? 18 : 16;
            pg8::MoeDownOrder S{(const char*)(F.ws + WS_HID), (const char*)(F.ws + WS_WDN), mt_per, F.G, F.bid};
            pg8::EpiDown E{(bf16_t*)(F.ws + WS_YE)};
            pg8::gemm_phase<pg8::EpiDown, pg8::MoeDownOrder, false>(F.lds, EFF, EFF, EFF, S, E);
            SEAM(pb + 11);
        }
    }
    if (EN(13) && IN(PH_FINAL)) { relaunder(F); KIN_DECL; phase_norm1(F, NL, KP(0), KP(2), KP(6), KP(31)); }
#undef IN
#undef SEAM
}

extern "C" void kernel_launch(void* const* d_in, const int* in_sizes, int n_in, void* d_out, int out_size, void* d_ws, size_t ws_size, hipStream_t stream) {
    static int grid = 0;
    if (grid == 0) {
        if (n_in != 32 || in_sizes[0] != NLAT * DM || out_size != NLAT * DM || ws_size < WS_END) { fprintf(stderr, "kernel_launch: unexpected shapes / workspace (n_in %d, ws %zu)\n", n_in, ws_size); grid = -1; return; }
        int dev = 0, cus = 0, per_cu = 0;
        if (hipGetDevice(&dev) != hipSuccess || hipDeviceGetAttribute(&cus, hipDeviceAttributeMultiprocessorCount, dev) != hipSuccess) { grid = -1; return; }
        if (hipFuncSetAttribute((const void*)mega_fwd, hipFuncAttributeMaxDynamicSharedMemorySize, LDS_BYTES) != hipSuccess) { grid = -1; return; }
        if (hipOccupancyMaxActiveBlocksPerMultiprocessor(&per_cu, (const void*)mega_fwd, NTHR, LDS_BYTES) != hipSuccess || per_cu < 1) { fprintf(stderr, "kernel_launch: occupancy query says %d\n", per_cu); }
        (void)hipGetLastError();
        grid = cus;
        if (grid != 256) { fprintf(stderr, "kernel_launch: built for 256 CUs, got %d\n", grid); grid = -1; return; }
    }
    if (grid < 0) return;
    if (hipMemsetAsync((char*)d_ws + WS_CTL, 0, CTL_ZERO_BYTES, stream) != hipSuccess) return;
    Args a{};
    for (int i = 0; i < 32; ++i) a.in[i] = (const float*)d_in[i];
    a.out = (float*)d_out; a.ws = (unsigned char*)d_ws;
#ifndef MK_PER_PHASE
    a.ph_lo = 0; a.ph_hi = PH_END;
    hipLaunchKernelGGL(mega_fwd, dim3(grid), dim3(NTHR), LDS_BYTES, stream, a);
#else
    for (int p = 0; p < PH_END; ++p) { a.ph_lo = p; a.ph_hi = p + 1; hipLaunchKernelGGL(mega_fwd, dim3(grid), dim3(NTHR), LDS_BYTES, stream, a); }
#endif
}
```

```cpp
#include <hip/hip_runtime.h>
#include <hip/hip_bf16.h>
#include <cstdio>
#include <cstdint>
#include <cmath>

#define LAS __attribute__((address_space(3)))
typedef unsigned short bf16_t;
typedef short bf16x8 __attribute__((ext_vector_type(8)));
typedef float f32x4 __attribute__((ext_vector_type(4)));
typedef float f32x2 __attribute__((ext_vector_type(2)));
typedef unsigned u32x4 __attribute__((ext_vector_type(4)));
typedef unsigned u32x2 __attribute__((ext_vector_type(2)));

constexpr int DM = 1024, NB = 16, SEQ = 2048, NL = 4, CTXL = 256;
constexpr int NLAT = NB * SEQ;
constexpr int NCTX = NB * CTXL;
constexpr int NTOK = NLAT + NCTX;
constexpr int PW = 4224;
constexpr int NCOLS_IN = 7296;
constexpr int PWP = 7424;
constexpr int C_Q = 0, C_K = 512, C_V = 640, C_RW = 768, C_R = 768, C_RK = 1280, C_RV = 1792, C_WLO = 2304, C_ALO = 2432, C_GLO = 2560;
constexpr int C_BG = 2688, C_CG = 3200, C_U = 3712, C_GT = 4224;
constexpr int C_OATT = 3712, C_OCONV = 2688, C_ORWKV = 3200;
constexpr int WAGW = 2560;
constexpr int LRAW = 384;
constexpr int NEXP = 16, EFF = 1024, CAPL = 256, CAPC = 32, PAIRS_E = 4608;
constexpr float NORM_EPS = 1e-6f, GN_EPS = 64e-5f;
constexpr float QSCALE = 0.125f * 1.4426950408889634f;

constexpr size_t MiB = 1u << 20;
constexpr size_t WS_CTL = 0, CTL_ZERO_BYTES = 1 * MiB;
constexpr size_t WS_MOD = 1 * MiB;
constexpr size_t WS_ROPE = 3 * MiB;
constexpr size_t WS_WRT = 3 * MiB + 65536;
constexpr size_t WS_LIST = 4 * MiB;
constexpr size_t WS_SLOT = 5 * MiB;
constexpr size_t WS_AFF = 8 * MiB;
constexpr size_t WS_XC = 11 * MiB;
constexpr size_t WS_WIN = 27 * MiB;
constexpr size_t WS_WBR = 85 * MiB;
constexpr size_t WS_WOUT = 97 * MiB;
constexpr size_t WS_WLR = 105 * MiB;
constexpr size_t WS_WUP = 113 * MiB;
constexpr size_t WS_WDN = 177 * MiB;
constexpr size_t WS_H = 209 * MiB;
constexpr size_t WS_PROJ = 281 * MiB;
constexpr size_t WS_GATES = 578 * MiB;
constexpr size_t WS_HID = WS_PROJ;
constexpr size_t WS_YE = WS_PROJ + 144 * MiB;
constexpr size_t WS_XB = 686 * MiB;
constexpr size_t WS_WAG = 794 * MiB;
constexpr size_t WS_LRA = 974 * MiB;
constexpr size_t WS_YF = 1001 * MiB;
constexpr size_t WS_YB = 1037 * MiB;
constexpr size_t WS_BON = 1073 * MiB;
constexpr size_t WS_END = 1109 * MiB;
static_assert(WS_WIN + (size_t)NL * PWP * DM * 2 <= WS_WBR && WS_PROJ + (size_t)NTOK * PW * 2 <= WS_GATES && WS_GATES + (size_t)NTOK * 3072 <= WS_XB && WS_XB + (size_t)NTOK * DM * 2 <= WS_WAG && WS_WAG + (size_t)NTOK * WAGW * 2 <= WS_LRA && WS_LRA + (size_t)NTOK * LRAW * 2 <= WS_YF, "ws map");
static_assert(WS_YE + (size_t)NEXP * PAIRS_E * DM * 2 <= WS_GATES && WS_H + (size_t)NTOK * DM * 2 <= WS_PROJ, "ws map 2");
constexpr int CW_BAR = 4096;
constexpr int CW_DBG = 32768;

constexpr int RING_BYTES = 131072;
constexpr int XTRA_OFF = RING_BYTES;
constexpr int XTRA_BYTES = 12288;
constexpr int MISC_OFF = XTRA_OFF + XTRA_BYTES;
constexpr int LDS_BYTES = 147456;
static_assert(MISC_OFF + 256 <= LDS_BYTES, "lds map");
constexpr int NWAVES = 8, NTHR = 512;

__device__ __forceinline__ unsigned f2bf(float f) { unsigned u = __builtin_bit_cast(unsigned, f); return (u + 0x7fffu + ((u >> 16) & 1u)) >> 16; }
typedef __bf16 bf16v2 __attribute__((ext_vector_type(2)));
__device__ __forceinline__ unsigned pk2(float lo, float hi) { const f32x2 v = {lo, hi}; return __builtin_bit_cast(unsigned, __builtin_convertvector(v, bf16v2)); }
__device__ __forceinline__ float bflo(unsigned w) { return __builtin_bit_cast(float, w << 16); }
__device__ __forceinline__ float bfhi(unsigned w) { return __builtin_bit_cast(float, w & 0xffff0000u); }
__device__ __forceinline__ void unpack8(const u32x4 w, float (&f)[8]) { f[0] = bflo(w.x); f[1] = bfhi(w.x); f[2] = bflo(w.y); f[3] = bfhi(w.y); f[4] = bflo(w.z); f[5] = bfhi(w.z); f[6] = bflo(w.w); f[7] = bfhi(w.w); }
__device__ __forceinline__ u32x4 pack8(const float (&f)[8]) { u32x4 w; w.x = pk2(f[0], f[1]); w.y = pk2(f[2], f[3]); w.z = pk2(f[4], f[5]); w.w = pk2(f[6], f[7]); return w; }
__device__ __forceinline__ void ld8(const bf16_t* p, float (&f)[8]) { unpack8(*(const u32x4*)p, f); }
__device__ __forceinline__ void st8(bf16_t* p, const float (&f)[8]) { *(u32x4*)p = pack8(f); }
__device__ __forceinline__ float rcp_(float x) { return __builtin_amdgcn_rcpf(x); }
__device__ __forceinline__ float rsq_(float x) { return __builtin_amdgcn_rsqf(x); }
__device__ __forceinline__ float sigmoidf_(float x) { return rcp_(1.0f + __builtin_amdgcn_exp2f(-1.4426950408889634f * x)); }
__device__ __forceinline__ float tanhf_(float x) { return 2.0f * sigmoidf_(2.0f * x) - 1.0f; }
__device__ __forceinline__ float dpp_f(float x, const int ctrl_sel) {
    const int xi = __builtin_bit_cast(int, x); int r;
    if (ctrl_sel == 0) r = __builtin_amdgcn_update_dpp(0, xi, 0xB1, 0xF, 0xF, true);
    else if (ctrl_sel == 1) r = __builtin_amdgcn_update_dpp(0, xi, 0x4E, 0xF, 0xF, true);
    else if (ctrl_sel == 2) r = __builtin_amdgcn_update_dpp(0, xi, 0x141, 0xF, 0xF, true);
    else r = __builtin_amdgcn_update_dpp(0, xi, 0x140, 0xF, 0xF, true);
    return __builtin_bit_cast(float, r);
}
__device__ __forceinline__ float sum8(float x) { x += dpp_f(x, 0); x += dpp_f(x, 1); x += dpp_f(x, 2); return x; }
__device__ __forceinline__ float wave_sum(float x) {
    x += dpp_f(x, 0); x += dpp_f(x, 1); x += dpp_f(x, 2); x += dpp_f(x, 3);
    const int xi = __builtin_bit_cast(int, x);
    const float r0 = __builtin_bit_cast(float, __builtin_amdgcn_readlane(xi, 0)), r1 = __builtin_bit_cast(float, __builtin_amdgcn_readlane(xi, 16)),
                r2 = __builtin_bit_cast(float, __builtin_amdgcn_readlane(xi, 32)), r3 = __builtin_bit_cast(float, __builtin_amdgcn_readlane(xi, 48));
    return (r0 + r1) + (r2 + r3);
}
namespace pg8 {
constexpr int BM = 256, BK = 64, HALF = 128, HTB = HALF * BK * 2, STAGE_BYTES = 8 * HTB;
__host__ __device__ __forceinline__ int lds_byte(int r, int c) { const int st = (r >> 4) * 2 + (c >> 5), rr = r & 15, cc = c & 31, ob = rr * 64 + cc * 2; return st * 1024 + (ob ^ (((ob >> 9) & 1) << 5)); }
__host__ __device__ __forceinline__ void stage_rc(int b, int& R, int& C) { const int st = b / 1024, sb = b % 1024, swz = sb ^ (((sb >> 9) & 1) << 5); R = (st >> 1) * 16 + swz / 64; C = (st & 1) * 32 + (swz % 64) / 2; }
__host__ __device__ __forceinline__ int perm32(int rho) { const int n = rho >> 4, i = rho & 15; return 8 * (i >> 2) + 4 * n + (i & 3); }
__device__ __forceinline__ unsigned cvt_pk_bf16(float lo, float hi) { unsigned r; asm volatile("v_cvt_pk_bf16_f32 %0, %1, %2" : "=v"(r) : "v"(lo), "v"(hi)); return r; }

struct GUnit { const char* A; const char* B; int pm, pn, x0, x1; };

template <class Epi, class Sched, bool GATHER>
__device__ __forceinline__ void gemm_phase(LAS unsigned char* lds, const int K, const int lda, const int ldb, const Sched& S, const Epi& E) {
    int tid_ = threadIdx.x; asm volatile("" : "+v"(tid_));
    const int tid = tid_, wid = __builtin_amdgcn_readfirstlane(tid >> 6), lane = tid & 63, wr = wid >> 2, wc = wid & 3, fr = lane & 15, fq = lane >> 4;
    const int nt = K / BK;
    int sR[2], sC[2];
    unsigned voffA[2][2], voffB[2], voffAn[2][2];
#pragma unroll
    for (int i = 0; i < 2; ++i) { int R, C; stage_rc(tid * 16 + i * 8192, R, C); sR[i] = R; sC[i] = C; const int Rb = Epi::PERM ? ((R & ~31) + perm32(R & 31)) : R;
        voffB[i] = (unsigned)(Rb * ldb + C) * 2u;
#pragma unroll
        for (int h = 0; h < 2; ++h) { voffA[h][i] = (unsigned)((h * HALF + R) * lda + C) * 2u; voffAn[h][i] = voffA[h][i]; } }
    const size_t kstep = (size_t)(BK * 2);
    const size_t hstepB = (size_t)HALF * ldb * 2;
    const unsigned ldsw = (unsigned)wid * 1024u;
    const int aoff = lds_byte(wr * 64 + fr, fq * 8), boff = lds_byte(wc * 32 + fr, fq * 8);
#define PG8_SA(b, h) (((b) * 2 + (h)) * HTB)
#define PG8_SB(b, h) ((4 + (b) * 2 + (h)) * HTB)
#define PG8_STAGE(bufoff, gbase, voff) do { _Pragma("unroll") for (int _i = 0; _i < 2; ++_i) \
        __builtin_amdgcn_global_load_lds((const unsigned*)((const char*)(gbase) + (voff)[_i]), (LAS unsigned*)(lds + (bufoff) + ldsw + _i * 8192), 16, 0, 0); } while (0)
#define PG8_LDA(dst, b, h) do { _Pragma("unroll") for (int m = 0; m < 4; ++m) _Pragma("unroll") for (int k = 0; k < 2; ++k) dst[m][k] = *(const LAS bf16x8*)(lds + PG8_SA(b, h) + aoff + m * 2048 + k * 1024); } while (0)
#define PG8_LDB(dst, b, h) do { _Pragma("unroll") for (int n = 0; n < 2; ++n) _Pragma("unroll") for (int k = 0; k < 2; ++k) dst[n][k] = *(const LAS bf16x8*)(lds + PG8_SB(b, h) + boff + n * 2048 + k * 1024); } while (0)
#define PG8_MMA(ai, bj, At, Bt) do { __builtin_amdgcn_s_setprio(1); _Pragma("unroll") for (int m = 0; m < 4; ++m) _Pragma("unroll") for (int n = 0; n < 2; ++n) _Pragma("unroll") for (int k = 0; k < 2; ++k) \
        acc[ai][bj][m][n] = __builtin_amdgcn_mfma_f32_16x16x32_bf16(Bt[n][k], At[m][k], acc[ai][bj][m][n], 0, 0, 0); __builtin_amdgcn_s_setprio(0); } while (0)
#define PG8_WAIT_V(n) asm volatile("s_waitcnt vmcnt(" #n ")" ::: "memory")
#define PG8_WAIT_L(n) asm volatile("s_waitcnt lgkmcnt(" #n ")" ::: "memory")
#define PG8_BAR __builtin_amdgcn_s_barrier()
#define PG8_SCHED __builtin_amdgcn_sched_barrier(0)
    GUnit cur, nxt; int ui = 0;
    if (!S.next(0, cur)) return;
    if constexpr (GATHER) {
#pragma unroll
        for (int i = 0; i < 2; ++i)
#pragma unroll
            for (int h = 0; h < 2; ++h) voffA[h][i] = (S.arow(0, h * HALF + sR[i]) * (unsigned)lda + (unsigned)sC[i]) * 2u;
    }
    f32x4 acc[2][2][4][2];
#pragma unroll
    for (int a = 0; a < 2; ++a)
#pragma unroll
        for (int b = 0; b < 2; ++b)
#pragma unroll
            for (int m = 0; m < 4; ++m)
#pragma unroll
                for (int n = 0; n < 2; ++n) acc[a][b][m][n] = (f32x4){0.f, 0.f, 0.f, 0.f};
    bf16x8 At[4][2], B0[2][2], B1[2][2];
    const char* cA = cur.A; const char* cB = cur.B;
    PG8_STAGE(PG8_SB(0, 0), cB, voffB); PG8_STAGE(PG8_SB(0, 1), cB + hstepB, voffB); PG8_STAGE(PG8_SA(0, 0), cA, voffA[0]); PG8_STAGE(PG8_SA(0, 1), cA, voffA[1]);
    if (wr == 1) PG8_BAR;
    PG8_WAIT_V(2); PG8_BAR;
    PG8_STAGE(PG8_SB(1, 0), cB + kstep, voffB); PG8_STAGE(PG8_SA(1, 0), cA + kstep, voffA[0]); PG8_STAGE(PG8_SB(1, 1), cB + hstepB + kstep, voffB);
    PG8_WAIT_V(6); PG8_BAR;
    for (;;) {
        const bool has_next = S.next(ui + 1, nxt);
        const char* nA = has_next ? nxt.A : cA; const char* nB = has_next ? nxt.B : cB;
        if constexpr (GATHER) {
#pragma unroll
            for (int i = 0; i < 2; ++i)
#pragma unroll
                for (int h = 0; h < 2; ++h) voffAn[h][i] = has_next ? (S.arow(ui + 1, h * HALF + sR[i]) * (unsigned)lda + (unsigned)sC[i]) * 2u : voffA[h][i];
        }
#pragma unroll 1
        for (int t = 0; t < nt; t += 2) {
            const bool last = (t == nt - 2);
            const char* a1 = cA + (size_t)(t + 1) * kstep;
            const char* a2 = last ? nA : cA + (size_t)(t + 2) * kstep; const char* b2 = last ? nB : cB + (size_t)(t + 2) * kstep;
            const char* a3 = a2 + kstep; const char* b3 = b2 + kstep;
            unsigned v2[2][2];
#pragma unroll
            for (int i = 0; i < 2; ++i)
#pragma unroll
                for (int h = 0; h < 2; ++h) v2[h][i] = GATHER ? (last ? voffAn[h][i] : voffA[h][i]) : voffA[h][i];
            PG8_LDB(B0, 0, 0); PG8_LDB(B1, 0, 1); PG8_SCHED; PG8_LDA(At, 0, 0); PG8_STAGE(PG8_SA(1, 1), a1, voffA[1]);
            PG8_WAIT_V(8); PG8_WAIT_L(0); PG8_BAR; PG8_MMA(0, 0, At, B0); PG8_MMA(0, 1, At, B1); PG8_BAR; PG8_SCHED;
            PG8_LDA(At, 0, 1); PG8_STAGE(PG8_SB(0, 0), b2, voffB); PG8_STAGE(PG8_SB(0, 1), b2 + hstepB, voffB); PG8_STAGE(PG8_SA(0, 0), a2, v2[0]);
            PG8_WAIT_V(8); PG8_WAIT_L(0); PG8_BAR; PG8_MMA(1, 0, At, B0); PG8_MMA(1, 1, At, B1); PG8_BAR; PG8_SCHED;
            PG8_LDB(B0, 1, 0); PG8_LDB(B1, 1, 1); PG8_SCHED; PG8_LDA(At, 1, 0); PG8_STAGE(PG8_SA(0, 1), a2, v2[1]);
            PG8_WAIT_V(8); PG8_WAIT_L(0); PG8_BAR; PG8_MMA(0, 0, At, B0); PG8_MMA(0, 1, At, B1); PG8_BAR; PG8_SCHED;
            PG8_LDA(At, 1, 1); PG8_STAGE(PG8_SB(1, 0), b3, voffB); PG8_STAGE(PG8_SB(1, 1), b3 + hstepB, voffB); PG8_STAGE(PG8_SA(1, 0), a3, v2[0]);
            PG8_WAIT_V(8); PG8_WAIT_L(0); PG8_BAR; PG8_MMA(1, 0, At, B0); PG8_MMA(1, 1, At, B1); PG8_BAR; PG8_SCHED;
        }
        if (wr == 0) PG8_BAR;
        E(acc, cur, wr, wc, fr, fq);
        if (!has_next) break;
        if (!(Epi::CHAIN && cur.x1 != 0)) {
#pragma unroll
        for (int a = 0; a < 2; ++a)
#pragma unroll
            for (int b = 0; b < 2; ++b)
#pragma unroll
                for (int m = 0; m < 4; ++m)
#pragma unroll
                    for (int n = 0; n < 2; ++n) acc[a][b][m][n] = (f32x4){0.f, 0.f, 0.f, 0.f};
        }
        cur = nxt; cA = nA; cB = nB; ++ui;
        if constexpr (GATHER) {
#pragma unroll
            for (int i = 0; i < 2; ++i)
#pragma unroll
                for (int h = 0; h < 2; ++h) voffA[h][i] = voffAn[h][i];
        }
        if (wr == 1) PG8_BAR;
    }
    PG8_WAIT_V(0);
    PG8_BAR;
#undef PG8_SA
#undef PG8_SB
#undef PG8_STAGE
#undef PG8_LDA
#undef PG8_LDB
#undef PG8_MMA
#undef PG8_WAIT_V
#undef PG8_WAIT_L
#undef PG8_BAR
#undef PG8_SCHED
}
}
namespace pg8 {
struct EpiProj {
    static constexpr bool PERM = true, CHAIN = false;
    bf16_t* P; unsigned char* GT;
    __device__ __forceinline__ void operator()(f32x4 (&acc)[2][2][4][2], const GUnit& u, int wr, int wc, int fr, int fq) const {
        const int row0 = u.pm * BM + wr * 64 + fr;
#pragma unroll
        for (int bj = 0; bj < 2; ++bj) {
            const int ct = u.pn * BM + bj * HALF;
            if (ct >= NCOLS_IN) continue;
            const bool sig = ct >= C_GT;
            const int col0 = ct + wc * 32 + 8 * fq;
#pragma unroll
            for (int ai = 0; ai < 2; ++ai)
#pragma unroll
                for (int m = 0; m < 4; ++m) {
                    const f32x4 v0 = acc[ai][bj][m][0], v1 = acc[ai][bj][m][1];
                    const size_t row = (size_t)(row0 + ai * HALF + m * 16);
                    if (sig) {
                        unsigned q[8];
#pragma unroll
                        for (int j = 0; j < 4; ++j) { q[j] = (unsigned)fmaxf(255.0f * sigmoidf_(v0[j]) + 0.5f, 1.0f); q[4 + j] = (unsigned)fmaxf(255.0f * sigmoidf_(v1[j]) + 0.5f, 1.0f); }
                        u32x2 w; w.x = q[0] | (q[1] << 8) | (q[2] << 16) | (q[3] << 24); w.y = q[4] | (q[5] << 8) | (q[6] << 16) | (q[7] << 24);
                        *(u32x2*)(GT + row * 3072 + (col0 - C_GT)) = w;
                    } else {
                        u32x4 w; w.x = cvt_pk_bf16(v0[0], v0[1]); w.y = cvt_pk_bf16(v0[2], v0[3]); w.z = cvt_pk_bf16(v1[0], v1[1]); w.w = cvt_pk_bf16(v1[2], v1[3]);
                        *(u32x4*)(P + row * PW + col0) = w;
                    }
                }
        }
    }
};
struct EpiLowRank {
    static constexpr bool PERM = true, CHAIN = false;
    bf16_t* W; const float* w0; const float* a0;
    __device__ __forceinline__ void operator()(f32x4 (&acc)[2][2][4][2], const GUnit& u, int wr, int wc, int fr, int fq) const {
        const int row0 = u.pm * BM + wr * 64 + fr;
#pragma unroll
        for (int bj = 0; bj < 2; ++bj) {
            const int ct = u.pn * BM + bj * HALF;
            const int col0 = ct + wc * 32 + 8 * fq;
            const int mode = ct < 1024 ? 0 : (ct < 2048 ? 1 : 2);
            float bias[8];
#pragma unroll
            for (int j = 0; j < 8; ++j) bias[j] = mode == 0 ? w0[col0 + j] : (mode == 1 ? a0[col0 - 1024 + j] : 0.f);
#pragma unroll
            for (int ai = 0; ai < 2; ++ai)
#pragma unroll
                for (int m = 0; m < 4; ++m) {
                    float v[8];
#pragma unroll
                    for (int j = 0; j < 4; ++j) { v[j] = acc[ai][bj][m][0][j] + bias[j]; v[4 + j] = acc[ai][bj][m][1][j] + bias[4 + j]; }
                    if (mode == 0) {
#pragma unroll
                        for (int j = 0; j < 8; ++j) v[j] = 0.60653066f * sigmoidf_(v[j]);
                    } else if (mode == 1) {
#pragma unroll
                        for (int j = 0; j < 8; ++j) v[j] = sigmoidf_(v[j]);
                    }
                    u32x4 w; w.x = cvt_pk_bf16(v[0], v[1]); w.y = cvt_pk_bf16(v[2], v[3]); w.z = cvt_pk_bf16(v[4], v[5]); w.w = cvt_pk_bf16(v[6], v[7]);
                    *(u32x4*)(W + (size_t)(row0 + ai * HALF + m * 16) * WAGW + col0) = w;
                    asm volatile("" ::: "memory");
                }
        }
    }
};
__device__ __forceinline__ void ldg8(const unsigned char* p, float (&g)[8]) {
    const u32x2 w = *(const u32x2*)p;
#pragma unroll
    for (int j = 0; j < 4; ++j) { g[j] = (float)((w.x >> (8 * j)) & 255u) * (1.0f / 255.0f); g[4 + j] = (float)((w.y >> (8 * j)) & 255u) * (1.0f / 255.0f); }
}
struct EpiMerge {
    static constexpr bool PERM = true, CHAIN = true;
    const unsigned char* GT; bf16_t* M;
    __device__ __forceinline__ void operator()(f32x4 (&acc)[2][2][4][2], const GUnit& u, int wr, int wc, int fr, int fq) const {
        const int row0 = u.pm * BM + wr * 64 + fr; const int br = u.x0;
#pragma unroll
        for (int bj = 0; bj < 2; ++bj) {
            const int col0 = u.pn * BM + bj * HALF + wc * 32 + 8 * fq;
#pragma unroll
            for (int ai = 0; ai < 2; ++ai)
#pragma unroll
                for (int m = 0; m < 4; ++m) {
                    const size_t row = (size_t)(row0 + ai * HALF + m * 16);
                    float g[8];
                    ldg8(GT + row * 3072 + br * 1024 + col0, g);
                    if (br < 2) {
                        float gn[8];
                        ldg8(GT + row * 3072 + (br + 1) * 1024 + col0, gn);
#pragma unroll
                        for (int j = 0; j < 8; ++j) g[j] = g[j] * rcp_(fmaxf(gn[j], 1.0f / 512.0f));
#pragma unroll
                        for (int j = 0; j < 4; ++j) { acc[ai][bj][m][0][j] *= g[j]; acc[ai][bj][m][1][j] *= g[4 + j]; }
                    } else {
                        float o[8];
#pragma unroll
                        for (int j = 0; j < 4; ++j) { o[j] = g[j] * acc[ai][bj][m][0][j]; o[4 + j] = g[4 + j] * acc[ai][bj][m][1][j]; }
                        st8(M + row * DM + col0, o);
                    }
                }
        }
    }
};
struct EpiOut {
    static constexpr bool PERM = true, CHAIN = false;
    bf16_t* XB; const float* mod;
    __device__ __forceinline__ void operator()(f32x4 (&acc)[2][2][4][2], const GUnit& u, int wr, int wc, int fr, int fq) const {
        const int rt = u.pm * BM; const int modrow = rt < NLAT ? (rt >> 11) : 16;
        const float* g1 = mod + (size_t)modrow * 6144 + 2048;
        const int row0 = rt + wr * 64 + fr;
#pragma unroll
        for (int bj = 0; bj < 2; ++bj) {
            const int col0 = u.pn * BM + bj * HALF + wc * 32 + 8 * fq;
            const f32x4 ga = *(const f32x4*)(g1 + col0), gb = *(const f32x4*)(g1 + col0 + 4);
#pragma unroll
            for (int ai = 0; ai < 2; ++ai)
#pragma unroll
                for (int m = 0; m < 4; ++m) {
                    bf16_t* xp = XB + (size_t)(row0 + ai * HALF + m * 16) * DM + col0;
                    float x[8]; ld8(xp, x);
#pragma unroll
                    for (int j = 0; j < 4; ++j) { x[j] += ga[j] * acc[ai][bj][m][0][j]; x[4 + j] += gb[j] * acc[ai][bj][m][1][j]; }
                    st8(xp, x);
                }
        }
    }
};
struct EpiUp {
    static constexpr bool PERM = true, CHAIN = false;
    bf16_t* HID;
    __device__ __forceinline__ void operator()(f32x4 (&acc)[2][2][4][2], const GUnit& u, int wr, int wc, int fr, int fq) const {
        const int row0 = u.x0 * PAIRS_E + u.pm * BM + wr * 64 + fr;
        const int col0 = u.pn * HALF + wc * 32 + 8 * fq;
#pragma unroll
        for (int ai = 0; ai < 2; ++ai)
#pragma unroll
            for (int m = 0; m < 4; ++m) {
                float v[8];
#pragma unroll
                for (int j = 0; j < 4; ++j) {
                    const float g0 = acc[ai][0][m][0][j], g1 = acc[ai][0][m][1][j];
                    v[j] = g0 * sigmoidf_(g0) * acc[ai][1][m][0][j]; v[4 + j] = g1 * sigmoidf_(g1) * acc[ai][1][m][1][j];
                }
                u32x4 w; w.x = cvt_pk_bf16(v[0], v[1]); w.y = cvt_pk_bf16(v[2], v[3]); w.z = cvt_pk_bf16(v[4], v[5]); w.w = cvt_pk_bf16(v[6], v[7]);
                *(u32x4*)(HID + (size_t)(row0 + ai * HALF + m * 16) * EFF + col0) = w;
            }
    }
};
struct EpiDown {
    static constexpr bool PERM = true, CHAIN = false;
    bf16_t* YE;
    __device__ __forceinline__ void operator()(f32x4 (&acc)[2][2][4][2], const GUnit& u, int wr, int wc, int fr, int fq) const {
        const int row0 = u.x0 * PAIRS_E + u.pm * BM + wr * 64 + fr;
#pragma unroll
        for (int bj = 0; bj < 2; ++bj) {
            const int col0 = u.pn * BM + bj * HALF + wc * 32 + 8 * fq;
#pragma unroll
            for (int ai = 0; ai < 2; ++ai)
#pragma unroll
                for (int m = 0; m < 4; ++m) {
                    const f32x4 v0 = acc[ai][bj][m][0], v1 = acc[ai][bj][m][1];
                    u32x4 w; w.x = cvt_pk_bf16(v0[0], v0[1]); w.y = cvt_pk_bf16(v0[2], v0[3]); w.z = cvt_pk_bf16(v1[0], v1[1]); w.w = cvt_pk_bf16(v1[2], v1[3]);
                    *(u32x4*)(YE + (size_t)(row0 + ai * HALF + m * 16) * DM + col0) = w;
                }
        }
    }
};

struct PlainOrder {
    const char* A; const char* B; int nM, nN, nwg, G, c; size_t astep, bstep;
    __device__ __forceinline__ void init(const void* A_, const void* B_, int M, int N, int lda, int ldb, int G_, int c_) { A = (const char*)A_; B = (const char*)B_; nM = M / BM; nN = N / BM; nwg = nM * nN; G = G_; c = c_; astep = (size_t)BM * lda * 2; bstep = (size_t)BM * ldb * 2; }
    __device__ __forceinline__ bool next(int i, GUnit& u) const {
        const long L = (long)i * G + c; if (L >= nwg) return false;
        int wgid = (int)L; { const int q = nwg / 8, r = nwg % 8, xcd = wgid % 8, off = wgid / 8; wgid = (xcd < r ? xcd * (q + 1) : r * (q + 1) + (xcd - r) * q) + off; }
#ifndef PG8_WGM
#define PG8_WGM 8
#endif
        const int nig = PG8_WGM * nN, gid = wgid / nig, fm = gid * PG8_WGM, gsz = (nM - fm) < PG8_WGM ? (nM - fm) : PG8_WGM;
        u.pm = fm + ((wgid % nig) % gsz); u.pn = (wgid % nig) / gsz; u.x0 = 0; u.x1 = 0;
        u.A = A + (size_t)u.pm * astep; u.B = B + (size_t)u.pn * bstep; return true;
    }
    __device__ __forceinline__ unsigned arow(int, int) const { return 0u; }
};
struct LastProjOrder {
    PlainOrder lat; const char* A; const char* B; size_t astep, bstep;
    __device__ __forceinline__ void init(const void* A_, const void* B_, int lda, int ldb, int G_, int c_) { lat.init(A_, B_, NLAT, PWP, lda, ldb, G_, c_); A = (const char*)A_; B = (const char*)B_; astep = (size_t)BM * lda * 2; bstep = (size_t)BM * ldb * 2; }
    __device__ __forceinline__ bool next(int i, GUnit& u) const {
        const long L = (long)i * lat.G + lat.c;
        if (L < lat.nwg) return lat.next(i, u);
        const int r = (int)(L - lat.nwg); if (r >= (NCTX / BM) * 8) return false;
        u.pm = NLAT / BM + r / 8; u.pn = 2 + (r % 8); u.x0 = 0; u.x1 = 0;
        u.A = A + (size_t)u.pm * astep; u.B = B + (size_t)u.pn * bstep; return true;
    }
    __device__ __forceinline__ unsigned arow(int, int) const { return 0u; }
};
struct LowRankOrder {
    const char* A; const char* B; int nM, G, c;
    __device__ __forceinline__ bool next(int i, GUnit& u) const {
        const long L = (long)i * G + c; if (L >= (long)nM * 10) return false;
        u.pm = (int)(L / 10); u.pn = (int)(L % 10); u.x0 = 0; u.x1 = 0;
        const int kwin = u.pn < 4 ? 0 : (u.pn < 8 ? 128 : 256);
        u.A = A + ((size_t)u.pm * BM * LRAW + kwin) * 2; u.B = B + (size_t)u.pn * BM * 128 * 2; return true;
    }
    __device__ __forceinline__ unsigned arow(int, int) const { return 0u; }
};
struct MergeOrder {
    const char* P; const char* W; int nM, G, c;
    __device__ __forceinline__ bool next(int i, GUnit& u) const {
        const long tl = (long)(i / 3) * G + c; if (tl >= (long)nM * 4) return false;
        const int tile = (int)tl, br = i % 3;
        u.pm = tile >> 2; u.pn = tile & 3; u.x0 = br; u.x1 = br < 2 ? 1 : 0;
        const int acol = br == 0 ? C_OATT : (br == 1 ? C_ORWKV : C_OCONV);
        u.A = P + ((size_t)u.pm * BM * PW + acol) * 2; u.B = W + ((size_t)br * 1024 * 512 + (size_t)u.pn * BM * 512) * 2; return true;
    }
    __device__ __forceinline__ unsigned arow(int, int) const { return 0u; }
};
struct MoeOrder {
    const char* A; const char* W; const LAS int* rows; int mt_per, npn, G, c; size_t wexp;
    __device__ __forceinline__ bool decode(long L, int& e, int& mt, int& pn) const {
        const int per_e = mt_per * npn; if (L >= (long)NEXP * per_e) return false;
        e = (int)(L / per_e); const int r = (int)(L % per_e); pn = r / mt_per; mt = r % mt_per; return true;
    }
    __device__ __forceinline__ bool next(int i, GUnit& u) const {
        int e, mt, pn; if (!decode((long)i * G + c, e, mt, pn)) return false;
        u.pm = mt; u.pn = pn; u.x0 = e; u.x1 = 0;
        u.A = A; u.B = W + (size_t)e * wexp + (size_t)pn * BM * 1024 * 2; return true;
    }
    __device__ __forceinline__ unsigned arow(int i, int r) const { return (unsigned)rows[i * 256 + r]; }
};
struct MoeDownOrder {
    const char* A; const char* W; int mt_per, G, c;
    __device__ __forceinline__ bool next(int i, GUnit& u) const {
        const long L = (long)i * G + c; const int per_e = mt_per * 4; if (L >= (long)NEXP * per_e) return false;
        const int e = (int)(L / per_e), r = (int)(L % per_e); u.pn = r / mt_per; u.pm = r % mt_per; u.x0 = e; u.x1 = 0;
        u.A = A + ((size_t)e * PAIRS_E + (size_t)u.pm * BM) * EFF * 2; u.B = W + ((size_t)e * 1024 + (size_t)u.pn * BM) * 1024 * 2; return true;
    }
    __device__ __forceinline__ unsigned arow(int, int) const { return 0u; }
};
}
namespace attn_body {
using bf16=__hip_bfloat16;
using bf16x8=__attribute__((ext_vector_type(8)))short;
using s16x4=__attribute__((ext_vector_type(4)))short;
using f32x16=__attribute__((ext_vector_type(16)))float;
using u32x4=__attribute__((ext_vector_type(4)))unsigned;
constexpr int D=64,DM=4224;
constexpr int NW=8,QBLK=32,QB=QBLK*NW,KVBLK=64;
constexpr int ATTN_PITCH=DM, ATTN_UNIT_ROWS=QB;
__device__ __forceinline__ int crow(int r,int hi){return (r&3)+8*(r>>2)+4*hi;}
#define SBAR() __builtin_amdgcn_sched_barrier(0)
__device__ __forceinline__ void cmask(f32x16&p0,f32x16&p1,int jb,int qrel,int hi){
  const float NEG=-INFINITY; int kb=64*jb+4*hi;
  #pragma unroll
  for(int r=0;r<16;++r){int kv=kb+(r&3)+8*(r>>2); if(kv>qrel)p0[r]=NEG; if(kv+32>qrel)p1[r]=NEG;}
}

constexpr int NSLOT=3, SLOTB=8192;
constexpr int LDS_K=0, LDS_V=NSLOT*SLOTB, LDS_WS=2*NSLOT*SLOTB, LDS_OST=LDS_WS+NW*64*4, LDS_BYTES=LDS_OST+NW*4096;
constexpr float C2=0.125f*1.4426950408889634f;
__device__ __forceinline__ void glds16(const void*gsrc,unsigned lds_dst){unsigned keep;
  asm volatile("s_mov_b32 %0, m0\n\ts_mov_b32 m0, %2\n\ts_nop 0\n\tglobal_load_lds_dwordx4 %1, off\n\ts_mov_b32 m0, %0":"=&s"(keep):"v"(gsrc),"s"(lds_dst):"memory");}
__device__ __forceinline__ float max3f(float a,float b,float c){float r;asm("v_max3_f32 %0, %1, %2, %3":"=v"(r):"v"(a),"v"(b),"v"(c));return r;}
__device__ __forceinline__ float max2f(float a,float b){float r;asm("v_max_f32_e32 %0, %1, %2":"=v"(r):"v"(a),"v"(b));return r;}
__device__ __forceinline__ float fadd_s(float a,float b){float r;asm("v_add_f32_e32 %0, %1, %2":"=v"(r):"v"(a),"v"(b));return r;}
__device__ __forceinline__ float fsub_s(float a,float b){float r;asm("v_sub_f32_e32 %0, %1, %2":"=v"(r):"v"(a),"v"(b));return r;}
typedef float f32x2_t __attribute__((ext_vector_type(2))); typedef __bf16 bf16x2_t __attribute__((ext_vector_type(2)));
__device__ __forceinline__ unsigned cvtpk_s(float lo,float hi){f32x2_t v={lo,hi};bf16x2_t b=__builtin_convertvector(v,bf16x2_t);return __builtin_bit_cast(unsigned,b);}
#define WAIT_BAR(N) asm volatile("s_waitcnt vmcnt(" #N ") lgkmcnt(0)\n\ts_barrier":::"memory")

__device__ __forceinline__ void qkt(f32x16&p0,f32x16&p1,const char*Kslot,const bf16x8*qr,const f32x16&negm,int r32,int hi){
  const char*kb=Kslot+hi*1024+r32*16;
  #pragma unroll
  for(int d0=0;d0<4;++d0){
    const bf16x8 b0=*reinterpret_cast<const bf16x8*>(kb+d0*2048);
    const bf16x8 b1=*reinterpret_cast<const bf16x8*>(kb+d0*2048+512);
    if(d0==0){p0=__builtin_amdgcn_mfma_f32_32x32x16_bf16(b0,qr[0],negm,0,0,0);p1=__builtin_amdgcn_mfma_f32_32x32x16_bf16(b1,qr[0],negm,0,0,0);}
    else{p0=__builtin_amdgcn_mfma_f32_32x32x16_bf16(b0,qr[d0],p0,0,0,0);p1=__builtin_amdgcn_mfma_f32_32x32x16_bf16(b1,qr[d0],p1,0,0,0);}}
}
typedef __attribute__((address_space(3))) const char* lds_cptr;
typedef short v4i16_t __attribute__((ext_vector_type(4)));
__device__ __forceinline__ void kload8(bf16x8*kf,lds_cptr kp){
  kf[0]=*(const __attribute__((address_space(3))) bf16x8*)(kp);      kf[1]=*(const __attribute__((address_space(3))) bf16x8*)(kp+512);
  kf[2]=*(const __attribute__((address_space(3))) bf16x8*)(kp+2048); kf[3]=*(const __attribute__((address_space(3))) bf16x8*)(kp+2560);
  kf[4]=*(const __attribute__((address_space(3))) bf16x8*)(kp+4096); kf[5]=*(const __attribute__((address_space(3))) bf16x8*)(kp+4608);
  kf[6]=*(const __attribute__((address_space(3))) bf16x8*)(kp+6144); kf[7]=*(const __attribute__((address_space(3))) bf16x8*)(kp+6656);
}
__device__ __forceinline__ void kload2(bf16x8*kf,lds_cptr kp,int j){ kf[2*j]=*(const __attribute__((address_space(3))) bf16x8*)(kp+j*2048); kf[2*j+1]=*(const __attribute__((address_space(3))) bf16x8*)(kp+j*2048+512); }
__device__ __forceinline__ s16x4 vtr(lds_cptr p){ return __builtin_bit_cast(s16x4,__builtin_amdgcn_ds_read_tr16_b64_v4i16((__attribute__((address_space(3))) v4i16_t*)p)); }
__device__ __forceinline__ float rowmax(const f32x16&p0,const f32x16&p1){
  float a=max3f(p0[0],p0[1],p1[0]),b=max3f(p0[2],p0[3],p1[1]);a=max3f(a,p1[2],p1[3]);
  #pragma unroll
  for(int r=4;r<16;r+=4){a=max3f(a,p0[r],p0[r+1]);b=max3f(b,p0[r+2],p0[r+3]);a=max3f(a,p1[r],p1[r+1]);b=max3f(b,p1[r+2],p1[r+3]);}
  const float m=max2f(a,b);
  auto rr=__builtin_amdgcn_permlane32_swap(__float_as_uint(m),__float_as_uint(m),false,false);
  return max2f(__uint_as_float(rr[0]),__uint_as_float(rr[1]));
}
__device__ __forceinline__ void pv(f32x16*o,int vb,bf16x8 pa0,bf16x8 pa1,bf16x8 pa2,bf16x8 pa3){
  #pragma unroll
  for(int d0=0;d0<2;++d0){s16x4 lo[4],hi[4];
    #pragma unroll
    for(int ks=0;ks<4;++ks){
      asm volatile("ds_read_b64_tr_b16 %0,%1 offset:%c2":"=&v"(lo[ks]):"v"(vb),"i"(d0*4096+ks*1024):"memory");
      asm volatile("ds_read_b64_tr_b16 %0,%1 offset:%c2":"=&v"(hi[ks]):"v"(vb),"i"(d0*4096+ks*1024+512):"memory");}
    asm volatile("s_waitcnt lgkmcnt(0)":::"memory");SBAR();
    #define PK(k) (bf16x8){lo[k][0],lo[k][1],lo[k][2],lo[k][3],hi[k][0],hi[k][1],hi[k][2],hi[k][3]}
    o[d0]=__builtin_amdgcn_mfma_f32_32x32x16_bf16(pa0,PK(0),o[d0],0,0,0);
    o[d0]=__builtin_amdgcn_mfma_f32_32x32x16_bf16(pa1,PK(1),o[d0],0,0,0);
    o[d0]=__builtin_amdgcn_mfma_f32_32x32x16_bf16(pa2,PK(2),o[d0],0,0,0);
    o[d0]=__builtin_amdgcn_mfma_f32_32x32x16_bf16(pa3,PK(3),o[d0],0,0,0);
    #undef PK
  }
}

#ifndef ATTN_STORE16
#define ATTN_STORE16(p,v) (*(u32x4*)(p)=(v))
#endif
template<int THRL> __device__ __forceinline__ void attn_unit(const bf16*Qu,bf16*Ou,const bf16*KV0,const int crow0,const int lrow0,const int NT,const int nct,char*shm){
  constexpr int VOFF=128;
  int tid_=threadIdx.x; asm volatile("":"+v"(tid_)); const int tid=tid_,lane=tid&63,r32=lane&31,hi=lane>>5; const int wid=__builtin_amdgcn_readfirstlane(tid>>6);
  const bf16*Qw=Qu+(long)(wid*QBLK)*DM;
  const unsigned lds0=(unsigned)(uintptr_t)shm;
  float*wsf=(float*)(shm+LDS_WS)+wid*64;
  const long klane=(long)lane*DM+wid*8;
  const long vlane=(long)(16*(wid&3)+(lane>>2))*DM+(wid>>2)*32+(lane&3)*8;
  const unsigned kdst=lds0+LDS_K+wid*1024, vdst=lds0+LDS_V+wid*1024;
  #define KTILE(t) (KV0+(long)(((t)<nct)?(crow0+(t)*KVBLK):(lrow0+((t)-nct)*KVBLK))*DM)
  #define VTILE(t) (KTILE(t)+VOFF)
  #define DMA_K(t,slot) glds16(KTILE(t)+klane,(unsigned)__builtin_amdgcn_readfirstlane(kdst+(slot)))
  #define DMA_V(t,slot) glds16(VTILE(t)+vlane,(unsigned)__builtin_amdgcn_readfirstlane(vdst+(slot)))
  const int vb0=(int)(lds0+LDS_V)+((lane>>4)&1)*32+(lane&3)*8+(4*hi+((lane&15)>>2))*64;
  const char*Kbase=shm+LDS_K; bf16x8 kf[8];
  const lds_cptr shm3=(lds_cptr)shm; const lds_cptr kp0=shm3+LDS_K+hi*1024+r32*16; const lds_cptr vp0=shm3+LDS_V+((lane>>4)&1)*32+(lane&3)*8+(4*hi+((lane&15)>>2))*64;
  DMA_K(0,0);DMA_V(0,0);DMA_K(1,SLOTB);
  bf16x8 qr[4];
  #pragma unroll
  for(int d0=0;d0<4;++d0)qr[d0]=*reinterpret_cast<const bf16x8*>(&Qw[(long)r32*DM+d0*16+hi*8]);
  float mhat=0.f,l_reg=0.f;f32x16 o[2];o[0]=f32x16{};o[1]=f32x16{};f32x16 negm=f32x16{};asm volatile("":"+v"(negm));
  #define CMASK(P0,P1,t) do{}while(0)
  bool resc=false;
#ifndef ATTN_NOMAX
#define ATTN_NOMAX 1
#endif
#if ATTN_NOMAX
  #define START(P0,P1) do{ resc=false; _Pragma("unroll") for(int r=0;r<16;++r)P0[r]=__builtin_amdgcn_exp2f(P0[r]); }while(0)
#else
  #define START(P0,P1) do{ const float rm=rowmax(P0,P1); resc=false; \
    { const float dl=rm; mhat=fadd_s(mhat,dl); \
      _Pragma("unroll") for(int r=0;r<16;++r){P0[r]=fsub_s(P0[r],dl);P1[r]=fsub_s(P1[r],dl);} \
      _Pragma("unroll") for(int r=0;r<16;++r)negm[r]=-mhat; asm volatile("":"+v"(negm)); } \
    _Pragma("unroll") for(int r=0;r<16;++r)P0[r]=__builtin_amdgcn_exp2f(P0[r]); }while(0)
#endif
  #define RESC() do{ if(resc){ asm volatile("s_waitcnt lgkmcnt(0)":::"memory"); \
      _Pragma("unroll") for(int d_=0;d_<2;++d_) _Pragma("unroll") for(int r=0;r<16;++r)o[d_][r]*=wsf[crow(r,hi)]; } }while(0)
  f32x16 pA0,pA1,pB0,pB1;
  int sl_prev=0,sl_cur=0,sl_next=SLOTB;
  #define ROT() do{sl_prev=sl_cur;sl_cur=sl_next;sl_next=(sl_next==(NSLOT-1)*SLOTB)?0:sl_next+SLOTB;}while(0)
  DMA_K(2,2*SLOTB);
  WAIT_BAR(3);
  qkt(pA0,pA1,Kbase,qr,negm,r32,hi);asm volatile("s_nop 15\n\ts_nop 7":"+v"(pA0),"+v"(pA1));CMASK(pA0,pA1,0);
  START(pA0,pA1);
  _Pragma("unroll") for(int r=0;r<16;++r)pA1[r]=__builtin_amdgcn_exp2f(pA1[r]);
  WAIT_BAR(0);
  DMA_K(3,0);DMA_V(1,SLOTB);
  ROT();
  kload8(kf,kp0+sl_cur);
  WAIT_BAR(2);
  s16x4 vlo[8],vhi[8]; u32x4 pw0,pw1,pw2,pw3;
  #define PKW(P,B) cvtpk_s(P[B],P[B+1])
  #define PAF(k) __builtin_bit_cast(bf16x8,pw##k)
  #define VFR(i) (bf16x8){vlo[i][0],vlo[i][1],vlo[i][2],vlo[i][3],vhi[i][0],vhi[i][1],vhi[i][2],vhi[i][3]}
  #define PIN(x) asm volatile("":"+v"(x))
  #define MX3(a,b,c) __builtin_fmaxf(__builtin_fmaxf((a),(b)),(c))
  #define GAPA(MF,A0,A1,A2,A3,W0,W1,PW) do{ MF; sacc+=A0; sacc+=A1; sacc+=A2; sacc+=A3; PIN(sacc); W0; W1; PIN(PW); SBAR(); }while(0)
  #define EX(v) __builtin_amdgcn_exp2f(v)
  #define GAPB(MF,X,B) do{ MF; X[B]=EX(X[B]); X[B+1]=EX(X[B+1]); X[B+2]=EX(X[B+2]); X[B+3]=EX(X[B+3]); PIN(X); SBAR(); }while(0)
  #define VRD(i) do{ vlo[i]=vtr(vp_+(((i)>>2)*4096+((i)&3)*1024)); vhi[i]=vtr(vp_+(((i)>>2)*4096+((i)&3)*1024+512)); }while(0)
  #define KRD(G,j) do{ if(G){ kload2(kf,kp0+sl_next,j); SBAR(); } }while(0)
#if ATTN_NOMAX
  #define ROWMAX_BLOCK(C0,C1) do{ resc=false; }while(0)
#else
  #define ROWMAX_BLOCK(C0,C1) do    { float a=MX3(C0[0],C0[1],C1[0]),b=MX3(C0[2],C0[3],C1[1]); a=MX3(a,C1[2],C1[3]); \
      _Pragma("unroll") for(int r=4;r<16;r+=4){a=MX3(a,C0[r],C0[r+1]);b=MX3(b,C0[r+2],C0[r+3]);a=MX3(a,C1[r],C1[r+1]);b=MX3(b,C1[r+2],C1[r+3]);} \
      float rm=__builtin_fmaxf(a,b); { auto rr=__builtin_amdgcn_permlane32_swap(__float_as_uint(rm),__float_as_uint(rm),false,false); rm=__builtin_fmaxf(__uint_as_float(rr[0]),__uint_as_float(rr[1])); } \
      resc=false; \
      if(__builtin_expect(__any(rm>(float)THRL),0)){ const float dl=__builtin_fmaxf(rm,0.f); mhat+=dl; \
        _Pragma("unroll") for(int r=0;r<16;++r){C0[r]-=dl;C1[r]-=dl;} \
        _Pragma("unroll") for(int r=0;r<16;++r)negm[r]=-mhat; asm volatile("":"+v"(negm)); \
        const float f=__builtin_amdgcn_exp2f(-dl); l_reg*=f; if(hi==0)wsf[r32]=f; resc=true; } } while(0)
#endif
  #define STEP(C0,C1,P0,P1,t,GK,GV,GL) do{ SBAR(); \
    const lds_cptr vp_=vp0+sl_prev; \
    VRD(0); SBAR(); float sacc=(P0[0]+P0[1]); \
    GAPA(C0=__builtin_amdgcn_mfma_f32_32x32x16_bf16(kf[0],qr[0],negm,0,0,0), P0[2],P0[3],P0[4],P0[5],     pw0[0]=PKW(P0,0), pw0[1]=PKW(P0,2), pw0); \
    VRD(4); SBAR(); GAPA(C1=__builtin_amdgcn_mfma_f32_32x32x16_bf16(kf[1],qr[0],negm,0,0,0), P0[6],P0[7],P0[8],P0[9],     pw0[2]=PKW(P0,4), pw0[3]=PKW(P0,6), pw0); \
    VRD(1); SBAR(); GAPA(C0=__builtin_amdgcn_mfma_f32_32x32x16_bf16(kf[2],qr[1],C0,0,0,0),   P0[10],P0[11],P0[12],P0[13], pw1[0]=PKW(P0,8), pw1[1]=PKW(P0,10), pw1); \
    VRD(5); SBAR(); GAPA(C1=__builtin_amdgcn_mfma_f32_32x32x16_bf16(kf[3],qr[1],C1,0,0,0),   P0[14],P0[15],P1[0],P1[1],   pw1[2]=PKW(P0,12),pw1[3]=PKW(P0,14), pw1); \
    VRD(2); SBAR(); GAPA(C0=__builtin_amdgcn_mfma_f32_32x32x16_bf16(kf[4],qr[2],C0,0,0,0),   P1[2],P1[3],P1[4],P1[5],     pw2[0]=PKW(P1,0), pw2[1]=PKW(P1,2), pw2); \
    VRD(6); SBAR(); GAPA(C1=__builtin_amdgcn_mfma_f32_32x32x16_bf16(kf[5],qr[2],C1,0,0,0),   P1[6],P1[7],P1[8],P1[9],     pw2[2]=PKW(P1,4), pw2[3]=PKW(P1,6), pw2); \
    VRD(3); SBAR(); GAPA(C0=__builtin_amdgcn_mfma_f32_32x32x16_bf16(kf[6],qr[3],C0,0,0,0),   P1[10],P1[11],P1[12],P1[13], pw3[0]=PKW(P1,8), pw3[1]=PKW(P1,10), pw3); \
    VRD(7); SBAR(); GAPA(C1=__builtin_amdgcn_mfma_f32_32x32x16_bf16(kf[7],qr[3],C1,0,0,0),   P1[14],P1[15],0.f,0.f,       pw3[2]=PKW(P1,12),pw3[3]=PKW(P1,14), pw3); \
    l_reg+=sacc; \
    if(GK){DMA_K((t)+3,sl_cur);} if(GV){DMA_V((t)+1,sl_next);} \
    CMASK(C0,C1,t); \
    ROWMAX_BLOCK(C0,C1); \
    SBAR(); \
    GAPB(o[0]=__builtin_amdgcn_mfma_f32_32x32x16_bf16(PAF(0),VFR(0),o[0],0,0,0), C0,0); \
    GAPB(o[1]=__builtin_amdgcn_mfma_f32_32x32x16_bf16(PAF(0),VFR(4),o[1],0,0,0), C0,4); \
    KRD(GL,0); GAPB(o[0]=__builtin_amdgcn_mfma_f32_32x32x16_bf16(PAF(1),VFR(1),o[0],0,0,0), C0,8); \
    KRD(GL,1); GAPB(o[1]=__builtin_amdgcn_mfma_f32_32x32x16_bf16(PAF(1),VFR(5),o[1],0,0,0), C0,12); \
    KRD(GL,2); GAPB(o[0]=__builtin_amdgcn_mfma_f32_32x32x16_bf16(PAF(2),VFR(2),o[0],0,0,0), C1,0); \
    KRD(GL,3); GAPB(o[1]=__builtin_amdgcn_mfma_f32_32x32x16_bf16(PAF(2),VFR(6),o[1],0,0,0), C1,4); \
    GAPB(o[0]=__builtin_amdgcn_mfma_f32_32x32x16_bf16(PAF(3),VFR(3),o[0],0,0,0), C1,8); \
    GAPB(o[1]=__builtin_amdgcn_mfma_f32_32x32x16_bf16(PAF(3),VFR(7),o[1],0,0,0), C1,12); \
    }while(0)
  int t=1;
  #undef CMASK
  #define CMASK(P0,P1,t) do{}while(0)
  for(;t+5<NT;t+=2){
    STEP(pB0,pB1,pA0,pA1,t,true,true,true);     WAIT_BAR(2); RESC(); ROT();
    STEP(pA0,pA1,pB0,pB1,t+1,true,true,true);   WAIT_BAR(2); RESC(); ROT();
  }
  #undef CMASK
  #define CMASK(P0,P1,t) do{}while(0)
  #define ENDW(tt) do{ if((tt)+3<NT){WAIT_BAR(2);} else if((tt)+2<NT){WAIT_BAR(1);} else {WAIT_BAR(0);} }while(0)
  for(;t+1<NT;t+=2){
    STEP(pB0,pB1,pA0,pA1,t,(t+3<NT),(t+1<NT),(t+1<NT));       ENDW(t);   RESC(); ROT();
    STEP(pA0,pA1,pB0,pB1,t+1,(t+4<NT),(t+2<NT),(t+2<NT));     ENDW(t+1); RESC(); ROT();
  }
  STEP(pB0,pB1,pA0,pA1,NT-1,false,false,false); RESC();
  { float sacc=pB0[0]+pB0[1]; _Pragma("unroll") for(int r=2;r<16;++r)sacc+=pB0[r]; _Pragma("unroll") for(int r=0;r<16;++r)sacc+=pB1[r]; l_reg+=sacc;
    pw0=(u32x4){PKW(pB0,0),PKW(pB0,2),PKW(pB0,4),PKW(pB0,6)};pw1=(u32x4){PKW(pB0,8),PKW(pB0,10),PKW(pB0,12),PKW(pB0,14)};pw2=(u32x4){PKW(pB1,0),PKW(pB1,2),PKW(pB1,4),PKW(pB1,6)};pw3=(u32x4){PKW(pB1,8),PKW(pB1,10),PKW(pB1,12),PKW(pB1,14)};
    SBAR(); pv(o,vb0+sl_cur,PAF(0),PAF(1),PAF(2),PAF(3)); }
  #undef PKW
  #undef PAF
  #undef VFR
  #undef PIN
  #undef MX3
  #undef GAPA
  #undef GAPB
  #undef EX
  #undef VRD
  #undef KRD
  #undef STEP
  #undef ROWMAX_BLOCK
  #undef ENDW
  {auto rr=__builtin_amdgcn_permlane32_swap(__float_as_uint(l_reg),__float_as_uint(l_reg),false,false);l_reg=__uint_as_float(rr[0])+__uint_as_float(rr[1]);}
  if(hi==0)wsf[32+r32]=l_reg;asm volatile("s_waitcnt lgkmcnt(0)":::"memory");
  float rli[16];
  #pragma unroll
  for(int r=0;r<16;++r)rli[r]=__builtin_amdgcn_rcpf(wsf[32+crow(r,hi)]);
  bf16*Ow=Ou+(long)(wid*QBLK)*DM;
  { bf16*stg=(bf16*)(shm+LDS_OST)+wid*2048;
    #pragma unroll
    for(int r=0;r<16;++r){const int orow=crow(r,hi);
      #pragma unroll
      for(int d0=0;d0<2;++d0)stg[orow*64+d0*32+r32]=__float2bfloat16(o[d0][r]*rli[r]);}
    asm volatile("s_waitcnt lgkmcnt(0)":::"memory");
    #pragma unroll
    for(int i=0;i<4;++i){const int row=i*8+(lane>>3),ch=lane&7; const u32x4 v=*(const u32x4*)(stg+row*64+ch*8); ATTN_STORE16(Ow+(long)row*DM+ch*8,v);} }
  asm volatile("s_waitcnt lgkmcnt(0)\n\ts_barrier":::"memory");
  #undef DMA_K
  #undef KTILE
  #undef VTILE
  #undef DMA_V
  #undef CMASK
  #undef START
  #undef RESC
  #undef ROT
}
constexpr int ATTN_LDS_BYTES=LDS_BYTES;
#undef SBAR
#undef WAIT_BAR
}
#define XB_TMO      128
#define XB_XCNT(j)  (256  + 64 * (j))
#define XB_XSUB(j)  (1280 + 64 * (j))
#define XB_XGEN(j)  (2304 + 64 * (j))
#define XB_TOP      3328
#define XB_TOPGEN   3392
#define XCD_BAR_WORDS 3456
#define XB_SPIN_CAP (1u << 18)
__device__ __forceinline__ unsigned xb_ld(unsigned* p)              { return __hip_atomic_load(p, __ATOMIC_RELAXED, __HIP_MEMORY_SCOPE_AGENT); }
__device__ __forceinline__ unsigned xb_add(unsigned* p, unsigned v) { return __hip_atomic_fetch_add(p, v, __ATOMIC_RELAXED, __HIP_MEMORY_SCOPE_AGENT); }
__device__ __forceinline__ unsigned xb_xcc_id() { return (unsigned)__builtin_amdgcn_s_getreg((3 << 11) | 20) & 0xFu; }
#define XB_SPIN(cond, bar) do { unsigned _sp = 0; while (cond) { __builtin_amdgcn_s_sleep(1); \
    if ((++_sp & 255u) == 0u) { if (xb_ld(&(bar)[XB_TMO])) break; if (_sp > XB_SPIN_CAP) { atomicAdd(&(bar)[XB_TMO], 1u); break; } } } } while (0)
struct XcdBarrier { unsigned* bar; unsigned x; volatile LAS unsigned* st; };
__device__ __forceinline__ XcdBarrier xcd_barrier_post(unsigned* bar, volatile LAS unsigned* st) {
    XcdBarrier b; b.bar = bar; b.x = xb_xcc_id(); b.st = st;
    if (threadIdx.x == 0) (void)xb_add(&bar[XB_XCNT(b.x)], 1u);
    return b;
}
__device__ __forceinline__ void xcd_barrier_complete(unsigned* bar, unsigned x, unsigned& nloc, unsigned& nx) {
    const unsigned G = gridDim.x * gridDim.y * gridDim.z;
    unsigned sum, cnt, mine, sp = 0u;
    for (;;) {
        sum = 0u; cnt = 0u; mine = 0u;
#pragma unroll
        for (unsigned j = 0; j < 16; ++j) { const unsigned c = xb_ld(&bar[XB_XCNT(j)]); sum += c; cnt += (c > 0u) ? 1u : 0u; mine = (j == x) ? c : mine; }
        if (sum == G) break;
        __builtin_amdgcn_s_sleep(1);
        if ((++sp & 255u) == 0u) { if (xb_ld(&bar[XB_TMO])) break; if (sp > XB_SPIN_CAP) { atomicAdd(&bar[XB_TMO], 1u); break; } }
    }
    nloc = mine > 0u ? mine : 1u; nx = cnt > 0u ? cnt : 1u;
}
__device__ __forceinline__ void xcd_barrier(const XcdBarrier& b) {
    asm volatile("s_waitcnt vmcnt(0)" ::: "memory");
    __syncthreads();
    if (threadIdx.x == 0) {
        unsigned long long bar_i = (unsigned long long)b.bar; unsigned bx_ = b.x; asm volatile("" : "+s"(bar_i), "+s"(bx_));
        unsigned* bar = (unsigned*)(__attribute__((address_space(1))) unsigned*)bar_i;
        __builtin_amdgcn_s_waitcnt(0);
        unsigned nloc = b.st[0], nx = b.st[1];
        if (nloc == 0u) { xcd_barrier_complete(bar, bx_, nloc, nx); b.st[0] = nloc; b.st[1] = nx; }
        const unsigned old = xb_add(&bar[XB_XSUB(bx_)], 1u);
        const unsigned gen = old / nloc;
        if (old + 1u == (gen + 1u) * nloc) {
            __builtin_amdgcn_fence(__ATOMIC_RELEASE, "agent");
            asm volatile("s_waitcnt vmcnt(0)" ::: "memory");
            const unsigned og = xb_add(&bar[XB_TOP], 1u);
            const unsigned tg = og / nx;
            if (og + 1u == (tg + 1u) * nx) xb_add(&bar[XB_TOPGEN], 1u);
            else XB_SPIN(xb_ld(&bar[XB_TOPGEN]) == tg, bar);
            __builtin_amdgcn_fence(__ATOMIC_ACQUIRE, "agent");
            xb_add(&bar[XB_XGEN(bx_)], 1u);
            asm volatile("s_waitcnt vmcnt(0)" ::: "memory");
        } else {
            XB_SPIN(xb_ld(&bar[XB_XGEN(bx_)]) == gen, bar);
            __builtin_amdgcn_fence(__ATOMIC_ACQUIRE, "agent");
            asm volatile("s_waitcnt vmcnt(0)" ::: "memory");
        }
    }
    __syncthreads();
}

struct Frame {
    LAS unsigned char* lds;
    int tid, lane, wave, vcu, G, gw, NGW, bid;
    float* out; unsigned char* ws;
};
__device__ __forceinline__ void relaunder(Frame& F) {
    unsigned long long w = (unsigned long long)F.ws, o = (unsigned long long)F.out;
    int vcu = F.vcu, G = F.G, wave = F.wave, tid = F.tid, bid = F.bid;
    asm volatile("" : "+s"(w), "+s"(o), "+s"(vcu), "+s"(G), "+s"(wave), "+s"(bid));
    asm volatile("" : "+v"(tid));
    F.ws = (unsigned char*)(__attribute__((address_space(1))) unsigned char*)w; F.out = (float*)(__attribute__((address_space(1))) float*)o;
    F.vcu = vcu; F.G = G; F.wave = wave; F.tid = tid; F.lane = tid & 63; F.bid = bid; F.gw = vcu * NWAVES + wave; F.NGW = G * NWAVES;
}
#define LDS_WAIT() asm volatile("s_waitcnt lgkmcnt(0)" ::: "memory")

__device__ __forceinline__ void transpose_item(const float* W, int N, int k0, int n0, bf16_t* dst, int ldk, LAS float* scr, int lane) {
#pragma unroll 8
    for (int i = 0; i < 32; ++i) { const int kk = 2 * i + (lane >> 5); scr[kk * 33 + (lane & 31)] = W[(size_t)(k0 + kk) * N + n0 + (lane & 31)]; }
    LDS_WAIT(); asm volatile("" ::: "memory");
    const int c = lane & 7;
#pragma unroll
    for (int j = 0; j < 4; ++j) { const int n = (lane >> 3) + 8 * j; const LAS float* s = scr + (8 * c) * 33 + n;
        u32x4 o; o.x = pk2(s[0 * 33], s[1 * 33]); o.y = pk2(s[2 * 33], s[3 * 33]); o.z = pk2(s[4 * 33], s[5 * 33]); o.w = pk2(s[6 * 33], s[7 * 33]);
        *(u32x4*)(dst + (size_t)n * ldk + 8 * c) = o; }
    LDS_WAIT(); asm volatile("" ::: "memory");
}

__device__ __forceinline__ void transpose_item32(const float* W, int N, int k0, int n0, bf16_t* dst, int ldk, LAS float* scr, int lane) {
#pragma unroll 8
    for (int i = 0; i < 16; ++i) { const int kk = 2 * i + (lane >> 5); scr[kk * 33 + (lane & 31)] = W[(size_t)(k0 + kk) * N + n0 + (lane & 31)]; }
    LDS_WAIT(); asm volatile("" ::: "memory");
    const int c = lane & 3;
#pragma unroll
    for (int j = 0; j < 2; ++j) { const int n = (lane >> 2) + 16 * j; const LAS float* s = scr + (8 * c) * 33 + n;
        u32x4 o; o.x = pk2(s[0 * 33], s[1 * 33]); o.y = pk2(s[2 * 33], s[3 * 33]); o.z = pk2(s[4 * 33], s[5 * 33]); o.w = pk2(s[6 * 33], s[7 * 33]);
        *(u32x4*)(dst + (size_t)n * ldk + 8 * c) = o; }
    LDS_WAIT(); asm volatile("" ::: "memory");
}
__device__ __forceinline__ void transpose_issue32(const float* W, int N, int k0, int n0, float (&v)[16], int lane) {
#pragma unroll
    for (int i = 0; i < 16; ++i) { const int kk = 2 * i + (lane >> 5); v[i] = W[(size_t)(k0 + kk) * N + n0 + (lane & 31)]; }
}
__device__ __forceinline__ void transpose_finish32(const float (&v)[16], bf16_t* dst, int ldk, LAS float* scr, int lane, bool store) {
#pragma unroll
    for (int i = 0; i < 16; ++i) { const int kk = 2 * i + (lane >> 5); scr[kk * 33 + (lane & 31)] = v[i]; }
    LDS_WAIT(); asm volatile("" ::: "memory");
    if (!store) return;
    const int c = lane & 3;
#pragma unroll
    for (int j = 0; j < 2; ++j) { const int n = (lane >> 2) + 16 * j; const LAS float* s = scr + (8 * c) * 33 + n;
        u32x4 o; o.x = pk2(s[0 * 33], s[1 * 33]); o.y = pk2(s[2 * 33], s[3 * 33]); o.z = pk2(s[4 * 33], s[5 * 33]); o.w = pk2(s[6 * 33], s[7 * 33]);
        *(u32x4*)(dst + (size_t)n * ldk + 8 * c) = o; }
    LDS_WAIT(); asm volatile("" ::: "memory");
}
__device__ __forceinline__ void convert_expert_issue32(int l, int it, const float* exp_gate, const float* exp_up, const float* exp_down, float (&v)[16], int lane) {
    constexpr int I_M = 32 * 32;
    const int which = it / (NEXP * I_M), r = it % (NEXP * I_M), e = r / I_M, q = r % I_M, kb = q / 32, nb = q % 32, n0 = nb * 32;
    const float* W = (which == 0 ? exp_gate : (which == 1 ? exp_up : exp_down)) + ((size_t)l * NEXP + e) * DM * EFF;
    transpose_issue32(W, which < 2 ? EFF : DM, kb * 32, n0, v, lane);
}
__device__ __forceinline__ void convert_expert_finish32(unsigned char* ws, int it_, const float (&v)[16], LAS float* scr, int lane) {
    bf16_t* Wup = (bf16_t*)(ws + WS_WUP); bf16_t* Wdn = (bf16_t*)(ws + WS_WDN);
    constexpr int I_M = 32 * 32;
    const bool store = it_ >= 0; const int it = store ? it_ : 0;
    const int which = it / (NEXP * I_M), r = it % (NEXP * I_M), e = r / I_M, q = r % I_M, kb = q / 32, nb = q % 32, n0 = nb * 32;
    if (which < 2) { const int drow = 256 * (n0 >> 7) + 128 * which + (n0 & 127);
        transpose_finish32(v, Wup + ((size_t)e * 2048 + drow) * DM + kb * 32, DM, scr, lane, store); }
    else transpose_finish32(v, Wdn + ((size_t)e * 1024 + n0) * EFF + kb * 32, EFF, scr, lane, store);
}
__device__ __forceinline__ void convert_expert_item32(unsigned char* ws, int l, int it, const float* exp_gate, const float* exp_up, const float* exp_down, LAS float* scr, int lane) {
    bf16_t* Wup = (bf16_t*)(ws + WS_WUP); bf16_t* Wdn = (bf16_t*)(ws + WS_WDN);
    constexpr int I_M = 32 * 32;
    const int which = it / (NEXP * I_M), r = it % (NEXP * I_M), e = r / I_M, q = r % I_M, kb = q / 32, nb = q % 32, n0 = nb * 32;
    const float* W = (which == 0 ? exp_gate : (which == 1 ? exp_up : exp_down)) + ((size_t)l * NEXP + e) * DM * EFF;
    if (which < 2) { const int drow = 256 * (n0 >> 7) + 128 * which + (n0 & 127);
        transpose_item32(W, EFF, kb * 32, n0, Wup + ((size_t)e * 2048 + drow) * DM + kb * 32, DM, scr, lane); }
    else transpose_item32(W, DM, kb * 32, n0, Wdn + ((size_t)e * 1024 + n0) * EFF + kb * 32, EFF, scr, lane);
}

__device__ __forceinline__ void phase_prologue(Frame& F, const float* c_in, const float* cctx_in, const float* ada_w, const float* ada_b, const float* w_in, const float* decay_w2, const float* iclr_a2, const float* gate_g2,
                                               const float* w_br_att, const float* w_br_rwkv, const float* w_br_conv, const float* w_out, const float* w_router) {
    LAS float* scr = (LAS float*)(F.lds + F.wave * 16384);
    bf16_t* Win = (bf16_t*)(F.ws + WS_WIN); bf16_t* Wbr = (bf16_t*)(F.ws + WS_WBR); bf16_t* Wout = (bf16_t*)(F.ws + WS_WOUT); bf16_t* Wlr = (bf16_t*)(F.ws + WS_WLR);
    constexpr int I_IN = 16 * 228, I_BR = 8 * 32, I_OUT = 16 * 32;
    constexpr int PER_L = I_IN + 3 * I_BR + I_OUT;
    for (int it = F.gw; it < NL * PER_L; it += F.NGW) {
        const int l = it / PER_L; int r = it % PER_L;
        if (r < I_IN) { const int kb = r / 228, nb = r % 228; transpose_item(w_in + (size_t)l * DM * NCOLS_IN, NCOLS_IN, kb * 64, nb * 32, Win + ((size_t)l * PWP + nb * 32) * DM + kb * 64, DM, scr, F.lane); continue; }
        r -= I_IN;
        if (r < 3 * I_BR) { const int br = r / I_BR, q = r % I_BR, kb = q / 32, nb = q % 32;
            const float* W = (br == 0 ? w_br_att : (br == 1 ? w_br_rwkv : w_br_conv)) + (size_t)l * 512 * DM;
            transpose_item(W, DM, kb * 64, nb * 32, Wbr + (((size_t)l * 3 + br) * 1024 + nb * 32) * 512 + kb * 64, 512, scr, F.lane); continue; }
        r -= 3 * I_BR;
        { const int kb = r / 32, nb = r % 32; transpose_item(w_out + (size_t)l * DM * DM, DM, kb * 64, nb * 32, Wout + ((size_t)l * 1024 + nb * 32) * DM + kb * 64, DM, scr, F.lane); }
    }
    for (int i = F.gw * 64 + F.lane; i < NL * (PWP - NCOLS_IN) * DM / 8; i += F.NGW * 64) {
        const int l = i / ((PWP - NCOLS_IN) * DM / 8), r = i % ((PWP - NCOLS_IN) * DM / 8);
        *(u32x4*)(Win + ((size_t)l * PWP + NCOLS_IN) * DM + (size_t)r * 8) = (u32x4){0u, 0u, 0u, 0u};
    }
    for (int i = F.gw * 64 + F.lane; i < NL * WAGW * 128; i += F.NGW * 64) {
        const int l = i / (WAGW * 128), r = i % (WAGW * 128), n = r / 128, kk = r % 128;
        float v = 0.f;
        if (n < 512) { if (kk < 64) v = decay_w2[(((size_t)l * 2 + 0) * 64 + kk) * 512 + n]; }
        else if (n < 1024) { if (kk >= 64) v = decay_w2[(((size_t)l * 2 + 1) * 64 + (kk - 64)) * 512 + (n - 512)]; }
        else if (n < 1536) { if (kk < 64) v = iclr_a2[(((size_t)l * 2 + 0) * 64 + kk) * 512 + (n - 1024)]; }
        else if (n < 2048) { if (kk >= 64) v = iclr_a2[(((size_t)l * 2 + 1) * 64 + (kk - 64)) * 512 + (n - 1536)]; }
        else v = gate_g2[((size_t)l * 128 + kk) * 512 + (n - 2048)];
        Wlr[i] = (bf16_t)f2bf(v);
    }
    { bf16_t* WRT = (bf16_t*)(F.ws + WS_WRT);
      for (int i = F.gw * 64 + F.lane; i < NL * 16 * 1024; i += F.NGW * 64) { const int l = i / 16384, r = i % 16384, e = r / 1024, k = r % 1024;
          const float w = w_router[((size_t)l * 1024 + k) * 16 + e]; const unsigned hi = f2bf(w); const unsigned lo = f2bf(w - bflo(hi));
          WRT[((size_t)l * 2 + 0) * 16384 + r] = (bf16_t)hi; WRT[((size_t)l * 2 + 1) * 16384 + r] = (bf16_t)lo; } }
    if (blockIdx.x == 0) {
        float* rope = (float*)(F.ws + WS_ROPE);
        for (int i = F.tid; i < 64 * 16; i += NTHR) { const int pos = i >> 4, fi = i & 15;
            const float inv = powf(10000.0f, -(float)(2 * fi) / 32.0f); const float ang = (float)pos * inv;
            rope[2 * i] = cosf(ang); rope[2 * i + 1] = sinf(ang); }
    }
    __syncthreads();
    LAS float* sc = (LAS float*)F.lds;
    LAS float* part = (LAS float*)(F.lds + 17 * 1024 * 4);
    for (int i = F.tid; i < 17 * 1024; i += NTHR) { const float v = (i < 16 * 1024) ? c_in[i] : cctx_in[i - 16 * 1024]; sc[i] = v * sigmoidf_(v); }
    __syncthreads();
    float* MOD = (float*)(F.ws + WS_MOD);
    for (int item = F.vcu; item < NL * 96; item += F.G) {
        const int l = item / 96, n0 = (item % 96) * 64;
        float acc[17];
#pragma unroll
        for (int r = 0; r < 17; ++r) acc[r] = 0.f;
        const float* wp = ada_w + ((size_t)l * DM + F.wave * 128) * 6144 + n0 + F.lane;
        for (int kk0 = 0; kk0 < 128; kk0 += 16) {
            float w[16];
#pragma unroll
            for (int j = 0; j < 16; ++j) w[j] = wp[(size_t)(kk0 + j) * 6144];
#pragma unroll
            for (int j = 0; j < 16; ++j) {
                const int k = F.wave * 128 + kk0 + j;
#pragma unroll
                for (int r = 0; r < 17; ++r) acc[r] += sc[r * 1024 + k] * w[j];
            }
        }
#pragma unroll
        for (int r = 0; r < 17; ++r) part[(F.wave * 17 + r) * 64 + F.lane] = acc[r];
        __syncthreads();
        for (int idx = F.tid; idx < 17 * 64; idx += NTHR) { const int r = idx >> 6, j = idx & 63; float s = 0.f;
#pragma unroll
            for (int w = 0; w < 8; ++w) s += part[(w * 17 + r) * 64 + j];
            MOD[((size_t)l * 17 + r) * 6144 + n0 + j] = s + ada_b[(size_t)l * 6144 + n0 + j]; }
        __syncthreads();
    }
}

__device__ __forceinline__ void convert_experts(Frame& F, int l, const float* exp_gate, const float* exp_up, const float* exp_down, int wk, int nwk, int it_lo, int it_hi) {
    LAS float* scr = (LAS float*)(F.lds + F.wave * 16384);
    bf16_t* Wup = (bf16_t*)(F.ws + WS_WUP); bf16_t* Wdn = (bf16_t*)(F.ws + WS_WDN);
    constexpr int I_M = 16 * 32;
    for (int it = it_lo + wk; it < it_hi; it += nwk) {
        const int which = it / (NEXP * I_M), r = it % (NEXP * I_M), e = r / I_M, q = r % I_M, kb = q / 32, nb = q % 32, n0 = nb * 32;
        const float* W = (which == 0 ? exp_gate : (which == 1 ? exp_up : exp_down)) + ((size_t)l * NEXP + e) * DM * EFF;
        if (which < 2) { const int drow = 256 * (n0 >> 7) + 128 * which + (n0 & 127);
            transpose_item(W, EFF, kb * 64, n0, Wup + ((size_t)e * 2048 + drow) * DM + kb * 64, DM, scr, F.lane); }
        else transpose_item(W, DM, kb * 64, n0, Wdn + ((size_t)e * 1024 + n0) * EFF + kb * 64, EFF, scr, F.lane);
    }
}

struct N1Row { f32x4 v[4]; int slot; float gate; int row; bool ok; };
__device__ __forceinline__ void n1_load(Frame& F, N1Row& R, int row, int nrows, int l, const float* x_in, const float* ctx_in) {
    R.ok = row < nrows; R.row = R.ok ? row : 0;
    const bool lat = R.row < NLAT;
    if (l == 0) {
        const float* xs = lat ? x_in + (size_t)R.row * DM : ctx_in + (size_t)(R.row - NLAT) * DM;
#pragma unroll
        for (int j = 0; j < 4; ++j) R.v[j] = *(const f32x4*)(xs + 4 * F.lane + 256 * j);
    } else {
        const bf16_t* xb = (const bf16_t*)(F.ws + WS_XB) + (size_t)R.row * DM + 4 * F.lane;
#pragma unroll
        for (int j = 0; j < 4; ++j) { const u32x2 w = *(const u32x2*)(xb + 256 * j); R.v[j] = (f32x4){bflo(w.x), bfhi(w.x), bflo(w.y), bfhi(w.y)}; }
    }
    R.slot = -1; R.gate = 0.f;
    if (l > 0) { R.slot = ((const int*)(F.ws + WS_SLOT))[(size_t)R.row * 16 + (F.lane & 15)]; R.gate = ((const float*)(F.ws + WS_AFF))[(size_t)R.row * 16 + (F.lane & 15)]; }
}
__device__ __forceinline__ void n1_finish(Frame& F, N1Row& R, int l, const float* norm1, const float* final_norm, bool dry) {
    const bool fin = (l == NL);
    const float* MOD = (const float*)(F.ws + WS_MOD);
    const bf16_t* YE = (const bf16_t*)(F.ws + WS_YE); bf16_t* H = (bf16_t*)(F.ws + WS_H);
    const int row = R.row; const bool lat = row < NLAT; const int b = lat ? (row >> 11) : ((row - NLAT) >> 8); const int modrow = lat ? b : 16;
    bf16_t* xbw = (bf16_t*)(F.ws + WS_XB) + (size_t)row * DM;
    if (dry) { xbw = (bf16_t*)(F.ws + WS_WAG) + (size_t)row * DM; H = (bf16_t*)(F.ws + WS_YF); }
    if (l > 0) {
        f32x4 a[4];
#pragma unroll
        for (int j = 0; j < 4; ++j) a[j] = (f32x4){0.f, 0.f, 0.f, 0.f};
        unsigned mask = (unsigned)(__ballot(R.slot >= 0 && F.lane < 16));
        const size_t pbase = (size_t)(lat ? b * CAPL : NB * CAPL + b * CAPC);
        while (mask) {
            const int e0 = __builtin_ctz(mask); mask &= mask - 1u;
            const bool two = mask != 0u; const int e1 = two ? __builtin_ctz(mask) : e0; if (two) mask &= mask - 1u;
            const int s0 = __builtin_amdgcn_readlane(R.slot, e0), s1 = __builtin_amdgcn_readlane(R.slot, e1);
            const float g0 = __builtin_bit_cast(float, __builtin_amdgcn_readlane(__builtin_bit_cast(int, R.gate), e0));
            const float g1 = two ? __builtin_bit_cast(float, __builtin_amdgcn_readlane(__builtin_bit_cast(int, R.gate), e1)) : 0.f;
            const bf16_t* y0 = YE + ((size_t)e0 * PAIRS_E + pbase + s0) * DM + 4 * F.lane;
            const bf16_t* y1 = YE + ((size_t)e1 * PAIRS_E + pbase + s1) * DM + 4 * F.lane;
            u32x2 w0[4], w1[4];
#pragma unroll
            for (int j = 0; j < 4; ++j) { w0[j] = *(const u32x2*)(y0 + 256 * j); w1[j] = *(const u32x2*)(y1 + 256 * j); }
#pragma unroll
            for (int j = 0; j < 4; ++j) {
                a[j][0] += g0 * bflo(w0[j].x) + g1 * bflo(w1[j].x); a[j][1] += g0 * bfhi(w0[j].x) + g1 * bfhi(w1[j].x);
                a[j][2] += g0 * bflo(w0[j].y) + g1 * bflo(w1[j].y); a[j][3] += g0 * bfhi(w0[j].y) + g1 * bfhi(w1[j].y);
            }
        }
        const float* g2 = MOD + ((size_t)(l - 1) * 17 + modrow) * 6144 + 5 * 1024 + 4 * F.lane;
#pragma unroll
        for (int j = 0; j < 4; ++j) R.v[j] += *(const f32x4*)(g2 + 256 * j) * a[j];
    }
    if (!fin && R.ok) {
#pragma unroll
        for (int j = 0; j < 4; ++j) { u32x2 w; w.x = pk2(R.v[j][0], R.v[j][1]); w.y = pk2(R.v[j][2], R.v[j][3]); *(u32x2*)(xbw + 4 * F.lane + 256 * j) = w; }
    }
    float ss = 0.f;
#pragma unroll
    for (int j = 0; j < 4; ++j) ss += (R.v[j][0] * R.v[j][0] + R.v[j][1] * R.v[j][1]) + (R.v[j][2] * R.v[j][2] + R.v[j][3] * R.v[j][3]);
    const float rstd = rsq_(wave_sum(ss) * (1.0f / DM) + NORM_EPS);
    if (!R.ok) return;
    if (fin) {
        const float* gn = final_norm + 4 * F.lane;
#pragma unroll
        for (int j = 0; j < 4; ++j) *(f32x4*)(F.out + (size_t)row * DM + 4 * F.lane + 256 * j) = R.v[j] * rstd * *(const f32x4*)(gn + 256 * j);
    } else {
        const float* gn = norm1 + (size_t)l * DM + 4 * F.lane;
        const float* md = MOD + ((size_t)l * 17 + modrow) * 6144 + 4 * F.lane;
#pragma unroll
        for (int j = 0; j < 4; ++j) {
            const f32x4 h = R.v[j] * rstd * *(const f32x4*)(gn + 256 * j) * (*(const f32x4*)(md + 1024 + 256 * j) + 1.0f) + *(const f32x4*)(md + 256 * j);
            u32x2 w; w.x = pk2(h[0], h[1]); w.y = pk2(h[2], h[3]);
            *(u32x2*)(H + (size_t)row * DM + 4 * F.lane + 256 * j) = w;
        }
    }
}
__device__ __forceinline__ void phase_norm1(Frame& F, int l, const float* x_in, const float* ctx_in, const float* norm1, const float* final_norm, bool dry = false) {
    const int nrows = (l == NL) ? NLAT : NTOK;
    for (int row = F.gw; row < nrows; row += 4 * F.NGW) {
        N1Row A, B, C, D;
        n1_load(F, A, row, nrows, l, x_in, ctx_in); n1_load(F, B, row + F.NGW, nrows, l, x_in, ctx_in); n1_load(F, C, row + 2 * F.NGW, nrows, l, x_in, ctx_in); n1_load(F, D, row + 3 * F.NGW, nrows, l, x_in, ctx_in);
        n1_finish(F, A, l, norm1, final_norm, dry); n1_finish(F, B, l, norm1, final_norm, dry); n1_finish(F, C, l, norm1, final_norm, dry); n1_finish(F, D, l, norm1, final_norm, dry);
    }
}

struct PrepRow { u32x4 q, k, bg, cg[3], u[3], lr[3]; };
__device__ __forceinline__ void prep_load(PrepRow& R, const bf16_t* pr, int t, int slen, int lane) {
    const bool hp = t > 0, hn = t + 1 < slen; const u32x4 z = {0u, 0u, 0u, 0u};
    R.q = *(const u32x4*)(pr + C_Q + 8 * lane); R.k = *(const u32x4*)(pr + C_K + 8 * (lane & 15));
    R.bg = *(const u32x4*)(pr + C_BG + 8 * lane);
    R.cg[0] = *(const u32x4*)(pr + C_CG + 8 * lane); R.u[0] = *(const u32x4*)(pr + C_U + 8 * lane);
    R.cg[1] = hp ? *(const u32x4*)(pr - PW + C_CG + 8 * lane) : z; R.u[1] = hp ? *(const u32x4*)(pr - PW + C_U + 8 * lane) : z;
    R.cg[2] = hn ? *(const u32x4*)(pr + PW + C_CG + 8 * lane) : z; R.u[2] = hn ? *(const u32x4*)(pr + PW + C_U + 8 * lane) : z;
    const int ll = lane < 48 ? lane : 47;
    R.lr[0] = *(const u32x4*)(pr + C_WLO + 8 * ll);
    R.lr[1] = hp ? *(const u32x4*)(pr - PW + C_WLO + 8 * ll) : z; R.lr[2] = hn ? *(const u32x4*)(pr + PW + C_WLO + 8 * ll) : z;
}
__device__ __forceinline__ void phase_prep(Frame& F, int l, const float* q_gain, const float* k_gain, const float* conv_w, const float* shift_mu, bool dry = false) {
    bf16_t* P = (bf16_t*)(F.ws + WS_PROJ); bf16_t* LRA = (bf16_t*)(F.ws + WS_LRA);
    LAS float* rope = (LAS float*)F.lds;
    for (int i = F.tid; i < 64 * 16 * 2; i += NTHR) rope[i] = ((const float*)(F.ws + WS_ROPE))[i];
    __syncthreads();
    const int lane = F.lane, s8 = lane & 7;
    float qg[8], kg[8], cw0[8], cw1[8], cw2[8], mu[8];
#pragma unroll
    for (int i = 0; i < 8; ++i) { qg[i] = q_gain[l * 64 + s8 * 8 + i]; kg[i] = k_gain[l * 64 + s8 * 8 + i];
        cw0[i] = conv_w[((size_t)l * 3 + 0) * 512 + 8 * lane + i]; cw1[i] = conv_w[((size_t)l * 3 + 1) * 512 + 8 * lane + i]; cw2[i] = conv_w[((size_t)l * 3 + 2) * 512 + 8 * lane + i];
        mu[i] = (lane < 48) ? shift_mu[(size_t)l * 1920 + (C_WLO - C_RW) + 8 * lane + i] : 0.f; }
    for (int row0 = F.gw; row0 < NTOK; row0 += 2 * F.NGW) {
        const int row1 = row0 + F.NGW; const bool ok1 = row1 < NTOK;
        PrepRow RR[2]; int tt[2]; bool latt[2];
#pragma unroll
        for (int z = 0; z < 2; ++z) { const int row = (z == 0 || !ok1) ? row0 : row1; latt[z] = row < NLAT; tt[z] = latt[z] ? (row & 2047) : ((row - NLAT) & 255);
            prep_load(RR[z], P + (size_t)row * PW, tt[z], latt[z] ? SEQ : CTXL, lane); }
#pragma unroll
        for (int z = 0; z < 2; ++z) {
            if (z == 1 && !ok1) break;
            const int row = z == 0 ? row0 : row1; const PrepRow& R = RR[z]; const bool lat = latt[z]; const int t = tt[z];
            bf16_t* pr = P + (size_t)row * PW;
#pragma unroll
            for (int which = 0; which < 2; ++which) {
                float x[8]; unpack8(which == 0 ? R.q : R.k, x);
                float ss = 0.f;
#pragma unroll
                for (int i = 0; i < 8; ++i) ss += x[i] * x[i];
                ss = sum8(ss);
                const float rstd = rsq_(ss * (1.0f / 64.0f) + NORM_EPS);
#pragma unroll
                for (int i = 0; i < 8; ++i) x[i] = x[i] * rstd * (which == 0 ? qg[i] : kg[i]);
                if (lat) {
                    const int pos = (s8 < 4) ? (t >> 6) : (t & 63);
                    float o[8];
#pragma unroll
                    for (int i = 0; i < 8; ++i) {
                        const float partner = dpp_f(x[i], 1);
                        const int fi = (s8 & 1) * 8 + i;
                        const float c = rope[(pos * 16 + fi) * 2], sn = rope[(pos * 16 + fi) * 2 + 1];
                        o[i] = (s8 & 2) ? (partner * sn + x[i] * c) : (x[i] * c - partner * sn);
                    }
#pragma unroll
                    for (int i = 0; i < 8; ++i) x[i] = o[i];
                }
                if (which == 0) {
#pragma unroll
                    for (int i = 0; i < 8; ++i) x[i] *= QSCALE;
                    if (!dry) st8(pr + C_Q + 8 * lane, x);
                } else if (lane < 16 && !dry) st8(pr + C_K + 8 * lane, x);
            }
            {
                float bg[8], c0[8], u0[8], z0[8], zp[8], zn[8];
                unpack8(R.bg, bg);
                unpack8(R.cg[0], c0); unpack8(R.u[0], u0);
#pragma unroll
                for (int i = 0; i < 8; ++i) z0[i] = c0[i] * u0[i];
                unpack8(R.cg[1], c0); unpack8(R.u[1], u0);
#pragma unroll
                for (int i = 0; i < 8; ++i) zp[i] = c0[i] * u0[i];
                unpack8(R.cg[2], c0); unpack8(R.u[2], u0);
#pragma unroll
                for (int i = 0; i < 8; ++i) zn[i] = c0[i] * u0[i];
                float o[8];
#pragma unroll
                for (int i = 0; i < 8; ++i) o[i] = bg[i] * (cw0[i] * zp[i] + cw1[i] * z0[i] + cw2[i] * zn[i]);
                if (!dry) st8(pr + C_OCONV + 8 * lane, o);
            }
            {
                float x[8], xp[8], xn[8], o[8];
                unpack8(R.lr[0], x); unpack8(R.lr[1], xp); unpack8(R.lr[2], xn);
#pragma unroll
                for (int i = 0; i < 8; ++i) { const float sft = x[i] + mu[i] * (0.5f * (xp[i] + xn[i]) - x[i]);
                    const float sg = sigmoidf_(lane < 16 ? 2.0f * sft : sft); o[i] = lane < 16 ? 2.0f * sg - 1.0f : (lane < 32 ? sft : sg); }
                if (lane < 48) st8(LRA + (size_t)row * LRAW + 8 * lane, o);
            }
        }
    }
}
__device__ __forceinline__ void n2_modulate(Frame& F, f32x4 (&v)[4], int row, int l, const float* norm2) {
    const float* MOD = (const float*)(F.ws + WS_MOD); bf16_t* H = (bf16_t*)(F.ws + WS_H);
    const bool lat = row < NLAT; const int b = lat ? (row >> 11) : ((row - NLAT) >> 8); const int modrow = lat ? b : 16;
    float ss = 0.f;
#pragma unroll
    for (int j = 0; j < 4; ++j) ss += (v[j][0] * v[j][0] + v[j][1] * v[j][1]) + (v[j][2] * v[j][2] + v[j][3] * v[j][3]);
    const float rstd = rsq_(wave_sum(ss) * (1.0f / DM) + NORM_EPS);
    const float* gn = norm2 + (size_t)l * DM + 4 * F.lane;
    const float* md = MOD + ((size_t)l * 17 + modrow) * 6144 + 3 * 1024 + 4 * F.lane;
#pragma unroll
    for (int j = 0; j < 4; ++j) {
        v[j] = v[j] * rstd * *(const f32x4*)(gn + 256 * j) * (*(const f32x4*)(md + 1024 + 256 * j) + 1.0f) + *(const f32x4*)(md + 256 * j);
        u32x2 w; w.x = pk2(v[j][0], v[j][1]); w.y = pk2(v[j][2], v[j][3]);
        *(u32x2*)(H + (size_t)row * DM + 4 * F.lane + 256 * j) = w;
    }
}
__device__ __forceinline__ void n2_softmax_store(Frame& F, float (&lg)[16], int row) {
    float* AFF = (float*)(F.ws + WS_AFF);
    float mx = lg[0];
#pragma unroll
    for (int e = 1; e < 16; ++e) mx = fmaxf(mx, lg[e]);
    float den = 0.f;
#pragma unroll
    for (int e = 0; e < 16; ++e) { lg[e] = __expf(lg[e] - mx); den += lg[e]; }
    const float inv = rcp_(den);
    float mine = 0.f;
#pragma unroll
    for (int e = 0; e < 16; ++e) mine = (F.lane == e) ? lg[e] * inv : mine;
    if (F.lane < 16) AFF[(size_t)row * 16 + F.lane] = mine;
}
__device__ __forceinline__ void phase_norm2_router(Frame& F, int l, int nrows, const float* norm2, const float* w_router) {
    LAS float* wrT = (LAS float*)F.lds;
    for (int i = F.tid; i < 16 * 1024; i += NTHR) { const int c = i >> 4, e = i & 15; wrT[e * 1024 + c] = w_router[(size_t)l * DM * 16 + i]; }
    __syncthreads();
    const bf16_t* XB = (const bf16_t*)(F.ws + WS_XB);
    for (int row = F.gw; row < nrows; row += 2 * F.NGW) {
        const int row1 = row + F.NGW; const bool ok1 = row1 < nrows; const int r1 = ok1 ? row1 : row;
        f32x4 v0[4], v1[4];
#pragma unroll
        for (int j = 0; j < 4; ++j) { const u32x2 a = *(const u32x2*)(XB + (size_t)row * DM + 4 * F.lane + 256 * j), b = *(const u32x2*)(XB + (size_t)r1 * DM + 4 * F.lane + 256 * j);
            v0[j] = (f32x4){bflo(a.x), bfhi(a.x), bflo(a.y), bfhi(a.y)}; v1[j] = (f32x4){bflo(b.x), bfhi(b.x), bflo(b.y), bfhi(b.y)}; }
        n2_modulate(F, v0, row, l, norm2);
        n2_modulate(F, v1, r1, l, norm2);
        float lg0[16], lg1[16];
#pragma unroll
        for (int e = 0; e < 16; ++e) {
            float s0 = 0.f, s1 = 0.f;
#pragma unroll
            for (int j = 0; j < 4; ++j) { const f32x4 w = *(const LAS f32x4*)(wrT + e * 1024 + 4 * F.lane + 256 * j);
                s0 += (v0[j][0] * w[0] + v0[j][1] * w[1]) + (v0[j][2] * w[2] + v0[j][3] * w[3]); s1 += (v1[j][0] * w[0] + v1[j][1] * w[1]) + (v1[j][2] * w[2] + v1[j][3] * w[3]); }
            lg0[e] = wave_sum(s0); lg1[e] = wave_sum(s1);
            if ((e & 3) == 3) __builtin_amdgcn_sched_barrier(0);
        }
        n2_softmax_store(F, lg0, row);
        if (ok1) n2_softmax_store(F, lg1, row1);
    }
}

__device__ __forceinline__ float qsum4(float x) {
    x += __shfl_xor(x, 16); x += __shfl_xor(x, 32);
    return x;
}
__device__ __forceinline__ void n2_tile(Frame& F, int row0, const LAS float* Gs, const LAS float* Sh, const bf16_t* WRh, const bf16_t* WRl) {
    const int lane = F.lane, r = lane & 15, q = lane >> 4;
    const bf16_t* xrow = (const bf16_t*)(F.ws + WS_XB) + (size_t)(row0 + r) * DM + 8 * q;
    bf16_t* hrow = (bf16_t*)(F.ws + WS_H) + (size_t)(row0 + r) * DM + 8 * q;
    const bf16_t* wh = WRh + (size_t)r * 1024 + 8 * q; const bf16_t* wl = WRl + (size_t)r * 1024 + 8 * q;
    float ss = 0.f;
#pragma unroll 8
    for (int s = 0; s < 32; ++s) { float x[8]; ld8(xrow + 32 * s, x);
#pragma unroll
        for (int j = 0; j < 8; ++j) ss += x[j] * x[j]; }
    const float rstd = rsq_(qsum4(ss) * (1.0f / DM) + NORM_EPS);
    f32x4 acc = {0.f, 0.f, 0.f, 0.f};
#pragma unroll 2
    for (int s = 0; s < 32; ++s) {
        float x[8]; ld8(xrow + 32 * s, x);
        const f32x4 g0 = *(const LAS f32x4*)(Gs + 32 * s + 8 * q), g1 = *(const LAS f32x4*)(Gs + 32 * s + 8 * q + 4), h0 = *(const LAS f32x4*)(Sh + 32 * s + 8 * q), h1 = *(const LAS f32x4*)(Sh + 32 * s + 8 * q + 4);
        const bf16x8 bh = *(const bf16x8*)(wh + 32 * s), bl = *(const bf16x8*)(wl + 32 * s);
        float h[8];
#pragma unroll
        for (int j = 0; j < 4; ++j) { h[j] = x[j] * rstd * g0[j] + h0[j]; h[4 + j] = x[4 + j] * rstd * g1[j] + h1[j]; }
        u32x4 hw; hw.x = pk2(h[0], h[1]); hw.y = pk2(h[2], h[3]); hw.z = pk2(h[4], h[5]); hw.w = pk2(h[6], h[7]);
        *(u32x4*)(hrow + 32 * s) = hw;
        u32x4 lw; lw.x = pk2(h[0] - bflo(hw.x), h[1] - bfhi(hw.x)); lw.y = pk2(h[2] - bflo(hw.y), h[3] - bfhi(hw.y)); lw.z = pk2(h[4] - bflo(hw.z), h[5] - bfhi(hw.z)); lw.w = pk2(h[6] - bflo(hw.w), h[7] - bfhi(hw.w));
        const bf16x8 ah = __builtin_bit_cast(bf16x8, hw), al = __builtin_bit_cast(bf16x8, lw);
        acc = __builtin_amdgcn_mfma_f32_16x16x32_bf16(ah, bh, acc, 0, 0, 0);
        acc = __builtin_amdgcn_mfma_f32_16x16x32_bf16(ah, bl, acc, 0, 0, 0);
        acc = __builtin_amdgcn_mfma_f32_16x16x32_bf16(al, bh, acc, 0, 0, 0);
    }
    float* AFF = (float*)(F.ws + WS_AFF);
#pragma unroll
    for (int g = 0; g < 4; ++g) {
        float mx = acc[g];
#pragma unroll
        for (int c_ = 0; c_ < 4; ++c_) mx = fmaxf(mx, dpp_f(mx, c_));
        const float e = __expf(acc[g] - mx);
        float den = e;
#pragma unroll
        for (int c_ = 0; c_ < 4; ++c_) den += dpp_f(den, c_);
        AFF[(size_t)(row0 + 4 * q + g) * 16 + r] = e * rcp_(den);
    }
}
__device__ __forceinline__ void phase_norm2_router_mfma(Frame& F, int l, int nrows, const float* norm2) {
    LAS float* Gs = (LAS float*)F.lds;
    LAS float* Sh = Gs + 2048;
    const float* MOD = (const float*)(F.ws + WS_MOD);
    const int b = (F.vcu * NWAVES * 16) >> 11;
    for (int i = F.tid; i < 2048; i += NTHR) { const int c = i & 1023, modrow = i < 1024 ? b : 16; const float* md = MOD + ((size_t)l * 17 + modrow) * 6144 + 3 * 1024;
        Gs[i] = norm2[(size_t)l * DM + c] * (1.0f + md[1024 + c]); Sh[i] = md[c]; }
    __syncthreads();
    const bf16_t* WRh = (const bf16_t*)(F.ws + WS_WRT) + (size_t)l * 2 * 16384; const bf16_t* WRl = WRh + 16384;
    n2_tile(F, 16 * F.gw, Gs, Sh, WRh, WRl);
    if (nrows > NLAT && F.wave == 0) n2_tile(F, NLAT + 16 * F.vcu, Gs + 1024, Sh + 1024, WRh, WRl);
}

__device__ __forceinline__ int block_sum_i(LAS int* red, int& par, int wave_val, int wave, int lane) {
    if (lane == 0) red[par * 8 + wave] = wave_val;
    __syncthreads();
    int s = 0;
#pragma unroll
    for (int w = 0; w < 8; ++w) s += red[par * 8 + w];
    par ^= 1;
    return s;
}
__device__ __forceinline__ int block_exscan_i(LAS int* red, int& par, int val, int wave, int lane) {
    int inc = val;
#pragma unroll
    for (int o = 1; o < 64; o <<= 1) { const int t = __shfl_up(inc, o); if (lane >= o) inc += t; }
    if (lane == 63) red[par * 8 + wave] = inc;
    __syncthreads();
    int base = 0;
#pragma unroll
    for (int w = 0; w < 8; ++w) base += (w < wave) ? red[par * 8 + w] : 0;
    par ^= 1;
    return base + inc - val;
}
__device__ __forceinline__ void topk_set(Frame& F, LAS int* red, int& par, int n, int cap, int rowbase, int e, int listbase) {
    const float* AFF = (const float*)(F.ws + WS_AFF); int* LIST = (int*)(F.ws + WS_LIST); int* SLOT = (int*)(F.ws + WS_SLOT);
    unsigned key[4];
#pragma unroll
    for (int j = 0; j < 4; ++j) { const int tok = 4 * F.tid + j; key[j] = (tok < n) ? __builtin_bit_cast(unsigned, AFF[(size_t)(rowbase + tok) * 16 + e]) : 0u; }
    unsigned T = 0u;
    for (int bit = 30; bit >= 0; --bit) {
        const unsigned cand = T | (1u << bit);
        int c = 0;
#pragma unroll
        for (int j = 0; j < 4; ++j) c += __popcll(__ballot(key[j] >= cand));
        if (block_sum_i(red, par, c, F.wave, F.lane) >= cap) T = cand;
    }
    int cgt = 0, ceq = 0;
#pragma unroll
    for (int j = 0; j < 4; ++j) { cgt += __popcll(__ballot(key[j] > T)); ceq += (key[j] == T) ? 1 : 0; }
    const int n_gt = block_sum_i(red, par, cgt, F.wave, F.lane);
    const int need_eq = cap - n_gt;
    int eqrank = block_exscan_i(red, par, ceq, F.wave, F.lane);
    int sel[4], csel = 0;
#pragma unroll
    for (int j = 0; j < 4; ++j) { const bool eq = key[j] == T; sel[j] = (key[j] > T || (eq && eqrank < need_eq)) ? 1 : 0; eqrank += eq ? 1 : 0; csel += sel[j]; }
    int slot = block_exscan_i(red, par, csel, F.wave, F.lane);
#pragma unroll
    for (int j = 0; j < 4; ++j) { const int tok = 4 * F.tid + j;
        if (tok < n) { SLOT[(size_t)(rowbase + tok) * 16 + e] = sel[j] ? slot : -1; if (sel[j]) { LIST[listbase + slot] = rowbase + tok; ++slot; } } }
}
__device__ __forceinline__ void phase_topk(Frame& F, bool need_ctx) {
    LAS int* red = (LAS int*)F.lds; int par = 0;
    for (int pair = F.vcu; pair < NB * NEXP; pair += F.G) {
        const int b = pair >> 4, e = pair & 15;
        topk_set(F, red, par, SEQ, CAPL, b * SEQ, e, e * PAIRS_E + b * CAPL);
        if (need_ctx) topk_set(F, red, par, CTXL, CAPC, NLAT + b * CTXL, e, e * PAIRS_E + NB * CAPL + b * CAPC);
    }
}

constexpr int SC_STEPS = 32;
constexpr int CS_AT = 0, CS_BT = 4608, CS_KT = 9216, CS_RT = 13824, CS_ATF = 18432;
constexpr int CS_BKT = CS_ATF + 2 * 4352, CS_WC = CS_BKT + 2 * 4352, CS_SET = CS_WC + 512;
__device__ __forceinline__ int cs_atf(int sc, int c) { return sc * 4352 + (c * 16 + 8 * (c >> 3)) * 4; }
__device__ __forceinline__ int cs_bkt(int sc, int c) { return sc * 4352 + c * 64 + 32 * (c >> 3); }
__device__ __forceinline__ int cs_vt(int sc, int v) { return sc * 2176 + v * 32 + 16 * (v >> 3); }
constexpr int CS_WT = 2 * CS_SET, CS_NM = CS_WT + 1024, CS_ABK = CS_NM + 2560, CS_AVT = CS_ABK + 2 * 2560, CS_AH = CS_AVT + 10240, CS_UBT = CS_AH + 4608, CS_CONV = CS_UBT + 10240, CS_CST = CS_CONV + 4 * 4224, CS_YO = CS_CST + 1536, CS_VTR = CS_YO + 4608, CS_VTSZ = 2 * 2176;
static_assert(CS_SET % 16 == 0 && CS_VTR + 3 * CS_VTSZ <= MISC_OFF, "scan lds map");
__device__ __forceinline__ void scan_chunk_geom(int ci, int b, int d, int s, int& slen, int& t, size_t& row) {
    constexpr int NC = CTXL / SC_STEPS;
    const bool ctx = ci < NC; slen = ctx ? CTXL : SEQ; const int c0 = (ctx ? ci : ci - NC) * SC_STEPS; const int rowbase = ctx ? NLAT + b * CTXL : b * SEQ;
    t = d == 0 ? (c0 + s) : (slen - 1 - (c0 + s)); row = (size_t)(rowbase + t);
}
#define CS_MMA(x_, y_, c_) __builtin_amdgcn_mfma_f32_16x16x32_bf16(x_, y_, c_, 0, 0, 0)
__device__ __forceinline__ bf16x8 cs_ld16(const LAS char* p) { return *(const LAS bf16x8*)p; }
__device__ __forceinline__ bf16x8 cs_ld8x2(const LAS char* p0, const LAS char* p1) { const u32x2 a = *(const LAS u32x2*)p0, b = *(const LAS u32x2*)p1; const u32x4 w = {a.x, a.y, b.x, b.y}; return __builtin_bit_cast(bf16x8, w); }
__device__ __forceinline__ void cs_st16(LAS char* p, float x) { *(LAS unsigned short*)p = (unsigned short)pk2(x, x); }
#define CS_UD4(v_) asm volatile("" : "=v"(v_.x), "=v"(v_.y), "=v"(v_.z), "=v"(v_.w))
#define CS_UD8(a_) asm volatile("" : "=v"(a_[0]), "=v"(a_[1]), "=v"(a_[2]), "=v"(a_[3]), "=v"(a_[4]), "=v"(a_[5]), "=v"(a_[6]), "=v"(a_[7]))
#define CS_UNDEF_ALL() do { CS_UD4(rx[0]); CS_UD4(rx[1]); CS_UD4(rx[2]); CS_UD4(rp[0]); CS_UD4(rp[1]); CS_UD4(rp[2]); CS_UD4(rn[0]); CS_UD4(rn[1]); CS_UD4(rn[2]); CS_UD4(wu); CS_UD4(wa); \
        CS_UD8(pr_); CS_UD8(pkk); CS_UD8(pb); CS_UD8(pkd); asm volatile("" : "=v"(cv[0]), "=v"(cv[1]), "=v"(cv[2]), "=v"(cv[3]), "=v"(cv[4]), "=v"(cv[5]), "=v"(cv[6]), "=v"(cv[7])); \
        asm volatile("" : "=v"(cv[8]), "=v"(cv[9]), "=v"(cv[10]), "=v"(cv[11]), "=v"(cv[12]), "=v"(cv[13]), "=v"(cv[14]), "=v"(cv[15])); asm volatile("" : "=v"(cv_it)); } while (0)
#define CS_BAR() asm volatile("s_waitcnt lgkmcnt(0)\n\ts_barrier" ::: "memory")
template <int PR>
__device__ __forceinline__ void phase_scan(Frame& F, int l, const float* shift_mu, const float* rwkv_kk, const float* rwkv_ka, const float* exp_gate, const float* exp_up, const float* exp_down, const float* rwkv_rk, bool noconv_ = false) {
    const bool noconv = noconv_ || PR != 0;
    const bf16_t* P = (const bf16_t*)(F.ws + WS_PROJ); const bf16_t* WAG = (const bf16_t*)(F.ws + WS_WAG);
    LAS char* LB = (LAS char*)F.lds;
    const int tid = F.tid;
    const bool teamS = F.wave < 4;
    constexpr bool skipS = (PR & 1) != 0, skipP = (PR & 2) != 0, skipY = (PR & 4) != 0, skipS2 = (PR & 8) != 0, skipS3 = (PR & 16) != 0, skipP2 = (PR & 32) != 0;
    const int wv = F.wave & 3;
    const int pt = tid & 255, s = pt >> 3, cg = pt & 7;
    const int psc = s >> 4, pts = s & 15;
    constexpr int NCH = (CTXL + SEQ) / SC_STEPS;
    for (int chain = F.vcu; chain < 2 * NB * 8; chain += F.G) {
        const int d = chain >> 7, b = (chain >> 3) & 15, h = chain & 7;
        bf16_t* Y = (bf16_t*)(F.ws + (d == 0 ? WS_YF : WS_YB));
        const int hc = h * 64 + 8 * cg;
        if (tid < 384) {
            const int a_ = tid >> 6, c_ = tid & 63;
            const float* src = a_ == 0 ? rwkv_rk + (size_t)l * 512 : a_ == 4 ? rwkv_kk + (size_t)l * 512 : a_ == 5 ? rwkv_ka + (size_t)l * 512 : shift_mu + (size_t)l * 1920 + 512 * (a_ - 1);
            ((LAS float*)(LB + CS_CST))[tid] = src[h * 64 + c_];
        }
        __syncthreads();
        f32x4 Sacc[4];
#pragma unroll
        for (int j = 0; j < 4; ++j) Sacc[j] = (f32x4){0.f, 0.f, 0.f, 0.f};
        float pr_[8], pkk[8], pb[8], pkd[8];
        u32x4 rx[3], rp[3], rn[3], wu, wa;
        float cv[16]; int cv_it = -1;
#define CS_FETCH(cix_, dep_) do { int slen_, t_; size_t row_; scan_chunk_geom((cix_), b, d, s + (dep_), slen_, t_, row_); const bf16_t* pr_g = P + row_ * PW + C_RW + hc; const bool hp_ = t_ > 0, hn_ = t_ + 1 < slen_; \
            const bf16_t* pr_p = pr_g - (hp_ ? PW : 0); const bf16_t* pr_n = pr_g + (hn_ ? PW : 0);        \
            _Pragma("unroll") for (int q = 0; q < 3; ++q) { rx[q] = *(const u32x4*)(pr_g + 512 * q); rp[q] = *(const u32x4*)(pr_p + 512 * q); rn[q] = *(const u32x4*)(pr_n + 512 * q); } \
            wu = *(const u32x4*)(WAG + row_ * WAGW + d * 512 + hc); wa = *(const u32x4*)(WAG + row_ * WAGW + 1024 + d * 512 + hc); } while (0)
#pragma unroll
        for (int i = 0; i < 16; ++i) cv[i] = 0.f;
        if (!teamS) CS_FETCH(0, 0);
        for (int ci = -2; ci < NCH; ++ci) {
            int lane = F.lane; asm volatile("" : "+v"(lane));
            const int r16 = lane & 15, q4 = lane >> 4;
            const int s = ((tid & 255) >> 6) * 8 + (lane >> 3), cg = lane & 7;
            const int psc = s >> 4, pts = s & 15;
            const int hc = h * 64 + 8 * cg;
            const LAS char* set0 = LB + (ci & 1) * CS_SET;
            const LAS char* set1 = LB + ((ci + 1) & 1) * CS_SET;
            if (teamS) {
                if (ci >= 0 && !skipS && !skipS3) {
                    const LAS char* setc = set0; const LAS char* vtc = LB + CS_VTR + (ci % 3) * CS_VTSZ; const LAS char* abk = LB + CS_ABK + (ci & 1) * 2560;
                    const int vrow = 16 * wv + r16;
#pragma unroll
                    for (int sc = 0; sc < 2; ++sc) {
                        bf16x8 sop[2];
#pragma unroll
                        for (int kk = 0; kk < 2; ++kk) { const u32x4 w = {pk2(Sacc[2 * kk][0], Sacc[2 * kk][1]), pk2(Sacc[2 * kk][2], Sacc[2 * kk][3]), pk2(Sacc[2 * kk + 1][0], Sacc[2 * kk + 1][1]), pk2(Sacc[2 * kk + 1][2], Sacc[2 * kk + 1][3])}; sop[kk] = __builtin_bit_cast(bf16x8, w); }
                        f32x4 uacc = *(const LAS f32x4*)(LB + CS_UBT + (sc * 64 + vrow) * 80 + 16 * q4);
                        f32x4 yacc = {0.f, 0.f, 0.f, 0.f};
#pragma unroll
                        for (int kk = 0; kk < 2; ++kk) {
                            const LAS char* ah = LB + CS_AH + (sc * 16 + r16) * 144 + 64 * kk + 8 * q4;
                            uacc = CS_MMA(cs_ld8x2(ah, ah + 32), sop[kk], uacc);
                            const LAS char* rt = setc + CS_RT + (16 * sc + r16) * 144 + 64 * kk + 8 * q4;
                            yacc = CS_MMA(cs_ld8x2(rt, rt + 32), sop[kk], yacc);
                        }
                        const u32x2 v2 = *(const LAS u32x2*)(vtc + cs_vt(sc, vrow) + 8 * q4);
                        const u32x4 uvw = {pk2(uacc[0], uacc[1]), pk2(uacc[2], uacc[3]), v2.x, v2.y};
                        const bf16x8 uv = __builtin_bit_cast(bf16x8, uvw);
                        yacc = CS_MMA(cs_ld16(abk + (sc * 16 + r16) * 80 + 16 * q4), uv, yacc);
#pragma unroll
                        for (int tile = 0; tile < 4; ++tile) {
                            const f32x4 wc = *(const LAS f32x4*)(setc + CS_WC + (sc * 64 + 16 * tile + 4 * q4) * 4);
                            Sacc[tile] = CS_MMA(cs_ld16(setc + CS_BKT + cs_bkt(sc, 16 * tile + r16) + 16 * q4), uv, Sacc[tile] * wc);
                        }
#pragma unroll
                        for (int g = 0; g < 4; ++g) cs_st16(LB + CS_YO + (16 * sc + 4 * q4 + g) * 144 + 2 * vrow, yacc[g]);
                    }
                }
                if (ci + 1 >= 0 && ci + 1 < NCH && !skipS) {
                    const LAS char* setc = set1; const LAS char* vtc = LB + CS_VTR + ((ci + 1) % 3) * CS_VTSZ; LAS char* abk = LB + CS_ABK + ((ci + 1) & 1) * 2560;
                    const int sc = wv >> 1, role = wv & 1;
                    const LAS char* yop = setc + (role == 0 ? CS_AT : CS_RT) + (16 * sc + r16) * 144 + 16 * q4;
                    const LAS char* xb = setc + CS_BT + (16 * sc + r16) * 144 + 16 * q4;
                    const LAS char* xk = setc + CS_KT + (16 * sc + r16) * 144 + 16 * q4;
                    f32x4 accB = {0.f, 0.f, 0.f, 0.f}, accK = {0.f, 0.f, 0.f, 0.f};
#pragma unroll
                    for (int kk = 0; kk < 2; ++kk) { const bf16x8 yv = cs_ld16(yop + 64 * kk); accB = CS_MMA(cs_ld16(xb + 64 * kk), yv, accB); accK = CS_MMA(cs_ld16(xk + 64 * kk), yv, accK); }
                    if (role == 0) {
                        f32x4 nm; float ak[4];
#pragma unroll
                        for (int g = 0; g < 4; ++g) { const bool keep = 4 * q4 + g < r16; nm[g] = keep ? accB[g] : 0.f; ak[g] = keep ? accK[g] : 0.f; }
                        *(LAS f32x4*)(LB + CS_NM + (sc * 16 + r16) * 80 + 16 * q4) = nm;
                        const u32x4 xw = {pk2(ak[0], ak[1]), pk2(ak[2], ak[3]), 0u, 0u};
                        const bf16x8 xop = __builtin_bit_cast(bf16x8, xw);
#pragma unroll
                        for (int vt = 0; vt < 4; ++vt) {
                            const u32x2 v2 = *(const LAS u32x2*)(vtc + cs_vt(sc, 16 * vt + r16) + 8 * q4);
                            const u32x4 yw = {v2.x, v2.y, 0u, 0u};
                            f32x4 av = {0.f, 0.f, 0.f, 0.f};
                            av = CS_MMA(xop, __builtin_bit_cast(bf16x8, yw), av);
                            *(LAS f32x4*)(LB + CS_AVT + (sc * 64 + 16 * vt + r16) * 80 + 16 * q4) = av;
                        }
                    } else {
                        float rb[4], rk[4];
#pragma unroll
                        for (int g = 0; g < 4; ++g) { const bool keep = 4 * q4 + g <= r16; rb[g] = keep ? accB[g] : 0.f; rk[g] = keep ? accK[g] : 0.f; }
                        const u32x4 w = {pk2(rb[0], rb[1]), pk2(rb[2], rb[3]), pk2(rk[0], rk[1]), pk2(rk[2], rk[3])};
                        *(LAS u32x4*)(abk + (sc * 16 + r16) * 80 + 16 * q4) = w;
                    }
                }
                CS_UNDEF_ALL();
            } else {
              {
                  LAS float* scr = (LAS float*)(LB + CS_CONV) + (F.wave - 4) * (32 * 33);
                  convert_expert_finish32(F.ws, cv_it, cv, scr, F.lane);
              }
              int dep = 0;
              if (ci + 2 < NCH && !skipP) {
                int slen, t; size_t row;
                scan_chunk_geom(ci + 2, b, d, s, slen, t, row);
                const bool hp = t > 0, hn = t + 1 < slen;
                const LAS float* cst = (const LAS float*)(LB + CS_CST) + 8 * cg;
                float k[8], pv[8];
#pragma unroll
                for (int q = 0; q < 3; ++q) {
                    float x[8], xp[8], xn[8];
                    const unsigned mp = hp ? 0xffffffffu : 0u, mn = hn ? 0xffffffffu : 0u;
                    unpack8(rx[q], x); unpack8((u32x4){rp[q].x & mp, rp[q].y & mp, rp[q].z & mp, rp[q].w & mp}, xp); unpack8((u32x4){rn[q].x & mn, rn[q].y & mn, rn[q].z & mn, rn[q].w & mn}, xn);
                    const f32x4 m0 = *(const LAS f32x4*)(cst + 64 * (1 + q)), m1 = *(const LAS f32x4*)(cst + 64 * (1 + q) + 4);
#pragma unroll
                    for (int i = 0; i < 8; ++i) { const float m = i < 4 ? m0[i & 3] : m1[i & 3]; const float sft = x[i] + m * (0.5f * (xp[i] + xn[i]) - x[i]);
                        if (q == 0) pr_[i] = sft; else if (q == 1) k[i] = sft; else pv[i] = sft; }
                    __builtin_amdgcn_sched_barrier(0);
                }
                __builtin_amdgcn_sched_barrier(0);
                float pu[8], ag[8];
                unpack8(wu, pu); unpack8(wa, ag);
#pragma unroll
                for (int i = 0; i < 8; ++i) pu[i] *= 1.4426950408889634f;
                asm volatile("" : "+v"(dep) : "v"(pu[0]), "v"(pu[1]), "v"(pu[2]), "v"(pu[3]), "v"(pu[4]), "v"(pu[5]), "v"(pu[6]), "v"(pu[7]), "v"(ag[0]), "v"(ag[1]), "v"(ag[2]), "v"(ag[3]), "v"(ag[4]), "v"(ag[5]), "v"(ag[6]), "v"(ag[7]), "v"(pr_[0]), "v"(k[0]), "v"(pv[0]), "v"(pr_[7]), "v"(k[7]), "v"(pv[7]));
                CS_FETCH(ci + 3 < NCH ? ci + 3 : NCH - 1, dep);
#pragma unroll
                for (int i = 0; i < 8; ++i) cs_st16(LB + CS_VTR + ((ci + 2) % 3) * CS_VTSZ + cs_vt(psc, 8 * cg + i) + 2 * pts, pv[i]);
                if (d == 0) {
                    const f32x4 k0 = *(const LAS f32x4*)(cst), k1 = *(const LAS f32x4*)(cst + 4);
                    float bs = 0.f, bo[8];
#pragma unroll
                    for (int i = 0; i < 8; ++i) bs += pr_[i] * k[i] * (i < 4 ? k0[i & 3] : k1[i & 3]);
                    bs = sum8(bs);
#pragma unroll
                    for (int i = 0; i < 8; ++i) bo[i] = bs * pv[i];
                    st8((bf16_t*)(F.ws + WS_BON) + row * 512 + hc, bo);
                }
                LAS float* ub = (LAS float*)(LB + CS_CONV + (F.wave - 4) * 4224) + (s & 7) * 64 + 8 * cg;
                *(LAS f32x4*)ub = (f32x4){pu[0], pu[1], pu[2], pu[3]}; *(LAS f32x4*)(ub + 4) = (f32x4){pu[4], pu[5], pu[6], pu[7]};
                {
                    float pl[8];
                    const int srcA = ((lane >> 4) - 1) * 16 + 8 + cg, srcB = ((lane >> 4) - 2) * 16 + 8 + cg;
#pragma unroll
                    for (int i = 0; i < 8; ++i) pl[i] = pu[i] + __builtin_bit_cast(float, __builtin_amdgcn_update_dpp(0, __builtin_bit_cast(int, pu[i]), 0x118, 0xF, 0xF, true));
#pragma unroll
                    for (int i = 0; i < 8; ++i) { const float t_ = __builtin_bit_cast(float, __builtin_amdgcn_ds_bpermute(srcA * 4, __builtin_bit_cast(int, pl[i]))); pl[i] += lane >= 16 ? t_ : 0.f; }
#pragma unroll
                    for (int i = 0; i < 8; ++i) { const float t_ = __builtin_bit_cast(float, __builtin_amdgcn_ds_bpermute(srcB * 4, __builtin_bit_cast(int, pl[i]))); pl[i] += lane >= 32 ? t_ : 0.f; }
                    if (lane >= 56) { LAS float* wt = (LAS float*)(LB + CS_WT) + (s >> 3) * 64 + 8 * cg; *(LAS f32x4*)wt = (f32x4){pl[0], pl[1], pl[2], pl[3]}; *(LAS f32x4*)(wt + 4) = (f32x4){pl[4], pl[5], pl[6], pl[7]}; }
                    LAS float* ub2 = ub + 512;
                    *(LAS f32x4*)ub2 = (f32x4){pl[0], pl[1], pl[2], pl[3]}; *(LAS f32x4*)(ub2 + 4) = (f32x4){pl[4], pl[5], pl[6], pl[7]};
                }
                const f32x4 kk0 = *(const LAS f32x4*)(cst + 64 * 4), kk1 = *(const LAS f32x4*)(cst + 64 * 4 + 4), ka0 = *(const LAS f32x4*)(cst + 64 * 5), ka1 = *(const LAS f32x4*)(cst + 64 * 5 + 4);
                float kks[8], n2 = 0.f;
#pragma unroll
                for (int i = 0; i < 8; ++i) { kks[i] = k[i] * (i < 4 ? kk0[i & 3] : kk1[i & 3]); n2 += kks[i] * kks[i]; }
                n2 = sum8(n2);
                const float rn_ = rsq_(n2 + 1e-12f);
#pragma unroll
                for (int i = 0; i < 8; ++i) { pkk[i] = kks[i] * rn_; pb[i] = pkk[i] * ag[i]; pkd[i] = k[i] * (1.0f + (ag[i] - 1.0f) * (i < 4 ? ka0[i & 3] : ka1[i & 3])); }
              }
            }
            CS_BAR();
            if (teamS) {
                if (ci + 1 >= 0 && ci + 1 < NCH && !skipS && !skipS2) {
                    const LAS char* setc = set1;
                    const int sc = wv >> 1, part = wv & 1;
                    const LAS float* rhs = part == 0 ? (const LAS float*)(setc + CS_ATF + cs_atf(sc, lane)) : (const LAS float*)(LB + CS_AVT + (sc * 64 + lane) * 80);
                    const LAS float* nrow = (const LAS float*)(LB + CS_NM + sc * 1280);
                    float xs[16];
#pragma unroll
                    for (int t4 = 0; t4 < 4; ++t4) { const f32x4 v4 = *(const LAS f32x4*)(rhs + 4 * t4); xs[4 * t4] = v4[0]; xs[4 * t4 + 1] = v4[1]; xs[4 * t4 + 2] = v4[2]; xs[4 * t4 + 3] = v4[3]; }
#pragma unroll
                    for (int t = 1; t < 16; ++t) {
                        float a3[3] = {xs[t], 0.f, 0.f};
#pragma unroll
                        for (int i4 = 0; i4 < (t + 3) / 4; ++i4) {
                            const f32x4 n4 = *(const LAS f32x4*)(nrow + t * 20 + 4 * i4);
#pragma unroll
                            for (int j = 0; j < 4; ++j) if (4 * i4 + j < t) a3[(4 * i4 + j) % 3] += n4[j] * xs[4 * i4 + j];
                        }
                        xs[t] = (a3[0] + a3[1]) + a3[2];
                        if (t == 8 || t == 12) __builtin_amdgcn_sched_barrier(0);
                    }
                    if (part == 0) {
#pragma unroll
                        for (int t = 0; t < 16; ++t) cs_st16(LB + CS_AH + (sc * 16 + t) * 144 + 2 * lane, xs[t]);
                    } else {
#pragma unroll
                        for (int t4 = 0; t4 < 4; ++t4) *(LAS f32x4*)(LB + CS_UBT + (sc * 64 + lane) * 80 + 16 * t4) = (f32x4){xs[4 * t4], xs[4 * t4 + 1], xs[4 * t4 + 2], xs[4 * t4 + 3]};
                    }
                }
                CS_UNDEF_ALL();
            } else {
              {
                  const int pw = F.vcu * 4 + (F.wave - 4), npw = F.G * 4;
                  const int it = ((ci / 3) * 2 + (ci % 3)) * npw + pw;
                  const bool valid = ci >= 0 && ci % 3 != 2 && chain < F.G && !noconv && it < 3 * NEXP * 1024;
                  cv_it = valid ? it : -1;
                  convert_expert_issue32(l, valid ? it : pw, exp_gate, exp_up, exp_down, cv, lane);
              }
              if (ci + 2 < NCH && !skipP && !skipP2) {
                LAS char* setn = LB + (ci & 1) * CS_SET;
                float li[8], lt[8];
                const LAS float* ub = (const LAS float*)(LB + CS_CONV + (F.wave - 4) * 4224) + (s & 7) * 64 + 8 * cg;
                {
                    const int wq = s >> 3;
                    const LAS float* w0 = (const LAS float*)(LB + CS_WT) + wq * 64 + 8 * cg; const LAS float* w1 = (const LAS float*)(LB + CS_WT) + (wq ^ 1) * 64 + 8 * cg;
                    const f32x4 a0 = *(const LAS f32x4*)w0, a1 = *(const LAS f32x4*)(w0 + 4), b0 = *(const LAS f32x4*)w1, b1 = *(const LAS f32x4*)(w1 + 4);
                    const float m = (wq & 1) ? 1.0f : 0.0f;
                    const LAS float* ub2 = ub + 512;
                    const f32x4 p0 = *(const LAS f32x4*)ub2, p1 = *(const LAS f32x4*)(ub2 + 4);
#pragma unroll
                    for (int i = 0; i < 4; ++i) { lt[i] = a0[i] + b0[i]; lt[4 + i] = a1[i] + b1[i]; li[i] = p0[i] + m * b0[i]; li[4 + i] = p1[i] + m * b1[i]; }
                }
                float at[8], bt[8], kt[8], rt[8], bh[8], kh[8], pu[8];
                { const f32x4 u0 = *(const LAS f32x4*)(ub), u1 = *(const LAS f32x4*)(ub + 4); pu[0] = u0[0]; pu[1] = u0[1]; pu[2] = u0[2]; pu[3] = u0[3]; pu[4] = u1[0]; pu[5] = u1[1]; pu[6] = u1[2]; pu[7] = u1[3]; }
#pragma unroll
                for (int i = 0; i < 8; ++i) {
                    const float wt = __builtin_amdgcn_exp2f(-li[i]), wprev = __builtin_amdgcn_exp2f(pu[i] - li[i]), iw = __builtin_amdgcn_exp2f(li[i]), wrest = __builtin_amdgcn_exp2f(li[i] - lt[i]);
                    at[i] = -pkk[i] * wprev; bt[i] = pb[i] * iw; kt[i] = pkd[i] * iw; rt[i] = pr_[i] * wt; bh[i] = pb[i] * wrest; kh[i] = pkd[i] * wrest;
                }
                *(LAS u32x4*)(setn + CS_AT + s * 144 + 16 * cg) = pack8(at);
                *(LAS u32x4*)(setn + CS_BT + s * 144 + 16 * cg) = pack8(bt);
                *(LAS u32x4*)(setn + CS_KT + s * 144 + 16 * cg) = pack8(kt);
                *(LAS u32x4*)(setn + CS_RT + s * 144 + 16 * cg) = pack8(rt);
#pragma unroll
                for (int i = 0; i < 8; ++i) {
                    const int c = 8 * cg + i;
                    *(LAS float*)(setn + CS_ATF + cs_atf(psc, c) + 4 * pts) = at[i];
                    LAS char* bk = setn + CS_BKT + cs_bkt(psc, c) + 16 * (pts >> 2) + 2 * (pts & 3);
                    cs_st16(bk, bh[i]); cs_st16(bk + 8, kh[i]);
                }
                if (pts == 15) {
                    LAS float* wc = (LAS float*)(setn + CS_WC) + psc * 64 + 8 * cg;
                    *(LAS f32x4*)wc = (f32x4){__builtin_amdgcn_exp2f(-lt[0]), __builtin_amdgcn_exp2f(-lt[1]), __builtin_amdgcn_exp2f(-lt[2]), __builtin_amdgcn_exp2f(-lt[3])}; *(LAS f32x4*)(wc + 4) = (f32x4){__builtin_amdgcn_exp2f(-lt[4]), __builtin_amdgcn_exp2f(-lt[5]), __builtin_amdgcn_exp2f(-lt[6]), __builtin_amdgcn_exp2f(-lt[7])};
                }
            }
              if (ci >= 0 && !(skipS || skipS3 || skipY)) {
                  int slen, t; size_t row;
                  scan_chunk_geom(ci, b, d, s, slen, t, row);
                  *(u32x4*)(Y + row * 512 + hc) = *(const LAS u32x4*)(LB + CS_YO + s * 144 + 16 * cg);
              }
            }
            CS_BAR();
        }
        if (!teamS) { LAS float* scr = (LAS float*)(LB + CS_CONV) + (F.wave - 4) * (32 * 33); convert_expert_finish32(F.ws, cv_it, cv, scr, F.lane); }
        __syncthreads();
#undef CS_FETCH
    }
}
#undef CS_MMA

struct RoRow { u32x4 yf, yb, bo, g; };
__device__ __forceinline__ void ro_load(Frame& F, RoRow& R, int row) {
    const int lane = F.lane;
    R.yf = *(const u32x4*)((const bf16_t*)(F.ws + WS_YF) + (size_t)row * 512 + 8 * lane); R.yb = *(const u32x4*)((const bf16_t*)(F.ws + WS_YB) + (size_t)row * 512 + 8 * lane);
    R.bo = *(const u32x4*)((const bf16_t*)(F.ws + WS_BON) + (size_t)row * 512 + 8 * lane);
    R.g = *(const u32x4*)((const bf16_t*)(F.ws + WS_WAG) + (size_t)row * WAGW + 2048 + 8 * lane);
}
__device__ __forceinline__ void phase_readout(Frame& F, int l, int nrows, const float* gn_w, const float* gn_b) {
    bf16_t* P = (bf16_t*)(F.ws + WS_PROJ);
    const int lane = F.lane;
    float gw[8], gb[8];
#pragma unroll
    for (int i = 0; i < 8; ++i) { gw[i] = gn_w[(size_t)l * 512 + 8 * lane + i]; gb[i] = gn_b[(size_t)l * 512 + 8 * lane + i]; }
    for (int row0 = F.gw; row0 < nrows; row0 += 4 * F.NGW) {
        RoRow RR[4]; int rows[4]; bool ok[4];
#pragma unroll
        for (int z = 0; z < 4; ++z) { rows[z] = row0 + z * F.NGW; ok[z] = rows[z] < nrows; ro_load(F, RR[z], ok[z] ? rows[z] : row0); }
#pragma unroll
        for (int z = 0; z < 4; ++z) {
            if (!ok[z]) continue;
            const RoRow& R = RR[z];
            float yf[8], yb[8], y[8];
            unpack8(R.yf, yf); unpack8(R.yb, yb);
            float sm = 0.f;
#pragma unroll
            for (int i = 0; i < 8; ++i) { y[i] = yf[i] + yb[i]; sm += y[i]; }
            const float mean = sum8(sm) * (1.0f / 64.0f);
            float sq = 0.f;
#pragma unroll
            for (int i = 0; i < 8; ++i) { y[i] -= mean; sq += y[i] * y[i]; }
            const float rstd = rsq_(sum8(sq) * (1.0f / 64.0f) + GN_EPS);
            float bo[8], g[8], o[8];
            unpack8(R.bo, bo); unpack8(R.g, g);
#pragma unroll
            for (int i = 0; i < 8; ++i) o[i] = (y[i] * rstd * gw[i] + gb[i] + bo[i]) * g[i];
            st8(P + (size_t)rows[z] * PW + C_ORWKV + 8 * lane, o);
        }
    }
}
__device__ __forceinline__ void phase_attention(Frame& F, bool need_ctx, char* lds_generic) {
    typedef attn_body::bf16 abf;
    abf* P = (abf*)(F.ws + WS_PROJ);
    const int nu = (need_ctx && F.vcu < NB * 8) ? 5 : 4;
    for (int i = 0; i < nu; ++i) {
        int b, h, qrow, NT;
        if (i < 4) { const int u = F.vcu * 4 + i; b = u >> 6; h = (u >> 3) & 7; qrow = b * SEQ + (u & 7) * 256; NT = (CTXL + SEQ) / 64; }
        else { b = F.vcu >> 3; h = F.vcu & 7; qrow = NLAT + b * CTXL; NT = CTXL / 64; }
        abf* Qu = P + (size_t)qrow * PW + C_Q + h * 64;
        attn_body::attn_unit<8>(Qu, Qu + (C_OATT - C_Q), P + C_K + (h >> 2) * 64, NLAT + b * CTXL, b * SEQ, NT, CTXL / 64, lds_generic);
    }
}

struct Args { const float* in[32]; float* out; unsigned char* ws; int ph_lo, ph_hi; };
constexpr int PH_PER_LAYER = 12, PH_FINAL = 1 + NL * PH_PER_LAYER, PH_END = PH_FINAL + 1;

__global__ void __launch_bounds__(NTHR, 2) mega_fwd(Args args) {
    extern __shared__ __attribute__((aligned(16))) unsigned char lds[];
    Frame F;
    F.lds = (LAS unsigned char*)lds;
    F.tid = threadIdx.x; F.lane = F.tid & 63; F.wave = __builtin_amdgcn_readfirstlane(F.tid >> 6);
    F.G = gridDim.x; { const int bx = blockIdx.x; F.vcu = (F.G % 8 == 0) ? (bx % 8) * (F.G / 8) + bx / 8 : bx; }
    F.gw = F.vcu * NWAVES + F.wave; F.NGW = F.G * NWAVES; F.bid = blockIdx.x;
    F.out = args.out; F.ws = args.ws;
    volatile LAS unsigned* MISC = (volatile LAS unsigned*)(F.lds + MISC_OFF);
    for (int u = F.tid; u < (LDS_BYTES - MISC_OFF) / 4; u += NTHR) MISC[u] = 0u;
    __syncthreads();
    unsigned* ctl = (unsigned*)(F.ws + WS_CTL);
    XcdBarrier bar = xcd_barrier_post(ctl + CW_BAR, MISC + 8);
    const int lo = args.ph_lo, hi = args.ph_hi;
    typedef const __attribute__((address_space(1))) float* cfp_t;
#define KP(k) ((const float*)KIN[k])
#define KIN_DECL const __attribute__((address_space(4))) cfp_t* KIN = (const __attribute__((address_space(4))) cfp_t*)__builtin_amdgcn_kernarg_segment_ptr(); asm volatile("" : "+s"(KIN))
#ifndef PHMASK
#define PHMASK 0xFFFFFFFFu
#endif
#define IN(k) (lo <= (k) && (k) < hi)
#define EN(j) ((PHMASK >> (j)) & 1u)
#define SEAM(k) do { if ((k) + 1 < hi) xcd_barrier(bar); } while (0)
#ifndef DUPMASK
#define DUPMASK 0u
#endif
#define REP(j) for (int rep_ = 0; rep_ < 1 + (int)((DUPMASK >> (j)) & 1u); ++rep_)
#ifdef PROBE_T1
    unsigned long long pt0 = 0; int l_ = 0; volatile LAS unsigned* PTS = MISC + 64;
#define PB() do { pt0 = __builtin_amdgcn_s_memrealtime(); } while (0)
#define PE(j) do { PTS[(j) * 4 + (l_ & 3)] = (unsigned)(__builtin_amdgcn_s_memrealtime() - pt0); } while (0)
#else
#define PB() do {} while (0)
#define PE(j) do {} while (0)
#endif

    if (EN(0) && IN(0)) { relaunder(F); PB(); KIN_DECL; REP(0) phase_prologue(F, KP(1), KP(3), KP(4), KP(5), KP(7), KP(12), KP(14), KP(15), KP(22), KP(23), KP(24), KP(25), KP(27)); SEAM(0); PE(0); }

    for (int l = 0; l < NL; ++l) {
#ifdef PROBE_T1
        l_ = l;
#endif
        const int pb = 1 + l * PH_PER_LAYER;
        const bool need_ctx = l < NL - 1;
        const int nrows = need_ctx ? NTOK : NLAT;
        if (EN(1) && IN(pb + 0)) { relaunder(F); PB(); KIN_DECL; REP(1) phase_norm1(F, l, KP(0), KP(2), KP(6), KP(31), rep_ > 0); SEAM(pb + 0); PE(1); }
        if (EN(2) && IN(pb + 1)) { relaunder(F); PB();
            pg8::EpiProj E{(bf16_t*)(F.ws + WS_PROJ), F.ws + WS_GATES};
            if (need_ctx) { pg8::PlainOrder S; S.init(F.ws + WS_H, F.ws + WS_WIN + (size_t)l * PWP * DM * 2, NTOK, PWP, DM, DM, F.G, F.bid);
                REP(2) pg8::gemm_phase<pg8::EpiProj, pg8::PlainOrder, false>(F.lds, DM, DM, DM, S, E); }
            else { pg8::LastProjOrder S; S.init(F.ws + WS_H, F.ws + WS_WIN + (size_t)l * PWP * DM * 2, DM, DM, F.G, F.bid);
                pg8::gemm_phase<pg8::EpiProj, pg8::LastProjOrder, false>(F.lds, DM, DM, DM, S, E); }
            SEAM(pb + 1); PE(2);
        }
        if (EN(3) && IN(pb + 2)) { relaunder(F); PB(); KIN_DECL; REP(3) phase_prep(F, l, KP(8), KP(9), KP(21), KP(10), rep_ > 0); SEAM(pb + 2); PE(3); }
        if (EN(4) && IN(pb + 3)) { relaunder(F); PB();
            pg8::LowRankOrder S{(const char*)(F.ws + WS_LRA), (const char*)(F.ws + WS_WLR + (size_t)l * WAGW * 128 * 2), NTOK / 256, F.G, F.bid};
            KIN_DECL; pg8::EpiLowRank E{(bf16_t*)(F.ws + WS_WAG), KP(11) + (size_t)l * 1024, KP(13) + (size_t)l * 1024};
            int klr = 128; asm volatile("" : "+s"(klr));
            REP(4) pg8::gemm_phase<pg8::EpiLowRank, pg8::LowRankOrder, false>(F.lds, klr, LRAW, 128, S, E);
            REP(14) phase_attention(F, need_ctx, (char*)lds);
            SEAM(pb + 3); PE(4);
        }
        if (EN(5) && IN(pb + 4)) { relaunder(F); PB(); KIN_DECL; REP(5) phase_scan<0>(F, l, KP(10), KP(16), KP(17), KP(28), KP(29), KP(30), KP(18), rep_ > 0);
#ifdef SCAN_PROBE
            phase_scan<SCAN_PROBE>(F, l, KP(10), KP(16), KP(17), KP(28), KP(29), KP(30), KP(18), true);
#endif
 SEAM(pb + 4); PE(5); }
        if (EN(6) && IN(pb + 5)) { relaunder(F); PB(); KIN_DECL; REP(6) phase_readout(F, l, nrows, KP(19), KP(20)); SEAM(pb + 5); PE(6); }
        if (EN(7) && IN(pb + 6)) { relaunder(F); PB();
            pg8::MergeOrder S{(const char*)(F.ws + WS_PROJ), (const char*)(F.ws + WS_WBR + (size_t)l * 3 * 1024 * 512 * 2), nrows / 256, F.G, F.bid};
            pg8::EpiMerge E{(const unsigned char*)(F.ws + WS_GATES), (bf16_t*)(F.ws + WS_H)};
            REP(7) pg8::gemm_phase<pg8::EpiMerge, pg8::MergeOrder, false>(F.lds, 512, PW, 512, S, E);
            SEAM(pb + 6); PE(7);
        }
        if (EN(8) && IN(pb + 7)) { relaunder(F); PB();
            pg8::PlainOrder S; S.init(F.ws + WS_H, F.ws + WS_WOUT + (size_t)l * DM * DM * 2, nrows, DM, DM, DM, F.G, F.bid);
            pg8::EpiOut E{(bf16_t*)(F.ws + WS_XB), (const float*)(F.ws + WS_MOD) + (size_t)l * 17 * 6144};
            pg8::gemm_phase<pg8::EpiOut, pg8::PlainOrder, false>(F.lds, DM, DM, DM, S, E);
            SEAM(pb + 7); PE(8);
        }
        if (EN(9) && IN(pb + 8)) { relaunder(F); PB(); KIN_DECL; REP(9) phase_norm2_router_mfma(F, l, nrows, KP(26)); SEAM(pb + 8); PE(9); }
        if (EN(10) && IN(pb + 9)) { relaunder(F); PB(); REP(10) phase_topk(F, need_ctx); SEAM(pb + 9); PE(10); }
        if (EN(11) && IN(pb + 10)) { relaunder(F); PB();
            const int mt_per = need_ctx ? 18 : 16;
            LAS int* rows = (LAS int*)(F.lds + XTRA_OFF);
            pg8::MoeOrder S{(const char*)(F.ws + WS_H), (const char*)(F.ws + WS_WUP), rows, mt_per, 8, F.G, F.bid, (size_t)2048 * 1024 * 2};
            const int* LIST = (const int*)(F.ws + WS_LIST);
            for (int i = 0; i < XTRA_BYTES / 1024; ++i) { int e, mt, pn; if (!S.decode((long)i * F.G + F.bid, e, mt, pn)) break;
                if (F.tid < 256) rows[i * 256 + F.tid] = LIST[e * PAIRS_E + mt * 256 + F.tid]; }
            __syncthreads();
            pg8::EpiUp E{(bf16_t*)(F.ws + WS_HID)};
            REP(11) pg8::gemm_phase<pg8::EpiUp, pg8::MoeOrder, true>(F.lds, DM, DM, DM, S, E);
            SEAM(pb + 10); PE(11);
        }
        if (EN(12) && IN(pb + 11)) { relaunder(F); PB();
            const int mt_per = need_ctx ? 18 : 16;
            pg8::MoeDownOrder S{(const char*)(F.ws + WS_HID), (const char*)(F.ws + WS_WDN), mt_per, F.G, F.bid};
            pg8::EpiDown E{(bf16_t*)(F.ws + WS_YE)};
            REP(12) pg8::gemm_phase<pg8::EpiDown, pg8::MoeDownOrder, false>(F.lds, EFF, EFF, EFF, S, E);
            SEAM(pb + 11); PE(12);
        }
    }
    if (EN(13) && IN(PH_FINAL)) { relaunder(F); PB(); KIN_DECL; phase_norm1(F, NL, KP(0), KP(2), KP(6), KP(31)); PE(13); }
#ifdef PROBE_T1
    {
        __syncthreads();
        if (blockIdx.x == 0 && threadIdx.x == 0) { unsigned s1 = 0, s2 = 0; for (int q = 0; q < 4; ++q) { s1 += PTS[PROBE_T1 * 4 + q]; s2 += PTS[PROBE_T2 * 4 + q]; } ctl[CW_DBG] = s1; ctl[CW_DBG + 1] = s2; }
        xcd_barrier(bar);
        const float t1 = (float)__hip_atomic_load(ctl + CW_DBG, __ATOMIC_RELAXED, __HIP_MEMORY_SCOPE_AGENT), t2 = (float)__hip_atomic_load(ctl + CW_DBG + 1, __ATOMIC_RELAXED, __HIP_MEMORY_SCOPE_AGENT);
        const float cval = 10.0f * sqrtf(t1 * 0.01f);
        for (size_t i = (size_t)F.bid * NTHR + F.tid; i < (size_t)NLAT * DM; i += (size_t)F.G * NTHR) F.out[i] = (i == 0) ? t2 : cval;
    }
#endif
#undef IN
#undef SEAM
}

extern "C" void kernel_launch(void* const* d_in, const int* in_sizes, int n_in, void* d_out, int out_size, void* d_ws, size_t ws_size, hipStream_t stream) {
    static int grid = 0;
    if (grid == 0) {
        if (n_in != 32 || in_sizes[0] != NLAT * DM || out_size != NLAT * DM || ws_size < WS_END) { fprintf(stderr, "kernel_launch: unexpected shapes / workspace (n_in %d, ws %zu)\n", n_in, ws_size); grid = -1; return; }
        int dev = 0, cus = 0, per_cu = 0;
        if (hipGetDevice(&dev) != hipSuccess || hipDeviceGetAttribute(&cus, hipDeviceAttributeMultiprocessorCount, dev) != hipSuccess) { grid = -1; return; }
        if (hipFuncSetAttribute((const void*)mega_fwd, hipFuncAttributeMaxDynamicSharedMemorySize, LDS_BYTES) != hipSuccess) { grid = -1; return; }
        if (hipOccupancyMaxActiveBlocksPerMultiprocessor(&per_cu, (const void*)mega_fwd, NTHR, LDS_BYTES) != hipSuccess || per_cu < 1) { fprintf(stderr, "kernel_launch: occupancy query says %d\n", per_cu); }
        (void)hipGetLastError();
        grid = cus;
        if (grid != 256) { fprintf(stderr, "kernel_launch: built for 256 CUs, got %d\n", grid); grid = -1; return; }
    }
    if (grid < 0) return;
    if (hipMemsetAsync((char*)d_ws + WS_CTL, 0, CTL_ZERO_BYTES, stream) != hipSuccess) return;
    Args a{};
    for (int i = 0; i < 32; ++i) a.in[i] = (const float*)d_in[i];
    a.out = (float*)d_out; a.ws = (unsigned char*)d_ws;
#ifndef MK_PER_PHASE
    a.ph_lo = 0; a.ph_hi = PH_END;
    hipLaunchKernelGGL(mega_fwd, dim3(grid), dim3(NTHR), LDS_BYTES, stream, a);
#else
    for (int p = 0; p < PH_END; ++p) { a.ph_lo = p; a.ph_hi = p + 1; hipLaunchKernelGGL(mega_fwd, dim3(grid), dim3(NTHR), LDS_BYTES, stream, a); }
#endif
}
```

```cpp
#include <hip/hip_runtime.h>
#include <hip/hip_bf16.h>
#include <cstdio>
#include <cstdint>
#include <cmath>

#define LAS __attribute__((address_space(3)))
typedef unsigned short bf16_t;
typedef short bf16x8 __attribute__((ext_vector_type(8)));
typedef float f32x4 __attribute__((ext_vector_type(4)));
typedef float f32x2 __attribute__((ext_vector_type(2)));
typedef unsigned u32x4 __attribute__((ext_vector_type(4)));
typedef unsigned u32x2 __attribute__((ext_vector_type(2)));

constexpr int DM = 1024, NB = 16, SEQ = 2048, NL = 4, CTXL = 256;
constexpr int NLAT = NB * SEQ;
constexpr int NCTX = NB * CTXL;
constexpr int NTOK = NLAT + NCTX;
constexpr int PW = 4224;
constexpr int NCOLS_IN = 7296;
constexpr int PWP = 7424;
constexpr int C_Q = 0, C_K = 512, C_V = 640, C_RW = 768, C_R = 768, C_RK = 1280, C_RV = 1792, C_WLO = 2304, C_ALO = 2432, C_GLO = 2560;
constexpr int C_BG = 2688, C_CG = 3200, C_U = 3712, C_GT = 4224;
constexpr int C_OATT = 3712, C_OCONV = 2688, C_ORWKV = 3200;
constexpr int WAGW = 2560;
constexpr int LRAW = 384;
constexpr int NEXP = 16, EFF = 1024, CAPL = 256, CAPC = 32, PAIRS_E = 4608;
constexpr float NORM_EPS = 1e-6f, GN_EPS = 64e-5f;
constexpr float QSCALE = 0.125f * 1.4426950408889634f;

constexpr size_t MiB = 1u << 20;
constexpr size_t WS_CTL = 0, CTL_ZERO_BYTES = 1 * MiB;
constexpr size_t WS_MOD = 1 * MiB;
constexpr size_t WS_ROPE = 3 * MiB;
constexpr size_t WS_WRT = 3 * MiB + 65536;
constexpr size_t WS_LIST = 4 * MiB;
constexpr size_t WS_SLOT = 5 * MiB;
constexpr size_t WS_AFF = 8 * MiB;
constexpr size_t WS_XC = 11 * MiB;
constexpr size_t WS_WIN = 27 * MiB;
constexpr size_t WS_WBR = 85 * MiB;
constexpr size_t WS_WOUT = 97 * MiB;
constexpr size_t WS_WLR = 105 * MiB;
constexpr size_t WS_WUP = 113 * MiB;
constexpr size_t WS_WDN = 177 * MiB;
constexpr size_t WS_H = 209 * MiB;
constexpr size_t WS_PROJ = 281 * MiB;
constexpr size_t WS_GATES = 578 * MiB;
constexpr size_t WS_HID = WS_PROJ;
constexpr size_t WS_YE = WS_PROJ + 144 * MiB;
constexpr size_t WS_XB = 686 * MiB;
constexpr size_t WS_WAG = 794 * MiB;
constexpr size_t WS_LRA = 974 * MiB;
constexpr size_t WS_YF = 1001 * MiB;
constexpr size_t WS_YB = 1037 * MiB;
constexpr size_t WS_BON = 1073 * MiB;
constexpr size_t WS_END = 1109 * MiB;
static_assert(WS_WIN + (size_t)NL * PWP * DM * 2 <= WS_WBR && WS_PROJ + (size_t)NTOK * PW * 2 <= WS_GATES && WS_GATES + (size_t)NTOK * 3072 <= WS_XB && WS_XB + (size_t)NTOK * DM * 2 <= WS_WAG && WS_WAG + (size_t)NTOK * WAGW * 2 <= WS_LRA && WS_LRA + (size_t)NTOK * LRAW * 2 <= WS_YF, "ws map");
static_assert(WS_YE + (size_t)NEXP * PAIRS_E * DM * 2 <= WS_GATES && WS_H + (size_t)NTOK * DM * 2 <= WS_PROJ, "ws map 2");
constexpr int CW_BAR = 4096;
constexpr int CW_DBG = 32768;

constexpr int RING_BYTES = 131072;
constexpr int XTRA_OFF = RING_BYTES;
constexpr int XTRA_BYTES = 12288;
constexpr int MISC_OFF = XTRA_OFF + XTRA_BYTES;
constexpr int LDS_BYTES = 147456;
static_assert(MISC_OFF + 256 <= LDS_BYTES, "lds map");
constexpr int NWAVES = 8, NTHR = 512;

__device__ __forceinline__ unsigned f2bf(float f) { unsigned u = __builtin_bit_cast(unsigned, f); return (u + 0x7fffu + ((u >> 16) & 1u)) >> 16; }
typedef __bf16 bf16v2 __attribute__((ext_vector_type(2)));
__device__ __forceinline__ unsigned pk2(float lo, float hi) { const f32x2 v = {lo, hi}; return __builtin_bit_cast(unsigned, __builtin_convertvector(v, bf16v2)); }
__device__ __forceinline__ float bflo(unsigned w) { return __builtin_bit_cast(float, w << 16); }
__device__ __forceinline__ float bfhi(unsigned w) { return __builtin_bit_cast(float, w & 0xffff0000u); }
__device__ __forceinline__ void unpack8(const u32x4 w, float (&f)[8]) { f[0] = bflo(w.x); f[1] = bfhi(w.x); f[2] = bflo(w.y); f[3] = bfhi(w.y); f[4] = bflo(w.z); f[5] = bfhi(w.z); f[6] = bflo(w.w); f[7] = bfhi(w.w); }
__device__ __forceinline__ u32x4 pack8(const float (&f)[8]) { u32x4 w; w.x = pk2(f[0], f[1]); w.y = pk2(f[2], f[3]); w.z = pk2(f[4], f[5]); w.w = pk2(f[6], f[7]); return w; }
__device__ __forceinline__ void ld8(const bf16_t* p, float (&f)[8]) { unpack8(*(const u32x4*)p, f); }
__device__ __forceinline__ void st8(bf16_t* p, const float (&f)[8]) { *(u32x4*)p = pack8(f); }
__device__ __forceinline__ float rcp_(float x) { return __builtin_amdgcn_rcpf(x); }
__device__ __forceinline__ float rsq_(float x) { return __builtin_amdgcn_rsqf(x); }
__device__ __forceinline__ float sigmoidf_(float x) { return rcp_(1.0f + __builtin_amdgcn_exp2f(-1.4426950408889634f * x)); }
__device__ __forceinline__ float tanhf_(float x) { return 2.0f * sigmoidf_(2.0f * x) - 1.0f; }
__device__ __forceinline__ float dpp_f(float x, const int ctrl_sel) {
    const int xi = __builtin_bit_cast(int, x); int r;
    if (ctrl_sel == 0) r = __builtin_amdgcn_update_dpp(0, xi, 0xB1, 0xF, 0xF, true);
    else if (ctrl_sel == 1) r = __builtin_amdgcn_update_dpp(0, xi, 0x4E, 0xF, 0xF, true);
    else if (ctrl_sel == 2) r = __builtin_amdgcn_update_dpp(0, xi, 0x141, 0xF, 0xF, true);
    else r = __builtin_amdgcn_update_dpp(0, xi, 0x140, 0xF, 0xF, true);
    return __builtin_bit_cast(float, r);
}
__device__ __forceinline__ float sum8(float x) { x += dpp_f(x, 0); x += dpp_f(x, 1); x += dpp_f(x, 2); return x; }
__device__ __forceinline__ float wave_sum(float x) {
    x += dpp_f(x, 0); x += dpp_f(x, 1); x += dpp_f(x, 2); x += dpp_f(x, 3);
    const int xi = __builtin_bit_cast(int, x);
    const float r0 = __builtin_bit_cast(float, __builtin_amdgcn_readlane(xi, 0)), r1 = __builtin_bit_cast(float, __builtin_amdgcn_readlane(xi, 16)),
                r2 = __builtin_bit_cast(float, __builtin_amdgcn_readlane(xi, 32)), r3 = __builtin_bit_cast(float, __builtin_amdgcn_readlane(xi, 48));
    return (r0 + r1) + (r2 + r3);
}
namespace pg8 {
constexpr int BM = 256, BK = 64, HALF = 128, HTB = HALF * BK * 2, STAGE_BYTES = 8 * HTB;
__host__ __device__ __forceinline__ int lds_byte(int r, int c) { const int st = (r >> 4) * 2 + (c >> 5), rr = r & 15, cc = c & 31, ob = rr * 64 + cc * 2; return st * 1024 + (ob ^ (((ob >> 9) & 1) << 5)); }
__host__ __device__ __forceinline__ void stage_rc(int b, int& R, int& C) { const int st = b / 1024, sb = b % 1024, swz = sb ^ (((sb >> 9) & 1) << 5); R = (st >> 1) * 16 + swz / 64; C = (st & 1) * 32 + (swz % 64) / 2; }
__host__ __device__ __forceinline__ int perm32(int rho) { const int n = rho >> 4, i = rho & 15; return 8 * (i >> 2) + 4 * n + (i & 3); }
__device__ __forceinline__ unsigned cvt_pk_bf16(float lo, float hi) { unsigned r; asm volatile("v_cvt_pk_bf16_f32 %0, %1, %2" : "=v"(r) : "v"(lo), "v"(hi)); return r; }

struct GUnit { const char* A; const char* B; int pm, pn, x0, x1; };

template <class Epi, class Sched, bool GATHER>
__device__ __forceinline__ void gemm_phase(LAS unsigned char* lds, const int K, const int lda, const int ldb, const Sched& S, const Epi& E) {
    int tid_ = threadIdx.x; asm volatile("" : "+v"(tid_));
    const int tid = tid_, wid = __builtin_amdgcn_readfirstlane(tid >> 6), lane = tid & 63, wr = wid >> 2, wc = wid & 3, fr = lane & 15, fq = lane >> 4;
    const int nt = K / BK;
    int sR[2], sC[2];
    unsigned voffA[2][2], voffB[2], voffAn[2][2];
#pragma unroll
    for (int i = 0; i < 2; ++i) { int R, C; stage_rc(tid * 16 + i * 8192, R, C); sR[i] = R; sC[i] = C; const int Rb = Epi::PERM ? ((R & ~31) + perm32(R & 31)) : R;
        voffB[i] = (unsigned)(Rb * ldb + C) * 2u;
#pragma unroll
        for (int h = 0; h < 2; ++h) { voffA[h][i] = (unsigned)((h * HALF + R) * lda + C) * 2u; voffAn[h][i] = voffA[h][i]; } }
    const size_t kstep = (size_t)(BK * 2);
    const size_t hstepB = (size_t)HALF * ldb * 2;
    const unsigned ldsw = (unsigned)wid * 1024u;
    const int aoff = lds_byte(wr * 64 + fr, fq * 8), boff = lds_byte(wc * 32 + fr, fq * 8);
#define PG8_SA(b, h) (((b) * 2 + (h)) * HTB)
#define PG8_SB(b, h) ((4 + (b) * 2 + (h)) * HTB)
#define PG8_STAGE(bufoff, gbase, voff) do { _Pragma("unroll") for (int _i = 0; _i < 2; ++_i) \
        __builtin_amdgcn_global_load_lds((const unsigned*)((const char*)(gbase) + (voff)[_i]), (LAS unsigned*)(lds + (bufoff) + ldsw + _i * 8192), 16, 0, 0); } while (0)
#define PG8_LDA(dst, b, h) do { _Pragma("unroll") for (int m = 0; m < 4; ++m) _Pragma("unroll") for (int k = 0; k < 2; ++k) dst[m][k] = *(const LAS bf16x8*)(lds + PG8_SA(b, h) + aoff + m * 2048 + k * 1024); } while (0)
#define PG8_LDB(dst, b, h) do { _Pragma("unroll") for (int n = 0; n < 2; ++n) _Pragma("unroll") for (int k = 0; k < 2; ++k) dst[n][k] = *(const LAS bf16x8*)(lds + PG8_SB(b, h) + boff + n * 2048 + k * 1024); } while (0)
#define PG8_MMA(ai, bj, At, Bt) do { __builtin_amdgcn_s_setprio(1); _Pragma("unroll") for (int m = 0; m < 4; ++m) _Pragma("unroll") for (int n = 0; n < 2; ++n) _Pragma("unroll") for (int k = 0; k < 2; ++k) \
        acc[ai][bj][m][n] = __builtin_amdgcn_mfma_f32_16x16x32_bf16(Bt[n][k], At[m][k], acc[ai][bj][m][n], 0, 0, 0); __builtin_amdgcn_s_setprio(0); } while (0)
#define PG8_WAIT_V(n) asm volatile("s_waitcnt vmcnt(" #n ")" ::: "memory")
#define PG8_WAIT_L(n) asm volatile("s_waitcnt lgkmcnt(" #n ")" ::: "memory")
#define PG8_BAR __builtin_amdgcn_s_barrier()
#define PG8_SCHED __builtin_amdgcn_sched_barrier(0)
    GUnit cur, nxt; int ui = 0;
    if (!S.next(0, cur)) return;
    if constexpr (GATHER) {
#pragma unroll
        for (int i = 0; i < 2; ++i)
#pragma unroll
            for (int h = 0; h < 2; ++h) voffA[h][i] = (S.arow(0, h * HALF + sR[i]) * (unsigned)lda + (unsigned)sC[i]) * 2u;
    }
    f32x4 acc[2][2][4][2];
#pragma unroll
    for (int a = 0; a < 2; ++a)
#pragma unroll
        for (int b = 0; b < 2; ++b)
#pragma unroll
            for (int m = 0; m < 4; ++m)
#pragma unroll
                for (int n = 0; n < 2; ++n) acc[a][b][m][n] = (f32x4){0.f, 0.f, 0.f, 0.f};
    bf16x8 At[4][2], B0[2][2], B1[2][2];
    const char* cA = cur.A; const char* cB = cur.B;
    PG8_STAGE(PG8_SB(0, 0), cB, voffB); PG8_STAGE(PG8_SB(0, 1), cB + hstepB, voffB); PG8_STAGE(PG8_SA(0, 0), cA, voffA[0]); PG8_STAGE(PG8_SA(0, 1), cA, voffA[1]);
    if (wr == 1) PG8_BAR;
    PG8_WAIT_V(2); PG8_BAR;
    PG8_STAGE(PG8_SB(1, 0), cB + kstep, voffB); PG8_STAGE(PG8_SA(1, 0), cA + kstep, voffA[0]); PG8_STAGE(PG8_SB(1, 1), cB + hstepB + kstep, voffB);
    PG8_WAIT_V(6); PG8_BAR;
    for (;;) {
        const bool has_next = S.next(ui + 1, nxt);
        const char* nA = has_next ? nxt.A : cA; const char* nB = has_next ? nxt.B : cB;
        if constexpr (GATHER) {
#pragma unroll
            for (int i = 0; i < 2; ++i)
#pragma unroll
                for (int h = 0; h < 2; ++h) voffAn[h][i] = has_next ? (S.arow(ui + 1, h * HALF + sR[i]) * (unsigned)lda + (unsigned)sC[i]) * 2u : voffA[h][i];
        }
#pragma unroll 1
        for (int t = 0; t < nt; t += 2) {
            const bool last = (t == nt - 2);
            const char* a1 = cA + (size_t)(t + 1) * kstep;
            const char* a2 = last ? nA : cA + (size_t)(t + 2) * kstep; const char* b2 = last ? nB : cB + (size_t)(t + 2) * kstep;
            const char* a3 = a2 + kstep; const char* b3 = b2 + kstep;
            unsigned v2[2][2];
#pragma unroll
            for (int i = 0; i < 2; ++i)
#pragma unroll
                for (int h = 0; h < 2; ++h) v2[h][i] = GATHER ? (last ? voffAn[h][i] : voffA[h][i]) : voffA[h][i];
            PG8_LDB(B0, 0, 0); PG8_LDB(B1, 0, 1); PG8_SCHED; PG8_LDA(At, 0, 0); PG8_STAGE(PG8_SA(1, 1), a1, voffA[1]);
            PG8_WAIT_V(8); PG8_WAIT_L(0); PG8_BAR; PG8_MMA(0, 0, At, B0); PG8_MMA(0, 1, At, B1); PG8_BAR; PG8_SCHED;
            PG8_LDA(At, 0, 1); PG8_STAGE(PG8_SB(0, 0), b2, voffB); PG8_STAGE(PG8_SB(0, 1), b2 + hstepB, voffB); PG8_STAGE(PG8_SA(0, 0), a2, v2[0]);
            PG8_WAIT_V(8); PG8_WAIT_L(0); PG8_BAR; PG8_MMA(1, 0, At, B0); PG8_MMA(1, 1, At, B1); PG8_BAR; PG8_SCHED;
            PG8_LDB(B0, 1, 0); PG8_LDB(B1, 1, 1); PG8_SCHED; PG8_LDA(At, 1, 0); PG8_STAGE(PG8_SA(0, 1), a2, v2[1]);
            PG8_WAIT_V(8); PG8_WAIT_L(0); PG8_BAR; PG8_MMA(0, 0, At, B0); PG8_MMA(0, 1, At, B1); PG8_BAR; PG8_SCHED;
            PG8_LDA(At, 1, 1); PG8_STAGE(PG8_SB(1, 0), b3, voffB); PG8_STAGE(PG8_SB(1, 1), b3 + hstepB, voffB); PG8_STAGE(PG8_SA(1, 0), a3, v2[0]);
            PG8_WAIT_V(8); PG8_WAIT_L(0); PG8_BAR; PG8_MMA(1, 0, At, B0); PG8_MMA(1, 1, At, B1); PG8_BAR; PG8_SCHED;
        }
        if (wr == 0) PG8_BAR;
        E(acc, cur, wr, wc, fr, fq);
        if (!has_next) break;
        if (!(Epi::CHAIN && cur.x1 != 0)) {
#pragma unroll
        for (int a = 0; a < 2; ++a)
#pragma unroll
            for (int b = 0; b < 2; ++b)
#pragma unroll
                for (int m = 0; m < 4; ++m)
#pragma unroll
                    for (int n = 0; n < 2; ++n) acc[a][b][m][n] = (f32x4){0.f, 0.f, 0.f, 0.f};
        }
        cur = nxt; cA = nA; cB = nB; ++ui;
        if constexpr (GATHER) {
#pragma unroll
            for (int i = 0; i < 2; ++i)
#pragma unroll
                for (int h = 0; h < 2; ++h) voffA[h][i] = voffAn[h][i];
        }
        if (wr == 1) PG8_BAR;
    }
    PG8_WAIT_V(0);
    PG8_BAR;
#undef PG8_SA
#undef PG8_SB
#undef PG8_STAGE
#undef PG8_LDA
#undef PG8_LDB
#undef PG8_MMA
#undef PG8_WAIT_V
#undef PG8_WAIT_L
#undef PG8_BAR
#undef PG8_SCHED
}
}
namespace pg8 {
struct EpiProj {
    static constexpr bool PERM = true, CHAIN = false;
    bf16_t* P; unsigned char* GT;
    __device__ __forceinline__ void operator()(f32x4 (&acc)[2][2][4][2], const GUnit& u, int wr, int wc, int fr, int fq) const {
        const int row0 = u.pm * BM + wr * 64 + fr;
#pragma unroll
        for (int bj = 0; bj < 2; ++bj) {
            const int ct = u.pn * BM + bj * HALF;
            if (ct >= NCOLS_IN) continue;
            const bool sig = ct >= C_GT;
            const int col0 = ct + wc * 32 + 8 * fq;
#pragma unroll
            for (int ai = 0; ai < 2; ++ai)
#pragma unroll
                for (int m = 0; m < 4; ++m) {
                    const f32x4 v0 = acc[ai][bj][m][0], v1 = acc[ai][bj][m][1];
                    const size_t row = (size_t)(row0 + ai * HALF + m * 16);
                    if (sig) {
                        unsigned q[8];
#pragma unroll
                        for (int j = 0; j < 4; ++j) { q[j] = (unsigned)fmaxf(255.0f * sigmoidf_(v0[j]) + 0.5f, 1.0f); q[4 + j] = (unsigned)fmaxf(255.0f * sigmoidf_(v1[j]) + 0.5f, 1.0f); }
                        u32x2 w; w.x = q[0] | (q[1] << 8) | (q[2] << 16) | (q[3] << 24); w.y = q[4] | (q[5] << 8) | (q[6] << 16) | (q[7] << 24);
                        *(u32x2*)(GT + row * 3072 + (col0 - C_GT)) = w;
                    } else {
                        u32x4 w; w.x = cvt_pk_bf16(v0[0], v0[1]); w.y = cvt_pk_bf16(v0[2], v0[3]); w.z = cvt_pk_bf16(v1[0], v1[1]); w.w = cvt_pk_bf16(v1[2], v1[3]);
                        *(u32x4*)(P + row * PW + col0) = w;
                    }
                }
        }
    }
};
struct EpiLowRank {
    static constexpr bool PERM = true, CHAIN = false;
    bf16_t* W; const float* w0; const float* a0;
    __device__ __forceinline__ void operator()(f32x4 (&acc)[2][2][4][2], const GUnit& u, int wr, int wc, int fr, int fq) const {
        const int row0 = u.pm * BM + wr * 64 + fr;
#pragma unroll
        for (int bj = 0; bj < 2; ++bj) {
            const int ct = u.pn * BM + bj * HALF;
            const int col0 = ct + wc * 32 + 8 * fq;
            const int mode = ct < 1024 ? 0 : (ct < 2048 ? 1 : 2);
            float bias[8];
#pragma unroll
            for (int j = 0; j < 8; ++j) bias[j] = mode == 0 ? w0[col0 + j] : (mode == 1 ? a0[col0 - 1024 + j] : 0.f);
#pragma unroll
            for (int ai = 0; ai < 2; ++ai)
#pragma unroll
                for (int m = 0; m < 4; ++m) {
                    float v[8];
#pragma unroll
                    for (int j = 0; j < 4; ++j) { v[j] = acc[ai][bj][m][0][j] + bias[j]; v[4 + j] = acc[ai][bj][m][1][j] + bias[4 + j]; }
                    if (mode == 0) {
#pragma unroll
                        for (int j = 0; j < 8; ++j) v[j] = 0.60653066f * sigmoidf_(v[j]);
                    } else if (mode == 1) {
#pragma unroll
                        for (int j = 0; j < 8; ++j) v[j] = sigmoidf_(v[j]);
                    }
                    u32x4 w; w.x = cvt_pk_bf16(v[0], v[1]); w.y = cvt_pk_bf16(v[2], v[3]); w.z = cvt_pk_bf16(v[4], v[5]); w.w = cvt_pk_bf16(v[6], v[7]);
                    *(u32x4*)(W + (size_t)(row0 + ai * HALF + m * 16) * WAGW + col0) = w;
                    asm volatile("" ::: "memory");
                }
        }
    }
};
__device__ __forceinline__ void ldg8(const unsigned char* p, float (&g)[8]) {
    const u32x2 w = *(const u32x2*)p;
#pragma unroll
    for (int j = 0; j < 4; ++j) { g[j] = (float)((w.x >> (8 * j)) & 255u) * (1.0f / 255.0f); g[4 + j] = (float)((w.y >> (8 * j)) & 255u) * (1.0f / 255.0f); }
}
struct EpiMerge {
    static constexpr bool PERM = true, CHAIN = true;
    const unsigned char* GT; bf16_t* M;
    __device__ __forceinline__ void operator()(f32x4 (&acc)[2][2][4][2], const GUnit& u, int wr, int wc, int fr, int fq) const {
        const int row0 = u.pm * BM + wr * 64 + fr; const int br = u.x0;
#pragma unroll
        for (int bj = 0; bj < 2; ++bj) {
            const int col0 = u.pn * BM + bj * HALF + wc * 32 + 8 * fq;
#pragma unroll
            for (int ai = 0; ai < 2; ++ai)
#pragma unroll
                for (int m = 0; m < 4; ++m) {
                    const size_t row = (size_t)(row0 + ai * HALF + m * 16);
                    float g[8];
                    ldg8(GT + row * 3072 + br * 1024 + col0, g);
                    if (br < 2) {
                        float gn[8];
                        ldg8(GT + row * 3072 + (br + 1) * 1024 + col0, gn);
#pragma unroll
                        for (int j = 0; j < 8; ++j) g[j] = g[j] * rcp_(fmaxf(gn[j], 1.0f / 512.0f));
#pragma unroll
                        for (int j = 0; j < 4; ++j) { acc[ai][bj][m][0][j] *= g[j]; acc[ai][bj][m][1][j] *= g[4 + j]; }
                    } else {
                        float o[8];
#pragma unroll
                        for (int j = 0; j < 4; ++j) { o[j] = g[j] * acc[ai][bj][m][0][j]; o[4 + j] = g[4 + j] * acc[ai][bj][m][1][j]; }
                        st8(M + row * DM + col0, o);
                    }
                }
        }
    }
};
struct EpiOut {
    static constexpr bool PERM = true, CHAIN = false;
    bf16_t* XB; const float* mod;
    __device__ __forceinline__ void operator()(f32x4 (&acc)[2][2][4][2], const GUnit& u, int wr, int wc, int fr, int fq) const {
        const int rt = u.pm * BM; const int modrow = rt < NLAT ? (rt >> 11) : 16;
        const float* g1 = mod + (size_t)modrow * 6144 + 2048;
        const int row0 = rt + wr * 64 + fr;
#pragma unroll
        for (int bj = 0; bj < 2; ++bj) {
            const int col0 = u.pn * BM + bj * HALF + wc * 32 + 8 * fq;
            const f32x4 ga = *(const f32x4*)(g1 + col0), gb = *(const f32x4*)(g1 + col0 + 4);
#pragma unroll
            for (int ai = 0; ai < 2; ++ai)
#pragma unroll
                for (int m = 0; m < 4; ++m) {
                    bf16_t* xp = XB + (size_t)(row0 + ai * HALF + m * 16) * DM + col0;
                    float x[8]; ld8(xp, x);
#pragma unroll
                    for (int j = 0; j < 4; ++j) { x[j] += ga[j] * acc[ai][bj][m][0][j]; x[4 + j] += gb[j] * acc[ai][bj][m][1][j]; }
                    st8(xp, x);
                }
        }
    }
};
struct EpiUp {
    static constexpr bool PERM = true, CHAIN = false;
    bf16_t* HID;
    __device__ __forceinline__ void operator()(f32x4 (&acc)[2][2][4][2], const GUnit& u, int wr, int wc, int fr, int fq) const {
        const int row0 = u.x0 * PAIRS_E + u.pm * BM + wr * 64 + fr;
        const int col0 = u.pn * HALF + wc * 32 + 8 * fq;
#pragma unroll
        for (int ai = 0; ai < 2; ++ai)
#pragma unroll
            for (int m = 0; m < 4; ++m) {
                float v[8];
#pragma unroll
                for (int j = 0; j < 4; ++j) {
                    const float g0 = acc[ai][0][m][0][j], g1 = acc[ai][0][m][1][j];
                    v[j] = g0 * sigmoidf_(g0) * acc[ai][1][m][0][j]; v[4 + j] = g1 * sigmoidf_(g1) * acc[ai][1][m][1][j];
                }
                u32x4 w; w.x = cvt_pk_bf16(v[0], v[1]); w.y = cvt_pk_bf16(v[2], v[3]); w.z = cvt_pk_bf16(v[4], v[5]); w.w = cvt_pk_bf16(v[6], v[7]);
                *(u32x4*)(HID + (size_t)(row0 + ai * HALF + m * 16) * EFF + col0) = w;
            }
    }
};
struct EpiDown {
    static constexpr bool PERM = true, CHAIN = false;
    bf16_t* YE;
    __device__ __forceinline__ void operator()(f32x4 (&acc)[2][2][4][2], const GUnit& u, int wr, int wc, int fr, int fq) const {
        const int row0 = u.x0 * PAIRS_E + u.pm * BM + wr * 64 + fr;
#pragma unroll
        for (int bj = 0; bj < 2; ++bj) {
            const int col0 = u.pn * BM + bj * HALF + wc * 32 + 8 * fq;
#pragma unroll
            for (int ai = 0; ai < 2; ++ai)
#pragma unroll
                for (int m = 0; m < 4; ++m) {
                    const f32x4 v0 = acc[ai][bj][m][0], v1 = acc[ai][bj][m][1];
                    u32x4 w; w.x = cvt_pk_bf16(v0[0], v0[1]); w.y = cvt_pk_bf16(v0[2], v0[3]); w.z = cvt_pk_bf16(v1[0], v1[1]); w.w = cvt_pk_bf16(v1[2], v1[3]);
                    *(u32x4*)(YE + (size_t)(row0 + ai * HALF + m * 16) * DM + col0) = w;
                }
        }
    }
};

struct PlainOrder {
    const char* A; const char* B; int nM, nN, nwg, G, c; size_t astep, bstep;
    __device__ __forceinline__ void init(const void* A_, const void* B_, int M, int N, int lda, int ldb, int G_, int c_) { A = (const char*)A_; B = (const char*)B_; nM = M / BM; nN = N / BM; nwg = nM * nN; G = G_; c = c_; astep = (size_t)BM * lda * 2; bstep = (size_t)BM * ldb * 2; }
    __device__ __forceinline__ bool next(int i, GUnit& u) const {
        const long L = (long)i * G + c; if (L >= nwg) return false;
        int wgid = (int)L; { const int q = nwg / 8, r = nwg % 8, xcd = wgid % 8, off = wgid / 8; wgid = (xcd < r ? xcd * (q + 1) : r * (q + 1) + (xcd - r) * q) + off; }
#ifndef PG8_WGM
#define PG8_WGM 8
#endif
        const int nig = PG8_WGM * nN, gid = wgid / nig, fm = gid * PG8_WGM, gsz = (nM - fm) < PG8_WGM ? (nM - fm) : PG8_WGM;
        u.pm = fm + ((wgid % nig) % gsz); u.pn = (wgid % nig) / gsz; u.x0 = 0; u.x1 = 0;
        u.A = A + (size_t)u.pm * astep; u.B = B + (size_t)u.pn * bstep; return true;
    }
    __device__ __forceinline__ unsigned arow(int, int) const { return 0u; }
};
struct LastProjOrder {
    PlainOrder lat; const char* A; const char* B; size_t astep, bstep;
    __device__ __forceinline__ void init(const void* A_, const void* B_, int lda, int ldb, int G_, int c_) { lat.init(A_, B_, NLAT, PWP, lda, ldb, G_, c_); A = (const char*)A_; B = (const char*)B_; astep = (size_t)BM * lda * 2; bstep = (size_t)BM * ldb * 2; }
    __device__ __forceinline__ bool next(int i, GUnit& u) const {
        const long L = (long)i * lat.G + lat.c;
        if (L < lat.nwg) return lat.next(i, u);
        const int r = (int)(L - lat.nwg); if (r >= (NCTX / BM) * 8) return false;
        u.pm = NLAT / BM + r / 8; u.pn = 2 + (r % 8); u.x0 = 0; u.x1 = 0;
        u.A = A + (size_t)u.pm * astep; u.B = B + (size_t)u.pn * bstep; return true;
    }
    __device__ __forceinline__ unsigned arow(int, int) const { return 0u; }
};
struct LowRankOrder {
    const char* A; const char* B; int nM, G, c;
    __device__ __forceinline__ bool next(int i, GUnit& u) const {
        const long L = (long)i * G + c; if (L >= (long)nM * 10) return false;
        u.pm = (int)(L / 10); u.pn = (int)(L % 10); u.x0 = 0; u.x1 = 0;
        const int kwin = u.pn < 4 ? 0 : (u.pn < 8 ? 128 : 256);
        u.A = A + ((size_t)u.pm * BM * LRAW + kwin) * 2; u.B = B + (size_t)u.pn * BM * 128 * 2; return true;
    }
    __device__ __forceinline__ unsigned arow(int, int) const { return 0u; }
};
struct MergeOrder {
    const char* P; const char* W; int nM, G, c;
    __device__ __forceinline__ bool next(int i, GUnit& u) const {
        const long tl = (long)(i / 3) * G + c; if (tl >= (long)nM * 4) return false;
        const int tile = (int)tl, br = i % 3;
        u.pm = tile >> 2; u.pn = tile & 3; u.x0 = br; u.x1 = br < 2 ? 1 : 0;
        const int acol = br == 0 ? C_OATT : (br == 1 ? C_ORWKV : C_OCONV);
        u.A = P + ((size_t)u.pm * BM * PW + acol) * 2; u.B = W + ((size_t)br * 1024 * 512 + (size_t)u.pn * BM * 512) * 2; return true;
    }
    __device__ __forceinline__ unsigned arow(int, int) const { return 0u; }
};
struct MoeOrder {
    const char* A; const char* W; const LAS int* rows; int mt_per, npn, G, c; size_t wexp;
    __device__ __forceinline__ bool decode(long L, int& e, int& mt, int& pn) const {
        const int per_e = mt_per * npn; if (L >= (long)NEXP * per_e) return false;
        e = (int)(L / per_e); const int r = (int)(L % per_e); pn = r / mt_per; mt = r % mt_per; return true;
    }
    __device__ __forceinline__ bool next(int i, GUnit& u) const {
        int e, mt, pn; if (!decode((long)i * G + c, e, mt, pn)) return false;
        u.pm = mt; u.pn = pn; u.x0 = e; u.x1 = 0;
        u.A = A; u.B = W + (size_t)e * wexp + (size_t)pn * BM * 1024 * 2; return true;
    }
    __device__ __forceinline__ unsigned arow(int i, int r) const { return (unsigned)rows[i * 256 + r]; }
};
struct MoeDownOrder {
    const char* A; const char* W; int mt_per, G, c;
    __device__ __forceinline__ bool next(int i, GUnit& u) const {
        const long L = (long)i * G + c; const int per_e = mt_per * 4; if (L >= (long)NEXP * per_e) return false;
        const int e = (int)(L / per_e), r = (int)(L % per_e); u.pn = r / mt_per; u.pm = r % mt_per; u.x0 = e; u.x1 = 0;
        u.A = A + ((size_t)e * PAIRS_E + (size_t)u.pm * BM) * EFF * 2; u.B = W + ((size_t)e * 1024 + (size_t)u.pn * BM) * 1024 * 2; return true;
    }
    __device__ __forceinline__ unsigned arow(int, int) const { return 0u; }
};
}
namespace attn_body {
using bf16=__hip_bfloat16;
using bf16x8=__attribute__((ext_vector_type(8)))short;
using s16x4=__attribute__((ext_vector_type(4)))short;
using f32x16=__attribute__((ext_vector_type(16)))float;
using u32x4=__attribute__((ext_vector_type(4)))unsigned;
constexpr int D=64,DM=4224;
constexpr int NW=8,QBLK=32,QB=QBLK*NW,KVBLK=64;
constexpr int ATTN_PITCH=DM, ATTN_UNIT_ROWS=QB;
__device__ __forceinline__ int crow(int r,int hi){return (r&3)+8*(r>>2)+4*hi;}
#define SBAR() __builtin_amdgcn_sched_barrier(0)
__device__ __forceinline__ void cmask(f32x16&p0,f32x16&p1,int jb,int qrel,int hi){
  const float NEG=-INFINITY; int kb=64*jb+4*hi;
  #pragma unroll
  for(int r=0;r<16;++r){int kv=kb+(r&3)+8*(r>>2); if(kv>qrel)p0[r]=NEG; if(kv+32>qrel)p1[r]=NEG;}
}

constexpr int NSLOT=3, SLOTB=8192;
constexpr int LDS_K=0, LDS_V=NSLOT*SLOTB, LDS_WS=2*NSLOT*SLOTB, LDS_OST=LDS_WS+NW*64*4, LDS_BYTES=LDS_OST+NW*4096;
constexpr float C2=0.125f*1.4426950408889634f;
__device__ __forceinline__ void glds16(const void*gsrc,unsigned lds_dst){unsigned keep;
  asm volatile("s_mov_b32 %0, m0\n\ts_mov_b32 m0, %2\n\ts_nop 0\n\tglobal_load_lds_dwordx4 %1, off\n\ts_mov_b32 m0, %0":"=&s"(keep):"v"(gsrc),"s"(lds_dst):"memory");}
__device__ __forceinline__ float max3f(float a,float b,float c){float r;asm("v_max3_f32 %0, %1, %2, %3":"=v"(r):"v"(a),"v"(b),"v"(c));return r;}
__device__ __forceinline__ float max2f(float a,float b){float r;asm("v_max_f32_e32 %0, %1, %2":"=v"(r):"v"(a),"v"(b));return r;}
__device__ __forceinline__ float fadd_s(float a,float b){float r;asm("v_add_f32_e32 %0, %1, %2":"=v"(r):"v"(a),"v"(b));return r;}
__device__ __forceinline__ float fsub_s(float a,float b){float r;asm("v_sub_f32_e32 %0, %1, %2":"=v"(r):"v"(a),"v"(b));return r;}
typedef float f32x2_t __attribute__((ext_vector_type(2))); typedef __bf16 bf16x2_t __attribute__((ext_vector_type(2)));
__device__ __forceinline__ unsigned cvtpk_s(float lo,float hi){f32x2_t v={lo,hi};bf16x2_t b=__builtin_convertvector(v,bf16x2_t);return __builtin_bit_cast(unsigned,b);}
#define WAIT_BAR(N) asm volatile("s_waitcnt vmcnt(" #N ") lgkmcnt(0)\n\ts_barrier":::"memory")

__device__ __forceinline__ void qkt(f32x16&p0,f32x16&p1,const char*Kslot,const bf16x8*qr,const f32x16&negm,int r32,int hi){
  const char*kb=Kslot+hi*1024+r32*16;
  #pragma unroll
  for(int d0=0;d0<4;++d0){
    const bf16x8 b0=*reinterpret_cast<const bf16x8*>(kb+d0*2048);
    const bf16x8 b1=*reinterpret_cast<const bf16x8*>(kb+d0*2048+512);
    if(d0==0){p0=__builtin_amdgcn_mfma_f32_32x32x16_bf16(b0,qr[0],negm,0,0,0);p1=__builtin_amdgcn_mfma_f32_32x32x16_bf16(b1,qr[0],negm,0,0,0);}
    else{p0=__builtin_amdgcn_mfma_f32_32x32x16_bf16(b0,qr[d0],p0,0,0,0);p1=__builtin_amdgcn_mfma_f32_32x32x16_bf16(b1,qr[d0],p1,0,0,0);}}
}
typedef __attribute__((address_space(3))) const char* lds_cptr;
typedef short v4i16_t __attribute__((ext_vector_type(4)));
__device__ __forceinline__ void kload8(bf16x8*kf,lds_cptr kp){
  kf[0]=*(const __attribute__((address_space(3))) bf16x8*)(kp);      kf[1]=*(const __attribute__((address_space(3))) bf16x8*)(kp+512);
  kf[2]=*(const __attribute__((address_space(3))) bf16x8*)(kp+2048); kf[3]=*(const __attribute__((address_space(3))) bf16x8*)(kp+2560);
  kf[4]=*(const __attribute__((address_space(3))) bf16x8*)(kp+4096); kf[5]=*(const __attribute__((address_space(3))) bf16x8*)(kp+4608);
  kf[6]=*(const __attribute__((address_space(3))) bf16x8*)(kp+6144); kf[7]=*(const __attribute__((address_space(3))) bf16x8*)(kp+6656);
}
__device__ __forceinline__ void kload2(bf16x8*kf,lds_cptr kp,int j){ kf[2*j]=*(const __attribute__((address_space(3))) bf16x8*)(kp+j*2048); kf[2*j+1]=*(const __attribute__((address_space(3))) bf16x8*)(kp+j*2048+512); }
__device__ __forceinline__ s16x4 vtr(lds_cptr p){ return __builtin_bit_cast(s16x4,__builtin_amdgcn_ds_read_tr16_b64_v4i16((__attribute__((address_space(3))) v4i16_t*)p)); }
__device__ __forceinline__ float rowmax(const f32x16&p0,const f32x16&p1){
  float a=max3f(p0[0],p0[1],p1[0]),b=max3f(p0[2],p0[3],p1[1]);a=max3f(a,p1[2],p1[3]);
  #pragma unroll
  for(int r=4;r<16;r+=4){a=max3f(a,p0[r],p0[r+1]);b=max3f(b,p0[r+2],p0[r+3]);a=max3f(a,p1[r],p1[r+1]);b=max3f(b,p1[r+2],p1[r+3]);}
  const float m=max2f(a,b);
  auto rr=__builtin_amdgcn_permlane32_swap(__float_as_uint(m),__float_as_uint(m),false,false);
  return max2f(__uint_as_float(rr[0]),__uint_as_float(rr[1]));
}
__device__ __forceinline__ void pv(f32x16*o,int vb,bf16x8 pa0,bf16x8 pa1,bf16x8 pa2,bf16x8 pa3){
  #pragma unroll
  for(int d0=0;d0<2;++d0){s16x4 lo[4],hi[4];
    #pragma unroll
    for(int ks=0;ks<4;++ks){
      asm volatile("ds_read_b64_tr_b16 %0,%1 offset:%c2":"=&v"(lo[ks]):"v"(vb),"i"(d0*4096+ks*1024):"memory");
      asm volatile("ds_read_b64_tr_b16 %0,%1 offset:%c2":"=&v"(hi[ks]):"v"(vb),"i"(d0*4096+ks*1024+512):"memory");}
    asm volatile("s_waitcnt lgkmcnt(0)":::"memory");SBAR();
    #define PK(k) (bf16x8){lo[k][0],lo[k][1],lo[k][2],lo[k][3],hi[k][0],hi[k][1],hi[k][2],hi[k][3]}
    o[d0]=__builtin_amdgcn_mfma_f32_32x32x16_bf16(pa0,PK(0),o[d0],0,0,0);
    o[d0]=__builtin_amdgcn_mfma_f32_32x32x16_bf16(pa1,PK(1),o[d0],0,0,0);
    o[d0]=__builtin_amdgcn_mfma_f32_32x32x16_bf16(pa2,PK(2),o[d0],0,0,0);
    o[d0]=__builtin_amdgcn_mfma_f32_32x32x16_bf16(pa3,PK(3),o[d0],0,0,0);
    #undef PK
  }
}

#ifndef ATTN_STORE16
#define ATTN_STORE16(p,v) (*(u32x4*)(p)=(v))
#endif
template<int THRL> __device__ __forceinline__ void attn_unit(const bf16*Qu,bf16*Ou,const bf16*KV0,const int crow0,const int lrow0,const int NT,const int nct,char*shm){
  constexpr int VOFF=128;
  int tid_=threadIdx.x; asm volatile("":"+v"(tid_)); const int tid=tid_,lane=tid&63,r32=lane&31,hi=lane>>5; const int wid=__builtin_amdgcn_readfirstlane(tid>>6);
  const bf16*Qw=Qu+(long)(wid*QBLK)*DM;
  const unsigned lds0=(unsigned)(uintptr_t)shm;
  float*wsf=(float*)(shm+LDS_WS)+wid*64;
  const long klane=(long)lane*DM+wid*8;
  const long vlane=(long)(16*(wid&3)+(lane>>2))*DM+(wid>>2)*32+(lane&3)*8;
  const unsigned kdst=lds0+LDS_K+wid*1024, vdst=lds0+LDS_V+wid*1024;
  #define KTILE(t) (KV0+(long)(((t)<nct)?(crow0+(t)*KVBLK):(lrow0+((t)-nct)*KVBLK))*DM)
  #define VTILE(t) (KTILE(t)+VOFF)
  #define DMA_K(t,slot) glds16(KTILE(t)+klane,(unsigned)__builtin_amdgcn_readfirstlane(kdst+(slot)))
  #define DMA_V(t,slot) glds16(VTILE(t)+vlane,(unsigned)__builtin_amdgcn_readfirstlane(vdst+(slot)))
  const int vb0=(int)(lds0+LDS_V)+((lane>>4)&1)*32+(lane&3)*8+(4*hi+((lane&15)>>2))*64;
  const char*Kbase=shm+LDS_K; bf16x8 kf[8];
  const lds_cptr shm3=(lds_cptr)shm; const lds_cptr kp0=shm3+LDS_K+hi*1024+r32*16; const lds_cptr vp0=shm3+LDS_V+((lane>>4)&1)*32+(lane&3)*8+(4*hi+((lane&15)>>2))*64;
  DMA_K(0,0);DMA_V(0,0);DMA_K(1,SLOTB);
  bf16x8 qr[4];
  #pragma unroll
  for(int d0=0;d0<4;++d0)qr[d0]=*reinterpret_cast<const bf16x8*>(&Qw[(long)r32*DM+d0*16+hi*8]);
  float mhat=0.f,l_reg=0.f;f32x16 o[2];o[0]=f32x16{};o[1]=f32x16{};f32x16 negm=f32x16{};asm volatile("":"+v"(negm));
  #define CMASK(P0,P1,t) do{}while(0)
  bool resc=false;
#ifndef ATTN_NOMAX
#define ATTN_NOMAX 1
#endif
#if ATTN_NOMAX
  #define START(P0,P1) do{ resc=false; _Pragma("unroll") for(int r=0;r<16;++r)P0[r]=__builtin_amdgcn_exp2f(P0[r]); }while(0)
#else
  #define START(P0,P1) do{ const float rm=rowmax(P0,P1); resc=false; \
    { const float dl=rm; mhat=fadd_s(mhat,dl); \
      _Pragma("unroll") for(int r=0;r<16;++r){P0[r]=fsub_s(P0[r],dl);P1[r]=fsub_s(P1[r],dl);} \
      _Pragma("unroll") for(int r=0;r<16;++r)negm[r]=-mhat; asm volatile("":"+v"(negm)); } \
    _Pragma("unroll") for(int r=0;r<16;++r)P0[r]=__builtin_amdgcn_exp2f(P0[r]); }while(0)
#endif
  #define RESC() do{ if(resc){ asm volatile("s_waitcnt lgkmcnt(0)":::"memory"); \
      _Pragma("unroll") for(int d_=0;d_<2;++d_) _Pragma("unroll") for(int r=0;r<16;++r)o[d_][r]*=wsf[crow(r,hi)]; } }while(0)
  f32x16 pA0,pA1,pB0,pB1;
  int sl_prev=0,sl_cur=0,sl_next=SLOTB;
  #define ROT() do{sl_prev=sl_cur;sl_cur=sl_next;sl_next=(sl_next==(NSLOT-1)*SLOTB)?0:sl_next+SLOTB;}while(0)
  DMA_K(2,2*SLOTB);
  WAIT_BAR(3);
  qkt(pA0,pA1,Kbase,qr,negm,r32,hi);asm volatile("s_nop 15\n\ts_nop 7":"+v"(pA0),"+v"(pA1));CMASK(pA0,pA1,0);
  START(pA0,pA1);
  _Pragma("unroll") for(int r=0;r<16;++r)pA1[r]=__builtin_amdgcn_exp2f(pA1[r]);
  WAIT_BAR(0);
  DMA_K(3,0);DMA_V(1,SLOTB);
  ROT();
  kload8(kf,kp0+sl_cur);
  WAIT_BAR(2);
  s16x4 vlo[8],vhi[8]; u32x4 pw0,pw1,pw2,pw3;
  #define PKW(P,B) cvtpk_s(P[B],P[B+1])
  #define PAF(k) __builtin_bit_cast(bf16x8,pw##k)
  #define VFR(i) (bf16x8){vlo[i][0],vlo[i][1],vlo[i][2],vlo[i][3],vhi[i][0],vhi[i][1],vhi[i][2],vhi[i][3]}
  #define PIN(x) asm volatile("":"+v"(x))
  #define MX3(a,b,c) __builtin_fmaxf(__builtin_fmaxf((a),(b)),(c))
  #define GAPA(MF,A0,A1,A2,A3,W0,W1,PW) do{ MF; sacc+=A0; sacc+=A1; sacc+=A2; sacc+=A3; PIN(sacc); W0; W1; PIN(PW); SBAR(); }while(0)
  #define EX(v) __builtin_amdgcn_exp2f(v)
  #define GAPB(MF,X,B) do{ MF; X[B]=EX(X[B]); X[B+1]=EX(X[B+1]); X[B+2]=EX(X[B+2]); X[B+3]=EX(X[B+3]); PIN(X); SBAR(); }while(0)
  #define VRD(i) do{ vlo[i]=vtr(vp_+(((i)>>2)*4096+((i)&3)*1024)); vhi[i]=vtr(vp_+(((i)>>2)*4096+((i)&3)*1024+512)); }while(0)
  #define KRD(G,j) do{ if(G){ kload2(kf,kp0+sl_next,j); SBAR(); } }while(0)
#if ATTN_NOMAX
  #define ROWMAX_BLOCK(C0,C1) do{ resc=false; }while(0)
#else
  #define ROWMAX_BLOCK(C0,C1) do    { float a=MX3(C0[0],C0[1],C1[0]),b=MX3(C0[2],C0[3],C1[1]); a=MX3(a,C1[2],C1[3]); \
      _Pragma("unroll") for(int r=4;r<16;r+=4){a=MX3(a,C0[r],C0[r+1]);b=MX3(b,C0[r+2],C0[r+3]);a=MX3(a,C1[r],C1[r+1]);b=MX3(b,C1[r+2],C1[r+3]);} \
      float rm=__builtin_fmaxf(a,b); { auto rr=__builtin_amdgcn_permlane32_swap(__float_as_uint(rm),__float_as_uint(rm),false,false); rm=__builtin_fmaxf(__uint_as_float(rr[0]),__uint_as_float(rr[1])); } \
      resc=false; \
      if(__builtin_expect(__any(rm>(float)THRL),0)){ const float dl=__builtin_fmaxf(rm,0.f); mhat+=dl; \
        _Pragma("unroll") for(int r=0;r<16;++r){C0[r]-=dl;C1[r]-=dl;} \
        _Pragma("unroll") for(int r=0;r<16;++r)negm[r]=-mhat; asm volatile("":"+v"(negm)); \
        const float f=__builtin_amdgcn_exp2f(-dl); l_reg*=f; if(hi==0)wsf[r32]=f; resc=true; } } while(0)
#endif
  #define STEP(C0,C1,P0,P1,t,GK,GV,GL) do{ SBAR(); \
    const lds_cptr vp_=vp0+sl_prev; \
    VRD(0); SBAR(); float sacc=(P0[0]+P0[1]); \
    GAPA(C0=__builtin_amdgcn_mfma_f32_32x32x16_bf16(kf[0],qr[0],negm,0,0,0), P0[2],P0[3],P0[4],P0[5],     pw0[0]=PKW(P0,0), pw0[1]=PKW(P0,2), pw0); \
    VRD(4); SBAR(); GAPA(C1=__builtin_amdgcn_mfma_f32_32x32x16_bf16(kf[1],qr[0],negm,0,0,0), P0[6],P0[7],P0[8],P0[9],     pw0[2]=PKW(P0,4), pw0[3]=PKW(P0,6), pw0); \
    VRD(1); SBAR(); GAPA(C0=__builtin_amdgcn_mfma_f32_32x32x16_bf16(kf[2],qr[1],C0,0,0,0),   P0[10],P0[11],P0[12],P0[13], pw1[0]=PKW(P0,8), pw1[1]=PKW(P0,10), pw1); \
    VRD(5); SBAR(); GAPA(C1=__builtin_amdgcn_mfma_f32_32x32x16_bf16(kf[3],qr[1],C1,0,0,0),   P0[14],P0[15],P1[0],P1[1],   pw1[2]=PKW(P0,12),pw1[3]=PKW(P0,14), pw1); \
    VRD(2); SBAR(); GAPA(C0=__builtin_amdgcn_mfma_f32_32x32x16_bf16(kf[4],qr[2],C0,0,0,0),   P1[2],P1[3],P1[4],P1[5],     pw2[0]=PKW(P1,0), pw2[1]=PKW(P1,2), pw2); \
    VRD(6); SBAR(); GAPA(C1=__builtin_amdgcn_mfma_f32_32x32x16_bf16(kf[5],qr[2],C1,0,0,0),   P1[6],P1[7],P1[8],P1[9],     pw2[2]=PKW(P1,4), pw2[3]=PKW(P1,6), pw2); \
    VRD(3); SBAR(); GAPA(C0=__builtin_amdgcn_mfma_f32_32x32x16_bf16(kf[6],qr[3],C0,0,0,0),   P1[10],P1[11],P1[12],P1[13], pw3[0]=PKW(P1,8), pw3[1]=PKW(P1,10), pw3); \
    VRD(7); SBAR(); GAPA(C1=__builtin_amdgcn_mfma_f32_32x32x16_bf16(kf[7],qr[3],C1,0,0,0),   P1[14],P1[15],0.f,0.f,       pw3[2]=PKW(P1,12),pw3[3]=PKW(P1,14), pw3); \
    l_reg+=sacc; \
    if(GK){DMA_K((t)+3,sl_cur);} if(GV){DMA_V((t)+1,sl_next);} \
    CMASK(C0,C1,t); \
    ROWMAX_BLOCK(C0,C1); \
    SBAR(); \
    GAPB(o[0]=__builtin_amdgcn_mfma_f32_32x32x16_bf16(PAF(0),VFR(0),o[0],0,0,0), C0,0); \
    GAPB(o[1]=__builtin_amdgcn_mfma_f32_32x32x16_bf16(PAF(0),VFR(4),o[1],0,0,0), C0,4); \
    KRD(GL,0); GAPB(o[0]=__builtin_amdgcn_mfma_f32_32x32x16_bf16(PAF(1),VFR(1),o[0],0,0,0), C0,8); \
    KRD(GL,1); GAPB(o[1]=__builtin_amdgcn_mfma_f32_32x32x16_bf16(PAF(1),VFR(5),o[1],0,0,0), C0,12); \
    KRD(GL,2); GAPB(o[0]=__builtin_amdgcn_mfma_f32_32x32x16_bf16(PAF(2),VFR(2),o[0],0,0,0), C1,0); \
    KRD(GL,3); GAPB(o[1]=__builtin_amdgcn_mfma_f32_32x32x16_bf16(PAF(2),VFR(6),o[1],0,0,0), C1,4); \
    GAPB(o[0]=__builtin_amdgcn_mfma_f32_32x32x16_bf16(PAF(3),VFR(3),o[0],0,0,0), C1,8); \
    GAPB(o[1]=__builtin_amdgcn_mfma_f32_32x32x16_bf16(PAF(3),VFR(7),o[1],0,0,0), C1,12); \
    }while(0)
  int t=1;
  #undef CMASK
  #define CMASK(P0,P1,t) do{}while(0)
  for(;t+5<NT;t+=2){
    STEP(pB0,pB1,pA0,pA1,t,true,true,true);     WAIT_BAR(2); RESC(); ROT();
    STEP(pA0,pA1,pB0,pB1,t+1,true,true,true);   WAIT_BAR(2); RESC(); ROT();
  }
  #undef CMASK
  #define CMASK(P0,P1,t) do{}while(0)
  #define ENDW(tt) do{ if((tt)+3<NT){WAIT_BAR(2);} else if((tt)+2<NT){WAIT_BAR(1);} else {WAIT_BAR(0);} }while(0)
  for(;t+1<NT;t+=2){
    STEP(pB0,pB1,pA0,pA1,t,(t+3<NT),(t+1<NT),(t+1<NT));       ENDW(t);   RESC(); ROT();
    STEP(pA0,pA1,pB0,pB1,t+1,(t+4<NT),(t+2<NT),(t+2<NT));     ENDW(t+1); RESC(); ROT();
  }
  STEP(pB0,pB1,pA0,pA1,NT-1,false,false,false); RESC();
  { float sacc=pB0[0]+pB0[1]; _Pragma("unroll") for(int r=2;r<16;++r)sacc+=pB0[r]; _Pragma("unroll") for(int r=0;r<16;++r)sacc+=pB1[r]; l_reg+=sacc;
    pw0=(u32x4){PKW(pB0,0),PKW(pB0,2),PKW(pB0,4),PKW(pB0,6)};pw1=(u32x4){PKW(pB0,8),PKW(pB0,10),PKW(pB0,12),PKW(pB0,14)};pw2=(u32x4){PKW(pB1,0),PKW(pB1,2),PKW(pB1,4),PKW(pB1,6)};pw3=(u32x4){PKW(pB1,8),PKW(pB1,10),PKW(pB1,12),PKW(pB1,14)};
    SBAR(); pv(o,vb0+sl_cur,PAF(0),PAF(1),PAF(2),PAF(3)); }
  #undef PKW
  #undef PAF
  #undef VFR
  #undef PIN
  #undef MX3
  #undef GAPA
  #undef GAPB
  #undef EX
  #undef VRD
  #undef KRD
  #undef STEP
  #undef ROWMAX_BLOCK
  #undef ENDW
  {auto rr=__builtin_amdgcn_permlane32_swap(__float_as_uint(l_reg),__float_as_uint(l_reg),false,false);l_reg=__uint_as_float(rr[0])+__uint_as_float(rr[1]);}
  if(hi==0)wsf[32+r32]=l_reg;asm volatile("s_waitcnt lgkmcnt(0)":::"memory");
  float rli[16];
  #pragma unroll
  for(int r=0;r<16;++r)rli[r]=__builtin_amdgcn_rcpf(wsf[32+crow(r,hi)]);
  bf16*Ow=Ou+(long)(wid*QBLK)*DM;
  { bf16*stg=(bf16*)(shm+LDS_OST)+wid*2048;
    #pragma unroll
    for(int r=0;r<16;++r){const int orow=crow(r,hi);
      #pragma unroll
      for(int d0=0;d0<2;++d0)stg[orow*64+d0*32+r32]=__float2bfloat16(o[d0][r]*rli[r]);}
    asm volatile("s_waitcnt lgkmcnt(0)":::"memory");
    #pragma unroll
    for(int i=0;i<4;++i){const int row=i*8+(lane>>3),ch=lane&7; const u32x4 v=*(const u32x4*)(stg+row*64+ch*8); ATTN_STORE16(Ow+(long)row*DM+ch*8,v);} }
  asm volatile("s_waitcnt lgkmcnt(0)\n\ts_barrier":::"memory");
  #undef DMA_K
  #undef KTILE
  #undef VTILE
  #undef DMA_V
  #undef CMASK
  #undef START
  #undef RESC
  #undef ROT
}
constexpr int ATTN_LDS_BYTES=LDS_BYTES;
#undef SBAR
#undef WAIT_BAR
}
#define XB_TMO      128
#define XB_XCNT(j)  (256  + 64 * (j))
#define XB_XSUB(j)  (1280 + 64 * (j))
#define XB_XGEN(j)  (2304 + 64 * (j))
#define XB_TOP      3328
#define XB_TOPGEN   3392
#define XCD_BAR_WORDS 3456
#define XB_SPIN_CAP (1u << 18)
__device__ __forceinline__ unsigned xb_ld(unsigned* p)              { return __hip_atomic_load(p, __ATOMIC_RELAXED, __HIP_MEMORY_SCOPE_AGENT); }
__device__ __forceinline__ unsigned xb_add(unsigned* p, unsigned v) { return __hip_atomic_fetch_add(p, v, __ATOMIC_RELAXED, __HIP_MEMORY_SCOPE_AGENT); }
__device__ __forceinline__ unsigned xb_xcc_id() { return (unsigned)__builtin_amdgcn_s_getreg((3 << 11) | 20) & 0xFu; }
#define XB_SPIN(cond, bar) do { unsigned _sp = 0; while (cond) { __builtin_amdgcn_s_sleep(1); \
    if ((++_sp & 255u) == 0u) { if (xb_ld(&(bar)[XB_TMO])) break; if (_sp > XB_SPIN_CAP) { atomicAdd(&(bar)[XB_TMO], 1u); break; } } } } while (0)
struct XcdBarrier { unsigned* bar; unsigned x; volatile LAS unsigned* st; };
__device__ __forceinline__ XcdBarrier xcd_barrier_post(unsigned* bar, volatile LAS unsigned* st) {
    XcdBarrier b; b.bar = bar; b.x = xb_xcc_id(); b.st = st;
    if (threadIdx.x == 0) (void)xb_add(&bar[XB_XCNT(b.x)], 1u);
    return b;
}
__device__ __forceinline__ void xcd_barrier_complete(unsigned* bar, unsigned x, unsigned& nloc, unsigned& nx) {
    const unsigned G = gridDim.x * gridDim.y * gridDim.z;
    unsigned sum, cnt, mine, sp = 0u;
    for (;;) {
        sum = 0u; cnt = 0u; mine = 0u;
#pragma unroll
        for (unsigned j = 0; j < 16; ++j) { const unsigned c = xb_ld(&bar[XB_XCNT(j)]); sum += c; cnt += (c > 0u) ? 1u : 0u; mine = (j == x) ? c : mine; }
        if (sum == G) break;
        __builtin_amdgcn_s_sleep(1);
        if ((++sp & 255u) == 0u) { if (xb_ld(&bar[XB_TMO])) break; if (sp > XB_SPIN_CAP) { atomicAdd(&bar[XB_TMO], 1u); break; } }
    }
    nloc = mine > 0u ? mine : 1u; nx = cnt > 0u ? cnt : 1u;
}
__device__ __forceinline__ void xcd_barrier(const XcdBarrier& b) {
    asm volatile("s_waitcnt vmcnt(0)" ::: "memory");
    __syncthreads();
    if (threadIdx.x == 0) {
        unsigned long long bar_i = (unsigned long long)b.bar; unsigned bx_ = b.x; asm volatile("" : "+s"(bar_i), "+s"(bx_));
        unsigned* bar = (unsigned*)(__attribute__((address_space(1))) unsigned*)bar_i;
        __builtin_amdgcn_s_waitcnt(0);
        unsigned nloc = b.st[0], nx = b.st[1];
        if (nloc == 0u) { xcd_barrier_complete(bar, bx_, nloc, nx); b.st[0] = nloc; b.st[1] = nx; }
        const unsigned old = xb_add(&bar[XB_XSUB(bx_)], 1u);
        const unsigned gen = old / nloc;
        if (old + 1u == (gen + 1u) * nloc) {
            __builtin_amdgcn_fence(__ATOMIC_RELEASE, "agent");
            asm volatile("s_waitcnt vmcnt(0)" ::: "memory");
            const unsigned og = xb_add(&bar[XB_TOP], 1u);
            const unsigned tg = og / nx;
            if (og + 1u == (tg + 1u) * nx) xb_add(&bar[XB_TOPGEN], 1u);
            else XB_SPIN(xb_ld(&bar[XB_TOPGEN]) == tg, bar);
            __builtin_amdgcn_fence(__ATOMIC_ACQUIRE, "agent");
            xb_add(&bar[XB_XGEN(bx_)], 1u);
            asm volatile("s_waitcnt vmcnt(0)" ::: "memory");
        } else {
            XB_SPIN(xb_ld(&bar[XB_XGEN(bx_)]) == gen, bar);
            __builtin_amdgcn_fence(__ATOMIC_ACQUIRE, "agent");
            asm volatile("s_waitcnt vmcnt(0)" ::: "memory");
        }
    }
    __syncthreads();
}

struct Frame {
    LAS unsigned char* lds;
    int tid, lane, wave, vcu, G, gw, NGW, bid;
    float* out; unsigned char* ws;
};
__device__ __forceinline__ void relaunder(Frame& F) {
    unsigned long long w = (unsigned long long)F.ws, o = (unsigned long long)F.out;
    int vcu = F.vcu, G = F.G, wave = F.wave, tid = F.tid, bid = F.bid;
    asm volatile("" : "+s"(w), "+s"(o), "+s"(vcu), "+s"(G), "+s"(wave), "+s"(bid));
    asm volatile("" : "+v"(tid));
    F.ws = (unsigned char*)(__attribute__((address_space(1))) unsigned char*)w; F.out = (float*)(__attribute__((address_space(1))) float*)o;
    F.vcu = vcu; F.G = G; F.wave = wave; F.tid = tid; F.lane = tid & 63; F.bid = bid; F.gw = vcu * NWAVES + wave; F.NGW = G * NWAVES;
}
#define LDS_WAIT() asm volatile("s_waitcnt lgkmcnt(0)" ::: "memory")

__device__ __forceinline__ void transpose_item(const float* W, int N, int k0, int n0, bf16_t* dst, int ldk, LAS float* scr, int lane) {
#pragma unroll 8
    for (int i = 0; i < 32; ++i) { const int kk = 2 * i + (lane >> 5); scr[kk * 33 + (lane & 31)] = W[(size_t)(k0 + kk) * N + n0 + (lane & 31)]; }
    LDS_WAIT(); asm volatile("" ::: "memory");
    const int c = lane & 7;
#pragma unroll
    for (int j = 0; j < 4; ++j) { const int n = (lane >> 3) + 8 * j; const LAS float* s = scr + (8 * c) * 33 + n;
        u32x4 o; o.x = pk2(s[0 * 33], s[1 * 33]); o.y = pk2(s[2 * 33], s[3 * 33]); o.z = pk2(s[4 * 33], s[5 * 33]); o.w = pk2(s[6 * 33], s[7 * 33]);
        *(u32x4*)(dst + (size_t)n * ldk + 8 * c) = o; }
    LDS_WAIT(); asm volatile("" ::: "memory");
}

__device__ __forceinline__ void transpose_item32(const float* W, int N, int k0, int n0, bf16_t* dst, int ldk, LAS float* scr, int lane) {
#pragma unroll 8
    for (int i = 0; i < 16; ++i) { const int kk = 2 * i + (lane >> 5); scr[kk * 33 + (lane & 31)] = W[(size_t)(k0 + kk) * N + n0 + (lane & 31)]; }
    LDS_WAIT(); asm volatile("" ::: "memory");
    const int c = lane & 3;
#pragma unroll
    for (int j = 0; j < 2; ++j) { const int n = (lane >> 2) + 16 * j; const LAS float* s = scr + (8 * c) * 33 + n;
        u32x4 o; o.x = pk2(s[0 * 33], s[1 * 33]); o.y = pk2(s[2 * 33], s[3 * 33]); o.z = pk2(s[4 * 33], s[5 * 33]); o.w = pk2(s[6 * 33], s[7 * 33]);
        *(u32x4*)(dst + (size_t)n * ldk + 8 * c) = o; }
    LDS_WAIT(); asm volatile("" ::: "memory");
}
__device__ __forceinline__ void transpose_issue32(const float* W, int N, int k0, int n0, float (&v)[16], int lane) {
#pragma unroll
    for (int i = 0; i < 16; ++i) { const int kk = 2 * i + (lane >> 5); v[i] = W[(size_t)(k0 + kk) * N + n0 + (lane & 31)]; }
}
__device__ __forceinline__ void transpose_finish32(const float (&v)[16], bf16_t* dst, int ldk, LAS float* scr, int lane, bool store) {
#pragma unroll
    for (int i = 0; i < 16; ++i) { const int kk = 2 * i + (lane >> 5); scr[kk * 33 + (lane & 31)] = v[i]; }
    LDS_WAIT(); asm volatile("" ::: "memory");
    if (!store) return;
    const int c = lane & 3;
#pragma unroll
    for (int j = 0; j < 2; ++j) { const int n = (lane >> 2) + 16 * j; const LAS float* s = scr + (8 * c) * 33 + n;
        u32x4 o; o.x = pk2(s[0 * 33], s[1 * 33]); o.y = pk2(s[2 * 33], s[3 * 33]); o.z = pk2(s[4 * 33], s[5 * 33]); o.w = pk2(s[6 * 33], s[7 * 33]);
        *(u32x4*)(dst + (size_t)n * ldk + 8 * c) = o; }
    LDS_WAIT(); asm volatile("" ::: "memory");
}
__device__ __forceinline__ void convert_expert_issue32(int l, int it, const float* exp_gate, const float* exp_up, const float* exp_down, float (&v)[16], int lane) {
    constexpr int I_M = 32 * 32;
    const int which = it / (NEXP * I_M), r = it % (NEXP * I_M), e = r / I_M, q = r % I_M, kb = q / 32, nb = q % 32, n0 = nb * 32;
    const float* W = (which == 0 ? exp_gate : (which == 1 ? exp_up : exp_down)) + ((size_t)l * NEXP + e) * DM * EFF;
    transpose_issue32(W, which < 2 ? EFF : DM, kb * 32, n0, v, lane);
}
__device__ __forceinline__ void convert_expert_finish32(unsigned char* ws, int it_, const float (&v)[16], LAS float* scr, int lane) {
    bf16_t* Wup = (bf16_t*)(ws + WS_WUP); bf16_t* Wdn = (bf16_t*)(ws + WS_WDN);
    constexpr int I_M = 32 * 32;
    const bool store = it_ >= 0; const int it = store ? it_ : 0;
    const int which = it / (NEXP * I_M), r = it % (NEXP * I_M), e = r / I_M, q = r % I_M, kb = q / 32, nb = q % 32, n0 = nb * 32;
    if (which < 2) { const int drow = 256 * (n0 >> 7) + 128 * which + (n0 & 127);
        transpose_finish32(v, Wup + ((size_t)e * 2048 + drow) * DM + kb * 32, DM, scr, lane, store); }
    else transpose_finish32(v, Wdn + ((size_t)e * 1024 + n0) * EFF + kb * 32, EFF, scr, lane, store);
}
__device__ __forceinline__ void convert_expert_item32(unsigned char* ws, int l, int it, const float* exp_gate, const float* exp_up, const float* exp_down, LAS float* scr, int lane) {
    bf16_t* Wup = (bf16_t*)(ws + WS_WUP); bf16_t* Wdn = (bf16_t*)(ws + WS_WDN);
    constexpr int I_M = 32 * 32;
    const int which = it / (NEXP * I_M), r = it % (NEXP * I_M), e = r / I_M, q = r % I_M, kb = q / 32, nb = q % 32, n0 = nb * 32;
    const float* W = (which == 0 ? exp_gate : (which == 1 ? exp_up : exp_down)) + ((size_t)l * NEXP + e) * DM * EFF;
    if (which < 2) { const int drow = 256 * (n0 >> 7) + 128 * which + (n0 & 127);
        transpose_item32(W, EFF, kb * 32, n0, Wup + ((size_t)e * 2048 + drow) * DM + kb * 32, DM, scr, lane); }
    else transpose_item32(W, DM, kb * 32, n0, Wdn + ((size_t)e * 1024 + n0) * EFF + kb * 32, EFF, scr, lane);
}

__device__ __forceinline__ void phase_prologue(Frame& F, const float* c_in, const float* cctx_in, const float* ada_w, const float* ada_b, const float* w_in, const float* decay_w2, const float* iclr_a2, const float* gate_g2,
                                               const float* w_br_att, const float* w_br_rwkv, const float* w_br_conv, const float* w_out, const float* w_router) {
    LAS float* scr = (LAS float*)(F.lds + F.wave * 16384);
    bf16_t* Win = (bf16_t*)(F.ws + WS_WIN); bf16_t* Wbr = (bf16_t*)(F.ws + WS_WBR); bf16_t* Wout = (bf16_t*)(F.ws + WS_WOUT); bf16_t* Wlr = (bf16_t*)(F.ws + WS_WLR);
    constexpr int I_IN = 16 * 228, I_BR = 8 * 32, I_OUT = 16 * 32;
    constexpr int PER_L = I_IN + 3 * I_BR + I_OUT;
    for (int it = F.gw; it < NL * PER_L; it += F.NGW) {
        const int l = it / PER_L; int r = it % PER_L;
        if (r < I_IN) { const int kb = r / 228, nb = r % 228; transpose_item(w_in + (size_t)l * DM * NCOLS_IN, NCOLS_IN, kb * 64, nb * 32, Win + ((size_t)l * PWP + nb * 32) * DM + kb * 64, DM, scr, F.lane); continue; }
        r -= I_IN;
        if (r < 3 * I_BR) { const int br = r / I_BR, q = r % I_BR, kb = q / 32, nb = q % 32;
            const float* W = (br == 0 ? w_br_att : (br == 1 ? w_br_rwkv : w_br_conv)) + (size_t)l * 512 * DM;
            transpose_item(W, DM, kb * 64, nb * 32, Wbr + (((size_t)l * 3 + br) * 1024 + nb * 32) * 512 + kb * 64, 512, scr, F.lane); continue; }
        r -= 3 * I_BR;
        { const int kb = r / 32, nb = r % 32; transpose_item(w_out + (size_t)l * DM * DM, DM, kb * 64, nb * 32, Wout + ((size_t)l * 1024 + nb * 32) * DM + kb * 64, DM, scr, F.lane); }
    }
    for (int i = F.gw * 64 + F.lane; i < NL * (PWP - NCOLS_IN) * DM / 8; i += F.NGW * 64) {
        const int l = i / ((PWP - NCOLS_IN) * DM / 8), r = i % ((PWP - NCOLS_IN) * DM / 8);
        *(u32x4*)(Win + ((size_t)l * PWP + NCOLS_IN) * DM + (size_t)r * 8) = (u32x4){0u, 0u, 0u, 0u};
    }
    for (int i = F.gw * 64 + F.lane; i < NL * WAGW * 128; i += F.NGW * 64) {
        const int l = i / (WAGW * 128), r = i % (WAGW * 128), n = r / 128, kk = r % 128;
        float v = 0.f;
        if (n < 512) { if (kk < 64) v = decay_w2[(((size_t)l * 2 + 0) * 64 + kk) * 512 + n]; }
        else if (n < 1024) { if (kk >= 64) v = decay_w2[(((size_t)l * 2 + 1) * 64 + (kk - 64)) * 512 + (n - 512)]; }
        else if (n < 1536) { if (kk < 64) v = iclr_a2[(((size_t)l * 2 + 0) * 64 + kk) * 512 + (n - 1024)]; }
        else if (n < 2048) { if (kk >= 64) v = iclr_a2[(((size_t)l * 2 + 1) * 64 + (kk - 64)) * 512 + (n - 1536)]; }
        else v = gate_g2[((size_t)l * 128 + kk) * 512 + (n - 2048)];
        Wlr[i] = (bf16_t)f2bf(v);
    }
    { bf16_t* WRT = (bf16_t*)(F.ws + WS_WRT);
      for (int i = F.gw * 64 + F.lane; i < NL * 16 * 1024; i += F.NGW * 64) { const int l = i / 16384, r = i % 16384, e = r / 1024, k = r % 1024;
          const float w = w_router[((size_t)l * 1024 + k) * 16 + e]; const unsigned hi = f2bf(w); const unsigned lo = f2bf(w - bflo(hi));
          WRT[((size_t)l * 2 + 0) * 16384 + r] = (bf16_t)hi; WRT[((size_t)l * 2 + 1) * 16384 + r] = (bf16_t)lo; } }
    if (blockIdx.x == 0) {
        float* rope = (float*)(F.ws + WS_ROPE);
        for (int i = F.tid; i < 64 * 16; i += NTHR) { const int pos = i >> 4, fi = i & 15;
            const float inv = powf(10000.0f, -(float)(2 * fi) / 32.0f); const float ang = (float)pos * inv;
            rope[2 * i] = cosf(ang); rope[2 * i + 1] = sinf(ang); }
    }
    __syncthreads();
    LAS float* sc = (LAS float*)F.lds;
    LAS float* part = (LAS float*)(F.lds + 17 * 1024 * 4);
    for (int i = F.tid; i < 17 * 1024; i += NTHR) { const float v = (i < 16 * 1024) ? c_in[i] : cctx_in[i - 16 * 1024]; sc[i] = v * sigmoidf_(v); }
    __syncthreads();
    float* MOD = (float*)(F.ws + WS_MOD);
    for (int item = F.vcu; item < NL * 96; item += F.G) {
        const int l = item / 96, n0 = (item % 96) * 64;
        float acc[17];
#pragma unroll
        for (int r = 0; r < 17; ++r) acc[r] = 0.f;
        const float* wp = ada_w + ((size_t)l * DM + F.wave * 128) * 6144 + n0 + F.lane;
        for (int kk0 = 0; kk0 < 128; kk0 += 16) {
            float w[16];
#pragma unroll
            for (int j = 0; j < 16; ++j) w[j] = wp[(size_t)(kk0 + j) * 6144];
#pragma unroll
            for (int j = 0; j < 16; ++j) {
                const int k = F.wave * 128 + kk0 + j;
#pragma unroll
                for (int r = 0; r < 17; ++r) acc[r] += sc[r * 1024 + k] * w[j];
            }
        }
#pragma unroll
        for (int r = 0; r < 17; ++r) part[(F.wave * 17 + r) * 64 + F.lane] = acc[r];
        __syncthreads();
        for (int idx = F.tid; idx < 17 * 64; idx += NTHR) { const int r = idx >> 6, j = idx & 63; float s = 0.f;
#pragma unroll
            for (int w = 0; w < 8; ++w) s += part[(w * 17 + r) * 64 + j];
            MOD[((size_t)l * 17 + r) * 6144 + n0 + j] = s + ada_b[(size_t)l * 6144 + n0 + j]; }
        __syncthreads();
    }
}

__device__ __forceinline__ void convert_experts(Frame& F, int l, const float* exp_gate, const float* exp_up, const float* exp_down, int wk, int nwk, int it_lo, int it_hi) {
    LAS float* scr = (LAS float*)(F.lds + F.wave * 16384);
    bf16_t* Wup = (bf16_t*)(F.ws + WS_WUP); bf16_t* Wdn = (bf16_t*)(F.ws + WS_WDN);
    constexpr int I_M = 16 * 32;
    for (int it = it_lo + wk; it < it_hi; it += nwk) {
        const int which = it / (NEXP * I_M), r = it % (NEXP * I_M), e = r / I_M, q = r % I_M, kb = q / 32, nb = q % 32, n0 = nb * 32;
        const float* W = (which == 0 ? exp_gate : (which == 1 ? exp_up : exp_down)) + ((size_t)l * NEXP + e) * DM * EFF;
        if (which < 2) { const int drow = 256 * (n0 >> 7) + 128 * which + (n0 & 127);
            transpose_item(W, EFF, kb * 64, n0, Wup + ((size_t)e * 2048 + drow) * DM + kb * 64, DM, scr, F.lane); }
        else transpose_item(W, DM, kb * 64, n0, Wdn + ((size_t)e * 1024 + n0) * EFF + kb * 64, EFF, scr, F.lane);
    }
}

struct N1Row { f32x4 v[4]; int slot; float gate; int row; bool ok; };
__device__ __forceinline__ void n1_load(Frame& F, N1Row& R, int row, int nrows, int l, const float* x_in, const float* ctx_in) {
    R.ok = row < nrows; R.row = R.ok ? row : 0;
    const bool lat = R.row < NLAT;
    if (l == 0) {
        const float* xs = lat ? x_in + (size_t)R.row * DM : ctx_in + (size_t)(R.row - NLAT) * DM;
#pragma unroll
        for (int j = 0; j < 4; ++j) R.v[j] = *(const f32x4*)(xs + 4 * F.lane + 256 * j);
    } else {
        const bf16_t* xb = (const bf16_t*)(F.ws + WS_XB) + (size_t)R.row * DM + 4 * F.lane;
#pragma unroll
        for (int j = 0; j < 4; ++j) { const u32x2 w = *(const u32x2*)(xb + 256 * j); R.v[j] = (f32x4){bflo(w.x), bfhi(w.x), bflo(w.y), bfhi(w.y)}; }
    }
    R.slot = -1; R.gate = 0.f;
    if (l > 0) { R.slot = ((const int*)(F.ws + WS_SLOT))[(size_t)R.row * 16 + (F.lane & 15)]; R.gate = ((const float*)(F.ws + WS_AFF))[(size_t)R.row * 16 + (F.lane & 15)]; }
}
__device__ __forceinline__ void n1_finish(Frame& F, N1Row& R, int l, const float* norm1, const float* final_norm, bool dry) {
    const bool fin = (l == NL);
    const float* MOD = (const float*)(F.ws + WS_MOD);
    const bf16_t* YE = (const bf16_t*)(F.ws + WS_YE); bf16_t* H = (bf16_t*)(F.ws + WS_H);
    const int row = R.row; const bool lat = row < NLAT; const int b = lat ? (row >> 11) : ((row - NLAT) >> 8); const int modrow = lat ? b : 16;
    bf16_t* xbw = (bf16_t*)(F.ws + WS_XB) + (size_t)row * DM;
    if (dry) { xbw = (bf16_t*)(F.ws + WS_WAG) + (size_t)row * DM; H = (bf16_t*)(F.ws + WS_YF); }
    if (l > 0) {
        f32x4 a[4];
#pragma unroll
        for (int j = 0; j < 4; ++j) a[j] = (f32x4){0.f, 0.f, 0.f, 0.f};
        unsigned mask = (unsigned)(__ballot(R.slot >= 0 && F.lane < 16));
        const size_t pbase = (size_t)(lat ? b * CAPL : NB * CAPL + b * CAPC);
        while (mask) {
            const int e0 = __builtin_ctz(mask); mask &= mask - 1u;
            const bool two = mask != 0u; const int e1 = two ? __builtin_ctz(mask) : e0; if (two) mask &= mask - 1u;
            const int s0 = __builtin_amdgcn_readlane(R.slot, e0), s1 = __builtin_amdgcn_readlane(R.slot, e1);
            const float g0 = __builtin_bit_cast(float, __builtin_amdgcn_readlane(__builtin_bit_cast(int, R.gate), e0));
            const float g1 = two ? __builtin_bit_cast(float, __builtin_amdgcn_readlane(__builtin_bit_cast(int, R.gate), e1)) : 0.f;
            const bf16_t* y0 = YE + ((size_t)e0 * PAIRS_E + pbase + s0) * DM + 4 * F.lane;
            const bf16_t* y1 = YE + ((size_t)e1 * PAIRS_E + pbase + s1) * DM + 4 * F.lane;
            u32x2 w0[4], w1[4];
#pragma unroll
            for (int j = 0; j < 4; ++j) { w0[j] = *(const u32x2*)(y0 + 256 * j); w1[j] = *(const u32x2*)(y1 + 256 * j); }
#pragma unroll
            for (int j = 0; j < 4; ++j) {
                a[j][0] += g0 * bflo(w0[j].x) + g1 * bflo(w1[j].x); a[j][1] += g0 * bfhi(w0[j].x) + g1 * bfhi(w1[j].x);
                a[j][2] += g0 * bflo(w0[j].y) + g1 * bflo(w1[j].y); a[j][3] += g0 * bfhi(w0[j].y) + g1 * bfhi(w1[j].y);
            }
        }
        const float* g2 = MOD + ((size_t)(l - 1) * 17 + modrow) * 6144 + 5 * 1024 + 4 * F.lane;
#pragma unroll
        for (int j = 0; j < 4; ++j) R.v[j] += *(const f32x4*)(g2 + 256 * j) * a[j];
    }
    if (!fin && R.ok) {
#pragma unroll
        for (int j = 0; j < 4; ++j) { u32x2 w; w.x = pk2(R.v[j][0], R.v[j][1]); w.y = pk2(R.v[j][2], R.v[j][3]); *(u32x2*)(xbw + 4 * F.lane + 256 * j) = w; }
    }
    float ss = 0.f;
#pragma unroll
    for (int j = 0; j < 4; ++j) ss += (R.v[j][0] * R.v[j][0] + R.v[j][1] * R.v[j][1]) + (R.v[j][2] * R.v[j][2] + R.v[j][3] * R.v[j][3]);
    const float rstd = rsq_(wave_sum(ss) * (1.0f / DM) + NORM_EPS);
    if (!R.ok) return;
    if (fin) {
        const float* gn = final_norm + 4 * F.lane;
#pragma unroll
        for (int j = 0; j < 4; ++j) *(f32x4*)(F.out + (size_t)row * DM + 4 * F.lane + 256 * j) = R.v[j] * rstd * *(const f32x4*)(gn + 256 * j);
    } else {
        const float* gn = norm1 + (size_t)l * DM + 4 * F.lane;
        const float* md = MOD + ((size_t)l * 17 + modrow) * 6144 + 4 * F.lane;
#pragma unroll
        for (int j = 0; j < 4; ++j) {
            const f32x4 h = R.v[j] * rstd * *(const f32x4*)(gn + 256 * j) * (*(const f32x4*)(md + 1024 + 256 * j) + 1.0f) + *(const f32x4*)(md + 256 * j);
            u32x2 w; w.x = pk2(h[0], h[1]); w.y = pk2(h[2], h[3]);
            *(u32x2*)(H + (size_t)row * DM + 4 * F.lane + 256 * j) = w;
        }
    }
}
__device__ __forceinline__ void phase_norm1(Frame& F, int l, const float* x_in, const float* ctx_in, const float* norm1, const float* final_norm, bool dry = false) {
    const int nrows = (l == NL) ? NLAT : NTOK;
    for (int row = F.gw; row < nrows; row += 4 * F.NGW) {
        N1Row A, B, C, D;
        n1_load(F, A, row, nrows, l, x_in, ctx_in); n1_load(F, B, row + F.NGW, nrows, l, x_in, ctx_in); n1_load(F, C, row + 2 * F.NGW, nrows, l, x_in, ctx_in); n1_load(F, D, row + 3 * F.NGW, nrows, l, x_in, ctx_in);
        n1_finish(F, A, l, norm1, final_norm, dry); n1_finish(F, B, l, norm1, final_norm, dry); n1_finish(F, C, l, norm1, final_norm, dry); n1_finish(F, D, l, norm1, final_norm, dry);
    }
}

struct PrepRow { u32x4 q, k, bg, cg[3], u[3], lr[3]; };
__device__ __forceinline__ void prep_load(PrepRow& R, const bf16_t* pr, int t, int slen, int lane) {
    const bool hp = t > 0, hn = t + 1 < slen; const u32x4 z = {0u, 0u, 0u, 0u};
    R.q = *(const u32x4*)(pr + C_Q + 8 * lane); R.k = *(const u32x4*)(pr + C_K + 8 * (lane & 15));
    R.bg = *(const u32x4*)(pr + C_BG + 8 * lane);
    R.cg[0] = *(const u32x4*)(pr + C_CG + 8 * lane); R.u[0] = *(const u32x4*)(pr + C_U + 8 * lane);
    R.cg[1] = hp ? *(const u32x4*)(pr - PW + C_CG + 8 * lane) : z; R.u[1] = hp ? *(const u32x4*)(pr - PW + C_U + 8 * lane) : z;
    R.cg[2] = hn ? *(const u32x4*)(pr + PW + C_CG + 8 * lane) : z; R.u[2] = hn ? *(const u32x4*)(pr + PW + C_U + 8 * lane) : z;
    const int ll = lane < 48 ? lane : 47;
    R.lr[0] = *(const u32x4*)(pr + C_WLO + 8 * ll);
    R.lr[1] = hp ? *(const u32x4*)(pr - PW + C_WLO + 8 * ll) : z; R.lr[2] = hn ? *(const u32x4*)(pr + PW + C_WLO + 8 * ll) : z;
}
__device__ __forceinline__ void phase_prep(Frame& F, int l, const float* q_gain, const float* k_gain, const float* conv_w, const float* shift_mu, bool dry = false) {
    bf16_t* P = (bf16_t*)(F.ws + WS_PROJ); bf16_t* LRA = (bf16_t*)(F.ws + WS_LRA);
    LAS float* rope = (LAS float*)F.lds;
    for (int i = F.tid; i < 64 * 16 * 2; i += NTHR) rope[i] = ((const float*)(F.ws + WS_ROPE))[i];
    __syncthreads();
    const int lane = F.lane, s8 = lane & 7;
    float qg[8], kg[8], cw0[8], cw1[8], cw2[8], mu[8];
#pragma unroll
    for (int i = 0; i < 8; ++i) { qg[i] = q_gain[l * 64 + s8 * 8 + i]; kg[i] = k_gain[l * 64 + s8 * 8 + i];
        cw0[i] = conv_w[((size_t)l * 3 + 0) * 512 + 8 * lane + i]; cw1[i] = conv_w[((size_t)l * 3 + 1) * 512 + 8 * lane + i]; cw2[i] = conv_w[((size_t)l * 3 + 2) * 512 + 8 * lane + i];
        mu[i] = (lane < 48) ? shift_mu[(size_t)l * 1920 + (C_WLO - C_RW) + 8 * lane + i] : 0.f; }
    for (int row0 = F.gw; row0 < NTOK; row0 += 2 * F.NGW) {
        const int row1 = row0 + F.NGW; const bool ok1 = row1 < NTOK;
        PrepRow RR[2]; int tt[2]; bool latt[2];
#pragma unroll
        for (int z = 0; z < 2; ++z) { const int row = (z == 0 || !ok1) ? row0 : row1; latt[z] = row < NLAT; tt[z] = latt[z] ? (row & 2047) : ((row - NLAT) & 255);
            prep_load(RR[z], P + (size_t)row * PW, tt[z], latt[z] ? SEQ : CTXL, lane); }
#pragma unroll
        for (int z = 0; z < 2; ++z) {
            if (z == 1 && !ok1) break;
            const int row = z == 0 ? row0 : row1; const PrepRow& R = RR[z]; const bool lat = latt[z]; const int t = tt[z];
            bf16_t* pr = P + (size_t)row * PW;
#pragma unroll
            for (int which = 0; which < 2; ++which) {
                float x[8]; unpack8(which == 0 ? R.q : R.k, x);
                float ss = 0.f;
#pragma unroll
                for (int i = 0; i < 8; ++i) ss += x[i] * x[i];
                ss = sum8(ss);
                const float rstd = rsq_(ss * (1.0f / 64.0f) + NORM_EPS);
#pragma unroll
                for (int i = 0; i < 8; ++i) x[i] = x[i] * rstd * (which == 0 ? qg[i] : kg[i]);
                if (lat) {
                    const int pos = (s8 < 4) ? (t >> 6) : (t & 63);
                    float o[8];
#pragma unroll
                    for (int i = 0; i < 8; ++i) {
                        const float partner = dpp_f(x[i], 1);
                        const int fi = (s8 & 1) * 8 + i;
                        const float c = rope[(pos * 16 + fi) * 2], sn = rope[(pos * 16 + fi) * 2 + 1];
                        o[i] = (s8 & 2) ? (partner * sn + x[i] * c) : (x[i] * c - partner * sn);
                    }
#pragma unroll
                    for (int i = 0; i < 8; ++i) x[i] = o[i];
                }
                if (which == 0) {
#pragma unroll
                    for (int i = 0; i < 8; ++i) x[i] *= QSCALE;
                    if (!dry) st8(pr + C_Q + 8 * lane, x);
                } else if (lane < 16 && !dry) st8(pr + C_K + 8 * lane, x);
            }
            {
                float bg[8], c0[8], u0[8], z0[8], zp[8], zn[8];
                unpack8(R.bg, bg);
                unpack8(R.cg[0], c0); unpack8(R.u[0], u0);
#pragma unroll
                for (int i = 0; i < 8; ++i) z0[i] = c0[i] * u0[i];
                unpack8(R.cg[1], c0); unpack8(R.u[1], u0);
#pragma unroll
                for (int i = 0; i < 8; ++i) zp[i] = c0[i] * u0[i];
                unpack8(R.cg[2], c0); unpack8(R.u[2], u0);
#pragma unroll
                for (int i = 0; i < 8; ++i) zn[i] = c0[i] * u0[i];
                float o[8];
#pragma unroll
                for (int i = 0; i < 8; ++i) o[i] = bg[i] * (cw0[i] * zp[i] + cw1[i] * z0[i] + cw2[i] * zn[i]);
                if (!dry) st8(pr + C_OCONV + 8 * lane, o);
            }
            {
                float x[8], xp[8], xn[8], o[8];
                unpack8(R.lr[0], x); unpack8(R.lr[1], xp); unpack8(R.lr[2], xn);
#pragma unroll
                for (int i = 0; i < 8; ++i) { const float sft = x[i] + mu[i] * (0.5f * (xp[i] + xn[i]) - x[i]);
                    const float sg = sigmoidf_(lane < 16 ? 2.0f * sft : sft); o[i] = lane < 16 ? 2.0f * sg - 1.0f : (lane < 32 ? sft : sg); }
                if (lane < 48) st8(LRA + (size_t)row * LRAW + 8 * lane, o);
            }
        }
    }
}
__device__ __forceinline__ void n2_modulate(Frame& F, f32x4 (&v)[4], int row, int l, const float* norm2) {
    const float* MOD = (const float*)(F.ws + WS_MOD); bf16_t* H = (bf16_t*)(F.ws + WS_H);
    const bool lat = row < NLAT; const int b = lat ? (row >> 11) : ((row - NLAT) >> 8); const int modrow = lat ? b : 16;
    float ss = 0.f;
#pragma unroll
    for (int j = 0; j < 4; ++j) ss += (v[j][0] * v[j][0] + v[j][1] * v[j][1]) + (v[j][2] * v[j][2] + v[j][3] * v[j][3]);
    const float rstd = rsq_(wave_sum(ss) * (1.0f / DM) + NORM_EPS);
    const float* gn = norm2 + (size_t)l * DM + 4 * F.lane;
    const float* md = MOD + ((size_t)l * 17 + modrow) * 6144 + 3 * 1024 + 4 * F.lane;
#pragma unroll
    for (int j = 0; j < 4; ++j) {
        v[j] = v[j] * rstd * *(const f32x4*)(gn + 256 * j) * (*(const f32x4*)(md + 1024 + 256 * j) + 1.0f) + *(const f32x4*)(md + 256 * j);
        u32x2 w; w.x = pk2(v[j][0], v[j][1]); w.y = pk2(v[j][2], v[j][3]);
        *(u32x2*)(H + (size_t)row * DM + 4 * F.lane + 256 * j) = w;
    }
}
__device__ __forceinline__ void n2_softmax_store(Frame& F, float (&lg)[16], int row) {
    float* AFF = (float*)(F.ws + WS_AFF);
    float mx = lg[0];
#pragma unroll
    for (int e = 1; e < 16; ++e) mx = fmaxf(mx, lg[e]);
    float den = 0.f;
#pragma unroll
    for (int e = 0; e < 16; ++e) { lg[e] = __expf(lg[e] - mx); den += lg[e]; }
    const float inv = rcp_(den);
    float mine = 0.f;
#pragma unroll
    for (int e = 0; e < 16; ++e) mine = (F.lane == e) ? lg[e] * inv : mine;
    if (F.lane < 16) AFF[(size_t)row * 16 + F.lane] = mine;
}
__device__ __forceinline__ void phase_norm2_router(Frame& F, int l, int nrows, const float* norm2, const float* w_router) {
    LAS float* wrT = (LAS float*)F.lds;
    for (int i = F.tid; i < 16 * 1024; i += NTHR) { const int c = i >> 4, e = i & 15; wrT[e * 1024 + c] = w_router[(size_t)l * DM * 16 + i]; }
    __syncthreads();
    const bf16_t* XB = (const bf16_t*)(F.ws + WS_XB);
    for (int row = F.gw; row < nrows; row += 2 * F.NGW) {
        const int row1 = row + F.NGW; const bool ok1 = row1 < nrows; const int r1 = ok1 ? row1 : row;
        f32x4 v0[4], v1[4];
#pragma unroll
        for (int j = 0; j < 4; ++j) { const u32x2 a = *(const u32x2*)(XB + (size_t)row * DM + 4 * F.lane + 256 * j), b = *(const u32x2*)(XB + (size_t)r1 * DM + 4 * F.lane + 256 * j);
            v0[j] = (f32x4){bflo(a.x), bfhi(a.x), bflo(a.y), bfhi(a.y)}; v1[j] = (f32x4){bflo(b.x), bfhi(b.x), bflo(b.y), bfhi(b.y)}; }
        n2_modulate(F, v0, row, l, norm2);
        n2_modulate(F, v1, r1, l, norm2);
        float lg0[16], lg1[16];
#pragma unroll
        for (int e = 0; e < 16; ++e) {
            float s0 = 0.f, s1 = 0.f;
#pragma unroll
            for (int j = 0; j < 4; ++j) { const f32x4 w = *(const LAS f32x4*)(wrT + e * 1024 + 4 * F.lane + 256 * j);
                s0 += (v0[j][0] * w[0] + v0[j][1] * w[1]) + (v0[j][2] * w[2] + v0[j][3] * w[3]); s1 += (v1[j][0] * w[0] + v1[j][1] * w[1]) + (v1[j][2] * w[2] + v1[j][3] * w[3]); }
            lg0[e] = wave_sum(s0); lg1[e] = wave_sum(s1);
            if ((e & 3) == 3) __builtin_amdgcn_sched_barrier(0);
        }
        n2_softmax_store(F, lg0, row);
        if (ok1) n2_softmax_store(F, lg1, row1);
    }
}

__device__ __forceinline__ float qsum4(float x) {
    x += __shfl_xor(x, 16); x += __shfl_xor(x, 32);
    return x;
}
__device__ __forceinline__ void n2_tile(Frame& F, int row0, const LAS float* Gs, const LAS float* Sh, const bf16_t* WRh, const bf16_t* WRl) {
    const int lane = F.lane, r = lane & 15, q = lane >> 4;
    const bf16_t* xrow = (const bf16_t*)(F.ws + WS_XB) + (size_t)(row0 + r) * DM + 8 * q;
    bf16_t* hrow = (bf16_t*)(F.ws + WS_H) + (size_t)(row0 + r) * DM + 8 * q;
    const bf16_t* wh = WRh + (size_t)r * 1024 + 8 * q; const bf16_t* wl = WRl + (size_t)r * 1024 + 8 * q;
    float ss = 0.f;
#pragma unroll 8
    for (int s = 0; s < 32; ++s) { float x[8]; ld8(xrow + 32 * s, x);
#pragma unroll
        for (int j = 0; j < 8; ++j) ss += x[j] * x[j]; }
    const float rstd = rsq_(qsum4(ss) * (1.0f / DM) + NORM_EPS);
    f32x4 acc = {0.f, 0.f, 0.f, 0.f};
#pragma unroll 2
    for (int s = 0; s < 32; ++s) {
        float x[8]; ld8(xrow + 32 * s, x);
        const f32x4 g0 = *(const LAS f32x4*)(Gs + 32 * s + 8 * q), g1 = *(const LAS f32x4*)(Gs + 32 * s + 8 * q + 4), h0 = *(const LAS f32x4*)(Sh + 32 * s + 8 * q), h1 = *(const LAS f32x4*)(Sh + 32 * s + 8 * q + 4);
        const bf16x8 bh = *(const bf16x8*)(wh + 32 * s), bl = *(const bf16x8*)(wl + 32 * s);
        float h[8];
#pragma unroll
        for (int j = 0; j < 4; ++j) { h[j] = x[j] * rstd * g0[j] + h0[j]; h[4 + j] = x[4 + j] * rstd * g1[j] + h1[j]; }
        u32x4 hw; hw.x = pk2(h[0], h[1]); hw.y = pk2(h[2], h[3]); hw.z = pk2(h[4], h[5]); hw.w = pk2(h[6], h[7]);
        *(u32x4*)(hrow + 32 * s) = hw;
        u32x4 lw; lw.x = pk2(h[0] - bflo(hw.x), h[1] - bfhi(hw.x)); lw.y = pk2(h[2] - bflo(hw.y), h[3] - bfhi(hw.y)); lw.z = pk2(h[4] - bflo(hw.z), h[5] - bfhi(hw.z)); lw.w = pk2(h[6] - bflo(hw.w), h[7] - bfhi(hw.w));
        const bf16x8 ah = __builtin_bit_cast(bf16x8, hw), al = __builtin_bit_cast(bf16x8, lw);
        acc = __builtin_amdgcn_mfma_f32_16x16x32_bf16(ah, bh, acc, 0, 0, 0);
        acc = __builtin_amdgcn_mfma_f32_16x16x32_bf16(ah, bl, acc, 0, 0, 0);
        acc = __builtin_amdgcn_mfma_f32_16x16x32_bf16(al, bh, acc, 0, 0, 0);
    }
    float* AFF = (float*)(F.ws + WS_AFF);
#pragma unroll
    for (int g = 0; g < 4; ++g) {
        float mx = acc[g];
#pragma unroll
        for (int c_ = 0; c_ < 4; ++c_) mx = fmaxf(mx, dpp_f(mx, c_));
        const float e = __expf(acc[g] - mx);
        float den = e;
#pragma unroll
        for (int c_ = 0; c_ < 4; ++c_) den += dpp_f(den, c_);
        AFF[(size_t)(row0 + 4 * q + g) * 16 + r] = e * rcp_(den);
    }
}
__device__ __forceinline__ void phase_norm2_router_mfma(Frame& F, int l, int nrows, const float* norm2) {
    LAS float* Gs = (LAS float*)F.lds;
    LAS float* Sh = Gs + 2048;
    const float* MOD = (const float*)(F.ws + WS_MOD);
    const int b = (F.vcu * NWAVES * 16) >> 11;
    for (int i = F.tid; i < 2048; i += NTHR) { const int c = i & 1023, modrow = i < 1024 ? b : 16; const float* md = MOD + ((size_t)l * 17 + modrow) * 6144 + 3 * 1024;
        Gs[i] = norm2[(size_t)l * DM + c] * (1.0f + md[1024 + c]); Sh[i] = md[c]; }
    __syncthreads();
    const bf16_t* WRh = (const bf16_t*)(F.ws + WS_WRT) + (size_t)l * 2 * 16384; const bf16_t* WRl = WRh + 16384;
    n2_tile(F, 16 * F.gw, Gs, Sh, WRh, WRl);
    if (nrows > NLAT && F.wave == 0) n2_tile(F, NLAT + 16 * F.vcu, Gs + 1024, Sh + 1024, WRh, WRl);
}

__device__ __forceinline__ int block_sum_i(LAS int* red, int& par, int wave_val, int wave, int lane) {
    if (lane == 0) red[par * 8 + wave] = wave_val;
    __syncthreads();
    int s = 0;
#pragma unroll
    for (int w = 0; w < 8; ++w) s += red[par * 8 + w];
    par ^= 1;
    return s;
}
__device__ __forceinline__ int block_exscan_i(LAS int* red, int& par, int val, int wave, int lane) {
    int inc = val;
#pragma unroll
    for (int o = 1; o < 64; o <<= 1) { const int t = __shfl_up(inc, o); if (lane >= o) inc += t; }
    if (lane == 63) red[par * 8 + wave] = inc;
    __syncthreads();
    int base = 0;
#pragma unroll
    for (int w = 0; w < 8; ++w) base += (w < wave) ? red[par * 8 + w] : 0;
    par ^= 1;
    return base + inc - val;
}
__device__ __forceinline__ void topk_set(Frame& F, LAS int* red, int& par, int n, int cap, int rowbase, int e, int listbase) {
    const float* AFF = (const float*)(F.ws + WS_AFF); int* LIST = (int*)(F.ws + WS_LIST); int* SLOT = (int*)(F.ws + WS_SLOT);
    unsigned key[4];
#pragma unroll
    for (int j = 0; j < 4; ++j) { const int tok = 4 * F.tid + j; key[j] = (tok < n) ? __builtin_bit_cast(unsigned, AFF[(size_t)(rowbase + tok) * 16 + e]) : 0u; }
    unsigned T = 0u;
    for (int bit = 30; bit >= 0; --bit) {
        const unsigned cand = T | (1u << bit);
        int c = 0;
#pragma unroll
        for (int j = 0; j < 4; ++j) c += __popcll(__ballot(key[j] >= cand));
        if (block_sum_i(red, par, c, F.wave, F.lane) >= cap) T = cand;
    }
    int cgt = 0, ceq = 0;
#pragma unroll
    for (int j = 0; j < 4; ++j) { cgt += __popcll(__ballot(key[j] > T)); ceq += (key[j] == T) ? 1 : 0; }
    const int n_gt = block_sum_i(red, par, cgt, F.wave, F.lane);
    const int need_eq = cap - n_gt;
    int eqrank = block_exscan_i(red, par, ceq, F.wave, F.lane);
    int sel[4], csel = 0;
#pragma unroll
    for (int j = 0; j < 4; ++j) { const bool eq = key[j] == T; sel[j] = (key[j] > T || (eq && eqrank < need_eq)) ? 1 : 0; eqrank += eq ? 1 : 0; csel += sel[j]; }
    int slot = block_exscan_i(red, par, csel, F.wave, F.lane);
#pragma unroll
    for (int j = 0; j < 4; ++j) { const int tok = 4 * F.tid + j;
        if (tok < n) { SLOT[(size_t)(rowbase + tok) * 16 + e] = sel[j] ? slot : -1; if (sel[j]) { LIST[listbase + slot] = rowbase + tok; ++slot; } } }
}
__device__ __forceinline__ void phase_topk(Frame& F, bool need_ctx) {
    LAS int* red = (LAS int*)F.lds; int par = 0;
    for (int pair = F.vcu; pair < NB * NEXP; pair += F.G) {
        const int b = pair >> 4, e = pair & 15;
        topk_set(F, red, par, SEQ, CAPL, b * SEQ, e, e * PAIRS_E + b * CAPL);
        if (need_ctx) topk_set(F, red, par, CTXL, CAPC, NLAT + b * CTXL, e, e * PAIRS_E + NB * CAPL + b * CAPC);
    }
}

constexpr int SC_STEPS = 32;
constexpr int CS_AT = 0, CS_BT = 4608, CS_KT = 9216, CS_RT = 13824, CS_ATF = 18432;
constexpr int CS_BKT = CS_ATF + 2 * 4352, CS_WC = CS_BKT + 2 * 4352, CS_SET = CS_WC + 512;
__device__ __forceinline__ int cs_atf(int sc, int c) { return sc * 4352 + (c * 16 + 8 * (c >> 3)) * 4; }
__device__ __forceinline__ int cs_bkt(int sc, int c) { return sc * 4352 + c * 64 + 32 * (c >> 3); }
__device__ __forceinline__ int cs_vt(int sc, int v) { return sc * 2176 + v * 32 + 16 * (v >> 3); }
constexpr int CS_WT = 2 * CS_SET, CS_NM = CS_WT + 1024, CS_ABK = CS_NM + 2560, CS_AVT = CS_ABK + 2 * 2560, CS_AH = CS_AVT + 10240, CS_UBT = CS_AH + 4608, CS_CONV = CS_UBT + 10240, CS_CST = CS_CONV + 4 * 4224, CS_YO = CS_CST + 1536, CS_VTR = CS_YO + 4608, CS_VTSZ = 2 * 2176;
static_assert(CS_SET % 16 == 0 && CS_VTR + 3 * CS_VTSZ <= MISC_OFF, "scan lds map");
__device__ __forceinline__ void scan_chunk_geom(int ci, int b, int d, int s, int& slen, int& t, size_t& row) {
    constexpr int NC = CTXL / SC_STEPS;
    const bool ctx = ci < NC; slen = ctx ? CTXL : SEQ; const int c0 = (ctx ? ci : ci - NC) * SC_STEPS; const int rowbase = ctx ? NLAT + b * CTXL : b * SEQ;
    t = d == 0 ? (c0 + s) : (slen - 1 - (c0 + s)); row = (size_t)(rowbase + t);
}
#define CS_MMA(x_, y_, c_) __builtin_amdgcn_mfma_f32_16x16x32_bf16(x_, y_, c_, 0, 0, 0)
__device__ __forceinline__ bf16x8 cs_ld16(const LAS char* p) { return *(const LAS bf16x8*)p; }
__device__ __forceinline__ bf16x8 cs_ld8x2(const LAS char* p0, const LAS char* p1) { const u32x2 a = *(const LAS u32x2*)p0, b = *(const LAS u32x2*)p1; const u32x4 w = {a.x, a.y, b.x, b.y}; return __builtin_bit_cast(bf16x8, w); }
__device__ __forceinline__ void cs_st16(LAS char* p, float x) { *(LAS unsigned short*)p = (unsigned short)pk2(x, x); }
#define CS_UD4(v_) asm volatile("" : "=v"(v_.x), "=v"(v_.y), "=v"(v_.z), "=v"(v_.w))
#define CS_UD8(a_) asm volatile("" : "=v"(a_[0]), "=v"(a_[1]), "=v"(a_[2]), "=v"(a_[3]), "=v"(a_[4]), "=v"(a_[5]), "=v"(a_[6]), "=v"(a_[7]))
#define CS_UNDEF_ALL() do { CS_UD4(rx[0]); CS_UD4(rx[1]); CS_UD4(rx[2]); CS_UD4(rp[0]); CS_UD4(rp[1]); CS_UD4(rp[2]); CS_UD4(rn[0]); CS_UD4(rn[1]); CS_UD4(rn[2]); CS_UD4(wu); CS_UD4(wa); \
        CS_UD8(pr_); CS_UD8(pkk); CS_UD8(pb); CS_UD8(pkd); asm volatile("" : "=v"(cv[0]), "=v"(cv[1]), "=v"(cv[2]), "=v"(cv[3]), "=v"(cv[4]), "=v"(cv[5]), "=v"(cv[6]), "=v"(cv[7])); \
        asm volatile("" : "=v"(cv[8]), "=v"(cv[9]), "=v"(cv[10]), "=v"(cv[11]), "=v"(cv[12]), "=v"(cv[13]), "=v"(cv[14]), "=v"(cv[15])); asm volatile("" : "=v"(cv_it)); } while (0)
#define CS_BAR() asm volatile("s_waitcnt lgkmcnt(0)\n\ts_barrier" ::: "memory")
template <int PR>
__device__ __forceinline__ void phase_scan(Frame& F, int l, const float* shift_mu, const float* rwkv_kk, const float* rwkv_ka, const float* exp_gate, const float* exp_up, const float* exp_down, const float* rwkv_rk, bool noconv_ = false) {
    const bool noconv = noconv_ || PR != 0;
    const bf16_t* P = (const bf16_t*)(F.ws + WS_PROJ); const bf16_t* WAG = (const bf16_t*)(F.ws + WS_WAG);
    LAS char* LB = (LAS char*)F.lds;
    const int tid = F.tid;
    const bool teamS = F.wave < 4;
    constexpr bool skipS = (PR & 1) != 0, skipP = (PR & 2) != 0, skipY = (PR & 4) != 0, skipS2 = (PR & 8) != 0, skipS3 = (PR & 16) != 0, skipP2 = (PR & 32) != 0;
    const int wv = F.wave & 3;
    const int pt = tid & 255, s = pt >> 3, cg = pt & 7;
    const int psc = s >> 4, pts = s & 15;
    constexpr int NCH = (CTXL + SEQ) / SC_STEPS;
    for (int chain = F.vcu; chain < 2 * NB * 8; chain += F.G) {
        const int d = chain >> 7, b = (chain >> 3) & 15, h = chain & 7;
        bf16_t* Y = (bf16_t*)(F.ws + (d == 0 ? WS_YF : WS_YB));
        const int hc = h * 64 + 8 * cg;
        if (tid < 384) {
            const int a_ = tid >> 6, c_ = tid & 63;
            const float* src = a_ == 0 ? rwkv_rk + (size_t)l * 512 : a_ == 4 ? rwkv_kk + (size_t)l * 512 : a_ == 5 ? rwkv_ka + (size_t)l * 512 : shift_mu + (size_t)l * 1920 + 512 * (a_ - 1);
            ((LAS float*)(LB + CS_CST))[tid] = src[h * 64 + c_];
        }
        __syncthreads();
        f32x4 Sacc[4];
#pragma unroll
        for (int j = 0; j < 4; ++j) Sacc[j] = (f32x4){0.f, 0.f, 0.f, 0.f};
        float pr_[8], pkk[8], pb[8], pkd[8];
        u32x4 rx[3], rp[3], rn[3], wu, wa;
        float cv[16]; int cv_it = -1;
#define CS_FETCH(cix_, dep_) do { int slen_, t_; size_t row_; scan_chunk_geom((cix_), b, d, s + (dep_), slen_, t_, row_); const bf16_t* pr_g = P + row_ * PW + C_RW + hc; const bool hp_ = t_ > 0, hn_ = t_ + 1 < slen_; \
            const bf16_t* pr_p = pr_g - (hp_ ? PW : 0); const bf16_t* pr_n = pr_g + (hn_ ? PW : 0);        \
            _Pragma("unroll") for (int q = 0; q < 3; ++q) { rx[q] = *(const u32x4*)(pr_g + 512 * q); rp[q] = *(const u32x4*)(pr_p + 512 * q); rn[q] = *(const u32x4*)(pr_n + 512 * q); } \
            wu = *(const u32x4*)(WAG + row_ * WAGW + d * 512 + hc); wa = *(const u32x4*)(WAG + row_ * WAGW + 1024 + d * 512 + hc); } while (0)
#pragma unroll
        for (int i = 0; i < 16; ++i) cv[i] = 0.f;
        if (!teamS) CS_FETCH(0, 0);
        for (int ci = -2; ci < NCH; ++ci) {
            int lane = F.lane; asm volatile("" : "+v"(lane));
            const int r16 = lane & 15, q4 = lane >> 4;
            const int s = ((tid & 255) >> 6) * 8 + (lane >> 3), cg = lane & 7;
            const int psc = s >> 4, pts = s & 15;
            const int hc = h * 64 + 8 * cg;
            const LAS char* set0 = LB + (ci & 1) * CS_SET;
            const LAS char* set1 = LB + ((ci + 1) & 1) * CS_SET;
            if (teamS) {
                if (ci >= 0 && !skipS && !skipS3) {
                    const LAS char* setc = set0; const LAS char* vtc = LB + CS_VTR + (ci % 3) * CS_VTSZ; const LAS char* abk = LB + CS_ABK + (ci & 1) * 2560;
                    const int vrow = 16 * wv + r16;
#pragma unroll
                    for (int sc = 0; sc < 2; ++sc) {
                        bf16x8 sop[2];
#pragma unroll
                        for (int kk = 0; kk < 2; ++kk) { const u32x4 w = {pk2(Sacc[2 * kk][0], Sacc[2 * kk][1]), pk2(Sacc[2 * kk][2], Sacc[2 * kk][3]), pk2(Sacc[2 * kk + 1][0], Sacc[2 * kk + 1][1]), pk2(Sacc[2 * kk + 1][2], Sacc[2 * kk + 1][3])}; sop[kk] = __builtin_bit_cast(bf16x8, w); }
                        f32x4 uacc = *(const LAS f32x4*)(LB + CS_UBT + (sc * 64 + vrow) * 80 + 16 * q4);
                        f32x4 yacc = {0.f, 0.f, 0.f, 0.f};
#pragma unroll
                        for (int kk = 0; kk < 2; ++kk) {
                            const LAS char* ah = LB + CS_AH + (sc * 16 + r16) * 144 + 64 * kk + 8 * q4;
                            uacc = CS_MMA(cs_ld8x2(ah, ah + 32), sop[kk], uacc);
                            const LAS char* rt = setc + CS_RT + (16 * sc + r16) * 144 + 64 * kk + 8 * q4;
                            yacc = CS_MMA(cs_ld8x2(rt, rt + 32), sop[kk], yacc);
                        }
                        const u32x2 v2 = *(const LAS u32x2*)(vtc + cs_vt(sc, vrow) + 8 * q4);
                        const u32x4 uvw = {pk2(uacc[0], uacc[1]), pk2(uacc[2], uacc[3]), v2.x, v2.y};
                        const bf16x8 uv = __builtin_bit_cast(bf16x8, uvw);
                        yacc = CS_MMA(cs_ld16(abk + (sc * 16 + r16) * 80 + 16 * q4), uv, yacc);
#pragma unroll
                        for (int tile = 0; tile < 4; ++tile) {
                            const f32x4 wc = *(const LAS f32x4*)(setc + CS_WC + (sc * 64 + 16 * tile + 4 * q4) * 4);
                            Sacc[tile] = CS_MMA(cs_ld16(setc + CS_BKT + cs_bkt(sc, 16 * tile + r16) + 16 * q4), uv, Sacc[tile] * wc);
                        }
#pragma unroll
                        for (int g = 0; g < 4; ++g) cs_st16(LB + CS_YO + (16 * sc + 4 * q4 + g) * 144 + 2 * vrow, yacc[g]);
                    }
                }
                if (ci + 1 >= 0 && ci + 1 < NCH && !skipS) {
                    const LAS char* setc = set1; const LAS char* vtc = LB + CS_VTR + ((ci + 1) % 3) * CS_VTSZ; LAS char* abk = LB + CS_ABK + ((ci + 1) & 1) * 2560;
                    const int sc = wv >> 1, role = wv & 1;
                    const LAS char* yop = setc + (role == 0 ? CS_AT : CS_RT) + (16 * sc + r16) * 144 + 16 * q4;
                    const LAS char* xb = setc + CS_BT + (16 * sc + r16) * 144 + 16 * q4;
                    const LAS char* xk = setc + CS_KT + (16 * sc + r16) * 144 + 16 * q4;
                    f32x4 accB = {0.f, 0.f, 0.f, 0.f}, accK = {0.f, 0.f, 0.f, 0.f};
#pragma unroll
                    for (int kk = 0; kk < 2; ++kk) { const bf16x8 yv = cs_ld16(yop + 64 * kk); accB = CS_MMA(cs_ld16(xb + 64 * kk), yv, accB); accK = CS_MMA(cs_ld16(xk + 64 * kk), yv, accK); }
                    if (role == 0) {
                        f32x4 nm; float ak[4];
#pragma unroll
                        for (int g = 0; g < 4; ++g) { const bool keep = 4 * q4 + g < r16; nm[g] = keep ? accB[g] : 0.f; ak[g] = keep ? accK[g] : 0.f; }
                        *(LAS f32x4*)(LB + CS_NM + (sc * 16 + r16) * 80 + 16 * q4) = nm;
                        const u32x4 xw = {pk2(ak[0], ak[1]), pk2(ak[2], ak[3]), 0u, 0u};
                        const bf16x8 xop = __builtin_bit_cast(bf16x8, xw);
#pragma unroll
                        for (int vt = 0; vt < 4; ++vt) {
                            const u32x2 v2 = *(const LAS u32x2*)(vtc + cs_vt(sc, 16 * vt + r16) + 8 * q4);
                            const u32x4 yw = {v2.x, v2.y, 0u, 0u};
                            f32x4 av = {0.f, 0.f, 0.f, 0.f};
                            av = CS_MMA(xop, __builtin_bit_cast(bf16x8, yw), av);
                            *(LAS f32x4*)(LB + CS_AVT + (sc * 64 + 16 * vt + r16) * 80 + 16 * q4) = av;
                        }
                    } else {
                        float rb[4], rk[4];
#pragma unroll
                        for (int g = 0; g < 4; ++g) { const bool keep = 4 * q4 + g <= r16; rb[g] = keep ? accB[g] : 0.f; rk[g] = keep ? accK[g] : 0.f; }
                        const u32x4 w = {pk2(rb[0], rb[1]), pk2(rb[2], rb[3]), pk2(rk[0], rk[1]), pk2(rk[2], rk[3])};
                        *(LAS u32x4*)(abk + (sc * 16 + r16) * 80 + 16 * q4) = w;
                    }
                }
                CS_UNDEF_ALL();
            } else {
              {
                  LAS float* scr = (LAS float*)(LB + CS_CONV) + (F.wave - 4) * (32 * 33);
                  convert_expert_finish32(F.ws, cv_it, cv, scr, F.lane);
              }
              int dep = 0;
              if (ci + 2 < NCH && !skipP) {
                int slen, t; size_t row;
                scan_chunk_geom(ci + 2, b, d, s, slen, t, row);
                const bool hp = t > 0, hn = t + 1 < slen;
                const LAS float* cst = (const LAS float*)(LB + CS_CST) + 8 * cg;
                float k[8], pv[8];
#pragma unroll
                for (int q = 0; q < 3; ++q) {
                    float x[8], xp[8], xn[8];
                    const unsigned mp = hp ? 0xffffffffu : 0u, mn = hn ? 0xffffffffu : 0u;
                    unpack8(rx[q], x); unpack8((u32x4){rp[q].x & mp, rp[q].y & mp, rp[q].z & mp, rp[q].w & mp}, xp); unpack8((u32x4){rn[q].x & mn, rn[q].y & mn, rn[q].z & mn, rn[q].w & mn}, xn);
                    const f32x4 m0 = *(const LAS f32x4*)(cst + 64 * (1 + q)), m1 = *(const LAS f32x4*)(cst + 64 * (1 + q) + 4);
#pragma unroll
                    for (int i = 0; i < 8; ++i) { const float m = i < 4 ? m0[i & 3] : m1[i & 3]; const float sft = x[i] + m * (0.5f * (xp[i] + xn[i]) - x[i]);
                        if (q == 0) pr_[i] = sft; else if (q == 1) k[i] = sft; else pv[i] = sft; }
                    __builtin_amdgcn_sched_barrier(0);
                }
                __builtin_amdgcn_sched_barrier(0);
                float pu[8], ag[8];
                unpack8(wu, pu); unpack8(wa, ag);
#pragma unroll
                for (int i = 0; i < 8; ++i) pu[i] *= 1.4426950408889634f;
                asm volatile("" : "+v"(dep) : "v"(pu[0]), "v"(pu[1]), "v"(pu[2]), "v"(pu[3]), "v"(pu[4]), "v"(pu[5]), "v"(pu[6]), "v"(pu[7]), "v"(ag[0]), "v"(ag[1]), "v"(ag[2]), "v"(ag[3]), "v"(ag[4]), "v"(ag[5]), "v"(ag[6]), "v"(ag[7]), "v"(pr_[0]), "v"(k[0]), "v"(pv[0]), "v"(pr_[7]), "v"(k[7]), "v"(pv[7]));
                CS_FETCH(ci + 3 < NCH ? ci + 3 : NCH - 1, dep);
#pragma unroll
                for (int i = 0; i < 8; ++i) cs_st16(LB + CS_VTR + ((ci + 2) % 3) * CS_VTSZ + cs_vt(psc, 8 * cg + i) + 2 * pts, pv[i]);
                if (d == 0) {
                    const f32x4 k0 = *(const LAS f32x4*)(cst), k1 = *(const LAS f32x4*)(cst + 4);
                    float bs = 0.f, bo[8];
#pragma unroll
                    for (int i = 0; i < 8; ++i) bs += pr_[i] * k[i] * (i < 4 ? k0[i & 3] : k1[i & 3]);
                    bs = sum8(bs);
#pragma unroll
                    for (int i = 0; i < 8; ++i) bo[i] = bs * pv[i];
                    st8((bf16_t*)(F.ws + WS_BON) + row * 512 + hc, bo);
                }
                LAS float* ub = (LAS float*)(LB + CS_CONV + (F.wave - 4) * 4224) + (s & 7) * 64 + 8 * cg;
                *(LAS f32x4*)ub = (f32x4){pu[0], pu[1], pu[2], pu[3]}; *(LAS f32x4*)(ub + 4) = (f32x4){pu[4], pu[5], pu[6], pu[7]};
                {
                    float pl[8];
                    const int srcA = ((lane >> 4) - 1) * 16 + 8 + cg, srcB = ((lane >> 4) - 2) * 16 + 8 + cg;
#pragma unroll
                    for (int i = 0; i < 8; ++i) pl[i] = pu[i] + __builtin_bit_cast(float, __builtin_amdgcn_update_dpp(0, __builtin_bit_cast(int, pu[i]), 0x118, 0xF, 0xF, true));
#pragma unroll
                    for (int i = 0; i < 8; ++i) { const float t_ = __builtin_bit_cast(float, __builtin_amdgcn_ds_bpermute(srcA * 4, __builtin_bit_cast(int, pl[i]))); pl[i] += lane >= 16 ? t_ : 0.f; }
#pragma unroll
                    for (int i = 0; i < 8; ++i) { const float t_ = __builtin_bit_cast(float, __builtin_amdgcn_ds_bpermute(srcB * 4, __builtin_bit_cast(int, pl[i]))); pl[i] += lane >= 32 ? t_ : 0.f; }
                    if (lane >= 56) { LAS float* wt = (LAS float*)(LB + CS_WT) + (s >> 3) * 64 + 8 * cg; *(LAS f32x4*)wt = (f32x4){pl[0], pl[1], pl[2], pl[3]}; *(LAS f32x4*)(wt + 4) = (f32x4){pl[4], pl[5], pl[6], pl[7]}; }
                    LAS float* ub2 = ub + 512;
                    *(LAS f32x4*)ub2 = (f32x4){pl[0], pl[1], pl[2], pl[3]}; *(LAS f32x4*)(ub2 + 4) = (f32x4){pl[4], pl[5], pl[6], pl[7]};
                }
                const f32x4 kk0 = *(const LAS f32x4*)(cst + 64 * 4), kk1 = *(const LAS f32x4*)(cst + 64 * 4 + 4), ka0 = *(const LAS f32x4*)(cst + 64 * 5), ka1 = *(const LAS f32x4*)(cst + 64 * 5 + 4);
                float kks[8], n2 = 0.f;
#pragma unroll
                for (int i = 0; i < 8; ++i) { kks[i] = k[i] * (i < 4 ? kk0[i & 3] : kk1[i & 3]); n2 += kks[i] * kks[i]; }
                n2 = sum8(n2);
                const float rn_ = rsq_(n2 + 1e-12f);
#pragma unroll
                for (int i = 0; i < 8; ++i) { pkk[i] = kks[i] * rn_; pb[i] = pkk[i] * ag[i]; pkd[i] = k[i] * (1.0f + (ag[i] - 1.0f) * (i < 4 ? ka0[i & 3] : ka1[i & 3])); }
              }
            }
            CS_BAR();
            if (teamS) {
                if (ci + 1 >= 0 && ci + 1 < NCH && !skipS && !skipS2) {
                    const LAS char* setc = set1;
                    const int sc = wv >> 1, part = wv & 1;
                    const LAS float* rhs = part == 0 ? (const LAS float*)(setc + CS_ATF + cs_atf(sc, lane)) : (const LAS float*)(LB + CS_AVT + (sc * 64 + lane) * 80);
                    const LAS float* nrow = (const LAS float*)(LB + CS_NM + sc * 1280);
                    float xs[16];
#pragma unroll
                    for (int t4 = 0; t4 < 4; ++t4) { const f32x4 v4 = *(const LAS f32x4*)(rhs + 4 * t4); xs[4 * t4] = v4[0]; xs[4 * t4 + 1] = v4[1]; xs[4 * t4 + 2] = v4[2]; xs[4 * t4 + 3] = v4[3]; }
#pragma unroll
                    for (int t = 1; t < 16; ++t) {
                        float a3[3] = {xs[t], 0.f, 0.f};
#pragma unroll
                        for (int i4 = 0; i4 < (t + 3) / 4; ++i4) {
                            const f32x4 n4 = *(const LAS f32x4*)(nrow + t * 20 + 4 * i4);
#pragma unroll
                            for (int j = 0; j < 4; ++j) if (4 * i4 + j < t) a3[(4 * i4 + j) % 3] += n4[j] * xs[4 * i4 + j];
                        }
                        xs[t] = (a3[0] + a3[1]) + a3[2];
                    }
                    if (part == 0) {
#pragma unroll
                        for (int t = 0; t < 16; ++t) cs_st16(LB + CS_AH + (sc * 16 + t) * 144 + 2 * lane, xs[t]);
                    } else {
#pragma unroll
                        for (int t4 = 0; t4 < 4; ++t4) *(LAS f32x4*)(LB + CS_UBT + (sc * 64 + lane) * 80 + 16 * t4) = (f32x4){xs[4 * t4], xs[4 * t4 + 1], xs[4 * t4 + 2], xs[4 * t4 + 3]};
                    }
                }
                CS_UNDEF_ALL();
            } else {
              {
                  const int pw = F.vcu * 4 + (F.wave - 4), npw = F.G * 4;
                  const int it = ((ci / 3) * 2 + (ci % 3)) * npw + pw;
                  const bool valid = ci >= 0 && ci % 3 != 2 && chain < F.G && !noconv && it < 3 * NEXP * 1024;
                  cv_it = valid ? it : -1;
                  convert_expert_issue32(l, valid ? it : pw, exp_gate, exp_up, exp_down, cv, lane);
              }
              if (ci + 2 < NCH && !skipP && !skipP2) {
                LAS char* setn = LB + (ci & 1) * CS_SET;
                float li[8], lt[8];
                const LAS float* ub = (const LAS float*)(LB + CS_CONV + (F.wave - 4) * 4224) + (s & 7) * 64 + 8 * cg;
                {
                    const int wq = s >> 3;
                    const LAS float* w0 = (const LAS float*)(LB + CS_WT) + wq * 64 + 8 * cg; const LAS float* w1 = (const LAS float*)(LB + CS_WT) + (wq ^ 1) * 64 + 8 * cg;
                    const f32x4 a0 = *(const LAS f32x4*)w0, a1 = *(const LAS f32x4*)(w0 + 4), b0 = *(const LAS f32x4*)w1, b1 = *(const LAS f32x4*)(w1 + 4);
                    const float m = (wq & 1) ? 1.0f : 0.0f;
                    const LAS float* ub2 = ub + 512;
                    const f32x4 p0 = *(const LAS f32x4*)ub2, p1 = *(const LAS f32x4*)(ub2 + 4);
#pragma unroll
                    for (int i = 0; i < 4; ++i) { lt[i] = a0[i] + b0[i]; lt[4 + i] = a1[i] + b1[i]; li[i] = p0[i] + m * b0[i]; li[4 + i] = p1[i] + m * b1[i]; }
                }
                float at[8], bt[8], kt[8], rt[8], bh[8], kh[8], pu[8];
                { const f32x4 u0 = *(const LAS f32x4*)(ub), u1 = *(const LAS f32x4*)(ub + 4); pu[0] = u0[0]; pu[1] = u0[1]; pu[2] = u0[2]; pu[3] = u0[3]; pu[4] = u1[0]; pu[5] = u1[1]; pu[6] = u1[2]; pu[7] = u1[3]; }
#pragma unroll
                for (int i = 0; i < 8; ++i) {
                    const float wt = __builtin_amdgcn_exp2f(-li[i]), wprev = __builtin_amdgcn_exp2f(pu[i] - li[i]), iw = __builtin_amdgcn_exp2f(li[i]), wrest = __builtin_amdgcn_exp2f(li[i] - lt[i]);
                    at[i] = -pkk[i] * wprev; bt[i] = pb[i] * iw; kt[i] = pkd[i] * iw; rt[i] = pr_[i] * wt; bh[i] = pb[i] * wrest; kh[i] = pkd[i] * wrest;
                }
                *(LAS u32x4*)(setn + CS_AT + s * 144 + 16 * cg) = pack8(at);
                *(LAS u32x4*)(setn + CS_BT + s * 144 + 16 * cg) = pack8(bt);
                *(LAS u32x4*)(setn + CS_KT + s * 144 + 16 * cg) = pack8(kt);
                *(LAS u32x4*)(setn + CS_RT + s * 144 + 16 * cg) = pack8(rt);
#pragma unroll
                for (int i = 0; i < 8; ++i) {
                    const int c = 8 * cg + i;
                    *(LAS float*)(setn + CS_ATF + cs_atf(psc, c) + 4 * pts) = at[i];
                    LAS char* bk = setn + CS_BKT + cs_bkt(psc, c) + 16 * (pts >> 2) + 2 * (pts & 3);
                    cs_st16(bk, bh[i]); cs_st16(bk + 8, kh[i]);
                }
                if (pts == 15) {
                    LAS float* wc = (LAS float*)(setn + CS_WC) + psc * 64 + 8 * cg;
                    *(LAS f32x4*)wc = (f32x4){__builtin_amdgcn_exp2f(-lt[0]), __builtin_amdgcn_exp2f(-lt[1]), __builtin_amdgcn_exp2f(-lt[2]), __builtin_amdgcn_exp2f(-lt[3])}; *(LAS f32x4*)(wc + 4) = (f32x4){__builtin_amdgcn_exp2f(-lt[4]), __builtin_amdgcn_exp2f(-lt[5]), __builtin_amdgcn_exp2f(-lt[6]), __builtin_amdgcn_exp2f(-lt[7])};
                }
            }
              if (ci >= 0 && !(skipS || skipS3 || skipY)) {
                  int slen, t; size_t row;
                  scan_chunk_geom(ci, b, d, s, slen, t, row);
                  *(u32x4*)(Y + row * 512 + hc) = *(const LAS u32x4*)(LB + CS_YO + s * 144 + 16 * cg);
              }
            }
            CS_BAR();
        }
        if (!teamS) { LAS float* scr = (LAS float*)(LB + CS_CONV) + (F.wave - 4) * (32 * 33); convert_expert_finish32(F.ws, cv_it, cv, scr, F.lane); }
        __syncthreads();
#undef CS_FETCH
    }
}
#undef CS_MMA

struct RoRow { u32x4 yf, yb, bo, g; };
__device__ __forceinline__ void ro_load(Frame& F, RoRow& R, int row) {
    const int lane = F.lane;
    R.yf = *(const u32x4*)((const bf16_t*)(F.ws + WS_YF) + (size_t)row * 512 + 8 * lane); R.yb = *(const u32x4*)((const bf16_t*)(F.ws + WS_YB) + (size_t)row * 512 + 8 * lane);
    R.bo = *(const u32x4*)((const bf16_t*)(F.ws + WS_BON) + (size_t)row * 512 + 8 * lane);
    R.g = *(const u32x4*)((const bf16_t*)(F.ws + WS_WAG) + (size_t)row * WAGW + 2048 + 8 * lane);
}
__device__ __forceinline__ void phase_readout(Frame& F, int l, int nrows, const float* gn_w, const float* gn_b) {
    bf16_t* P = (bf16_t*)(F.ws + WS_PROJ);
    const int lane = F.lane;
    float gw[8], gb[8];
#pragma unroll
    for (int i = 0; i < 8; ++i) { gw[i] = gn_w[(size_t)l * 512 + 8 * lane + i]; gb[i] = gn_b[(size_t)l * 512 + 8 * lane + i]; }
    for (int row0 = F.gw; row0 < nrows; row0 += 4 * F.NGW) {
        RoRow RR[4]; int rows[4]; bool ok[4];
#pragma unroll
        for (int z = 0; z < 4; ++z) { rows[z] = row0 + z * F.NGW; ok[z] = rows[z] < nrows; ro_load(F, RR[z], ok[z] ? rows[z] : row0); }
#pragma unroll
        for (int z = 0; z < 4; ++z) {
            if (!ok[z]) continue;
            const RoRow& R = RR[z];
            float yf[8], yb[8], y[8];
            unpack8(R.yf, yf); unpack8(R.yb, yb);
            float sm = 0.f;
#pragma unroll
            for (int i = 0; i < 8; ++i) { y[i] = yf[i] + yb[i]; sm += y[i]; }
            const float mean = sum8(sm) * (1.0f / 64.0f);
            float sq = 0.f;
#pragma unroll
            for (int i = 0; i < 8; ++i) { y[i] -= mean; sq += y[i] * y[i]; }
            const float rstd = rsq_(sum8(sq) * (1.0f / 64.0f) + GN_EPS);
            float bo[8], g[8], o[8];
            unpack8(R.bo, bo); unpack8(R.g, g);
#pragma unroll
            for (int i = 0; i < 8; ++i) o[i] = (y[i] * rstd * gw[i] + gb[i] + bo[i]) * g[i];
            st8(P + (size_t)rows[z] * PW + C_ORWKV + 8 * lane, o);
        }
    }
}
__device__ __forceinline__ void phase_attention(Frame& F, bool need_ctx, char* lds_generic) {
    typedef attn_body::bf16 abf;
    abf* P = (abf*)(F.ws + WS_PROJ);
    const int nu = (need_ctx && F.vcu < NB * 8) ? 5 : 4;
    for (int i = 0; i < nu; ++i) {
        int b, h, qrow, NT;
        if (i < 4) { const int u = F.vcu * 4 + i; b = u >> 6; h = (u >> 3) & 7; qrow = b * SEQ + (u & 7) * 256; NT = (CTXL + SEQ) / 64; }
        else { b = F.vcu >> 3; h = F.vcu & 7; qrow = NLAT + b * CTXL; NT = CTXL / 64; }
        abf* Qu = P + (size_t)qrow * PW + C_Q + h * 64;
        attn_body::attn_unit<8>(Qu, Qu + (C_OATT - C_Q), P + C_K + (h >> 2) * 64, NLAT + b * CTXL, b * SEQ, NT, CTXL / 64, lds_generic);
    }
}

struct Args { const float* in[32]; float* out; unsigned char* ws; int ph_lo, ph_hi; };
constexpr int PH_PER_LAYER = 12, PH_FINAL = 1 + NL * PH_PER_LAYER, PH_END = PH_FINAL + 1;

__global__ void __launch_bounds__(NTHR, 2) mega_fwd(Args args) {
    extern __shared__ __attribute__((aligned(16))) unsigned char lds[];
    Frame F;
    F.lds = (LAS unsigned char*)lds;
    F.tid = threadIdx.x; F.lane = F.tid & 63; F.wave = __builtin_amdgcn_readfirstlane(F.tid >> 6);
    F.G = gridDim.x; { const int bx = blockIdx.x; F.vcu = (F.G % 8 == 0) ? (bx % 8) * (F.G / 8) + bx / 8 : bx; }
    F.gw = F.vcu * NWAVES + F.wave; F.NGW = F.G * NWAVES; F.bid = blockIdx.x;
    F.out = args.out; F.ws = args.ws;
    volatile LAS unsigned* MISC = (volatile LAS unsigned*)(F.lds + MISC_OFF);
    for (int u = F.tid; u < (LDS_BYTES - MISC_OFF) / 4; u += NTHR) MISC[u] = 0u;
    __syncthreads();
    unsigned* ctl = (unsigned*)(F.ws + WS_CTL);
    XcdBarrier bar = xcd_barrier_post(ctl + CW_BAR, MISC + 8);
    const int lo = args.ph_lo, hi = args.ph_hi;
    typedef const __attribute__((address_space(1))) float* cfp_t;
#define KP(k) ((const float*)KIN[k])
#define KIN_DECL const __attribute__((address_space(4))) cfp_t* KIN = (const __attribute__((address_space(4))) cfp_t*)__builtin_amdgcn_kernarg_segment_ptr(); asm volatile("" : "+s"(KIN))
#ifndef PHMASK
#define PHMASK 0xFFFFFFFFu
#endif
#define IN(k) (lo <= (k) && (k) < hi)
#define EN(j) ((PHMASK >> (j)) & 1u)
#define SEAM(k) do { if ((k) + 1 < hi) xcd_barrier(bar); } while (0)
#ifndef DUPMASK
#define DUPMASK 0u
#endif
#define REP(j) for (int rep_ = 0; rep_ < 1 + (int)((DUPMASK >> (j)) & 1u); ++rep_)
#ifdef PROBE_T1
    unsigned long long pt0 = 0; int l_ = 0; volatile LAS unsigned* PTS = MISC + 64;
#define PB() do { pt0 = __builtin_amdgcn_s_memrealtime(); } while (0)
#define PE(j) do { PTS[(j) * 4 + (l_ & 3)] = (unsigned)(__builtin_amdgcn_s_memrealtime() - pt0); } while (0)
#else
#define PB() do {} while (0)
#define PE(j) do {} while (0)
#endif

    if (EN(0) && IN(0)) { relaunder(F); PB(); KIN_DECL; REP(0) phase_prologue(F, KP(1), KP(3), KP(4), KP(5), KP(7), KP(12), KP(14), KP(15), KP(22), KP(23), KP(24), KP(25), KP(27)); SEAM(0); PE(0); }

    for (int l = 0; l < NL; ++l) {
#ifdef PROBE_T1
        l_ = l;
#endif
        const int pb = 1 + l * PH_PER_LAYER;
        const bool need_ctx = l < NL - 1;
        const int nrows = need_ctx ? NTOK : NLAT;
        if (EN(1) && IN(pb + 0)) { relaunder(F); PB(); KIN_DECL; REP(1) phase_norm1(F, l, KP(0), KP(2), KP(6), KP(31), rep_ > 0); SEAM(pb + 0); PE(1); }
        if (EN(2) && IN(pb + 1)) { relaunder(F); PB();
            pg8::EpiProj E{(bf16_t*)(F.ws + WS_PROJ), F.ws + WS_GATES};
            if (need_ctx) { pg8::PlainOrder S; S.init(F.ws + WS_H, F.ws + WS_WIN + (size_t)l * PWP * DM * 2, NTOK, PWP, DM, DM, F.G, F.bid);
                REP(2) pg8::gemm_phase<pg8::EpiProj, pg8::PlainOrder, false>(F.lds, DM, DM, DM, S, E); }
            else { pg8::LastProjOrder S; S.init(F.ws + WS_H, F.ws + WS_WIN + (size_t)l * PWP * DM * 2, DM, DM, F.G, F.bid);
                pg8::gemm_phase<pg8::EpiProj, pg8::LastProjOrder, false>(F.lds, DM, DM, DM, S, E); }
            SEAM(pb + 1); PE(2);
        }
        if (EN(3) && IN(pb + 2)) { relaunder(F); PB(); KIN_DECL; REP(3) phase_prep(F, l, KP(8), KP(9), KP(21), KP(10), rep_ > 0); SEAM(pb + 2); PE(3); }
        if (EN(4) && IN(pb + 3)) { relaunder(F); PB();
            pg8::LowRankOrder S{(const char*)(F.ws + WS_LRA), (const char*)(F.ws + WS_WLR + (size_t)l * WAGW * 128 * 2), NTOK / 256, F.G, F.bid};
            KIN_DECL; pg8::EpiLowRank E{(bf16_t*)(F.ws + WS_WAG), KP(11) + (size_t)l * 1024, KP(13) + (size_t)l * 1024};
            int klr = 128; asm volatile("" : "+s"(klr));
            REP(4) pg8::gemm_phase<pg8::EpiLowRank, pg8::LowRankOrder, false>(F.lds, klr, LRAW, 128, S, E);
            REP(14) phase_attention(F, need_ctx, (char*)lds);
            SEAM(pb + 3); PE(4);
        }
        if (EN(5) && IN(pb + 4)) { relaunder(F); PB(); KIN_DECL; REP(5) phase_scan<0>(F, l, KP(10), KP(16), KP(17), KP(28), KP(29), KP(30), KP(18), rep_ > 0);
#ifdef SCAN_PROBE
            phase_scan<SCAN_PROBE>(F, l, KP(10), KP(16), KP(17), KP(28), KP(29), KP(30), KP(18), true);
#endif
 SEAM(pb + 4); PE(5); }
        if (EN(6) && IN(pb + 5)) { relaunder(F); PB(); KIN_DECL; REP(6) phase_readout(F, l, nrows, KP(19), KP(20)); SEAM(pb + 5); PE(6); }
        if (EN(7) && IN(pb + 6)) { relaunder(F); PB();
            pg8::MergeOrder S{(const char*)(F.ws + WS_PROJ), (const char*)(F.ws + WS_WBR + (size_t)l * 3 * 1024 * 512 * 2), nrows / 256, F.G, F.bid};
            pg8::EpiMerge E{(const unsigned char*)(F.ws + WS_GATES), (bf16_t*)(F.ws + WS_H)};
            REP(7) pg8::gemm_phase<pg8::EpiMerge, pg8::MergeOrder, false>(F.lds, 512, PW, 512, S, E);
            SEAM(pb + 6); PE(7);
        }
        if (EN(8) && IN(pb + 7)) { relaunder(F); PB();
            pg8::PlainOrder S; S.init(F.ws + WS_H, F.ws + WS_WOUT + (size_t)l * DM * DM * 2, nrows, DM, DM, DM, F.G, F.bid);
            pg8::EpiOut E{(bf16_t*)(F.ws + WS_XB), (const float*)(F.ws + WS_MOD) + (size_t)l * 17 * 6144};
            pg8::gemm_phase<pg8::EpiOut, pg8::PlainOrder, false>(F.lds, DM, DM, DM, S, E);
            SEAM(pb + 7); PE(8);
        }
        if (EN(9) && IN(pb + 8)) { relaunder(F); PB(); KIN_DECL; REP(9) phase_norm2_router_mfma(F, l, nrows, KP(26)); SEAM(pb + 8); PE(9); }
        if (EN(10) && IN(pb + 9)) { relaunder(F); PB(); REP(10) phase_topk(F, need_ctx); SEAM(pb + 9); PE(10); }
        if (EN(11) && IN(pb + 10)) { relaunder(F); PB();
            const int mt_per = need_ctx ? 18 : 16;
            LAS int* rows = (LAS int*)(F.lds + XTRA_OFF);
            pg8::MoeOrder S{(const char*)(F.ws + WS_H), (const char*)(F.ws + WS_WUP), rows, mt_per, 8, F.G, F.bid, (size_t)2048 * 1024 * 2};
            const int* LIST = (const int*)(F.ws + WS_LIST);
            for (int i = 0; i < XTRA_BYTES / 1024; ++i) { int e, mt, pn; if (!S.decode((long)i * F.G + F.bid, e, mt, pn)) break;
                if (F.tid < 256) rows[i * 256 + F.tid] = LIST[e * PAIRS_E + mt * 256 + F.tid]; }
            __syncthreads();
            pg8::EpiUp E{(bf16_t*)(F.ws + WS_HID)};
            REP(11) pg8::gemm_phase<pg8::EpiUp, pg8::MoeOrder, true>(F.lds, DM, DM, DM, S, E);
            SEAM(pb + 10); PE(11);
        }
        if (EN(12) && IN(pb + 11)) { relaunder(F); PB();
            const int mt_per = need_ctx ? 18 : 16;
            pg8::MoeDownOrder S{(const char*)(F.ws + WS_HID), (const char*)(F.ws + WS_WDN), mt_per, F.G, F.bid};
            pg8::EpiDown E{(bf16_t*)(F.ws + WS_YE)};
            REP(12) pg8::gemm_phase<pg8::EpiDown, pg8::MoeDownOrder, false>(F.lds, EFF, EFF, EFF, S, E);
            SEAM(pb + 11); PE(12);
        }
    }
    if (EN(13) && IN(PH_FINAL)) { relaunder(F); PB(); KIN_DECL; phase_norm1(F, NL, KP(0), KP(2), KP(6), KP(31)); PE(13); }
#ifdef PROBE_T1
    {
        __syncthreads();
        if (blockIdx.x == 0 && threadIdx.x == 0) { unsigned s1 = 0, s2 = 0; for (int q = 0; q < 4; ++q) { s1 += PTS[PROBE_T1 * 4 + q]; s2 += PTS[PROBE_T2 * 4 + q]; } ctl[CW_DBG] = s1; ctl[CW_DBG + 1] = s2; }
        xcd_barrier(bar);
        const float t1 = (float)__hip_atomic_load(ctl + CW_DBG, __ATOMIC_RELAXED, __HIP_MEMORY_SCOPE_AGENT), t2 = (float)__hip_atomic_load(ctl + CW_DBG + 1, __ATOMIC_RELAXED, __HIP_MEMORY_SCOPE_AGENT);
        const float cval = 10.0f * sqrtf(t1 * 0.01f);
        for (size_t i = (size_t)F.bid * NTHR + F.tid; i < (size_t)NLAT * DM; i += (size_t)F.G * NTHR) F.out[i] = (i == 0) ? t2 : cval;
    }
#endif
#undef IN
#undef SEAM
}

extern "C" void kernel_launch(void* const* d_in, const int* in_sizes, int n_in, void* d_out, int out_size, void* d_ws, size_t ws_size, hipStream_t stream) {
    static int grid = 0;
    if (grid == 0) {
        if (n_in != 32 || in_sizes[0] != NLAT * DM || out_size != NLAT * DM || ws_size < WS_END) { fprintf(stderr, "kernel_launch: unexpected shapes / workspace (n_in %d, ws %zu)\n", n_in, ws_size); grid = -1; return; }
        int dev = 0, cus = 0, per_cu = 0;
        if (hipGetDevice(&dev) != hipSuccess || hipDeviceGetAttribute(&cus, hipDeviceAttributeMultiprocessorCount, dev) != hipSuccess) { grid = -1; return; }
        if (hipFuncSetAttribute((const void*)mega_fwd, hipFuncAttributeMaxDynamicSharedMemorySize, LDS_BYTES) != hipSuccess) { grid = -1; return; }
        if (hipOccupancyMaxActiveBlocksPerMultiprocessor(&per_cu, (const void*)mega_fwd, NTHR, LDS_BYTES) != hipSuccess || per_cu < 1) { fprintf(stderr, "kernel_launch: occupancy query says %d\n", per_cu); }
        (void)hipGetLastError();
        grid = cus;
        if (grid != 256) { fprintf(stderr, "kernel_launch: built for 256 CUs, got %d\n", grid); grid = -1; return; }
    }
    if (grid < 0) return;
    if (hipMemsetAsync((char*)d_ws + WS_CTL, 0, CTL_ZERO_BYTES, stream) != hipSuccess) return;
    Args a{};
    for (int i = 0; i < 32; ++i) a.in[i] = (const float*)d_in[i];
    a.out = (float*)d_out; a.ws = (unsigned char*)d_ws;
#ifndef MK_PER_PHASE
    a.ph_lo = 0; a.ph_hi = PH_END;
    hipLaunchKernelGGL(mega_fwd, dim3(grid), dim3(NTHR), LDS_BYTES, stream, a);
#else
    for (int p = 0; p < PH_END; ++p) { a.ph_lo = p; a.ph_hi = p + 1; hipLaunchKernelGGL(mega_fwd, dim3(grid), dim3(NTHR), LDS_BYTES, stream, a); }
#endif
}
```

```cpp
#include <hip/hip_runtime.h>
#include <hip/hip_bf16.h>
#include <cstdio>
#include <cstdint>
#include <cmath>

#define LAS __attribute__((address_space(3)))
typedef unsigned short bf16_t;
typedef short bf16x8 __attribute__((ext_vector_type(8)));
typedef float f32x4 __attribute__((ext_vector_type(4)));
typedef float f32x2 __attribute__((ext_vector_type(2)));
typedef unsigned u32x4 __attribute__((ext_vector_type(4)));
typedef unsigned u32x2 __attribute__((ext_vector_type(2)));

constexpr int DM = 1024, NB = 16, SEQ = 2048, NL = 4, CTXL = 256;
constexpr int NLAT = NB * SEQ;
constexpr int NCTX = NB * CTXL;
constexpr int NTOK = NLAT + NCTX;
constexpr int PW = 4224;
constexpr int NCOLS_IN = 7296;
constexpr int PWP = 7424;
constexpr int C_Q = 0, C_K = 512, C_V = 640, C_RW = 768, C_R = 768, C_RK = 1280, C_RV = 1792, C_WLO = 2304, C_ALO = 2432, C_GLO = 2560;
constexpr int C_BG = 2688, C_CG = 3200, C_U = 3712, C_GT = 4224;
constexpr int C_OATT = 3712, C_OCONV = 2688, C_ORWKV = 3200;
constexpr int WAGW = 2560;
constexpr int LRAW = 384;
constexpr int NEXP = 16, EFF = 1024, CAPL = 256, CAPC = 32, PAIRS_E = 4608;
constexpr float NORM_EPS = 1e-6f, GN_EPS = 64e-5f;
constexpr float QSCALE = 0.125f * 1.4426950408889634f;

constexpr size_t MiB = 1u << 20;
constexpr size_t WS_CTL = 0, CTL_ZERO_BYTES = 1 * MiB;
constexpr size_t WS_MOD = 1 * MiB;
constexpr size_t WS_ROPE = 3 * MiB;
constexpr size_t WS_WRT = 3 * MiB + 65536;
constexpr size_t WS_LIST = 4 * MiB;
constexpr size_t WS_SLOT = 5 * MiB;
constexpr size_t WS_AFF = 8 * MiB;
constexpr size_t WS_XC = 11 * MiB;
constexpr size_t WS_WIN = 27 * MiB;
constexpr size_t WS_WBR = 85 * MiB;
constexpr size_t WS_WOUT = 97 * MiB;
constexpr size_t WS_WLR = 105 * MiB;
constexpr size_t WS_WUP = 113 * MiB;
constexpr size_t WS_WDN = 177 * MiB;
constexpr size_t WS_H = 209 * MiB;
constexpr size_t WS_PROJ = 281 * MiB;
constexpr size_t WS_GATES = 578 * MiB;
constexpr size_t WS_HID = WS_PROJ;
constexpr size_t WS_YE = WS_PROJ + 144 * MiB;
constexpr size_t WS_XB = 686 * MiB;
constexpr size_t WS_WAG = 794 * MiB;
constexpr size_t WS_LRA = 974 * MiB;
constexpr size_t WS_YF = 1001 * MiB;
constexpr size_t WS_YB = 1037 * MiB;
constexpr size_t WS_BON = 1073 * MiB;
constexpr size_t WS_END = 1109 * MiB;
static_assert(WS_WIN + (size_t)NL * PWP * DM * 2 <= WS_WBR && WS_PROJ + (size_t)NTOK * PW * 2 <= WS_GATES && WS_GATES + (size_t)NTOK * 3072 <= WS_XB && WS_XB + (size_t)NTOK * DM * 2 <= WS_WAG && WS_WAG + (size_t)NTOK * WAGW * 2 <= WS_LRA && WS_LRA + (size_t)NTOK * LRAW * 2 <= WS_YF, "ws map");
static_assert(WS_YE + (size_t)NEXP * PAIRS_E * DM * 2 <= WS_GATES && WS_H + (size_t)NTOK * DM * 2 <= WS_PROJ, "ws map 2");
constexpr int CW_BAR = 4096;
constexpr int CW_DBG = 32768;

constexpr int RING_BYTES = 131072;
constexpr int XTRA_OFF = RING_BYTES;
constexpr int XTRA_BYTES = 12288;
constexpr int MISC_OFF = XTRA_OFF + XTRA_BYTES;
constexpr int LDS_BYTES = 147456;
static_assert(MISC_OFF + 256 <= LDS_BYTES, "lds map");
constexpr int NWAVES = 8, NTHR = 512;

__device__ __forceinline__ unsigned f2bf(float f) { unsigned u = __builtin_bit_cast(unsigned, f); return (u + 0x7fffu + ((u >> 16) & 1u)) >> 16; }
typedef __bf16 bf16v2 __attribute__((ext_vector_type(2)));
__device__ __forceinline__ unsigned pk2(float lo, float hi) { const f32x2 v = {lo, hi}; return __builtin_bit_cast(unsigned, __builtin_convertvector(v, bf16v2)); }
__device__ __forceinline__ float bflo(unsigned w) { return __builtin_bit_cast(float, w << 16); }
__device__ __forceinline__ float bfhi(unsigned w) { return __builtin_bit_cast(float, w & 0xffff0000u); }
__device__ __forceinline__ void unpack8(const u32x4 w, float (&f)[8]) { f[0] = bflo(w.x); f[1] = bfhi(w.x); f[2] = bflo(w.y); f[3] = bfhi(w.y); f[4] = bflo(w.z); f[5] = bfhi(w.z); f[6] = bflo(w.w); f[7] = bfhi(w.w); }
__device__ __forceinline__ u32x4 pack8(const float (&f)[8]) { u32x4 w; w.x = pk2(f[0], f[1]); w.y = pk2(f[2], f[3]); w.z = pk2(f[4], f[5]); w.w = pk2(f[6], f[7]); return w; }
__device__ __forceinline__ void ld8(const bf16_t* p, float (&f)[8]) { unpack8(*(const u32x4*)p, f); }
__device__ __forceinline__ void st8(bf16_t* p, const float (&f)[8]) { *(u32x4*)p = pack8(f); }
__device__ __forceinline__ float rcp_(float x) { return __builtin_amdgcn_rcpf(x); }
__device__ __forceinline__ float rsq_(float x) { return __builtin_amdgcn_rsqf(x); }
__device__ __forceinline__ float sigmoidf_(float x) { return rcp_(1.0f + __builtin_amdgcn_exp2f(-1.4426950408889634f * x)); }
__device__ __forceinline__ float tanhf_(float x) { return 2.0f * sigmoidf_(2.0f * x) - 1.0f; }
__device__ __forceinline__ float dpp_f(float x, const int ctrl_sel) {
    const int xi = __builtin_bit_cast(int, x); int r;
    if (ctrl_sel == 0) r = __builtin_amdgcn_update_dpp(0, xi, 0xB1, 0xF, 0xF, true);
    else if (ctrl_sel == 1) r = __builtin_amdgcn_update_dpp(0, xi, 0x4E, 0xF, 0xF, true);
    else if (ctrl_sel == 2) r = __builtin_amdgcn_update_dpp(0, xi, 0x141, 0xF, 0xF, true);
    else r = __builtin_amdgcn_update_dpp(0, xi, 0x140, 0xF, 0xF, true);
    return __builtin_bit_cast(float, r);
}
__device__ __forceinline__ float sum8(float x) { x += dpp_f(x, 0); x += dpp_f(x, 1); x += dpp_f(x, 2); return x; }
__device__ __forceinline__ float wave_sum(float x) {
    x += dpp_f(x, 0); x += dpp_f(x, 1); x += dpp_f(x, 2); x += dpp_f(x, 3);
    const int xi = __builtin_bit_cast(int, x);
    const float r0 = __builtin_bit_cast(float, __builtin_amdgcn_readlane(xi, 0)), r1 = __builtin_bit_cast(float, __builtin_amdgcn_readlane(xi, 16)),
                r2 = __builtin_bit_cast(float, __builtin_amdgcn_readlane(xi, 32)), r3 = __builtin_bit_cast(float, __builtin_amdgcn_readlane(xi, 48));
    return (r0 + r1) + (r2 + r3);
}
namespace pg8 {
constexpr int BM = 256, BK = 64, HALF = 128, HTB = HALF * BK * 2, STAGE_BYTES = 8 * HTB;
__host__ __device__ __forceinline__ int lds_byte(int r, int c) { const int st = (r >> 4) * 2 + (c >> 5), rr = r & 15, cc = c & 31, ob = rr * 64 + cc * 2; return st * 1024 + (ob ^ (((ob >> 9) & 1) << 5)); }
__host__ __device__ __forceinline__ void stage_rc(int b, int& R, int& C) { const int st = b / 1024, sb = b % 1024, swz = sb ^ (((sb >> 9) & 1) << 5); R = (st >> 1) * 16 + swz / 64; C = (st & 1) * 32 + (swz % 64) / 2; }
__host__ __device__ __forceinline__ int perm32(int rho) { const int n = rho >> 4, i = rho & 15; return 8 * (i >> 2) + 4 * n + (i & 3); }
__device__ __forceinline__ unsigned cvt_pk_bf16(float lo, float hi) { unsigned r; asm volatile("v_cvt_pk_bf16_f32 %0, %1, %2" : "=v"(r) : "v"(lo), "v"(hi)); return r; }

struct GUnit { const char* A; const char* B; int pm, pn, x0, x1; };

template <class Epi, class Sched, bool GATHER>
__device__ __forceinline__ void gemm_phase(LAS unsigned char* lds, const int K, const int lda, const int ldb, const Sched& S, const Epi& E) {
    int tid_ = threadIdx.x; asm volatile("" : "+v"(tid_));
    const int tid = tid_, wid = __builtin_amdgcn_readfirstlane(tid >> 6), lane = tid & 63, wr = wid >> 2, wc = wid & 3, fr = lane & 15, fq = lane >> 4;
    const int nt = K / BK;
    int sR[2], sC[2];
    unsigned voffA[2][2], voffB[2], voffAn[2][2];
#pragma unroll
    for (int i = 0; i < 2; ++i) { int R, C; stage_rc(tid * 16 + i * 8192, R, C); sR[i] = R; sC[i] = C; const int Rb = Epi::PERM ? ((R & ~31) + perm32(R & 31)) : R;
        voffB[i] = (unsigned)(Rb * ldb + C) * 2u;
#pragma unroll
        for (int h = 0; h < 2; ++h) { voffA[h][i] = (unsigned)((h * HALF + R) * lda + C) * 2u; voffAn[h][i] = voffA[h][i]; } }
    const size_t kstep = (size_t)(BK * 2);
    const size_t hstepB = (size_t)HALF * ldb * 2;
    const unsigned ldsw = (unsigned)wid * 1024u;
    const int aoff = lds_byte(wr * 64 + fr, fq * 8), boff = lds_byte(wc * 32 + fr, fq * 8);
#define PG8_SA(b, h) (((b) * 2 + (h)) * HTB)
#define PG8_SB(b, h) ((4 + (b) * 2 + (h)) * HTB)
#define PG8_STAGE(bufoff, gbase, voff) do { _Pragma("unroll") for (int _i = 0; _i < 2; ++_i) \
        __builtin_amdgcn_global_load_lds((const unsigned*)((const char*)(gbase) + (voff)[_i]), (LAS unsigned*)(lds + (bufoff) + ldsw + _i * 8192), 16, 0, 0); } while (0)
#define PG8_LDA(dst, b, h) do { _Pragma("unroll") for (int m = 0; m < 4; ++m) _Pragma("unroll") for (int k = 0; k < 2; ++k) dst[m][k] = *(const LAS bf16x8*)(lds + PG8_SA(b, h) + aoff + m * 2048 + k * 1024); } while (0)
#define PG8_LDB(dst, b, h) do { _Pragma("unroll") for (int n = 0; n < 2; ++n) _Pragma("unroll") for (int k = 0; k < 2; ++k) dst[n][k] = *(const LAS bf16x8*)(lds + PG8_SB(b, h) + boff + n * 2048 + k * 1024); } while (0)
#define PG8_MMA(ai, bj, At, Bt) do { __builtin_amdgcn_s_setprio(1); _Pragma("unroll") for (int m = 0; m < 4; ++m) _Pragma("unroll") for (int n = 0; n < 2; ++n) _Pragma("unroll") for (int k = 0; k < 2; ++k) \
        acc[ai][bj][m][n] = __builtin_amdgcn_mfma_f32_16x16x32_bf16(Bt[n][k], At[m][k], acc[ai][bj][m][n], 0, 0, 0); __builtin_amdgcn_s_setprio(0); } while (0)
#define PG8_WAIT_V(n) asm volatile("s_waitcnt vmcnt(" #n ")" ::: "memory")
#define PG8_WAIT_L(n) asm volatile("s_waitcnt lgkmcnt(" #n ")" ::: "memory")
#define PG8_BAR __builtin_amdgcn_s_barrier()
#define PG8_SCHED __builtin_amdgcn_sched_barrier(0)
    GUnit cur, nxt; int ui = 0;
    if (!S.next(0, cur)) return;
    if constexpr (GATHER) {
#pragma unroll
        for (int i = 0; i < 2; ++i)
#pragma unroll
            for (int h = 0; h < 2; ++h) voffA[h][i] = (S.arow(0, h * HALF + sR[i]) * (unsigned)lda + (unsigned)sC[i]) * 2u;
    }
    f32x4 acc[2][2][4][2];
#pragma unroll
    for (int a = 0; a < 2; ++a)
#pragma unroll
        for (int b = 0; b < 2; ++b)
#pragma unroll
            for (int m = 0; m < 4; ++m)
#pragma unroll
                for (int n = 0; n < 2; ++n) acc[a][b][m][n] = (f32x4){0.f, 0.f, 0.f, 0.f};
    bf16x8 At[4][2], B0[2][2], B1[2][2];
    const char* cA = cur.A; const char* cB = cur.B;
    PG8_STAGE(PG8_SB(0, 0), cB, voffB); PG8_STAGE(PG8_SB(0, 1), cB + hstepB, voffB); PG8_STAGE(PG8_SA(0, 0), cA, voffA[0]); PG8_STAGE(PG8_SA(0, 1), cA, voffA[1]);
    if (wr == 1) PG8_BAR;
    PG8_WAIT_V(2); PG8_BAR;
    PG8_STAGE(PG8_SB(1, 0), cB + kstep, voffB); PG8_STAGE(PG8_SA(1, 0), cA + kstep, voffA[0]); PG8_STAGE(PG8_SB(1, 1), cB + hstepB + kstep, voffB);
    PG8_WAIT_V(6); PG8_BAR;
    for (;;) {
        const bool has_next = S.next(ui + 1, nxt);
        const char* nA = has_next ? nxt.A : cA; const char* nB = has_next ? nxt.B : cB;
        if constexpr (GATHER) {
#pragma unroll
            for (int i = 0; i < 2; ++i)
#pragma unroll
                for (int h = 0; h < 2; ++h) voffAn[h][i] = has_next ? (S.arow(ui + 1, h * HALF + sR[i]) * (unsigned)lda + (unsigned)sC[i]) * 2u : voffA[h][i];
        }
#pragma unroll 1
        for (int t = 0; t < nt; t += 2) {
            const bool last = (t == nt - 2);
            const char* a1 = cA + (size_t)(t + 1) * kstep;
            const char* a2 = last ? nA : cA + (size_t)(t + 2) * kstep; const char* b2 = last ? nB : cB + (size_t)(t + 2) * kstep;
            const char* a3 = a2 + kstep; const char* b3 = b2 + kstep;
            unsigned v2[2][2];
#pragma unroll
            for (int i = 0; i < 2; ++i)
#pragma unroll
                for (int h = 0; h < 2; ++h) v2[h][i] = GATHER ? (last ? voffAn[h][i] : voffA[h][i]) : voffA[h][i];
            PG8_LDB(B0, 0, 0); PG8_LDB(B1, 0, 1); PG8_SCHED; PG8_LDA(At, 0, 0); PG8_STAGE(PG8_SA(1, 1), a1, voffA[1]);
            PG8_WAIT_V(8); PG8_WAIT_L(0); PG8_BAR; PG8_MMA(0, 0, At, B0); PG8_MMA(0, 1, At, B1); PG8_BAR; PG8_SCHED;
            PG8_LDA(At, 0, 1); PG8_STAGE(PG8_SB(0, 0), b2, voffB); PG8_STAGE(PG8_SB(0, 1), b2 + hstepB, voffB); PG8_STAGE(PG8_SA(0, 0), a2, v2[0]);
            PG8_WAIT_V(8); PG8_WAIT_L(0); PG8_BAR; PG8_MMA(1, 0, At, B0); PG8_MMA(1, 1, At, B1); PG8_BAR; PG8_SCHED;
            PG8_LDB(B0, 1, 0); PG8_LDB(B1, 1, 1); PG8_SCHED; PG8_LDA(At, 1, 0); PG8_STAGE(PG8_SA(0, 1), a2, v2[1]);
            PG8_WAIT_V(8); PG8_WAIT_L(0); PG8_BAR; PG8_MMA(0, 0, At, B0); PG8_MMA(0, 1, At, B1); PG8_BAR; PG8_SCHED;
            PG8_LDA(At, 1, 1); PG8_STAGE(PG8_SB(1, 0), b3, voffB); PG8_STAGE(PG8_SB(1, 1), b3 + hstepB, voffB); PG8_STAGE(PG8_SA(1, 0), a3, v2[0]);
            PG8_WAIT_V(8); PG8_WAIT_L(0); PG8_BAR; PG8_MMA(1, 0, At, B0); PG8_MMA(1, 1, At, B1); PG8_BAR; PG8_SCHED;
        }
        if (wr == 0) PG8_BAR;
        E(acc, cur, wr, wc, fr, fq);
        if (!has_next) break;
        if (!(Epi::CHAIN && cur.x1 != 0)) {
#pragma unroll
        for (int a = 0; a < 2; ++a)
#pragma unroll
            for (int b = 0; b < 2; ++b)
#pragma unroll
                for (int m = 0; m < 4; ++m)
#pragma unroll
                    for (int n = 0; n < 2; ++n) acc[a][b][m][n] = (f32x4){0.f, 0.f, 0.f, 0.f};
        }
        cur = nxt; cA = nA; cB = nB; ++ui;
        if constexpr (GATHER) {
#pragma unroll
            for (int i = 0; i < 2; ++i)
#pragma unroll
                for (int h = 0; h < 2; ++h) voffA[h][i] = voffAn[h][i];
        }
        if (wr == 1) PG8_BAR;
    }
    PG8_WAIT_V(0);
    PG8_BAR;
#undef PG8_SA
#undef PG8_SB
#undef PG8_STAGE
#undef PG8_LDA
#undef PG8_LDB
#undef PG8_MMA
#undef PG8_WAIT_V
#undef PG8_WAIT_L
#undef PG8_BAR
#undef PG8_SCHED
}
}
namespace pg8 {
struct EpiProj {
    static constexpr bool PERM = true, CHAIN = false;
    bf16_t* P; unsigned char* GT;
    __device__ __forceinline__ void operator()(f32x4 (&acc)[2][2][4][2], const GUnit& u, int wr, int wc, int fr, int fq) const {
        const int row0 = u.pm * BM + wr * 64 + fr;
#pragma unroll
        for (int bj = 0; bj < 2; ++bj) {
            const int ct = u.pn * BM + bj * HALF;
            if (ct >= NCOLS_IN) continue;
            const bool sig = ct >= C_GT;
            const int col0 = ct + wc * 32 + 8 * fq;
#pragma unroll
            for (int ai = 0; ai < 2; ++ai)
#pragma unroll
                for (int m = 0; m < 4; ++m) {
                    const f32x4 v0 = acc[ai][bj][m][0], v1 = acc[ai][bj][m][1];
                    const size_t row = (size_t)(row0 + ai * HALF + m * 16);
                    if (sig) {
                        unsigned q[8];
#pragma unroll
                        for (int j = 0; j < 4; ++j) { q[j] = (unsigned)fmaxf(255.0f * sigmoidf_(v0[j]) + 0.5f, 1.0f); q[4 + j] = (unsigned)fmaxf(255.0f * sigmoidf_(v1[j]) + 0.5f, 1.0f); }
                        u32x2 w; w.x = q[0] | (q[1] << 8) | (q[2] << 16) | (q[3] << 24); w.y = q[4] | (q[5] << 8) | (q[6] << 16) | (q[7] << 24);
                        *(u32x2*)(GT + row * 3072 + (col0 - C_GT)) = w;
                    } else {
                        u32x4 w; w.x = cvt_pk_bf16(v0[0], v0[1]); w.y = cvt_pk_bf16(v0[2], v0[3]); w.z = cvt_pk_bf16(v1[0], v1[1]); w.w = cvt_pk_bf16(v1[2], v1[3]);
                        *(u32x4*)(P + row * PW + col0) = w;
                    }
                }
        }
    }
};
struct EpiLowRank {
    static constexpr bool PERM = true, CHAIN = false;
    bf16_t* W; const float* w0; const float* a0;
    __device__ __forceinline__ void operator()(f32x4 (&acc)[2][2][4][2], const GUnit& u, int wr, int wc, int fr, int fq) const {
        const int row0 = u.pm * BM + wr * 64 + fr;
#pragma unroll
        for (int bj = 0; bj < 2; ++bj) {
            const int ct = u.pn * BM + bj * HALF;
            const int col0 = ct + wc * 32 + 8 * fq;
            const int mode = ct < 1024 ? 0 : (ct < 2048 ? 1 : 2);
            float bias[8];
#pragma unroll
            for (int j = 0; j < 8; ++j) bias[j] = mode == 0 ? w0[col0 + j] : (mode == 1 ? a0[col0 - 1024 + j] : 0.f);
#pragma unroll
            for (int ai = 0; ai < 2; ++ai)
#pragma unroll
                for (int m = 0; m < 4; ++m) {
                    float v[8];
#pragma unroll
                    for (int j = 0; j < 4; ++j) { v[j] = acc[ai][bj][m][0][j] + bias[j]; v[4 + j] = acc[ai][bj][m][1][j] + bias[4 + j]; }
                    if (mode == 0) {
#pragma unroll
                        for (int j = 0; j < 8; ++j) v[j] = 0.60653066f * sigmoidf_(v[j]);
                    } else if (mode == 1) {
#pragma unroll
                        for (int j = 0; j < 8; ++j) v[j] = sigmoidf_(v[j]);
                    }
                    u32x4 w; w.x = cvt_pk_bf16(v[0], v[1]); w.y = cvt_pk_bf16(v[2], v[3]); w.z = cvt_pk_bf16(v[4], v[5]); w.w = cvt_pk_bf16(v[6], v[7]);
                    *(u32x4*)(W + (size_t)(row0 + ai * HALF + m * 16) * WAGW + col0) = w;
                    asm volatile("" ::: "memory");
                }
        }
    }
};
__device__ __forceinline__ void ldg8(const unsigned char* p, float (&g)[8]) {
    const u32x2 w = *(const u32x2*)p;
#pragma unroll
    for (int j = 0; j < 4; ++j) { g[j] = (float)((w.x >> (8 * j)) & 255u) * (1.0f / 255.0f); g[4 + j] = (float)((w.y >> (8 * j)) & 255u) * (1.0f / 255.0f); }
}
struct EpiMerge {
    static constexpr bool PERM = true, CHAIN = true;
    const unsigned char* GT; bf16_t* M;
    __device__ __forceinline__ void operator()(f32x4 (&acc)[2][2][4][2], const GUnit& u, int wr, int wc, int fr, int fq) const {
        const int row0 = u.pm * BM + wr * 64 + fr; const int br = u.x0;
#pragma unroll
        for (int bj = 0; bj < 2; ++bj) {
            const int col0 = u.pn * BM + bj * HALF + wc * 32 + 8 * fq;
#pragma unroll
            for (int ai = 0; ai < 2; ++ai)
#pragma unroll
                for (int m = 0; m < 4; ++m) {
                    const size_t row = (size_t)(row0 + ai * HALF + m * 16);
                    float g[8];
                    ldg8(GT + row * 3072 + br * 1024 + col0, g);
                    if (br < 2) {
                        float gn[8];
                        ldg8(GT + row * 3072 + (br + 1) * 1024 + col0, gn);
#pragma unroll
                        for (int j = 0; j < 8; ++j) g[j] = g[j] * rcp_(fmaxf(gn[j], 1.0f / 512.0f));
#pragma unroll
                        for (int j = 0; j < 4; ++j) { acc[ai][bj][m][0][j] *= g[j]; acc[ai][bj][m][1][j] *= g[4 + j]; }
                    } else {
                        float o[8];
#pragma unroll
                        for (int j = 0; j < 4; ++j) { o[j] = g[j] * acc[ai][bj][m][0][j]; o[4 + j] = g[4 + j] * acc[ai][bj][m][1][j]; }
                        st8(M + row * DM + col0, o);
                    }
                }
        }
    }
};
struct EpiOut {
    static constexpr bool PERM = true, CHAIN = false;
    bf16_t* XB; const float* mod;
    __device__ __forceinline__ void operator()(f32x4 (&acc)[2][2][4][2], const GUnit& u, int wr, int wc, int fr, int fq) const {
        const int rt = u.pm * BM; const int modrow = rt < NLAT ? (rt >> 11) : 16;
        const float* g1 = mod + (size_t)modrow * 6144 + 2048;
        const int row0 = rt + wr * 64 + fr;
#pragma unroll
        for (int bj = 0; bj < 2; ++bj) {
            const int col0 = u.pn * BM + bj * HALF + wc * 32 + 8 * fq;
            const f32x4 ga = *(const f32x4*)(g1 + col0), gb = *(const f32x4*)(g1 + col0 + 4);
#pragma unroll
            for (int ai = 0; ai < 2; ++ai)
#pragma unroll
                for (int m = 0; m < 4; ++m) {
                    bf16_t* xp = XB + (size_t)(row0 + ai * HALF + m * 16) * DM + col0;
                    float x[8]; ld8(xp, x);
#pragma unroll
                    for (int j = 0; j < 4; ++j) { x[j] += ga[j] * acc[ai][bj][m][0][j]; x[4 + j] += gb[j] * acc[ai][bj][m][1][j]; }
                    st8(xp, x);
                }
        }
    }
};
struct EpiUp {
    static constexpr bool PERM = true, CHAIN = false;
    bf16_t* HID;
    __device__ __forceinline__ void operator()(f32x4 (&acc)[2][2][4][2], const GUnit& u, int wr, int wc, int fr, int fq) const {
        const int row0 = u.x0 * PAIRS_E + u.pm * BM + wr * 64 + fr;
        const int col0 = u.pn * HALF + wc * 32 + 8 * fq;
#pragma unroll
        for (int ai = 0; ai < 2; ++ai)
#pragma unroll
            for (int m = 0; m < 4; ++m) {
                float v[8];
#pragma unroll
                for (int j = 0; j < 4; ++j) {
                    const float g0 = acc[ai][0][m][0][j], g1 = acc[ai][0][m][1][j];
                    v[j] = g0 * sigmoidf_(g0) * acc[ai][1][m][0][j]; v[4 + j] = g1 * sigmoidf_(g1) * acc[ai][1][m][1][j];
                }
                u32x4 w; w.x = cvt_pk_bf16(v[0], v[1]); w.y = cvt_pk_bf16(v[2], v[3]); w.z = cvt_pk_bf16(v[4], v[5]); w.w = cvt_pk_bf16(v[6], v[7]);
                *(u32x4*)(HID + (size_t)(row0 + ai * HALF + m * 16) * EFF + col0) = w;
            }
    }
};
struct EpiDown {
    static constexpr bool PERM = true, CHAIN = false;
    bf16_t* YE;
    __device__ __forceinline__ void operator()(f32x4 (&acc)[2][2][4][2], const GUnit& u, int wr, int wc, int fr, int fq) const {
        const int row0 = u.x0 * PAIRS_E + u.pm * BM + wr * 64 + fr;
#pragma unroll
        for (int bj = 0; bj < 2; ++bj) {
            const int col0 = u.pn * BM + bj * HALF + wc * 32 + 8 * fq;
#pragma unroll
            for (int ai = 0; ai < 2; ++ai)
#pragma unroll
                for (int m = 0; m < 4; ++m) {
                    const f32x4 v0 = acc[ai][bj][m][0], v1 = acc[ai][bj][m][1];
                    u32x4 w; w.x = cvt_pk_bf16(v0[0], v0[1]); w.y = cvt_pk_bf16(v0[2], v0[3]); w.z = cvt_pk_bf16(v1[0], v1[1]); w.w = cvt_pk_bf16(v1[2], v1[3]);
                    *(u32x4*)(YE + (size_t)(row0 + ai * HALF + m * 16) * DM + col0) = w;
                }
        }
    }
};

struct PlainOrder {
    const char* A; const char* B; int nM, nN, nwg, G, c; size_t astep, bstep;
    __device__ __forceinline__ void init(const void* A_, const void* B_, int M, int N, int lda, int ldb, int G_, int c_) { A = (const char*)A_; B = (const char*)B_; nM = M / BM; nN = N / BM; nwg = nM * nN; G = G_; c = c_; astep = (size_t)BM * lda * 2; bstep = (size_t)BM * ldb * 2; }
    __device__ __forceinline__ bool next(int i, GUnit& u) const {
        const long L = (long)i * G + c; if (L >= nwg) return false;
        int wgid = (int)L; { const int q = nwg / 8, r = nwg % 8, xcd = wgid % 8, off = wgid / 8; wgid = (xcd < r ? xcd * (q + 1) : r * (q + 1) + (xcd - r) * q) + off; }
#ifndef PG8_WGM
#define PG8_WGM 8
#endif
        const int nig = PG8_WGM * nN, gid = wgid / nig, fm = gid * PG8_WGM, gsz = (nM - fm) < PG8_WGM ? (nM - fm) : PG8_WGM;
        u.pm = fm + ((wgid % nig) % gsz); u.pn = (wgid % nig) / gsz; u.x0 = 0; u.x1 = 0;
        u.A = A + (size_t)u.pm * astep; u.B = B + (size_t)u.pn * bstep; return true;
    }
    __device__ __forceinline__ unsigned arow(int, int) const { return 0u; }
};
struct LastProjOrder {
    PlainOrder lat; const char* A; const char* B; size_t astep, bstep;
    __device__ __forceinline__ void init(const void* A_, const void* B_, int lda, int ldb, int G_, int c_) { lat.init(A_, B_, NLAT, PWP, lda, ldb, G_, c_); A = (const char*)A_; B = (const char*)B_; astep = (size_t)BM * lda * 2; bstep = (size_t)BM * ldb * 2; }
    __device__ __forceinline__ bool next(int i, GUnit& u) const {
        const long L = (long)i * lat.G + lat.c;
        if (L < lat.nwg) return lat.next(i, u);
        const int r = (int)(L - lat.nwg); if (r >= (NCTX / BM) * 8) return false;
        u.pm = NLAT / BM + r / 8; u.pn = 2 + (r % 8); u.x0 = 0; u.x1 = 0;
        u.A = A + (size_t)u.pm * astep; u.B = B + (size_t)u.pn * bstep; return true;
    }
    __device__ __forceinline__ unsigned arow(int, int) const { return 0u; }
};
struct LowRankOrder {
    const char* A; const char* B; int nM, G, c;
    __device__ __forceinline__ bool next(int i, GUnit& u) const {
        const long L = (long)i * G + c; if (L >= (long)nM * 10) return false;
        u.pm = (int)(L / 10); u.pn = (int)(L % 10); u.x0 = 0; u.x1 = 0;
        const int kwin = u.pn < 4 ? 0 : (u.pn < 8 ? 128 : 256);
        u.A = A + ((size_t)u.pm * BM * LRAW + kwin) * 2; u.B = B + (size_t)u.pn * BM * 128 * 2; return true;
    }
    __device__ __forceinline__ unsigned arow(int, int) const { return 0u; }
};
struct MergeOrder {
    const char* P; const char* W; int nM, G, c;
    __device__ __forceinline__ bool next(int i, GUnit& u) const {
        const long tl = (long)(i / 3) * G + c; if (tl >= (long)nM * 4) return false;
        const int tile = (int)tl, br = i % 3;
        u.pm = tile >> 2; u.pn = tile & 3; u.x0 = br; u.x1 = br < 2 ? 1 : 0;
        const int acol = br == 0 ? C_OATT : (br == 1 ? C_ORWKV : C_OCONV);
        u.A = P + ((size_t)u.pm * BM * PW + acol) * 2; u.B = W + ((size_t)br * 1024 * 512 + (size_t)u.pn * BM * 512) * 2; return true;
    }
    __device__ __forceinline__ unsigned arow(int, int) const { return 0u; }
};
struct MoeOrder {
    const char* A; const char* W; const LAS int* rows; int mt_per, npn, G, c; size_t wexp;
    __device__ __forceinline__ bool decode(long L, int& e, int& mt, int& pn) const {
        const int per_e = mt_per * npn; if (L >= (long)NEXP * per_e) return false;
        e = (int)(L / per_e); const int r = (int)(L % per_e); pn = r / mt_per; mt = r % mt_per; return true;
    }
    __device__ __forceinline__ bool next(int i, GUnit& u) const {
        int e, mt, pn; if (!decode((long)i * G + c, e, mt, pn)) return false;
        u.pm = mt; u.pn = pn; u.x0 = e; u.x1 = 0;
        u.A = A; u.B = W + (size_t)e * wexp + (size_t)pn * BM * 1024 * 2; return true;
    }
    __device__ __forceinline__ unsigned arow(int i, int r) const { return (unsigned)rows[i * 256 + r]; }
};
struct MoeDownOrder {
    const char* A; const char* W; int mt_per, G, c;
    __device__ __forceinline__ bool next(int i, GUnit& u) const {
        const long L = (long)i * G + c; const int per_e = mt_per * 4; if (L >= (long)NEXP * per_e) return false;
        const int e = (int)(L / per_e), r = (int)(L % per_e); u.pn = r / mt_per; u.pm = r % mt_per; u.x0 = e; u.x1 = 0;
        u.A = A + ((size_t)e * PAIRS_E + (size_t)u.pm * BM) * EFF * 2; u.B = W + ((size_t)e * 1024 + (size_t)u.pn * BM) * 1024 * 2; return true;
    }
    __device__ __forceinline__ unsigned arow(int, int) const { return 0u; }
};
}
namespace attn_body {
using bf16=__hip_bfloat16;
using bf16x8=__attribute__((ext_vector_type(8)))short;
using s16x4=__attribute__((ext_vector_type(4)))short;
using f32x16=__attribute__((ext_vector_type(16)))float;
using u32x4=__attribute__((ext_vector_type(4)))unsigned;
constexpr int D=64,DM=4224;
constexpr int NW=8,QBLK=32,QB=QBLK*NW,KVBLK=64;
constexpr int ATTN_PITCH=DM, ATTN_UNIT_ROWS=QB;
__device__ __forceinline__ int crow(int r,int hi){return (r&3)+8*(r>>2)+4*hi;}
#define SBAR() __builtin_amdgcn_sched_barrier(0)
__device__ __forceinline__ void cmask(f32x16&p0,f32x16&p1,int jb,int qrel,int hi){
  const float NEG=-INFINITY; int kb=64*jb+4*hi;
  #pragma unroll
  for(int r=0;r<16;++r){int kv=kb+(r&3)+8*(r>>2); if(kv>qrel)p0[r]=NEG; if(kv+32>qrel)p1[r]=NEG;}
}

constexpr int NSLOT=3, SLOTB=8192;
constexpr int LDS_K=0, LDS_V=NSLOT*SLOTB, LDS_WS=2*NSLOT*SLOTB, LDS_OST=LDS_WS+NW*64*4, LDS_BYTES=LDS_OST+NW*4096;
constexpr float C2=0.125f*1.4426950408889634f;
__device__ __forceinline__ void glds16(const void*gsrc,unsigned lds_dst){unsigned keep;
  asm volatile("s_mov_b32 %0, m0\n\ts_mov_b32 m0, %2\n\ts_nop 0\n\tglobal_load_lds_dwordx4 %1, off\n\ts_mov_b32 m0, %0":"=&s"(keep):"v"(gsrc),"s"(lds_dst):"memory");}
__device__ __forceinline__ float max3f(float a,float b,float c){float r;asm("v_max3_f32 %0, %1, %2, %3":"=v"(r):"v"(a),"v"(b),"v"(c));return r;}
__device__ __forceinline__ float max2f(float a,float b){float r;asm("v_max_f32_e32 %0, %1, %2":"=v"(r):"v"(a),"v"(b));return r;}
__device__ __forceinline__ float fadd_s(float a,float b){float r;asm("v_add_f32_e32 %0, %1, %2":"=v"(r):"v"(a),"v"(b));return r;}
__device__ __forceinline__ float fsub_s(float a,float b){float r;asm("v_sub_f32_e32 %0, %1, %2":"=v"(r):"v"(a),"v"(b));return r;}
typedef float f32x2_t __attribute__((ext_vector_type(2))); typedef __bf16 bf16x2_t __attribute__((ext_vector_type(2)));
__device__ __forceinline__ unsigned cvtpk_s(float lo,float hi){f32x2_t v={lo,hi};bf16x2_t b=__builtin_convertvector(v,bf16x2_t);return __builtin_bit_cast(unsigned,b);}
#define WAIT_BAR(N) asm volatile("s_waitcnt vmcnt(" #N ") lgkmcnt(0)\n\ts_barrier":::"memory")

__device__ __forceinline__ void qkt(f32x16&p0,f32x16&p1,const char*Kslot,const bf16x8*qr,const f32x16&negm,int r32,int hi){
  const char*kb=Kslot+hi*1024+r32*16;
  #pragma unroll
  for(int d0=0;d0<4;++d0){
    const bf16x8 b0=*reinterpret_cast<const bf16x8*>(kb+d0*2048);
    const bf16x8 b1=*reinterpret_cast<const bf16x8*>(kb+d0*2048+512);
    if(d0==0){p0=__builtin_amdgcn_mfma_f32_32x32x16_bf16(b0,qr[0],negm,0,0,0);p1=__builtin_amdgcn_mfma_f32_32x32x16_bf16(b1,qr[0],negm,0,0,0);}
    else{p0=__builtin_amdgcn_mfma_f32_32x32x16_bf16(b0,qr[d0],p0,0,0,0);p1=__builtin_amdgcn_mfma_f32_32x32x16_bf16(b1,qr[d0],p1,0,0,0);}}
}
typedef __attribute__((address_space(3))) const char* lds_cptr;
typedef short v4i16_t __attribute__((ext_vector_type(4)));
__device__ __forceinline__ void kload8(bf16x8*kf,lds_cptr kp){
  kf[0]=*(const __attribute__((address_space(3))) bf16x8*)(kp);      kf[1]=*(const __attribute__((address_space(3))) bf16x8*)(kp+512);
  kf[2]=*(const __attribute__((address_space(3))) bf16x8*)(kp+2048); kf[3]=*(const __attribute__((address_space(3))) bf16x8*)(kp+2560);
  kf[4]=*(const __attribute__((address_space(3))) bf16x8*)(kp+4096); kf[5]=*(const __attribute__((address_space(3))) bf16x8*)(kp+4608);
  kf[6]=*(const __attribute__((address_space(3))) bf16x8*)(kp+6144); kf[7]=*(const __attribute__((address_space(3))) bf16x8*)(kp+6656);
}
__device__ __forceinline__ void kload2(bf16x8*kf,lds_cptr kp,int j){ kf[2*j]=*(const __attribute__((address_space(3))) bf16x8*)(kp+j*2048); kf[2*j+1]=*(const __attribute__((address_space(3))) bf16x8*)(kp+j*2048+512); }
__device__ __forceinline__ s16x4 vtr(lds_cptr p){ return __builtin_bit_cast(s16x4,__builtin_amdgcn_ds_read_tr16_b64_v4i16((__attribute__((address_space(3))) v4i16_t*)p)); }
__device__ __forceinline__ float rowmax(const f32x16&p0,const f32x16&p1){
  float a=max3f(p0[0],p0[1],p1[0]),b=max3f(p0[2],p0[3],p1[1]);a=max3f(a,p1[2],p1[3]);
  #pragma unroll
  for(int r=4;r<16;r+=4){a=max3f(a,p0[r],p0[r+1]);b=max3f(b,p0[r+2],p0[r+3]);a=max3f(a,p1[r],p1[r+1]);b=max3f(b,p1[r+2],p1[r+3]);}
  const float m=max2f(a,b);
  auto rr=__builtin_amdgcn_permlane32_swap(__float_as_uint(m),__float_as_uint(m),false,false);
  return max2f(__uint_as_float(rr[0]),__uint_as_float(rr[1]));
}
__device__ __forceinline__ void pv(f32x16*o,int vb,bf16x8 pa0,bf16x8 pa1,bf16x8 pa2,bf16x8 pa3){
  #pragma unroll
  for(int d0=0;d0<2;++d0){s16x4 lo[4],hi[4];
    #pragma unroll
    for(int ks=0;ks<4;++ks){
      asm volatile("ds_read_b64_tr_b16 %0,%1 offset:%c2":"=&v"(lo[ks]):"v"(vb),"i"(d0*4096+ks*1024):"memory");
      asm volatile("ds_read_b64_tr_b16 %0,%1 offset:%c2":"=&v"(hi[ks]):"v"(vb),"i"(d0*4096+ks*1024+512):"memory");}
    asm volatile("s_waitcnt lgkmcnt(0)":::"memory");SBAR();
    #define PK(k) (bf16x8){lo[k][0],lo[k][1],lo[k][2],lo[k][3],hi[k][0],hi[k][1],hi[k][2],hi[k][3]}
    o[d0]=__builtin_amdgcn_mfma_f32_32x32x16_bf16(pa0,PK(0),o[d0],0,0,0);
    o[d0]=__builtin_amdgcn_mfma_f32_32x32x16_bf16(pa1,PK(1),o[d0],0,0,0);
    o[d0]=__builtin_amdgcn_mfma_f32_32x32x16_bf16(pa2,PK(2),o[d0],0,0,0);
    o[d0]=__builtin_amdgcn_mfma_f32_32x32x16_bf16(pa3,PK(3),o[d0],0,0,0);
    #undef PK
  }
}

#ifndef ATTN_STORE16
#define ATTN_STORE16(p,v) (*(u32x4*)(p)=(v))
#endif
template<int THRL> __device__ __forceinline__ void attn_unit(const bf16*Qu,bf16*Ou,const bf16*KV0,const int crow0,const int lrow0,const int NT,const int nct,char*shm){
  constexpr int VOFF=128;
  int tid_=threadIdx.x; asm volatile("":"+v"(tid_)); const int tid=tid_,lane=tid&63,r32=lane&31,hi=lane>>5; const int wid=__builtin_amdgcn_readfirstlane(tid>>6);
  const bf16*Qw=Qu+(long)(wid*QBLK)*DM;
  const unsigned lds0=(unsigned)(uintptr_t)shm;
  float*wsf=(float*)(shm+LDS_WS)+wid*64;
  const long klane=(long)lane*DM+wid*8;
  const long vlane=(long)(16*(wid&3)+(lane>>2))*DM+(wid>>2)*32+(lane&3)*8;
  const unsigned kdst=lds0+LDS_K+wid*1024, vdst=lds0+LDS_V+wid*1024;
  #define KTILE(t) (KV0+(long)(((t)<nct)?(crow0+(t)*KVBLK):(lrow0+((t)-nct)*KVBLK))*DM)
  #define VTILE(t) (KTILE(t)+VOFF)
  #define DMA_K(t,slot) glds16(KTILE(t)+klane,(unsigned)__builtin_amdgcn_readfirstlane(kdst+(slot)))
  #define DMA_V(t,slot) glds16(VTILE(t)+vlane,(unsigned)__builtin_amdgcn_readfirstlane(vdst+(slot)))
  const int vb0=(int)(lds0+LDS_V)+((lane>>4)&1)*32+(lane&3)*8+(4*hi+((lane&15)>>2))*64;
  const char*Kbase=shm+LDS_K; bf16x8 kf[8];
  const lds_cptr shm3=(lds_cptr)shm; const lds_cptr kp0=shm3+LDS_K+hi*1024+r32*16; const lds_cptr vp0=shm3+LDS_V+((lane>>4)&1)*32+(lane&3)*8+(4*hi+((lane&15)>>2))*64;
  DMA_K(0,0);DMA_V(0,0);DMA_K(1,SLOTB);
  bf16x8 qr[4];
  #pragma unroll
  for(int d0=0;d0<4;++d0)qr[d0]=*reinterpret_cast<const bf16x8*>(&Qw[(long)r32*DM+d0*16+hi*8]);
  float mhat=0.f,l_reg=0.f;f32x16 o[2];o[0]=f32x16{};o[1]=f32x16{};f32x16 negm=f32x16{};asm volatile("":"+v"(negm));
  #define CMASK(P0,P1,t) do{}while(0)
  bool resc=false;
#ifndef ATTN_NOMAX
#define ATTN_NOMAX 1
#endif
#if ATTN_NOMAX
  #define START(P0,P1) do{ resc=false; _Pragma("unroll") for(int r=0;r<16;++r)P0[r]=__builtin_amdgcn_exp2f(P0[r]); }while(0)
#else
  #define START(P0,P1) do{ const float rm=rowmax(P0,P1); resc=false; \
    { const float dl=rm; mhat=fadd_s(mhat,dl); \
      _Pragma("unroll") for(int r=0;r<16;++r){P0[r]=fsub_s(P0[r],dl);P1[r]=fsub_s(P1[r],dl);} \
      _Pragma("unroll") for(int r=0;r<16;++r)negm[r]=-mhat; asm volatile("":"+v"(negm)); } \
    _Pragma("unroll") for(int r=0;r<16;++r)P0[r]=__builtin_amdgcn_exp2f(P0[r]); }while(0)
#endif
  #define RESC() do{ if(resc){ asm volatile("s_waitcnt lgkmcnt(0)":::"memory"); \
      _Pragma("unroll") for(int d_=0;d_<2;++d_) _Pragma("unroll") for(int r=0;r<16;++r)o[d_][r]*=wsf[crow(r,hi)]; } }while(0)
  f32x16 pA0,pA1,pB0,pB1;
  int sl_prev=0,sl_cur=0,sl_next=SLOTB;
  #define ROT() do{sl_prev=sl_cur;sl_cur=sl_next;sl_next=(sl_next==(NSLOT-1)*SLOTB)?0:sl_next+SLOTB;}while(0)
  DMA_K(2,2*SLOTB);
  WAIT_BAR(3);
  qkt(pA0,pA1,Kbase,qr,negm,r32,hi);asm volatile("s_nop 15\n\ts_nop 7":"+v"(pA0),"+v"(pA1));CMASK(pA0,pA1,0);
  START(pA0,pA1);
  _Pragma("unroll") for(int r=0;r<16;++r)pA1[r]=__builtin_amdgcn_exp2f(pA1[r]);
  WAIT_BAR(0);
  DMA_K(3,0);DMA_V(1,SLOTB);
  ROT();
  kload8(kf,kp0+sl_cur);
  WAIT_BAR(2);
  s16x4 vlo[8],vhi[8]; u32x4 pw0,pw1,pw2,pw3;
  #define PKW(P,B) cvtpk_s(P[B],P[B+1])
  #define PAF(k) __builtin_bit_cast(bf16x8,pw##k)
  #define VFR(i) (bf16x8){vlo[i][0],vlo[i][1],vlo[i][2],vlo[i][3],vhi[i][0],vhi[i][1],vhi[i][2],vhi[i][3]}
  #define PIN(x) asm volatile("":"+v"(x))
  #define MX3(a,b,c) __builtin_fmaxf(__builtin_fmaxf((a),(b)),(c))
  #define GAPA(MF,A0,A1,A2,A3,W0,W1,PW) do{ MF; sacc+=A0; sacc+=A1; sacc+=A2; sacc+=A3; PIN(sacc); W0; W1; PIN(PW); SBAR(); }while(0)
  #define EX(v) __builtin_amdgcn_exp2f(v)
  #define GAPB(MF,X,B) do{ MF; X[B]=EX(X[B]); X[B+1]=EX(X[B+1]); X[B+2]=EX(X[B+2]); X[B+3]=EX(X[B+3]); PIN(X); SBAR(); }while(0)
  #define VRD(i) do{ vlo[i]=vtr(vp_+(((i)>>2)*4096+((i)&3)*1024)); vhi[i]=vtr(vp_+(((i)>>2)*4096+((i)&3)*1024+512)); }while(0)
  #define KRD(G,j) do{ if(G){ kload2(kf,kp0+sl_next,j); SBAR(); } }while(0)
#if ATTN_NOMAX
  #define ROWMAX_BLOCK(C0,C1) do{ resc=false; }while(0)
#else
  #define ROWMAX_BLOCK(C0,C1) do    { float a=MX3(C0[0],C0[1],C1[0]),b=MX3(C0[2],C0[3],C1[1]); a=MX3(a,C1[2],C1[3]); \
      _Pragma("unroll") for(int r=4;r<16;r+=4){a=MX3(a,C0[r],C0[r+1]);b=MX3(b,C0[r+2],C0[r+3]);a=MX3(a,C1[r],C1[r+1]);b=MX3(b,C1[r+2],C1[r+3]);} \
      float rm=__builtin_fmaxf(a,b); { auto rr=__builtin_amdgcn_permlane32_swap(__float_as_uint(rm),__float_as_uint(rm),false,false); rm=__builtin_fmaxf(__uint_as_float(rr[0]),__uint_as_float(rr[1])); } \
      resc=false; \
      if(__builtin_expect(__any(rm>(float)THRL),0)){ const float dl=__builtin_fmaxf(rm,0.f); mhat+=dl; \
        _Pragma("unroll") for(int r=0;r<16;++r){C0[r]-=dl;C1[r]-=dl;} \
        _Pragma("unroll") for(int r=0;r<16;++r)negm[r]=-mhat; asm volatile("":"+v"(negm)); \
        const float f=__builtin_amdgcn_exp2f(-dl); l_reg*=f; if(hi==0)wsf[r32]=f; resc=true; } } while(0)
#endif
  #define STEP(C0,C1,P0,P1,t,GK,GV,GL) do{ SBAR(); \
    const lds_cptr vp_=vp0+sl_prev; \
    VRD(0); SBAR(); float sacc=(P0[0]+P0[1]); \
    GAPA(C0=__builtin_amdgcn_mfma_f32_32x32x16_bf16(kf[0],qr[0],negm,0,0,0), P0[2],P0[3],P0[4],P0[5],     pw0[0]=PKW(P0,0), pw0[1]=PKW(P0,2), pw0); \
    VRD(4); SBAR(); GAPA(C1=__builtin_amdgcn_mfma_f32_32x32x16_bf16(kf[1],qr[0],negm,0,0,0), P0[6],P0[7],P0[8],P0[9],     pw0[2]=PKW(P0,4), pw0[3]=PKW(P0,6), pw0); \
    VRD(1); SBAR(); GAPA(C0=__builtin_amdgcn_mfma_f32_32x32x16_bf16(kf[2],qr[1],C0,0,0,0),   P0[10],P0[11],P0[12],P0[13], pw1[0]=PKW(P0,8), pw1[1]=PKW(P0,10), pw1); \
    VRD(5); SBAR(); GAPA(C1=__builtin_amdgcn_mfma_f32_32x32x16_bf16(kf[3],qr[1],C1,0,0,0),   P0[14],P0[15],P1[0],P1[1],   pw1[2]=PKW(P0,12),pw1[3]=PKW(P0,14), pw1); \
    VRD(2); SBAR(); GAPA(C0=__builtin_amdgcn_mfma_f32_32x32x16_bf16(kf[4],qr[2],C0,0,0,0),   P1[2],P1[3],P1[4],P1[5],     pw2[0]=PKW(P1,0), pw2[1]=PKW(P1,2), pw2); \
    VRD(6); SBAR(); GAPA(C1=__builtin_amdgcn_mfma_f32_32x32x16_bf16(kf[5],qr[2],C1,0,0,0),   P1[6],P1[7],P1[8],P1[9],     pw2[2]=PKW(P1,4), pw2[3]=PKW(P1,6), pw2); \
    VRD(3); SBAR(); GAPA(C0=__builtin_amdgcn_mfma_f32_32x32x16_bf16(kf[6],qr[3],C0,0,0,0),   P1[10],P1[11],P1[12],P1[13], pw3[0]=PKW(P1,8), pw3[1]=PKW(P1,10), pw3); \
    VRD(7); SBAR(); GAPA(C1=__builtin_amdgcn_mfma_f32_32x32x16_bf16(kf[7],qr[3],C1,0,0,0),   P1[14],P1[15],0.f,0.f,       pw3[2]=PKW(P1,12),pw3[3]=PKW(P1,14), pw3); \
    l_reg+=sacc; \
    if(GK){DMA_K((t)+3,sl_cur);} if(GV){DMA_V((t)+1,sl_next);} \
    CMASK(C0,C1,t); \
    ROWMAX_BLOCK(C0,C1); \
    SBAR(); \
    GAPB(o[0]=__builtin_amdgcn_mfma_f32_32x32x16_bf16(PAF(0),VFR(0),o[0],0,0,0), C0,0); \
    GAPB(o[1]=__builtin_amdgcn_mfma_f32_32x32x16_bf16(PAF(0),VFR(4),o[1],0,0,0), C0,4); \
    KRD(GL,0); GAPB(o[0]=__builtin_amdgcn_mfma_f32_32x32x16_bf16(PAF(1),VFR(1),o[0],0,0,0), C0,8); \
    KRD(GL,1); GAPB(o[1]=__builtin_amdgcn_mfma_f32_32x32x16_bf16(PAF(1),VFR(5),o[1],0,0,0), C0,12); \
    KRD(GL,2); GAPB(o[0]=__builtin_amdgcn_mfma_f32_32x32x16_bf16(PAF(2),VFR(2),o[0],0,0,0), C1,0); \
    KRD(GL,3); GAPB(o[1]=__builtin_amdgcn_mfma_f32_32x32x16_bf16(PAF(2),VFR(6),o[1],0,0,0), C1,4); \
    GAPB(o[0]=__builtin_amdgcn_mfma_f32_32x32x16_bf16(PAF(3),VFR(3),o[0],0,0,0), C1,8); \
    GAPB(o[1]=__builtin_amdgcn_mfma_f32_32x32x16_bf16(PAF(3),VFR(7),o[1],0,0,0), C1,12); \
    }while(0)
  int t=1;
  #undef CMASK
  #define CMASK(P0,P1,t) do{}while(0)
  for(;t+5<NT;t+=2){
    STEP(pB0,pB1,pA0,pA1,t,true,true,true);     WAIT_BAR(2); RESC(); ROT();
    STEP(pA0,pA1,pB0,pB1,t+1,true,true,true);   WAIT_BAR(2); RESC(); ROT();
  }
  #undef CMASK
  #define CMASK(P0,P1,t) do{}while(0)
  #define ENDW(tt) do{ if((tt)+3<NT){WAIT_BAR(2);} else if((tt)+2<NT){WAIT_BAR(1);} else {WAIT_BAR(0);} }while(0)
  for(;t+1<NT;t+=2){
    STEP(pB0,pB1,pA0,pA1,t,(t+3<NT),(t+1<NT),(t+1<NT));       ENDW(t);   RESC(); ROT();
    STEP(pA0,pA1,pB0,pB1,t+1,(t+4<NT),(t+2<NT),(t+2<NT));     ENDW(t+1); RESC(); ROT();
  }
  STEP(pB0,pB1,pA0,pA1,NT-1,false,false,false); RESC();
  { float sacc=pB0[0]+pB0[1]; _Pragma("unroll") for(int r=2;r<16;++r)sacc+=pB0[r]; _Pragma("unroll") for(int r=0;r<16;++r)sacc+=pB1[r]; l_reg+=sacc;
    pw0=(u32x4){PKW(pB0,0),PKW(pB0,2),PKW(pB0,4),PKW(pB0,6)};pw1=(u32x4){PKW(pB0,8),PKW(pB0,10),PKW(pB0,12),PKW(pB0,14)};pw2=(u32x4){PKW(pB1,0),PKW(pB1,2),PKW(pB1,4),PKW(pB1,6)};pw3=(u32x4){PKW(pB1,8),PKW(pB1,10),PKW(pB1,12),PKW(pB1,14)};
    SBAR(); pv(o,vb0+sl_cur,PAF(0),PAF(1),PAF(2),PAF(3)); }
  #undef PKW
  #undef PAF
  #undef VFR
  #undef PIN
  #undef MX3
  #undef GAPA
  #undef GAPB
  #undef EX
  #undef VRD
  #undef KRD
  #undef STEP
  #undef ROWMAX_BLOCK
  #undef ENDW
  {auto rr=__builtin_amdgcn_permlane32_swap(__float_as_uint(l_reg),__float_as_uint(l_reg),false,false);l_reg=__uint_as_float(rr[0])+__uint_as_float(rr[1]);}
  if(hi==0)wsf[32+r32]=l_reg;asm volatile("s_waitcnt lgkmcnt(0)":::"memory");
  float rli[16];
  #pragma unroll
  for(int r=0;r<16;++r)rli[r]=__builtin_amdgcn_rcpf(wsf[32+crow(r,hi)]);
  bf16*Ow=Ou+(long)(wid*QBLK)*DM;
  { bf16*stg=(bf16*)(shm+LDS_OST)+wid*2048;
    #pragma unroll
    for(int r=0;r<16;++r){const int orow=crow(r,hi);
      #pragma unroll
      for(int d0=0;d0<2;++d0)stg[orow*64+d0*32+r32]=__float2bfloat16(o[d0][r]*rli[r]);}
    asm volatile("s_waitcnt lgkmcnt(0)":::"memory");
    #pragma unroll
    for(int i=0;i<4;++i){const int row=i*8+(lane>>3),ch=lane&7; const u32x4 v=*(const u32x4*)(stg+row*64+ch*8); ATTN_STORE16(Ow+(long)row*DM+ch*8,v);} }
  asm volatile("s_waitcnt lgkmcnt(0)\n\ts_barrier":::"memory");
  #undef DMA_K
  #undef KTILE
  #undef VTILE
  #undef DMA_V
  #undef CMASK
  #undef START
  #undef RESC
  #undef ROT
}
constexpr int ATTN_LDS_BYTES=LDS_BYTES;
#undef SBAR
#undef WAIT_BAR
}
#define XB_TMO      128
#define XB_XCNT(j)  (256  + 64 * (j))
#define XB_XSUB(j)  (1280 + 64 * (j))
#define XB_XGEN(j)  (2304 + 64 * (j))
#define XB_TOP      3328
#define XB_TOPGEN   3392
#define XCD_BAR_WORDS 3456
#define XB_SPIN_CAP (1u << 18)
__device__ __forceinline__ unsigned xb_ld(unsigned* p)              { return __hip_atomic_load(p, __ATOMIC_RELAXED, __HIP_MEMORY_SCOPE_AGENT); }
__device__ __forceinline__ unsigned xb_add(unsigned* p, unsigned v) { return __hip_atomic_fetch_add(p, v, __ATOMIC_RELAXED, __HIP_MEMORY_SCOPE_AGENT); }
__device__ __forceinline__ unsigned xb_xcc_id() { return (unsigned)__builtin_amdgcn_s_getreg((3 << 11) | 20) & 0xFu; }
#define XB_SPIN(cond, bar) do { unsigned _sp = 0; while (cond) { __builtin_amdgcn_s_sleep(1); \
    if ((++_sp & 255u) == 0u) { if (xb_ld(&(bar)[XB_TMO])) break; if (_sp > XB_SPIN_CAP) { atomicAdd(&(bar)[XB_TMO], 1u); break; } } } } while (0)
struct XcdBarrier { unsigned* bar; unsigned x; volatile LAS unsigned* st; };
__device__ __forceinline__ XcdBarrier xcd_barrier_post(unsigned* bar, volatile LAS unsigned* st) {
    XcdBarrier b; b.bar = bar; b.x = xb_xcc_id(); b.st = st;
    if (threadIdx.x == 0) (void)xb_add(&bar[XB_XCNT(b.x)], 1u);
    return b;
}
__device__ __forceinline__ void xcd_barrier_complete(unsigned* bar, unsigned x, unsigned& nloc, unsigned& nx) {
    const unsigned G = gridDim.x * gridDim.y * gridDim.z;
    unsigned sum, cnt, mine, sp = 0u;
    for (;;) {
        sum = 0u; cnt = 0u; mine = 0u;
#pragma unroll
        for (unsigned j = 0; j < 16; ++j) { const unsigned c = xb_ld(&bar[XB_XCNT(j)]); sum += c; cnt += (c > 0u) ? 1u : 0u; mine = (j == x) ? c : mine; }
        if (sum == G) break;
        __builtin_amdgcn_s_sleep(1);
        if ((++sp & 255u) == 0u) { if (xb_ld(&bar[XB_TMO])) break; if (sp > XB_SPIN_CAP) { atomicAdd(&bar[XB_TMO], 1u); break; } }
    }
    nloc = mine > 0u ? mine : 1u; nx = cnt > 0u ? cnt : 1u;
}
__device__ __forceinline__ void xcd_barrier(const XcdBarrier& b) {
    asm volatile("s_waitcnt vmcnt(0)" ::: "memory");
    __syncthreads();
    if (threadIdx.x == 0) {
        unsigned long long bar_i = (unsigned long long)b.bar; unsigned bx_ = b.x; asm volatile("" : "+s"(bar_i), "+s"(bx_));
        unsigned* bar = (unsigned*)(__attribute__((address_space(1))) unsigned*)bar_i;
        __builtin_amdgcn_s_waitcnt(0);
        unsigned nloc = b.st[0], nx = b.st[1];
        if (nloc == 0u) { xcd_barrier_complete(bar, bx_, nloc, nx); b.st[0] = nloc; b.st[1] = nx; }
        const unsigned old = xb_add(&bar[XB_XSUB(bx_)], 1u);
        const unsigned gen = old / nloc;
        if (old + 1u == (gen + 1u) * nloc) {
            __builtin_amdgcn_fence(__ATOMIC_RELEASE, "agent");
            asm volatile("s_waitcnt vmcnt(0)" ::: "memory");
            const unsigned og = xb_add(&bar[XB_TOP], 1u);
            const unsigned tg = og / nx;
            if (og + 1u == (tg + 1u) * nx) xb_add(&bar[XB_TOPGEN], 1u);
            else XB_SPIN(xb_ld(&bar[XB_TOPGEN]) == tg, bar);
            __builtin_amdgcn_fence(__ATOMIC_ACQUIRE, "agent");
            xb_add(&bar[XB_XGEN(bx_)], 1u);
            asm volatile("s_waitcnt vmcnt(0)" ::: "memory");
        } else {
            XB_SPIN(xb_ld(&bar[XB_XGEN(bx_)]) == gen, bar);
            __builtin_amdgcn_fence(__ATOMIC_ACQUIRE, "agent");
            asm volatile("s_waitcnt vmcnt(0)" ::: "memory");
        }
    }
    __syncthreads();
}

struct Frame {
    LAS unsigned char* lds;
    int tid, lane, wave, vcu, G, gw, NGW, bid;
    float* out; unsigned char* ws;
};
__device__ __forceinline__ void relaunder(Frame& F) {
    unsigned long long w = (unsigned long long)F.ws, o = (unsigned long long)F.out;
    int vcu = F.vcu, G = F.G, wave = F.wave, tid = F.tid, bid = F.bid;
    asm volatile("" : "+s"(w), "+s"(o), "+s"(vcu), "+s"(G), "+s"(wave), "+s"(bid));
    asm volatile("" : "+v"(tid));
    F.ws = (unsigned char*)(__attribute__((address_space(1))) unsigned char*)w; F.out = (float*)(__attribute__((address_space(1))) float*)o;
    F.vcu = vcu; F.G = G; F.wave = wave; F.tid = tid; F.lane = tid & 63; F.bid = bid; F.gw = vcu * NWAVES + wave; F.NGW = G * NWAVES;
}
#define LDS_WAIT() asm volatile("s_waitcnt lgkmcnt(0)" ::: "memory")

__device__ __forceinline__ void transpose_item(const float* W, int N, int k0, int n0, bf16_t* dst, int ldk, LAS float* scr, int lane) {
#pragma unroll 8
    for (int i = 0; i < 32; ++i) { const int kk = 2 * i + (lane >> 5); scr[kk * 33 + (lane & 31)] = W[(size_t)(k0 + kk) * N + n0 + (lane & 31)]; }
    LDS_WAIT(); asm volatile("" ::: "memory");
    const int c = lane & 7;
#pragma unroll
    for (int j = 0; j < 4; ++j) { const int n = (lane >> 3) + 8 * j; const LAS float* s = scr + (8 * c) * 33 + n;
        u32x4 o; o.x = pk2(s[0 * 33], s[1 * 33]); o.y = pk2(s[2 * 33], s[3 * 33]); o.z = pk2(s[4 * 33], s[5 * 33]); o.w = pk2(s[6 * 33], s[7 * 33]);
        *(u32x4*)(dst + (size_t)n * ldk + 8 * c) = o; }
    LDS_WAIT(); asm volatile("" ::: "memory");
}

__device__ __forceinline__ void transpose_item32(const float* W, int N, int k0, int n0, bf16_t* dst, int ldk, LAS float* scr, int lane) {
#pragma unroll 8
    for (int i = 0; i < 16; ++i) { const int kk = 2 * i + (lane >> 5); scr[kk * 33 + (lane & 31)] = W[(size_t)(k0 + kk) * N + n0 + (lane & 31)]; }
    LDS_WAIT(); asm volatile("" ::: "memory");
    const int c = lane & 3;
#pragma unroll
    for (int j = 0; j < 2; ++j) { const int n = (lane >> 2) + 16 * j; const LAS float* s = scr + (8 * c) * 33 + n;
        u32x4 o; o.x = pk2(s[0 * 33], s[1 * 33]); o.y = pk2(s[2 * 33], s[3 * 33]); o.z = pk2(s[4 * 33], s[5 * 33]); o.w = pk2(s[6 * 33], s[7 * 33]);
        *(u32x4*)(dst + (size_t)n * ldk + 8 * c) = o; }
    LDS_WAIT(); asm volatile("" ::: "memory");
}
__device__ __forceinline__ void transpose_issue32(const float* W, int N, int k0, int n0, float (&v)[16], int lane) {
#pragma unroll
    for (int i = 0; i < 16; ++i) { const int kk = 2 * i + (lane >> 5); v[i] = W[(size_t)(k0 + kk) * N + n0 + (lane & 31)]; }
}
__device__ __forceinline__ void transpose_finish32(const float (&v)[16], bf16_t* dst, int ldk, LAS float* scr, int lane, bool store) {
#pragma unroll
    for (int i = 0; i < 16; ++i) { const int kk = 2 * i + (lane >> 5); scr[kk * 33 + (lane & 31)] = v[i]; }
    LDS_WAIT(); asm volatile("" ::: "memory");
    if (!store) return;
    const int c = lane & 3;
#pragma unroll
    for (int j = 0; j < 2; ++j) { const int n = (lane >> 2) + 16 * j; const LAS float* s = scr + (8 * c) * 33 + n;
        u32x4 o; o.x = pk2(s[0 * 33], s[1 * 33]); o.y = pk2(s[2 * 33], s[3 * 33]); o.z = pk2(s[4 * 33], s[5 * 33]); o.w = pk2(s[6 * 33], s[7 * 33]);
        *(u32x4*)(dst + (size_t)n * ldk + 8 * c) = o; }
    LDS_WAIT(); asm volatile("" ::: "memory");
}
__device__ __forceinline__ void convert_expert_issue32(int l, int it, const float* exp_gate, const float* exp_up, const float* exp_down, float (&v)[16], int lane) {
    constexpr int I_M = 32 * 32;
    const int which = it / (NEXP * I_M), r = it % (NEXP * I_M), e = r / I_M, q = r % I_M, kb = q / 32, nb = q % 32, n0 = nb * 32;
    const float* W = (which == 0 ? exp_gate : (which == 1 ? exp_up : exp_down)) + ((size_t)l * NEXP + e) * DM * EFF;
    transpose_issue32(W, which < 2 ? EFF : DM, kb * 32, n0, v, lane);
}
__device__ __forceinline__ void convert_expert_finish32(unsigned char* ws, int it_, const float (&v)[16], LAS float* scr, int lane) {
    bf16_t* Wup = (bf16_t*)(ws + WS_WUP); bf16_t* Wdn = (bf16_t*)(ws + WS_WDN);
    constexpr int I_M = 32 * 32;
    const bool store = it_ >= 0; const int it = store ? it_ : 0;
    const int which = it / (NEXP * I_M), r = it % (NEXP * I_M), e = r / I_M, q = r % I_M, kb = q / 32, nb = q % 32, n0 = nb * 32;
    if (which < 2) { const int drow = 256 * (n0 >> 7) + 128 * which + (n0 & 127);
        transpose_finish32(v, Wup + ((size_t)e * 2048 + drow) * DM + kb * 32, DM, scr, lane, store); }
    else transpose_finish32(v, Wdn + ((size_t)e * 1024 + n0) * EFF + kb * 32, EFF, scr, lane, store);
}
__device__ __forceinline__ void convert_expert_item32(unsigned char* ws, int l, int it, const float* exp_gate, const float* exp_up, const float* exp_down, LAS float* scr, int lane) {
    bf16_t* Wup = (bf16_t*)(ws + WS_WUP); bf16_t* Wdn = (bf16_t*)(ws + WS_WDN);
    constexpr int I_M = 32 * 32;
    const int which = it / (NEXP * I_M), r = it % (NEXP * I_M), e = r / I_M, q = r % I_M, kb = q / 32, nb = q % 32, n0 = nb * 32;
    const float* W = (which == 0 ? exp_gate : (which == 1 ? exp_up : exp_down)) + ((size_t)l * NEXP + e) * DM * EFF;
    if (which < 2) { const int drow = 256 * (n0 >> 7) + 128 * which + (n0 & 127);
        transpose_item32(W, EFF, kb * 32, n0, Wup + ((size_t)e * 2048 + drow) * DM + kb * 32, DM, scr, lane); }
    else transpose_item32(W, DM, kb * 32, n0, Wdn + ((size_t)e * 1024 + n0) * EFF + kb * 32, EFF, scr, lane);
}

__device__ __forceinline__ void phase_prologue(Frame& F, const float* c_in, const float* cctx_in, const float* ada_w, const float* ada_b, const float* w_in, const float* decay_w2, const float* iclr_a2, const float* gate_g2,
                                               const float* w_br_att, const float* w_br_rwkv, const float* w_br_conv, const float* w_out, const float* w_router) {
    LAS float* scr = (LAS float*)(F.lds + F.wave * 16384);
    bf16_t* Win = (bf16_t*)(F.ws + WS_WIN); bf16_t* Wbr = (bf16_t*)(F.ws + WS_WBR); bf16_t* Wout = (bf16_t*)(F.ws + WS_WOUT); bf16_t* Wlr = (bf16_t*)(F.ws + WS_WLR);
    constexpr int I_IN = 16 * 228, I_BR = 8 * 32, I_OUT = 16 * 32;
    constexpr int PER_L = I_IN + 3 * I_BR + I_OUT;
    for (int it = F.gw; it < NL * PER_L; it += F.NGW) {
        const int l = it / PER_L; int r = it % PER_L;
        if (r < I_IN) { const int kb = r / 228, nb = r % 228; transpose_item(w_in + (size_t)l * DM * NCOLS_IN, NCOLS_IN, kb * 64, nb * 32, Win + ((size_t)l * PWP + nb * 32) * DM + kb * 64, DM, scr, F.lane); continue; }
        r -= I_IN;
        if (r < 3 * I_BR) { const int br = r / I_BR, q = r % I_BR, kb = q / 32, nb = q % 32;
            const float* W = (br == 0 ? w_br_att : (br == 1 ? w_br_rwkv : w_br_conv)) + (size_t)l * 512 * DM;
            transpose_item(W, DM, kb * 64, nb * 32, Wbr + (((size_t)l * 3 + br) * 1024 + nb * 32) * 512 + kb * 64, 512, scr, F.lane); continue; }
        r -= 3 * I_BR;
        { const int kb = r / 32, nb = r % 32; transpose_item(w_out + (size_t)l * DM * DM, DM, kb * 64, nb * 32, Wout + ((size_t)l * 1024 + nb * 32) * DM + kb * 64, DM, scr, F.lane); }
    }
    for (int i = F.gw * 64 + F.lane; i < NL * (PWP - NCOLS_IN) * DM / 8; i += F.NGW * 64) {
        const int l = i / ((PWP - NCOLS_IN) * DM / 8), r = i % ((PWP - NCOLS_IN) * DM / 8);
        *(u32x4*)(Win + ((size_t)l * PWP + NCOLS_IN) * DM + (size_t)r * 8) = (u32x4){0u, 0u, 0u, 0u};
    }
    for (int i = F.gw * 64 + F.lane; i < NL * WAGW * 128; i += F.NGW * 64) {
        const int l = i / (WAGW * 128), r = i % (WAGW * 128), n = r / 128, kk = r % 128;
        float v = 0.f;
        if (n < 512) { if (kk < 64) v = decay_w2[(((size_t)l * 2 + 0) * 64 + kk) * 512 + n]; }
        else if (n < 1024) { if (kk >= 64) v = decay_w2[(((size_t)l * 2 + 1) * 64 + (kk - 64)) * 512 + (n - 512)]; }
        else if (n < 1536) { if (kk < 64) v = iclr_a2[(((size_t)l * 2 + 0) * 64 + kk) * 512 + (n - 1024)]; }
        else if (n < 2048) { if (kk >= 64) v = iclr_a2[(((size_t)l * 2 + 1) * 64 + (kk - 64)) * 512 + (n - 1536)]; }
        else v = gate_g2[((size_t)l * 128 + kk) * 512 + (n - 2048)];
        Wlr[i] = (bf16_t)f2bf(v);
    }
    { bf16_t* WRT = (bf16_t*)(F.ws + WS_WRT);
      for (int i = F.gw * 64 + F.lane; i < NL * 16 * 1024; i += F.NGW * 64) { const int l = i / 16384, r = i % 16384, e = r / 1024, k = r % 1024;
          const float w = w_router[((size_t)l * 1024 + k) * 16 + e]; const unsigned hi = f2bf(w); const unsigned lo = f2bf(w - bflo(hi));
          WRT[((size_t)l * 2 + 0) * 16384 + r] = (bf16_t)hi; WRT[((size_t)l * 2 + 1) * 16384 + r] = (bf16_t)lo; } }
    if (blockIdx.x == 0) {
        float* rope = (float*)(F.ws + WS_ROPE);
        for (int i = F.tid; i < 64 * 16; i += NTHR) { const int pos = i >> 4, fi = i & 15;
            const float inv = powf(10000.0f, -(float)(2 * fi) / 32.0f); const float ang = (float)pos * inv;
            rope[2 * i] = cosf(ang); rope[2 * i + 1] = sinf(ang); }
    }
    __syncthreads();
    LAS float* sc = (LAS float*)F.lds;
    LAS float* part = (LAS float*)(F.lds + 17 * 1024 * 4);
    for (int i = F.tid; i < 17 * 1024; i += NTHR) { const float v = (i < 16 * 1024) ? c_in[i] : cctx_in[i - 16 * 1024]; sc[i] = v * sigmoidf_(v); }
    __syncthreads();
    float* MOD = (float*)(F.ws + WS_MOD);
    for (int item = F.vcu; item < NL * 96; item += F.G) {
        const int l = item / 96, n0 = (item % 96) * 64;
        float acc[17];
#pragma unroll
        for (int r = 0; r < 17; ++r) acc[r] = 0.f;
        const float* wp = ada_w + ((size_t)l * DM + F.wave * 128) * 6144 + n0 + F.lane;
        for (int kk0 = 0; kk0 < 128; kk0 += 16) {
            float w[16];
#pragma unroll
            for (int j = 0; j < 16; ++j) w[j] = wp[(size_t)(kk0 + j) * 6144];
#pragma unroll
            for (int j = 0; j < 16; ++j) {
                const int k = F.wave * 128 + kk0 + j;
#pragma unroll
                for (int r = 0; r < 17; ++r) acc[r] += sc[r * 1024 + k] * w[j];
            }
        }
#pragma unroll
        for (int r = 0; r < 17; ++r) part[(F.wave * 17 + r) * 64 + F.lane] = acc[r];
        __syncthreads();
        for (int idx = F.tid; idx < 17 * 64; idx += NTHR) { const int r = idx >> 6, j = idx & 63; float s = 0.f;
#pragma unroll
            for (int w = 0; w < 8; ++w) s += part[(w * 17 + r) * 64 + j];
            MOD[((size_t)l * 17 + r) * 6144 + n0 + j] = s + ada_b[(size_t)l * 6144 + n0 + j]; }
        __syncthreads();
    }
}

__device__ __forceinline__ void convert_experts(Frame& F, int l, const float* exp_gate, const float* exp_up, const float* exp_down, int wk, int nwk, int it_lo, int it_hi) {
    LAS float* scr = (LAS float*)(F.lds + F.wave * 16384);
    bf16_t* Wup = (bf16_t*)(F.ws + WS_WUP); bf16_t* Wdn = (bf16_t*)(F.ws + WS_WDN);
    constexpr int I_M = 16 * 32;
    for (int it = it_lo + wk; it < it_hi; it += nwk) {
        const int which = it / (NEXP * I_M), r = it % (NEXP * I_M), e = r / I_M, q = r % I_M, kb = q / 32, nb = q % 32, n0 = nb * 32;
        const float* W = (which == 0 ? exp_gate : (which == 1 ? exp_up : exp_down)) + ((size_t)l * NEXP + e) * DM * EFF;
        if (which < 2) { const int drow = 256 * (n0 >> 7) + 128 * which + (n0 & 127);
            transpose_item(W, EFF, kb * 64, n0, Wup + ((size_t)e * 2048 + drow) * DM + kb * 64, DM, scr, F.lane); }
        else transpose_item(W, DM, kb * 64, n0, Wdn + ((size_t)e * 1024 + n0) * EFF + kb * 64, EFF, scr, F.lane);
    }
}

struct N1Row { f32x4 v[4]; int slot; float gate; int row; bool ok; };
__device__ __forceinline__ void n1_load(Frame& F, N1Row& R, int row, int nrows, int l, const float* x_in, const float* ctx_in) {
    R.ok = row < nrows; R.row = R.ok ? row : 0;
    const bool lat = R.row < NLAT;
    if (l == 0) {
        const float* xs = lat ? x_in + (size_t)R.row * DM : ctx_in + (size_t)(R.row - NLAT) * DM;
#pragma unroll
        for (int j = 0; j < 4; ++j) R.v[j] = *(const f32x4*)(xs + 4 * F.lane + 256 * j);
    } else {
        const bf16_t* xb = (const bf16_t*)(F.ws + WS_XB) + (size_t)R.row * DM + 4 * F.lane;
#pragma unroll
        for (int j = 0; j < 4; ++j) { const u32x2 w = *(const u32x2*)(xb + 256 * j); R.v[j] = (f32x4){bflo(w.x), bfhi(w.x), bflo(w.y), bfhi(w.y)}; }
    }
    R.slot = -1; R.gate = 0.f;
    if (l > 0) { R.slot = ((const int*)(F.ws + WS_SLOT))[(size_t)R.row * 16 + (F.lane & 15)]; R.gate = ((const float*)(F.ws + WS_AFF))[(size_t)R.row * 16 + (F.lane & 15)]; }
}
__device__ __forceinline__ void n1_finish(Frame& F, N1Row& R, int l, const float* norm1, const float* final_norm, bool dry) {
    const bool fin = (l == NL);
    const float* MOD = (const float*)(F.ws + WS_MOD);
    const bf16_t* YE = (const bf16_t*)(F.ws + WS_YE); bf16_t* H = (bf16_t*)(F.ws + WS_H);
    const int row = R.row; const bool lat = row < NLAT; const int b = lat ? (row >> 11) : ((row - NLAT) >> 8); const int modrow = lat ? b : 16;
    bf16_t* xbw = (bf16_t*)(F.ws + WS_XB) + (size_t)row * DM;
    if (dry) { xbw = (bf16_t*)(F.ws + WS_WAG) + (size_t)row * DM; H = (bf16_t*)(F.ws + WS_YF); }
    if (l > 0) {
        f32x4 a[4];
#pragma unroll
        for (int j = 0; j < 4; ++j) a[j] = (f32x4){0.f, 0.f, 0.f, 0.f};
        unsigned mask = (unsigned)(__ballot(R.slot >= 0 && F.lane < 16));
        const size_t pbase = (size_t)(lat ? b * CAPL : NB * CAPL + b * CAPC);
        while (mask) {
            const int e0 = __builtin_ctz(mask); mask &= mask - 1u;
            const bool two = mask != 0u; const int e1 = two ? __builtin_ctz(mask) : e0; if (two) mask &= mask - 1u;
            const int s0 = __builtin_amdgcn_readlane(R.slot, e0), s1 = __builtin_amdgcn_readlane(R.slot, e1);
            const float g0 = __builtin_bit_cast(float, __builtin_amdgcn_readlane(__builtin_bit_cast(int, R.gate), e0));
            const float g1 = two ? __builtin_bit_cast(float, __builtin_amdgcn_readlane(__builtin_bit_cast(int, R.gate), e1)) : 0.f;
            const bf16_t* y0 = YE + ((size_t)e0 * PAIRS_E + pbase + s0) * DM + 4 * F.lane;
            const bf16_t* y1 = YE + ((size_t)e1 * PAIRS_E + pbase + s1) * DM + 4 * F.lane;
            u32x2 w0[4], w1[4];
#pragma unroll
            for (int j = 0; j < 4; ++j) { w0[j] = *(const u32x2*)(y0 + 256 * j); w1[j] = *(const u32x2*)(y1 + 256 * j); }
#pragma unroll
            for (int j = 0; j < 4; ++j) {
                a[j][0] += g0 * bflo(w0[j].x) + g1 * bflo(w1[j].x); a[j][1] += g0 * bfhi(w0[j].x) + g1 * bfhi(w1[j].x);
                a[j][2] += g0 * bflo(w0[j].y) + g1 * bflo(w1[j].y); a[j][3] += g0 * bfhi(w0[j].y) + g1 * bfhi(w1[j].y);
            }
        }
        const float* g2 = MOD + ((size_t)(l - 1) * 17 + modrow) * 6144 + 5 * 1024 + 4 * F.lane;
#pragma unroll
        for (int j = 0; j < 4; ++j) R.v[j] += *(const f32x4*)(g2 + 256 * j) * a[j];
    }
    if (!fin && R.ok) {
#pragma unroll
        for (int j = 0; j < 4; ++j) { u32x2 w; w.x = pk2(R.v[j][0], R.v[j][1]); w.y = pk2(R.v[j][2], R.v[j][3]); *(u32x2*)(xbw + 4 * F.lane + 256 * j) = w; }
    }
    float ss = 0.f;
#pragma unroll
    for (int j = 0; j < 4; ++j) ss += (R.v[j][0] * R.v[j][0] + R.v[j][1] * R.v[j][1]) + (R.v[j][2] * R.v[j][2] + R.v[j][3] * R.v[j][3]);
    const float rstd = rsq_(wave_sum(ss) * (1.0f / DM) + NORM_EPS);
    if (!R.ok) return;
    if (fin) {
        const float* gn = final_norm + 4 * F.lane;
#pragma unroll
        for (int j = 0; j < 4; ++j) *(f32x4*)(F.out + (size_t)row * DM + 4 * F.lane + 256 * j) = R.v[j] * rstd * *(const f32x4*)(gn + 256 * j);
    } else {
        const float* gn = norm1 + (size_t)l * DM + 4 * F.lane;
        const float* md = MOD + ((size_t)l * 17 + modrow) * 6144 + 4 * F.lane;
#pragma unroll
        for (int j = 0; j < 4; ++j) {
            const f32x4 h = R.v[j] * rstd * *(const f32x4*)(gn + 256 * j) * (*(const f32x4*)(md + 1024 + 256 * j) + 1.0f) + *(const f32x4*)(md + 256 * j);
            u32x2 w; w.x = pk2(h[0], h[1]); w.y = pk2(h[2], h[3]);
            *(u32x2*)(H + (size_t)row * DM + 4 * F.lane + 256 * j) = w;
        }
    }
}
__device__ __forceinline__ void phase_norm1(Frame& F, int l, const float* x_in, const float* ctx_in, const float* norm1, const float* final_norm, bool dry = false) {
    const int nrows = (l == NL) ? NLAT : NTOK;
    for (int row = F.gw; row < nrows; row += 4 * F.NGW) {
        N1Row A, B, C, D;
        n1_load(F, A, row, nrows, l, x_in, ctx_in); n1_load(F, B, row + F.NGW, nrows, l, x_in, ctx_in); n1_load(F, C, row + 2 * F.NGW, nrows, l, x_in, ctx_in); n1_load(F, D, row + 3 * F.NGW, nrows, l, x_in, ctx_in);
        n1_finish(F, A, l, norm1, final_norm, dry); n1_finish(F, B, l, norm1, final_norm, dry); n1_finish(F, C, l, norm1, final_norm, dry); n1_finish(F, D, l, norm1, final_norm, dry);
    }
}

struct PrepRow { u32x4 q, k, bg, cg[3], u[3], lr[3]; };
__device__ __forceinline__ void prep_load(PrepRow& R, const bf16_t* pr, int t, int slen, int lane) {
    const bool hp = t > 0, hn = t + 1 < slen; const u32x4 z = {0u, 0u, 0u, 0u};
    R.q = *(const u32x4*)(pr + C_Q + 8 * lane); R.k = *(const u32x4*)(pr + C_K + 8 * (lane & 15));
    R.bg = *(const u32x4*)(pr + C_BG + 8 * lane);
    R.cg[0] = *(const u32x4*)(pr + C_CG + 8 * lane); R.u[0] = *(const u32x4*)(pr + C_U + 8 * lane);
    R.cg[1] = hp ? *(const u32x4*)(pr - PW + C_CG + 8 * lane) : z; R.u[1] = hp ? *(const u32x4*)(pr - PW + C_U + 8 * lane) : z;
    R.cg[2] = hn ? *(const u32x4*)(pr + PW + C_CG + 8 * lane) : z; R.u[2] = hn ? *(const u32x4*)(pr + PW + C_U + 8 * lane) : z;
    const int ll = lane < 48 ? lane : 47;
    R.lr[0] = *(const u32x4*)(pr + C_WLO + 8 * ll);
    R.lr[1] = hp ? *(const u32x4*)(pr - PW + C_WLO + 8 * ll) : z; R.lr[2] = hn ? *(const u32x4*)(pr + PW + C_WLO + 8 * ll) : z;
}
__device__ __forceinline__ void phase_prep(Frame& F, int l, const float* q_gain, const float* k_gain, const float* conv_w, const float* shift_mu, bool dry = false) {
    bf16_t* P = (bf16_t*)(F.ws + WS_PROJ); bf16_t* LRA = (bf16_t*)(F.ws + WS_LRA);
    LAS float* rope = (LAS float*)F.lds;
    for (int i = F.tid; i < 64 * 16 * 2; i += NTHR) rope[i] = ((const float*)(F.ws + WS_ROPE))[i];
    __syncthreads();
    const int lane = F.lane, s8 = lane & 7;
    float qg[8], kg[8], cw0[8], cw1[8], cw2[8], mu[8];
#pragma unroll
    for (int i = 0; i < 8; ++i) { qg[i] = q_gain[l * 64 + s8 * 8 + i]; kg[i] = k_gain[l * 64 + s8 * 8 + i];
        cw0[i] = conv_w[((size_t)l * 3 + 0) * 512 + 8 * lane + i]; cw1[i] = conv_w[((size_t)l * 3 + 1) * 512 + 8 * lane + i]; cw2[i] = conv_w[((size_t)l * 3 + 2) * 512 + 8 * lane + i];
        mu[i] = (lane < 48) ? shift_mu[(size_t)l * 1920 + (C_WLO - C_RW) + 8 * lane + i] : 0.f; }
    for (int row0 = F.gw; row0 < NTOK; row0 += 2 * F.NGW) {
        const int row1 = row0 + F.NGW; const bool ok1 = row1 < NTOK;
        PrepRow RR[2]; int tt[2]; bool latt[2];
#pragma unroll
        for (int z = 0; z < 2; ++z) { const int row = (z == 0 || !ok1) ? row0 : row1; latt[z] = row < NLAT; tt[z] = latt[z] ? (row & 2047) : ((row - NLAT) & 255);
            prep_load(RR[z], P + (size_t)row * PW, tt[z], latt[z] ? SEQ : CTXL, lane); }
#pragma unroll
        for (int z = 0; z < 2; ++z) {
            if (z == 1 && !ok1) break;
            const int row = z == 0 ? row0 : row1; const PrepRow& R = RR[z]; const bool lat = latt[z]; const int t = tt[z];
            bf16_t* pr = P + (size_t)row * PW;
#pragma unroll
            for (int which = 0; which < 2; ++which) {
                float x[8]; unpack8(which == 0 ? R.q : R.k, x);
                float ss = 0.f;
#pragma unroll
                for (int i = 0; i < 8; ++i) ss += x[i] * x[i];
                ss = sum8(ss);
                const float rstd = rsq_(ss * (1.0f / 64.0f) + NORM_EPS);
#pragma unroll
                for (int i = 0; i < 8; ++i) x[i] = x[i] * rstd * (which == 0 ? qg[i] : kg[i]);
                if (lat) {
                    const int pos = (s8 < 4) ? (t >> 6) : (t & 63);
                    float o[8];
#pragma unroll
                    for (int i = 0; i < 8; ++i) {
                        const float partner = dpp_f(x[i], 1);
                        const int fi = (s8 & 1) * 8 + i;
                        const float c = rope[(pos * 16 + fi) * 2], sn = rope[(pos * 16 + fi) * 2 + 1];
                        o[i] = (s8 & 2) ? (partner * sn + x[i] * c) : (x[i] * c - partner * sn);
                    }
#pragma unroll
                    for (int i = 0; i < 8; ++i) x[i] = o[i];
                }
                if (which == 0) {
#pragma unroll
                    for (int i = 0; i < 8; ++i) x[i] *= QSCALE;
                    if (!dry) st8(pr + C_Q + 8 * lane, x);
                } else if (lane < 16 && !dry) st8(pr + C_K + 8 * lane, x);
            }
            {
                float bg[8], c0[8], u0[8], z0[8], zp[8], zn[8];
                unpack8(R.bg, bg);
                unpack8(R.cg[0], c0); unpack8(R.u[0], u0);
#pragma unroll
                for (int i = 0; i < 8; ++i) z0[i] = c0[i] * u0[i];
                unpack8(R.cg[1], c0); unpack8(R.u[1], u0);
#pragma unroll
                for (int i = 0; i < 8; ++i) zp[i] = c0[i] * u0[i];
                unpack8(R.cg[2], c0); unpack8(R.u[2], u0);
#pragma unroll
                for (int i = 0; i < 8; ++i) zn[i] = c0[i] * u0[i];
                float o[8];
#pragma unroll
                for (int i = 0; i < 8; ++i) o[i] = bg[i] * (cw0[i] * zp[i] + cw1[i] * z0[i] + cw2[i] * zn[i]);
                if (!dry) st8(pr + C_OCONV + 8 * lane, o);
            }
            {
                float x[8], xp[8], xn[8], o[8];
                unpack8(R.lr[0], x); unpack8(R.lr[1], xp); unpack8(R.lr[2], xn);
#pragma unroll
                for (int i = 0; i < 8; ++i) { const float sft = x[i] + mu[i] * (0.5f * (xp[i] + xn[i]) - x[i]);
                    const float sg = sigmoidf_(lane < 16 ? 2.0f * sft : sft); o[i] = lane < 16 ? 2.0f * sg - 1.0f : (lane < 32 ? sft : sg); }
                if (lane < 48) st8(LRA + (size_t)row * LRAW + 8 * lane, o);
            }
        }
    }
}
__device__ __forceinline__ void n2_modulate(Frame& F, f32x4 (&v)[4], int row, int l, const float* norm2) {
    const float* MOD = (const float*)(F.ws + WS_MOD); bf16_t* H = (bf16_t*)(F.ws + WS_H);
    const bool lat = row < NLAT; const int b = lat ? (row >> 11) : ((row - NLAT) >> 8); const int modrow = lat ? b : 16;
    float ss = 0.f;
#pragma unroll
    for (int j = 0; j < 4; ++j) ss += (v[j][0] * v[j][0] + v[j][1] * v[j][1]) + (v[j][2] * v[j][2] + v[j][3] * v[j][3]);
    const float rstd = rsq_(wave_sum(ss) * (1.0f / DM) + NORM_EPS);
    const float* gn = norm2 + (size_t)l * DM + 4 * F.lane;
    const float* md = MOD + ((size_t)l * 17 + modrow) * 6144 + 3 * 1024 + 4 * F.lane;
#pragma unroll
    for (int j = 0; j < 4; ++j) {
        v[j] = v[j] * rstd * *(const f32x4*)(gn + 256 * j) * (*(const f32x4*)(md + 1024 + 256 * j) + 1.0f) + *(const f32x4*)(md + 256 * j);
        u32x2 w; w.x = pk2(v[j][0], v[j][1]); w.y = pk2(v[j][2], v[j][3]);
        *(u32x2*)(H + (size_t)row * DM + 4 * F.lane + 256 * j) = w;
    }
}
__device__ __forceinline__ void n2_softmax_store(Frame& F, float (&lg)[16], int row) {
    float* AFF = (float*)(F.ws + WS_AFF);
    float mx = lg[0];
#pragma unroll
    for (int e = 1; e < 16; ++e) mx = fmaxf(mx, lg[e]);
    float den = 0.f;
#pragma unroll
    for (int e = 0; e < 16; ++e) { lg[e] = __expf(lg[e] - mx); den += lg[e]; }
    const float inv = rcp_(den);
    float mine = 0.f;
#pragma unroll
    for (int e = 0; e < 16; ++e) mine = (F.lane == e) ? lg[e] * inv : mine;
    if (F.lane < 16) AFF[(size_t)row * 16 + F.lane] = mine;
}
__device__ __forceinline__ void phase_norm2_router(Frame& F, int l, int nrows, const float* norm2, const float* w_router) {
    LAS float* wrT = (LAS float*)F.lds;
    for (int i = F.tid; i < 16 * 1024; i += NTHR) { const int c = i >> 4, e = i & 15; wrT[e * 1024 + c] = w_router[(size_t)l * DM * 16 + i]; }
    __syncthreads();
    const bf16_t* XB = (const bf16_t*)(F.ws + WS_XB);
    for (int row = F.gw; row < nrows; row += 2 * F.NGW) {
        const int row1 = row + F.NGW; const bool ok1 = row1 < nrows; const int r1 = ok1 ? row1 : row;
        f32x4 v0[4], v1[4];
#pragma unroll
        for (int j = 0; j < 4; ++j) { const u32x2 a = *(const u32x2*)(XB + (size_t)row * DM + 4 * F.lane + 256 * j), b = *(const u32x2*)(XB + (size_t)r1 * DM + 4 * F.lane + 256 * j);
            v0[j] = (f32x4){bflo(a.x), bfhi(a.x), bflo(a.y), bfhi(a.y)}; v1[j] = (f32x4){bflo(b.x), bfhi(b.x), bflo(b.y), bfhi(b.y)}; }
        n2_modulate(F, v0, row, l, norm2);
        n2_modulate(F, v1, r1, l, norm2);
        float lg0[16], lg1[16];
#pragma unroll
        for (int e = 0; e < 16; ++e) {
            float s0 = 0.f, s1 = 0.f;
#pragma unroll
            for (int j = 0; j < 4; ++j) { const f32x4 w = *(const LAS f32x4*)(wrT + e * 1024 + 4 * F.lane + 256 * j);
                s0 += (v0[j][0] * w[0] + v0[j][1] * w[1]) + (v0[j][2] * w[2] + v0[j][3] * w[3]); s1 += (v1[j][0] * w[0] + v1[j][1] * w[1]) + (v1[j][2] * w[2] + v1[j][3] * w[3]); }
            lg0[e] = wave_sum(s0); lg1[e] = wave_sum(s1);
            if ((e & 3) == 3) __builtin_amdgcn_sched_barrier(0);
        }
        n2_softmax_store(F, lg0, row);
        if (ok1) n2_softmax_store(F, lg1, row1);
    }
}

__device__ __forceinline__ float qsum4(float x) {
    x += __shfl_xor(x, 16); x += __shfl_xor(x, 32);
    return x;
}
__device__ __forceinline__ void n2_tile(Frame& F, int row0, const LAS float* Gs, const LAS float* Sh, const bf16_t* WRh, const bf16_t* WRl) {
    const int lane = F.lane, r = lane & 15, q = lane >> 4;
    const bf16_t* xrow = (const bf16_t*)(F.ws + WS_XB) + (size_t)(row0 + r) * DM + 8 * q;
    bf16_t* hrow = (bf16_t*)(F.ws + WS_H) + (size_t)(row0 + r) * DM + 8 * q;
    const bf16_t* wh = WRh + (size_t)r * 1024 + 8 * q; const bf16_t* wl = WRl + (size_t)r * 1024 + 8 * q;
    float ss = 0.f;
#pragma unroll 8
    for (int s = 0; s < 32; ++s) { float x[8]; ld8(xrow + 32 * s, x);
#pragma unroll
        for (int j = 0; j < 8; ++j) ss += x[j] * x[j]; }
    const float rstd = rsq_(qsum4(ss) * (1.0f / DM) + NORM_EPS);
    f32x4 acc = {0.f, 0.f, 0.f, 0.f};
#pragma unroll 2
    for (int s = 0; s < 32; ++s) {
        float x[8]; ld8(xrow + 32 * s, x);
        const f32x4 g0 = *(const LAS f32x4*)(Gs + 32 * s + 8 * q), g1 = *(const LAS f32x4*)(Gs + 32 * s + 8 * q + 4), h0 = *(const LAS f32x4*)(Sh + 32 * s + 8 * q), h1 = *(const LAS f32x4*)(Sh + 32 * s + 8 * q + 4);
        const bf16x8 bh = *(const bf16x8*)(wh + 32 * s), bl = *(const bf16x8*)(wl + 32 * s);
        float h[8];
#pragma unroll
        for (int j = 0; j < 4; ++j) { h[j] = x[j] * rstd * g0[j] + h0[j]; h[4 + j] = x[4 + j] * rstd * g1[j] + h1[j]; }
        u32x4 hw; hw.x = pk2(h[0], h[1]); hw.y = pk2(h[2], h[3]); hw.z = pk2(h[4], h[5]); hw.w = pk2(h[6], h[7]);
        *(u32x4*)(hrow + 32 * s) = hw;
        u32x4 lw; lw.x = pk2(h[0] - bflo(hw.x), h[1] - bfhi(hw.x)); lw.y = pk2(h[2] - bflo(hw.y), h[3] - bfhi(hw.y)); lw.z = pk2(h[4] - bflo(hw.z), h[5] - bfhi(hw.z)); lw.w = pk2(h[6] - bflo(hw.w), h[7] - bfhi(hw.w));
        const bf16x8 ah = __builtin_bit_cast(bf16x8, hw), al = __builtin_bit_cast(bf16x8, lw);
        acc = __builtin_amdgcn_mfma_f32_16x16x32_bf16(ah, bh, acc, 0, 0, 0);
        acc = __builtin_amdgcn_mfma_f32_16x16x32_bf16(ah, bl, acc, 0, 0, 0);
        acc = __builtin_amdgcn_mfma_f32_16x16x32_bf16(al, bh, acc, 0, 0, 0);
    }
    float* AFF = (float*)(F.ws + WS_AFF);
#pragma unroll
    for (int g = 0; g < 4; ++g) {
        float mx = acc[g];
#pragma unroll
        for (int c_ = 0; c_ < 4; ++c_) mx = fmaxf(mx, dpp_f(mx, c_));
        const float e = __expf(acc[g] - mx);
        float den = e;
#pragma unroll
        for (int c_ = 0; c_ < 4; ++c_) den += dpp_f(den, c_);
        AFF[(size_t)(row0 + 4 * q + g) * 16 + r] = e * rcp_(den);
    }
}
__device__ __forceinline__ void phase_norm2_router_mfma(Frame& F, int l, int nrows, const float* norm2) {
    LAS float* Gs = (LAS float*)F.lds;
    LAS float* Sh = Gs + 2048;
    const float* MOD = (const float*)(F.ws + WS_MOD);
    const int b = (F.vcu * NWAVES * 16) >> 11;
    for (int i = F.tid; i < 2048; i += NTHR) { const int c = i & 1023, modrow = i < 1024 ? b : 16; const float* md = MOD + ((size_t)l * 17 + modrow) * 6144 + 3 * 1024;
        Gs[i] = norm2[(size_t)l * DM + c] * (1.0f + md[1024 + c]); Sh[i] = md[c]; }
    __syncthreads();
    const bf16_t* WRh = (const bf16_t*)(F.ws + WS_WRT) + (size_t)l * 2 * 16384; const bf16_t* WRl = WRh + 16384;
    n2_tile(F, 16 * F.gw, Gs, Sh, WRh, WRl);
    if (nrows > NLAT && F.wave == 0) n2_tile(F, NLAT + 16 * F.vcu, Gs + 1024, Sh + 1024, WRh, WRl);
}

__device__ __forceinline__ int block_sum_i(LAS int* red, int& par, int wave_val, int wave, int lane) {
    if (lane == 0) red[par * 8 + wave] = wave_val;
    __syncthreads();
    int s = 0;
#pragma unroll
    for (int w = 0; w < 8; ++w) s += red[par * 8 + w];
    par ^= 1;
    return s;
}
__device__ __forceinline__ int block_exscan_i(LAS int* red, int& par, int val, int wave, int lane) {
    int inc = val;
#pragma unroll
    for (int o = 1; o < 64; o <<= 1) { const int t = __shfl_up(inc, o); if (lane >= o) inc += t; }
    if (lane == 63) red[par * 8 + wave] = inc;
    __syncthreads();
    int base = 0;
#pragma unroll
    for (int w = 0; w < 8; ++w) base += (w < wave) ? red[par * 8 + w] : 0;
    par ^= 1;
    return base + inc - val;
}
__device__ __forceinline__ void topk_set(Frame& F, LAS int* red, int& par, int n, int cap, int rowbase, int e, int listbase) {
    const float* AFF = (const float*)(F.ws + WS_AFF); int* LIST = (int*)(F.ws + WS_LIST); int* SLOT = (int*)(F.ws + WS_SLOT);
    unsigned key[4];
#pragma unroll
    for (int j = 0; j < 4; ++j) { const int tok = 4 * F.tid + j; key[j] = (tok < n) ? __builtin_bit_cast(unsigned, AFF[(size_t)(rowbase + tok) * 16 + e]) : 0u; }
    unsigned T = 0u;
    for (int bit = 30; bit >= 0; --bit) {
        const unsigned cand = T | (1u << bit);
        int c = 0;
#pragma unroll
        for (int j = 0; j < 4; ++j) c += __popcll(__ballot(key[j] >= cand));
        if (block_sum_i(red, par, c, F.wave, F.lane) >= cap) T = cand;
    }
    int cgt = 0, ceq = 0;
#pragma unroll
    for (int j = 0; j < 4; ++j) { cgt += __popcll(__ballot(key[j] > T)); ceq += (key[j] == T) ? 1 : 0; }
    const int n_gt = block_sum_i(red, par, cgt, F.wave, F.lane);
    const int need_eq = cap - n_gt;
    int eqrank = block_exscan_i(red, par, ceq, F.wave, F.lane);
    int sel[4], csel = 0;
#pragma unroll
    for (int j = 0; j < 4; ++j) { const bool eq = key[j] == T; sel[j] = (key[j] > T || (eq && eqrank < need_eq)) ? 1 : 0; eqrank += eq ? 1 : 0; csel += sel[j]; }
    int slot = block_exscan_i(red, par, csel, F.wave, F.lane);
#pragma unroll
    for (int j = 0; j < 4; ++j) { const int tok = 4 * F.tid + j;
        if (tok < n) { SLOT[(size_t)(rowbase + tok) * 16 + e] = sel[j] ? slot : -1; if (sel[j]) { LIST[listbase + slot] = rowbase + tok; ++slot; } } }
}
__device__ __forceinline__ void phase_topk(Frame& F, bool need_ctx) {
    LAS int* red = (LAS int*)F.lds; int par = 0;
    for (int pair = F.vcu; pair < NB * NEXP; pair += F.G) {
        const int b = pair >> 4, e = pair & 15;
        topk_set(F, red, par, SEQ, CAPL, b * SEQ, e, e * PAIRS_E + b * CAPL);
        if (need_ctx) topk_set(F, red, par, CTXL, CAPC, NLAT + b * CTXL, e, e * PAIRS_E + NB * CAPL + b * CAPC);
    }
}

constexpr int SC_STEPS = 32;
constexpr int CS_AT = 0, CS_BT = 4608, CS_KT = 9216, CS_RT = 13824;
constexpr int CS_BKT = 18432, CS_WC = CS_BKT + 2 * 4352, CS_SET = CS_WC + 512;
__device__ __forceinline__ int cs_bkt(int sc, int c) { return sc * 4352 + c * 64 + 32 * (c >> 3); }
__device__ __forceinline__ int cs_vt(int sc, int v) { return sc * 2176 + v * 32 + 16 * (v >> 3); }
constexpr int CS_WT = 2 * CS_SET, CS_NM = CS_WT + 1024, CS_ABK = CS_NM + 2560, CS_AVT = CS_ABK + 2 * 2560, CS_TT = CS_AVT + 2 * 10240, CS_CONV = CS_TT + 1024;
constexpr int CS_CST = CS_CONV + 4 * 4224, CS_YO = CS_CST + 1536, CS_VTR = CS_YO + 4608, CS_VTSZ = 2 * 2176;
static_assert(CS_SET % 16 == 0 && CS_VTR + 3 * CS_VTSZ <= MISC_OFF, "scan lds map");
__device__ __forceinline__ void scan_chunk_geom(int ci, int b, int d, int s, int& slen, int& t, size_t& row) {
    constexpr int NC = CTXL / SC_STEPS;
    const bool ctx = ci < NC; slen = ctx ? CTXL : SEQ; const int c0 = (ctx ? ci : ci - NC) * SC_STEPS; const int rowbase = ctx ? NLAT + b * CTXL : b * SEQ;
    t = d == 0 ? (c0 + s) : (slen - 1 - (c0 + s)); row = (size_t)(rowbase + t);
}
#define CS_MMA(x_, y_, c_) __builtin_amdgcn_mfma_f32_16x16x32_bf16(x_, y_, c_, 0, 0, 0)
__device__ __forceinline__ bf16x8 cs_ld16(const LAS char* p) { return *(const LAS bf16x8*)p; }
__device__ __forceinline__ bf16x8 cs_ld8x2(const LAS char* p0, const LAS char* p1) { const u32x2 a = *(const LAS u32x2*)p0, b = *(const LAS u32x2*)p1; const u32x4 w = {a.x, a.y, b.x, b.y}; return __builtin_bit_cast(bf16x8, w); }
__device__ __forceinline__ void cs_st16(LAS char* p, float x) { *(LAS unsigned short*)p = (unsigned short)pk2(x, x); }
#define CS_UD4(v_) asm volatile("" : "=v"(v_.x), "=v"(v_.y), "=v"(v_.z), "=v"(v_.w))
#define CS_UD8(a_) asm volatile("" : "=v"(a_[0]), "=v"(a_[1]), "=v"(a_[2]), "=v"(a_[3]), "=v"(a_[4]), "=v"(a_[5]), "=v"(a_[6]), "=v"(a_[7]))
#define CS_UNDEF_ALL() do { CS_UD4(rx[0]); CS_UD4(rx[1]); CS_UD4(rx[2]); CS_UD4(rp[0]); CS_UD4(rp[1]); CS_UD4(rp[2]); CS_UD4(rn[0]); CS_UD4(rn[1]); CS_UD4(rn[2]); CS_UD4(wu); CS_UD4(wa); \
        CS_UD8(pr_); CS_UD8(pkk); CS_UD8(pb); CS_UD8(pkd); asm volatile("" : "=v"(cv[0]), "=v"(cv[1]), "=v"(cv[2]), "=v"(cv[3]), "=v"(cv[4]), "=v"(cv[5]), "=v"(cv[6]), "=v"(cv[7])); \
        asm volatile("" : "=v"(cv[8]), "=v"(cv[9]), "=v"(cv[10]), "=v"(cv[11]), "=v"(cv[12]), "=v"(cv[13]), "=v"(cv[14]), "=v"(cv[15])); asm volatile("" : "=v"(cv_it)); } while (0)
#define CS_BAR() asm volatile("s_waitcnt lgkmcnt(0)\n\ts_barrier" ::: "memory")
template <int PR>
__device__ __forceinline__ void phase_scan(Frame& F, int l, const float* shift_mu, const float* rwkv_kk, const float* rwkv_ka, const float* exp_gate, const float* exp_up, const float* exp_down, const float* rwkv_rk, bool noconv_ = false) {
    const bool noconv = noconv_ || PR != 0;
    const bf16_t* P = (const bf16_t*)(F.ws + WS_PROJ); const bf16_t* WAG = (const bf16_t*)(F.ws + WS_WAG);
    LAS char* LB = (LAS char*)F.lds;
    const int tid = F.tid;
    const bool teamS = F.wave < 4;
    constexpr bool skipS = (PR & 1) != 0, skipP = (PR & 2) != 0, skipY = (PR & 4) != 0, skipS2 = (PR & 8) != 0, skipS3 = (PR & 16) != 0, skipP2 = (PR & 32) != 0;
    const int wv = F.wave & 3;
    const int pt = tid & 255, s = pt >> 3, cg = pt & 7;
    const int psc = s >> 4, pts = s & 15;
    constexpr int NCH = (CTXL + SEQ) / SC_STEPS;
    for (int chain = F.vcu; chain < 2 * NB * 8; chain += F.G) {
        const int d = chain >> 7, b = (chain >> 3) & 15, h = chain & 7;
        bf16_t* Y = (bf16_t*)(F.ws + (d == 0 ? WS_YF : WS_YB));
        const int hc = h * 64 + 8 * cg;
        if (tid < 384) {
            const int a_ = tid >> 6, c_ = tid & 63;
            const float* src = a_ == 0 ? rwkv_rk + (size_t)l * 512 : a_ == 4 ? rwkv_kk + (size_t)l * 512 : a_ == 5 ? rwkv_ka + (size_t)l * 512 : shift_mu + (size_t)l * 1920 + 512 * (a_ - 1);
            ((LAS float*)(LB + CS_CST))[tid] = src[h * 64 + c_];
        }
        __syncthreads();
        f32x4 Sacc[4];
#pragma unroll
        for (int j = 0; j < 4; ++j) Sacc[j] = (f32x4){0.f, 0.f, 0.f, 0.f};
        float pr_[8], pkk[8], pb[8], pkd[8];
        u32x4 rx[3], rp[3], rn[3], wu, wa;
        float cv[16]; int cv_it = -1;
#define CS_FETCH(cix_, dep_) do { int slen_, t_; size_t row_; scan_chunk_geom((cix_), b, d, s + (dep_), slen_, t_, row_); const bf16_t* pr_g = P + row_ * PW + C_RW + hc; const bool hp_ = t_ > 0, hn_ = t_ + 1 < slen_; \
            const bf16_t* pr_p = pr_g - (hp_ ? PW : 0); const bf16_t* pr_n = pr_g + (hn_ ? PW : 0);        \
            _Pragma("unroll") for (int q = 0; q < 3; ++q) { rx[q] = *(const u32x4*)(pr_g + 512 * q); rp[q] = *(const u32x4*)(pr_p + 512 * q); rn[q] = *(const u32x4*)(pr_n + 512 * q); } \
            wu = *(const u32x4*)(WAG + row_ * WAGW + d * 512 + hc); wa = *(const u32x4*)(WAG + row_ * WAGW + 1024 + d * 512 + hc); } while (0)
#pragma unroll
        for (int i = 0; i < 16; ++i) cv[i] = 0.f;
        if (!teamS) CS_FETCH(0, 0);
        for (int ci = -2; ci < NCH; ++ci) {
            int lane = F.lane; asm volatile("" : "+v"(lane));
            const int r16 = lane & 15, q4 = lane >> 4;
            const int s = ((tid & 255) >> 6) * 8 + (lane >> 3), cg = lane & 7;
            const int psc = s >> 4, pts = s & 15;
            const int hc = h * 64 + 8 * cg;
            const LAS char* set0 = LB + (ci & 1) * CS_SET;
            const LAS char* set1 = LB + ((ci + 1) & 1) * CS_SET;
            if (teamS) {
                if (ci >= 0 && !skipS && !skipS3) {
                    const LAS char* setc = set0; const LAS char* vtc = LB + CS_VTR + (ci % 3) * CS_VTSZ; const LAS char* abk = LB + CS_ABK + (ci & 1) * 2560;
                    const int vrow = 16 * wv + r16;
#pragma unroll
                    for (int sc = 0; sc < 2; ++sc) {
                        bf16x8 sop[2];
#pragma unroll
                        for (int kk = 0; kk < 2; ++kk) { const u32x4 w = {pk2(Sacc[2 * kk][0], Sacc[2 * kk][1]), pk2(Sacc[2 * kk][2], Sacc[2 * kk][3]), pk2(Sacc[2 * kk + 1][0], Sacc[2 * kk + 1][1]), pk2(Sacc[2 * kk + 1][2], Sacc[2 * kk + 1][3])}; sop[kk] = __builtin_bit_cast(bf16x8, w); }
                        f32x4 uacc = *(const LAS f32x4*)(LB + CS_AVT + (ci & 1) * 10240 + (sc * 64 + vrow) * 80 + 16 * q4);
                        f32x4 yacc = {0.f, 0.f, 0.f, 0.f};
#pragma unroll
                        for (int kk = 0; kk < 2; ++kk) {
                            const LAS char* ah = setc + CS_AT + (16 * sc + r16) * 144 + 64 * kk + 8 * q4;
                            uacc = CS_MMA(cs_ld8x2(ah, ah + 32), sop[kk], uacc);
                            const LAS char* rt = setc + CS_RT + (16 * sc + r16) * 144 + 64 * kk + 8 * q4;
                            yacc = CS_MMA(cs_ld8x2(rt, rt + 32), sop[kk], yacc);
                        }
                        {
                            const u32x2 t2 = *(const LAS u32x2*)(LB + CS_TT + (sc * 16 + r16) * 32 + 8 * q4);
                            const u32x4 tw = {t2.x, t2.y, 0u, 0u}, pw = {pk2(uacc[0], uacc[1]), pk2(uacc[2], uacc[3]), 0u, 0u};
                            uacc = CS_MMA(__builtin_bit_cast(bf16x8, tw), __builtin_bit_cast(bf16x8, pw), ((f32x4){0.f, 0.f, 0.f, 0.f}));
                        }
                        const u32x2 v2 = *(const LAS u32x2*)(vtc + cs_vt(sc, vrow) + 8 * q4);
                        const u32x4 uvw = {pk2(uacc[0], uacc[1]), pk2(uacc[2], uacc[3]), v2.x, v2.y};
                        const bf16x8 uv = __builtin_bit_cast(bf16x8, uvw);
                        yacc = CS_MMA(cs_ld16(abk + (sc * 16 + r16) * 80 + 16 * q4), uv, yacc);
#pragma unroll
                        for (int tile = 0; tile < 4; ++tile) {
                            const f32x4 wc = *(const LAS f32x4*)(setc + CS_WC + (sc * 64 + 16 * tile + 4 * q4) * 4);
                            Sacc[tile] = CS_MMA(cs_ld16(setc + CS_BKT + cs_bkt(sc, 16 * tile + r16) + 16 * q4), uv, Sacc[tile] * wc);
                        }
#pragma unroll
                        for (int g = 0; g < 4; ++g) cs_st16(LB + CS_YO + (16 * sc + 4 * q4 + g) * 144 + 2 * vrow, yacc[g]);
                    }
                }
                if (ci + 1 >= 0 && ci + 1 < NCH && !skipS) {
                    const LAS char* setc = set1; const LAS char* vtc = LB + CS_VTR + ((ci + 1) % 3) * CS_VTSZ; LAS char* abk = LB + CS_ABK + ((ci + 1) & 1) * 2560;
                    const int sc = wv >> 1, role = wv & 1;
                    const LAS char* yop = setc + (role == 0 ? CS_AT : CS_RT) + (16 * sc + r16) * 144 + 16 * q4;
                    const LAS char* xb = setc + CS_BT + (16 * sc + r16) * 144 + 16 * q4;
                    const LAS char* xk = setc + CS_KT + (16 * sc + r16) * 144 + 16 * q4;
                    f32x4 accB = {0.f, 0.f, 0.f, 0.f}, accK = {0.f, 0.f, 0.f, 0.f};
#pragma unroll
                    for (int kk = 0; kk < 2; ++kk) { const bf16x8 yv = cs_ld16(yop + 64 * kk); accB = CS_MMA(cs_ld16(xb + 64 * kk), yv, accB); accK = CS_MMA(cs_ld16(xk + 64 * kk), yv, accK); }
                    if (role == 0) {
                        f32x4 nm; float ak[4];
#pragma unroll
                        for (int g = 0; g < 4; ++g) { const bool keep = 4 * q4 + g < r16; nm[g] = keep ? accB[g] : 0.f; ak[g] = keep ? accK[g] : 0.f; }
                        *(LAS f32x4*)(LB + CS_NM + (sc * 16 + r16) * 80 + 16 * q4) = nm;
                        const u32x4 xw = {pk2(ak[0], ak[1]), pk2(ak[2], ak[3]), 0u, 0u};
                        const bf16x8 xop = __builtin_bit_cast(bf16x8, xw);
#pragma unroll
                        for (int vt = 0; vt < 4; ++vt) {
                            const u32x2 v2 = *(const LAS u32x2*)(vtc + cs_vt(sc, 16 * vt + r16) + 8 * q4);
                            const u32x4 yw = {v2.x, v2.y, 0u, 0u};
                            f32x4 av = {0.f, 0.f, 0.f, 0.f};
                            av = CS_MMA(xop, __builtin_bit_cast(bf16x8, yw), av);
                            *(LAS f32x4*)(LB + CS_AVT + ((ci + 1) & 1) * 10240 + (sc * 64 + 16 * vt + r16) * 80 + 16 * q4) = av;
                        }
                    } else {
                        float rb[4], rk[4];
#pragma unroll
                        for (int g = 0; g < 4; ++g) { const bool keep = 4 * q4 + g <= r16; rb[g] = keep ? accB[g] : 0.f; rk[g] = keep ? accK[g] : 0.f; }
                        const u32x4 w = {pk2(rb[0], rb[1]), pk2(rb[2], rb[3]), pk2(rk[0], rk[1]), pk2(rk[2], rk[3])};
                        *(LAS u32x4*)(abk + (sc * 16 + r16) * 80 + 16 * q4) = w;
                    }
                }
                CS_UNDEF_ALL();
            } else {
              {
                  LAS float* scr = (LAS float*)(LB + CS_CONV) + (F.wave - 4) * (32 * 33);
                  convert_expert_finish32(F.ws, cv_it, cv, scr, F.lane);
              }
              int dep = 0;
              if (ci + 2 < NCH && !skipP) {
                int slen, t; size_t row;
                scan_chunk_geom(ci + 2, b, d, s, slen, t, row);
                const bool hp = t > 0, hn = t + 1 < slen;
                const LAS float* cst = (const LAS float*)(LB + CS_CST) + 8 * cg;
                float k[8], pv[8];
#pragma unroll
                for (int q = 0; q < 3; ++q) {
                    float x[8], xp[8], xn[8];
                    const unsigned mp = hp ? 0xffffffffu : 0u, mn = hn ? 0xffffffffu : 0u;
                    unpack8(rx[q], x); unpack8((u32x4){rp[q].x & mp, rp[q].y & mp, rp[q].z & mp, rp[q].w & mp}, xp); unpack8((u32x4){rn[q].x & mn, rn[q].y & mn, rn[q].z & mn, rn[q].w & mn}, xn);
                    const f32x4 m0 = *(const LAS f32x4*)(cst + 64 * (1 + q)), m1 = *(const LAS f32x4*)(cst + 64 * (1 + q) + 4);
#pragma unroll
                    for (int i = 0; i < 8; ++i) { const float m = i < 4 ? m0[i & 3] : m1[i & 3]; const float sft = x[i] + m * (0.5f * (xp[i] + xn[i]) - x[i]);
                        if (q == 0) pr_[i] = sft; else if (q == 1) k[i] = sft; else pv[i] = sft; }
                    __builtin_amdgcn_sched_barrier(0);
                }
                __builtin_amdgcn_sched_barrier(0);
                float pu[8], ag[8];
                unpack8(wu, pu); unpack8(wa, ag);
#pragma unroll
                for (int i = 0; i < 8; ++i) pu[i] *= 1.4426950408889634f;
                asm volatile("" : "+v"(dep) : "v"(pu[0]), "v"(pu[1]), "v"(pu[2]), "v"(pu[3]), "v"(pu[4]), "v"(pu[5]), "v"(pu[6]), "v"(pu[7]), "v"(ag[0]), "v"(ag[1]), "v"(ag[2]), "v"(ag[3]), "v"(ag[4]), "v"(ag[5]), "v"(ag[6]), "v"(ag[7]), "v"(pr_[0]), "v"(k[0]), "v"(pv[0]), "v"(pr_[7]), "v"(k[7]), "v"(pv[7]));
                CS_FETCH(ci + 3 < NCH ? ci + 3 : NCH - 1, dep);
#pragma unroll
                for (int i = 0; i < 8; ++i) cs_st16(LB + CS_VTR + ((ci + 2) % 3) * CS_VTSZ + cs_vt(psc, 8 * cg + i) + 2 * pts, pv[i]);
                if (d == 0) {
                    const f32x4 k0 = *(const LAS f32x4*)(cst), k1 = *(const LAS f32x4*)(cst + 4);
                    float bs = 0.f, bo[8];
#pragma unroll
                    for (int i = 0; i < 8; ++i) bs += pr_[i] * k[i] * (i < 4 ? k0[i & 3] : k1[i & 3]);
                    bs = sum8(bs);
#pragma unroll
                    for (int i = 0; i < 8; ++i) bo[i] = bs * pv[i];
                    st8((bf16_t*)(F.ws + WS_BON) + row * 512 + hc, bo);
                }
                LAS float* ub = (LAS float*)(LB + CS_CONV + (F.wave - 4) * 4224) + (s & 7) * 64 + 8 * cg;
                *(LAS f32x4*)ub = (f32x4){pu[0], pu[1], pu[2], pu[3]}; *(LAS f32x4*)(ub + 4) = (f32x4){pu[4], pu[5], pu[6], pu[7]};
                {
                    float pl[8];
                    const int srcA = ((lane >> 4) - 1) * 16 + 8 + cg, srcB = ((lane >> 4) - 2) * 16 + 8 + cg;
#pragma unroll
                    for (int i = 0; i < 8; ++i) pl[i] = pu[i] + __builtin_bit_cast(float, __builtin_amdgcn_update_dpp(0, __builtin_bit_cast(int, pu[i]), 0x118, 0xF, 0xF, true));
#pragma unroll
                    for (int i = 0; i < 8; ++i) { const float t_ = __builtin_bit_cast(float, __builtin_amdgcn_ds_bpermute(srcA * 4, __builtin_bit_cast(int, pl[i]))); pl[i] += lane >= 16 ? t_ : 0.f; }
#pragma unroll
                    for (int i = 0; i < 8; ++i) { const float t_ = __builtin_bit_cast(float, __builtin_amdgcn_ds_bpermute(srcB * 4, __builtin_bit_cast(int, pl[i]))); pl[i] += lane >= 32 ? t_ : 0.f; }
                    if (lane >= 56) { LAS float* wt = (LAS float*)(LB + CS_WT) + (s >> 3) * 64 + 8 * cg; *(LAS f32x4*)wt = (f32x4){pl[0], pl[1], pl[2], pl[3]}; *(LAS f32x4*)(wt + 4) = (f32x4){pl[4], pl[5], pl[6], pl[7]}; }
                    LAS float* ub2 = ub + 512;
                    *(LAS f32x4*)ub2 = (f32x4){pl[0], pl[1], pl[2], pl[3]}; *(LAS f32x4*)(ub2 + 4) = (f32x4){pl[4], pl[5], pl[6], pl[7]};
                }
                const f32x4 kk0 = *(const LAS f32x4*)(cst + 64 * 4), kk1 = *(const LAS f32x4*)(cst + 64 * 4 + 4), ka0 = *(const LAS f32x4*)(cst + 64 * 5), ka1 = *(const LAS f32x4*)(cst + 64 * 5 + 4);
                float kks[8], n2 = 0.f;
#pragma unroll
                for (int i = 0; i < 8; ++i) { kks[i] = k[i] * (i < 4 ? kk0[i & 3] : kk1[i & 3]); n2 += kks[i] * kks[i]; }
                n2 = sum8(n2);
                const float rn_ = rsq_(n2 + 1e-12f);
#pragma unroll
                for (int i = 0; i < 8; ++i) { pkk[i] = kks[i] * rn_; pb[i] = pkk[i] * ag[i]; pkd[i] = k[i] * (1.0f + (ag[i] - 1.0f) * (i < 4 ? ka0[i & 3] : ka1[i & 3])); }
              }
            }
            CS_BAR();
            if (teamS) {
                if (ci + 1 >= 0 && ci + 1 < NCH && !skipS && !skipS2) {
                    const LAS char* setc = set1;
                    const int sc = wv >> 1, part = wv & 1;
                    if (part == 0) {
                        const LAS float* nrow = (const LAS float*)(LB + CS_NM + sc * 1280);
                        float xs[16];
#pragma unroll
                        for (int t = 0; t < 16; ++t) xs[t] = t == r16 ? 1.0f : 0.0f;
#pragma unroll
                        for (int t = 1; t < 16; ++t) {
                            float a3[3] = {xs[t], 0.f, 0.f};
#pragma unroll
                            for (int i4 = 0; i4 < (t + 3) / 4; ++i4) {
                                const f32x4 n4 = *(const LAS f32x4*)(nrow + t * 20 + 4 * i4);
#pragma unroll
                                for (int jx = 0; jx < 4; ++jx) if (4 * i4 + jx < t) a3[(4 * i4 + jx) % 3] += n4[jx] * xs[4 * i4 + jx];
                            }
                            xs[t] = (a3[0] + a3[1]) + a3[2];
                        }
                        if (lane < 16) {
#pragma unroll
                            for (int t = 0; t < 16; ++t) cs_st16(LB + CS_TT + (sc * 16 + t) * 32 + 2 * lane, xs[t]);
                        }
                    }
                }
                CS_UNDEF_ALL();
            } else {
              {
                  const int pw = F.vcu * 4 + (F.wave - 4), npw = F.G * 4;
                  const int it = ((ci / 3) * 2 + (ci % 3)) * npw + pw;
                  const bool valid = ci >= 0 && ci % 3 != 2 && chain < F.G && !noconv && it < 3 * NEXP * 1024;
                  cv_it = valid ? it : -1;
                  convert_expert_issue32(l, valid ? it : pw, exp_gate, exp_up, exp_down, cv, lane);
              }
              if (ci + 2 < NCH && !skipP && !skipP2) {
                LAS char* setn = LB + (ci & 1) * CS_SET;
                float li[8], lt[8];
                const LAS float* ub = (const LAS float*)(LB + CS_CONV + (F.wave - 4) * 4224) + (s & 7) * 64 + 8 * cg;
                {
                    const int wq = s >> 3;
                    const LAS float* w0 = (const LAS float*)(LB + CS_WT) + wq * 64 + 8 * cg; const LAS float* w1 = (const LAS float*)(LB + CS_WT) + (wq ^ 1) * 64 + 8 * cg;
                    const f32x4 a0 = *(const LAS f32x4*)w0, a1 = *(const LAS f32x4*)(w0 + 4), b0 = *(const LAS f32x4*)w1, b1 = *(const LAS f32x4*)(w1 + 4);
                    const float m = (wq & 1) ? 1.0f : 0.0f;
                    const LAS float* ub2 = ub + 512;
                    const f32x4 p0 = *(const LAS f32x4*)ub2, p1 = *(const LAS f32x4*)(ub2 + 4);
#pragma unroll
                    for (int i = 0; i < 4; ++i) { lt[i] = a0[i] + b0[i]; lt[4 + i] = a1[i] + b1[i]; li[i] = p0[i] + m * b0[i]; li[4 + i] = p1[i] + m * b1[i]; }
                }
                float at[8], bt[8], kt[8], rt[8], bh[8], kh[8], pu[8];
                { const f32x4 u0 = *(const LAS f32x4*)(ub), u1 = *(const LAS f32x4*)(ub + 4); pu[0] = u0[0]; pu[1] = u0[1]; pu[2] = u0[2]; pu[3] = u0[3]; pu[4] = u1[0]; pu[5] = u1[1]; pu[6] = u1[2]; pu[7] = u1[3]; }
#pragma unroll
                for (int i = 0; i < 8; ++i) {
                    const float wt = __builtin_amdgcn_exp2f(-li[i]), wprev = __builtin_amdgcn_exp2f(pu[i] - li[i]), iw = __builtin_amdgcn_exp2f(li[i]), wrest = __builtin_amdgcn_exp2f(li[i] - lt[i]);
                    at[i] = -pkk[i] * wprev; bt[i] = pb[i] * iw; kt[i] = pkd[i] * iw; rt[i] = pr_[i] * wt; bh[i] = pb[i] * wrest; kh[i] = pkd[i] * wrest;
                }
                *(LAS u32x4*)(setn + CS_AT + s * 144 + 16 * cg) = pack8(at);
                *(LAS u32x4*)(setn + CS_BT + s * 144 + 16 * cg) = pack8(bt);
                *(LAS u32x4*)(setn + CS_KT + s * 144 + 16 * cg) = pack8(kt);
                *(LAS u32x4*)(setn + CS_RT + s * 144 + 16 * cg) = pack8(rt);
#pragma unroll
                for (int i = 0; i < 8; ++i) {
                    const int c = 8 * cg + i;
                    LAS char* bk = setn + CS_BKT + cs_bkt(psc, c) + 16 * (pts >> 2) + 2 * (pts & 3);
                    cs_st16(bk, bh[i]); cs_st16(bk + 8, kh[i]);
                }
                if (pts == 15) {
                    LAS float* wc = (LAS float*)(setn + CS_WC) + psc * 64 + 8 * cg;
                    *(LAS f32x4*)wc = (f32x4){__builtin_amdgcn_exp2f(-lt[0]), __builtin_amdgcn_exp2f(-lt[1]), __builtin_amdgcn_exp2f(-lt[2]), __builtin_amdgcn_exp2f(-lt[3])}; *(LAS f32x4*)(wc + 4) = (f32x4){__builtin_amdgcn_exp2f(-lt[4]), __builtin_amdgcn_exp2f(-lt[5]), __builtin_amdgcn_exp2f(-lt[6]), __builtin_amdgcn_exp2f(-lt[7])};
                }
            }
              if (ci >= 0 && !(skipS || skipS3 || skipY)) {
                  int slen, t; size_t row;
                  scan_chunk_geom(ci, b, d, s, slen, t, row);
                  *(u32x4*)(Y + row * 512 + hc) = *(const LAS u32x4*)(LB + CS_YO + s * 144 + 16 * cg);
              }
            }
            CS_BAR();
        }
        if (!teamS) { LAS float* scr = (LAS float*)(LB + CS_CONV) + (F.wave - 4) * (32 * 33); convert_expert_finish32(F.ws, cv_it, cv, scr, F.lane); }
        __syncthreads();
#undef CS_FETCH
    }
}
#undef CS_MMA

struct RoRow { u32x4 yf, yb, bo, g; };
__device__ __forceinline__ void ro_load(Frame& F, RoRow& R, int row) {
    const int lane = F.lane;
    R.yf = *(const u32x4*)((const bf16_t*)(F.ws + WS_YF) + (size_t)row * 512 + 8 * lane); R.yb = *(const u32x4*)((const bf16_t*)(F.ws + WS_YB) + (size_t)row * 512 + 8 * lane);
    R.bo = *(const u32x4*)((const bf16_t*)(F.ws + WS_BON) + (size_t)row * 512 + 8 * lane);
    R.g = *(const u32x4*)((const bf16_t*)(F.ws + WS_WAG) + (size_t)row * WAGW + 2048 + 8 * lane);
}
__device__ __forceinline__ void phase_readout(Frame& F, int l, int nrows, const float* gn_w, const float* gn_b) {
    bf16_t* P = (bf16_t*)(F.ws + WS_PROJ);
    const int lane = F.lane;
    float gw[8], gb[8];
#pragma unroll
    for (int i = 0; i < 8; ++i) { gw[i] = gn_w[(size_t)l * 512 + 8 * lane + i]; gb[i] = gn_b[(size_t)l * 512 + 8 * lane + i]; }
    for (int row0 = F.gw; row0 < nrows; row0 += 4 * F.NGW) {
        RoRow RR[4]; int rows[4]; bool ok[4];
#pragma unroll
        for (int z = 0; z < 4; ++z) { rows[z] = row0 + z * F.NGW; ok[z] = rows[z] < nrows; ro_load(F, RR[z], ok[z] ? rows[z] : row0); }
#pragma unroll
        for (int z = 0; z < 4; ++z) {
            if (!ok[z]) continue;
            const RoRow& R = RR[z];
            float yf[8], yb[8], y[8];
            unpack8(R.yf, yf); unpack8(R.yb, yb);
            float sm = 0.f;
#pragma unroll
            for (int i = 0; i < 8; ++i) { y[i] = yf[i] + yb[i]; sm += y[i]; }
            const float mean = sum8(sm) * (1.0f / 64.0f);
            float sq = 0.f;
#pragma unroll
            for (int i = 0; i < 8; ++i) { y[i] -= mean; sq += y[i] * y[i]; }
            const float rstd = rsq_(sum8(sq) * (1.0f / 64.0f) + GN_EPS);
            float bo[8], g[8], o[8];
            unpack8(R.bo, bo); unpack8(R.g, g);
#pragma unroll
            for (int i = 0; i < 8; ++i) o[i] = (y[i] * rstd * gw[i] + gb[i] + bo[i]) * g[i];
            st8(P + (size_t)rows[z] * PW + C_ORWKV + 8 * lane, o);
        }
    }
}
__device__ __forceinline__ void phase_attention(Frame& F, bool need_ctx, char* lds_generic) {
    typedef attn_body::bf16 abf;
    abf* P = (abf*)(F.ws + WS_PROJ);
    const int nu = (need_ctx && F.vcu < NB * 8) ? 5 : 4;
    for (int i = 0; i < nu; ++i) {
        int b, h, qrow, NT;
        if (i < 4) { const int u = F.vcu * 4 + i; b = u >> 6; h = (u >> 3) & 7; qrow = b * SEQ + (u & 7) * 256; NT = (CTXL + SEQ) / 64; }
        else { b = F.vcu >> 3; h = F.vcu & 7; qrow = NLAT + b * CTXL; NT = CTXL / 64; }
        abf* Qu = P + (size_t)qrow * PW + C_Q + h * 64;
        attn_body::attn_unit<8>(Qu, Qu + (C_OATT - C_Q), P + C_K + (h >> 2) * 64, NLAT + b * CTXL, b * SEQ, NT, CTXL / 64, lds_generic);
    }
}

struct Args { const float* in[32]; float* out; unsigned char* ws; int ph_lo, ph_hi; };
constexpr int PH_PER_LAYER = 12, PH_FINAL = 1 + NL * PH_PER_LAYER, PH_END = PH_FINAL + 1;

__global__ void __launch_bounds__(NTHR, 2) mega_fwd(Args args) {
    extern __shared__ __attribute__((aligned(16))) unsigned char lds[];
    Frame F;
    F.lds = (LAS unsigned char*)lds;
    F.tid = threadIdx.x; F.lane = F.tid & 63; F.wave = __builtin_amdgcn_readfirstlane(F.tid >> 6);
    F.G = gridDim.x; { const int bx = blockIdx.x; F.vcu = (F.G % 8 == 0) ? (bx % 8) * (F.G / 8) + bx / 8 : bx; }
    F.gw = F.vcu * NWAVES + F.wave; F.NGW = F.G * NWAVES; F.bid = blockIdx.x;
    F.out = args.out; F.ws = args.ws;
    volatile LAS unsigned* MISC = (volatile LAS unsigned*)(F.lds + MISC_OFF);
    for (int u = F.tid; u < (LDS_BYTES - MISC_OFF) / 4; u += NTHR) MISC[u] = 0u;
    __syncthreads();
    unsigned* ctl = (unsigned*)(F.ws + WS_CTL);
    XcdBarrier bar = xcd_barrier_post(ctl + CW_BAR, MISC + 8);
    const int lo = args.ph_lo, hi = args.ph_hi;
    typedef const __attribute__((address_space(1))) float* cfp_t;
#define KP(k) ((const float*)KIN[k])
#define KIN_DECL const __attribute__((address_space(4))) cfp_t* KIN = (const __attribute__((address_space(4))) cfp_t*)__builtin_amdgcn_kernarg_segment_ptr(); asm volatile("" : "+s"(KIN))
#ifndef PHMASK
#define PHMASK 0xFFFFFFFFu
#endif
#define IN(k) (lo <= (k) && (k) < hi)
#define EN(j) ((PHMASK >> (j)) & 1u)
#define SEAM(k) do { if ((k) + 1 < hi) xcd_barrier(bar); } while (0)
#ifndef DUPMASK
#define DUPMASK 0u
#endif
#define REP(j) for (int rep_ = 0; rep_ < 1 + (int)((DUPMASK >> (j)) & 1u); ++rep_)
#ifdef PROBE_T1
    unsigned long long pt0 = 0; int l_ = 0; volatile LAS unsigned* PTS = MISC + 64;
#define PB() do { pt0 = __builtin_amdgcn_s_memrealtime(); } while (0)
#define PE(j) do { PTS[(j) * 4 + (l_ & 3)] = (unsigned)(__builtin_amdgcn_s_memrealtime() - pt0); } while (0)
#else
#define PB() do {} while (0)
#define PE(j) do {} while (0)
#endif

    if (EN(0) && IN(0)) { relaunder(F); PB(); KIN_DECL; REP(0) phase_prologue(F, KP(1), KP(3), KP(4), KP(5), KP(7), KP(12), KP(14), KP(15), KP(22), KP(23), KP(24), KP(25), KP(27)); SEAM(0); PE(0); }

    for (int l = 0; l < NL; ++l) {
#ifdef PROBE_T1
        l_ = l;
#endif
        const int pb = 1 + l * PH_PER_LAYER;
        const bool need_ctx = l < NL - 1;
        const int nrows = need_ctx ? NTOK : NLAT;
        if (EN(1) && IN(pb + 0)) { relaunder(F); PB(); KIN_DECL; REP(1) phase_norm1(F, l, KP(0), KP(2), KP(6), KP(31), rep_ > 0); SEAM(pb + 0); PE(1); }
        if (EN(2) && IN(pb + 1)) { relaunder(F); PB();
            pg8::EpiProj E{(bf16_t*)(F.ws + WS_PROJ), F.ws + WS_GATES};
            if (need_ctx) { pg8::PlainOrder S; S.init(F.ws + WS_H, F.ws + WS_WIN + (size_t)l * PWP * DM * 2, NTOK, PWP, DM, DM, F.G, F.bid);
                REP(2) pg8::gemm_phase<pg8::EpiProj, pg8::PlainOrder, false>(F.lds, DM, DM, DM, S, E); }
            else { pg8::LastProjOrder S; S.init(F.ws + WS_H, F.ws + WS_WIN + (size_t)l * PWP * DM * 2, DM, DM, F.G, F.bid);
                pg8::gemm_phase<pg8::EpiProj, pg8::LastProjOrder, false>(F.lds, DM, DM, DM, S, E); }
            SEAM(pb + 1); PE(2);
        }
        if (EN(3) && IN(pb + 2)) { relaunder(F); PB(); KIN_DECL; REP(3) phase_prep(F, l, KP(8), KP(9), KP(21), KP(10), rep_ > 0); SEAM(pb + 2); PE(3); }
        if (EN(4) && IN(pb + 3)) { relaunder(F); PB();
            pg8::LowRankOrder S{(const char*)(F.ws + WS_LRA), (const char*)(F.ws + WS_WLR + (size_t)l * WAGW * 128 * 2), NTOK / 256, F.G, F.bid};
            KIN_DECL; pg8::EpiLowRank E{(bf16_t*)(F.ws + WS_WAG), KP(11) + (size_t)l * 1024, KP(13) + (size_t)l * 1024};
            int klr = 128; asm volatile("" : "+s"(klr));
            REP(4) pg8::gemm_phase<pg8::EpiLowRank, pg8::LowRankOrder, false>(F.lds, klr, LRAW, 128, S, E);
            REP(14) phase_attention(F, need_ctx, (char*)lds);
            SEAM(pb + 3); PE(4);
        }
        if (EN(5) && IN(pb + 4)) { relaunder(F); PB(); KIN_DECL; REP(5) phase_scan<0>(F, l, KP(10), KP(16), KP(17), KP(28), KP(29), KP(30), KP(18), rep_ > 0);
#ifdef SCAN_PROBE
            phase_scan<SCAN_PROBE>(F, l, KP(10), KP(16), KP(17), KP(28), KP(29), KP(30), KP(18), true);
#endif
 SEAM(pb + 4); PE(5); }
        if (EN(6) && IN(pb + 5)) { relaunder(F); PB(); KIN_DECL; REP(6) phase_readout(F, l, nrows, KP(19), KP(20)); SEAM(pb + 5); PE(6); }
        if (EN(7) && IN(pb + 6)) { relaunder(F); PB();
            pg8::MergeOrder S{(const char*)(F.ws + WS_PROJ), (const char*)(F.ws + WS_WBR + (size_t)l * 3 * 1024 * 512 * 2), nrows / 256, F.G, F.bid};
            pg8::EpiMerge E{(const unsigned char*)(F.ws + WS_GATES), (bf16_t*)(F.ws + WS_H)};
            REP(7) pg8::gemm_phase<pg8::EpiMerge, pg8::MergeOrder, false>(F.lds, 512, PW, 512, S, E);
            SEAM(pb + 6); PE(7);
        }
        if (EN(8) && IN(pb + 7)) { relaunder(F); PB();
            pg8::PlainOrder S; S.init(F.ws + WS_H, F.ws + WS_WOUT + (size_t)l * DM * DM * 2, nrows, DM, DM, DM, F.G, F.bid);
            pg8::EpiOut E{(bf16_t*)(F.ws + WS_XB), (const float*)(F.ws + WS_MOD) + (size_t)l * 17 * 6144};
            pg8::gemm_phase<pg8::EpiOut, pg8::PlainOrder, false>(F.lds, DM, DM, DM, S, E);
            SEAM(pb + 7); PE(8);
        }
        if (EN(9) && IN(pb + 8)) { relaunder(F); PB(); KIN_DECL; REP(9) phase_norm2_router_mfma(F, l, nrows, KP(26)); SEAM(pb + 8); PE(9); }
        if (EN(10) && IN(pb + 9)) { relaunder(F); PB(); REP(10) phase_topk(F, need_ctx); SEAM(pb + 9); PE(10); }
        if (EN(11) && IN(pb + 10)) { relaunder(F); PB();
            const int mt_per = need_ctx ? 18 : 16;
            LAS int* rows = (LAS int*)(F.lds + XTRA_OFF);
            pg8::MoeOrder S{(const char*)(F.ws + WS_H), (const char*)(F.ws + WS_WUP), rows, mt_per, 8, F.G, F.bid, (size_t)2048 * 1024 * 2};
            const int* LIST = (const int*)(F.ws + WS_LIST);
            for (int i = 0; i < XTRA_BYTES / 1024; ++i) { int e, mt, pn; if (!S.decode((long)i * F.G + F.bid, e, mt, pn)) break;
                if (F.tid < 256) rows[i * 256 + F.tid] = LIST[e * PAIRS_E + mt * 256 + F.tid]; }
            __syncthreads();
            pg8::EpiUp E{(bf16_t*)(F.ws + WS_HID)};
            REP(11) pg8::gemm_phase<pg8::EpiUp, pg8::MoeOrder, true>(F.lds, DM, DM, DM, S, E);
            SEAM(pb + 10); PE(11);
        }
        if (EN(12) && IN(pb + 11)) { relaunder(F); PB();
            const int mt_per = need_ctx ? 18 : 16;
            pg8::MoeDownOrder S{(const char*)(F.ws + WS_HID), (const char*)(F.ws + WS_WDN), mt_per, F.G, F.bid};
            pg8::EpiDown E{(bf16_t*)(F.ws + WS_YE)};
            REP(12) pg8::gemm_phase<pg8::EpiDown, pg8::MoeDownOrder, false>(F.lds, EFF, EFF, EFF, S, E);
            SEAM(pb + 11); PE(12);
        }
    }
    if (EN(13) && IN(PH_FINAL)) { relaunder(F); PB(); KIN_DECL; phase_norm1(F, NL, KP(0), KP(2), KP(6), KP(31)); PE(13); }
#ifdef PROBE_T1
    {
        __syncthreads();
        if (blockIdx.x == 0 && threadIdx.x == 0) { unsigned s1 = 0, s2 = 0; for (int q = 0; q < 4; ++q) { s1 += PTS[PROBE_T1 * 4 + q]; s2 += PTS[PROBE_T2 * 4 + q]; } ctl[CW_DBG] = s1; ctl[CW_DBG + 1] = s2; }
        xcd_barrier(bar);
        const float t1 = (float)__hip_atomic_load(ctl + CW_DBG, __ATOMIC_RELAXED, __HIP_MEMORY_SCOPE_AGENT), t2 = (float)__hip_atomic_load(ctl + CW_DBG + 1, __ATOMIC_RELAXED, __HIP_MEMORY_SCOPE_AGENT);
        const float cval = 10.0f * sqrtf(t1 * 0.01f);
        for (size_t i = (size_t)F.bid * NTHR + F.tid; i < (size_t)NLAT * DM; i += (size_t)F.G * NTHR) F.out[i] = (i == 0) ? t2 : cval;
    }
#endif
#undef IN
#undef SEAM
}

extern "C" void kernel_launch(void* const* d_in, const int* in_sizes, int n_in, void* d_out, int out_size, void* d_ws, size_t ws_size, hipStream_t stream) {
    static int grid = 0;
    if (grid == 0) {
        if (n_in != 32 || in_sizes[0] != NLAT * DM || out_size != NLAT * DM || ws_size < WS_END) { fprintf(stderr, "kernel_launch: unexpected shapes / workspace (n_in %d, ws %zu)\n", n_in, ws_size); grid = -1; return; }
        int dev = 0, cus = 0, per_cu = 0;
        if (hipGetDevice(&dev) != hipSuccess || hipDeviceGetAttribute(&cus, hipDeviceAttributeMultiprocessorCount, dev) != hipSuccess) { grid = -1; return; }
        if (hipFuncSetAttribute((const void*)mega_fwd, hipFuncAttributeMaxDynamicSharedMemorySize, LDS_BYTES) != hipSuccess) { grid = -1; return; }
        if (hipOccupancyMaxActiveBlocksPerMultiprocessor(&per_cu, (const void*)mega_fwd, NTHR, LDS_BYTES) != hipSuccess || per_cu < 1) { fprintf(stderr, "kernel_launch: occupancy query says %d\n", per_cu); }
        (void)hipGetLastError();
        grid = cus;
        if (grid != 256) { fprintf(stderr, "kernel_launch: built for 256 CUs, got %d\n", grid); grid = -1; return; }
    }
    if (grid < 0) return;
    if (hipMemsetAsync((char*)d_ws + WS_CTL, 0, CTL_ZERO_BYTES, stream) != hipSuccess) return;
    Args a{};
    for (int i = 0; i < 32; ++i) a.in[i] = (const float*)d_in[i];
    a.out = (float*)d_out; a.ws = (unsigned char*)d_ws;
#ifndef MK_PER_PHASE
    a.ph_lo = 0; a.ph_hi = PH_END;
    hipLaunchKernelGGL(mega_fwd, dim3(grid), dim3(NTHR), LDS_BYTES, stream, a);
#else
    for (int p = 0; p < PH_END; ++p) { a.ph_lo = p; a.ph_hi = p + 1; hipLaunchKernelGGL(mega_fwd, dim3(grid), dim3(NTHR), LDS_BYTES, stream, a); }
#endif
}
```

```cpp
#include <hip/hip_runtime.h>
#include <hip/hip_bf16.h>
#include <cstdio>
#include <cstdint>
#include <cmath>

#define LAS __attribute__((address_space(3)))
typedef unsigned short bf16_t;
typedef short bf16x8 __attribute__((ext_vector_type(8)));
typedef float f32x4 __attribute__((ext_vector_type(4)));
typedef float f32x2 __attribute__((ext_vector_type(2)));
typedef unsigned u32x4 __attribute__((ext_vector_type(4)));
typedef unsigned u32x2 __attribute__((ext_vector_type(2)));

constexpr int DM = 1024, NB = 16, SEQ = 2048, NL = 4, CTXL = 256;
constexpr int NLAT = NB * SEQ;
constexpr int NCTX = NB * CTXL;
constexpr int NTOK = NLAT + NCTX;
constexpr int PW = 4224;
constexpr int NCOLS_IN = 7296;
constexpr int PWP = 7424;
constexpr int C_Q = 0, C_K = 512, C_V = 640, C_RW = 768, C_R = 768, C_RK = 1280, C_RV = 1792, C_WLO = 2304, C_ALO = 2432, C_GLO = 2560;
constexpr int C_BG = 2688, C_CG = 3200, C_U = 3712, C_GT = 4224;
constexpr int C_OATT = 3712, C_OCONV = 2688, C_ORWKV = 3200;
constexpr int WAGW = 2560;
constexpr int LRAW = 384;
constexpr int NEXP = 16, EFF = 1024, CAPL = 256, CAPC = 32, PAIRS_E = 4608;
constexpr float NORM_EPS = 1e-6f, GN_EPS = 64e-5f;
constexpr float QSCALE = 0.125f * 1.4426950408889634f;

constexpr size_t MiB = 1u << 20;
constexpr size_t WS_CTL = 0, CTL_ZERO_BYTES = 1 * MiB;
constexpr size_t WS_MOD = 1 * MiB;
constexpr size_t WS_ROPE = 3 * MiB;
constexpr size_t WS_WRT = 3 * MiB + 65536;
constexpr size_t WS_LIST = 4 * MiB;
constexpr size_t WS_SLOT = 5 * MiB;
constexpr size_t WS_AFF = 8 * MiB;
constexpr size_t WS_XC = 11 * MiB;
constexpr size_t WS_WIN = 27 * MiB;
constexpr size_t WS_WBR = 85 * MiB;
constexpr size_t WS_WOUT = 97 * MiB;
constexpr size_t WS_WLR = 105 * MiB;
constexpr size_t WS_WUP = 113 * MiB;
constexpr size_t WS_WDN = 177 * MiB;
constexpr size_t WS_H = 209 * MiB;
constexpr size_t WS_PROJ = 281 * MiB;
constexpr size_t WS_GATES = 578 * MiB;
constexpr size_t WS_HID = WS_PROJ;
constexpr size_t WS_YE = WS_PROJ + 144 * MiB;
constexpr size_t WS_XB = 686 * MiB;
constexpr size_t WS_WAG = 794 * MiB;
constexpr size_t WS_LRA = 974 * MiB;
constexpr size_t WS_YF = 1001 * MiB;
constexpr size_t WS_YB = 1037 * MiB;
constexpr size_t WS_BON = 1073 * MiB;
constexpr size_t WS_END = 1109 * MiB;
static_assert(WS_WIN + (size_t)NL * PWP * DM * 2 <= WS_WBR && WS_PROJ + (size_t)NTOK * PW * 2 <= WS_GATES && WS_GATES + (size_t)NTOK * 3072 <= WS_XB && WS_XB + (size_t)NTOK * DM * 2 <= WS_WAG && WS_WAG + (size_t)NTOK * WAGW * 2 <= WS_LRA && WS_LRA + (size_t)NTOK * LRAW * 2 <= WS_YF, "ws map");
static_assert(WS_YE + (size_t)NEXP * PAIRS_E * DM * 2 <= WS_GATES && WS_H + (size_t)NTOK * DM * 2 <= WS_PROJ, "ws map 2");
constexpr int CW_BAR = 4096;
constexpr int CW_DBG = 32768;

constexpr int RING_BYTES = 131072;
constexpr int XTRA_OFF = RING_BYTES;
constexpr int XTRA_BYTES = 12288;
constexpr int MISC_OFF = XTRA_OFF + XTRA_BYTES;
constexpr int LDS_BYTES = 147456;
static_assert(MISC_OFF + 256 <= LDS_BYTES, "lds map");
constexpr int NWAVES = 8, NTHR = 512;

__device__ __forceinline__ unsigned f2bf(float f) { unsigned u = __builtin_bit_cast(unsigned, f); return (u + 0x7fffu + ((u >> 16) & 1u)) >> 16; }
typedef __bf16 bf16v2 __attribute__((ext_vector_type(2)));
__device__ __forceinline__ unsigned pk2(float lo, float hi) { const f32x2 v = {lo, hi}; return __builtin_bit_cast(unsigned, __builtin_convertvector(v, bf16v2)); }
__device__ __forceinline__ float bflo(unsigned w) { return __builtin_bit_cast(float, w << 16); }
__device__ __forceinline__ float bfhi(unsigned w) { return __builtin_bit_cast(float, w & 0xffff0000u); }
__device__ __forceinline__ void unpack8(const u32x4 w, float (&f)[8]) { f[0] = bflo(w.x); f[1] = bfhi(w.x); f[2] = bflo(w.y); f[3] = bfhi(w.y); f[4] = bflo(w.z); f[5] = bfhi(w.z); f[6] = bflo(w.w); f[7] = bfhi(w.w); }
__device__ __forceinline__ u32x4 pack8(const float (&f)[8]) { u32x4 w; w.x = pk2(f[0], f[1]); w.y = pk2(f[2], f[3]); w.z = pk2(f[4], f[5]); w.w = pk2(f[6], f[7]); return w; }
__device__ __forceinline__ void ld8(const bf16_t* p, float (&f)[8]) { unpack8(*(const u32x4*)p, f); }
__device__ __forceinline__ void st8(bf16_t* p, const float (&f)[8]) { *(u32x4*)p = pack8(f); }
__device__ __forceinline__ float rcp_(float x) { return __builtin_amdgcn_rcpf(x); }
__device__ __forceinline__ float rsq_(float x) { return __builtin_amdgcn_rsqf(x); }
__device__ __forceinline__ float sigmoidf_(float x) { return rcp_(1.0f + __builtin_amdgcn_exp2f(-1.4426950408889634f * x)); }
__device__ __forceinline__ float tanhf_(float x) { return 2.0f * sigmoidf_(2.0f * x) - 1.0f; }
__device__ __forceinline__ float dpp_f(float x, const int ctrl_sel) {
    const int xi = __builtin_bit_cast(int, x); int r;
    if (ctrl_sel == 0) r = __builtin_amdgcn_update_dpp(0, xi, 0xB1, 0xF, 0xF, true);
    else if (ctrl_sel == 1) r = __builtin_amdgcn_update_dpp(0, xi, 0x4E, 0xF, 0xF, true);
    else if (ctrl_sel == 2) r = __builtin_amdgcn_update_dpp(0, xi, 0x141, 0xF, 0xF, true);
    else r = __builtin_amdgcn_update_dpp(0, xi, 0x140, 0xF, 0xF, true);
    return __builtin_bit_cast(float, r);
}
__device__ __forceinline__ float sum8(float x) { x += dpp_f(x, 0); x += dpp_f(x, 1); x += dpp_f(x, 2); return x; }
__device__ __forceinline__ float wave_sum(float x) {
    x += dpp_f(x, 0); x += dpp_f(x, 1); x += dpp_f(x, 2); x += dpp_f(x, 3);
    const int xi = __builtin_bit_cast(int, x);
    const float r0 = __builtin_bit_cast(float, __builtin_amdgcn_readlane(xi, 0)), r1 = __builtin_bit_cast(float, __builtin_amdgcn_readlane(xi, 16)),
                r2 = __builtin_bit_cast(float, __builtin_amdgcn_readlane(xi, 32)), r3 = __builtin_bit_cast(float, __builtin_amdgcn_readlane(xi, 48));
    return (r0 + r1) + (r2 + r3);
}
namespace pg8 {
constexpr int BM = 256, BK = 64, HALF = 128, HTB = HALF * BK * 2, STAGE_BYTES = 8 * HTB;
__host__ __device__ __forceinline__ int lds_byte(int r, int c) { const int st = (r >> 4) * 2 + (c >> 5), rr = r & 15, cc = c & 31, ob = rr * 64 + cc * 2; return st * 1024 + (ob ^ (((ob >> 9) & 1) << 5)); }
__host__ __device__ __forceinline__ void stage_rc(int b, int& R, int& C) { const int st = b / 1024, sb = b % 1024, swz = sb ^ (((sb >> 9) & 1) << 5); R = (st >> 1) * 16 + swz / 64; C = (st & 1) * 32 + (swz % 64) / 2; }
__host__ __device__ __forceinline__ int perm32(int rho) { const int n = rho >> 4, i = rho & 15; return 8 * (i >> 2) + 4 * n + (i & 3); }
__device__ __forceinline__ unsigned cvt_pk_bf16(float lo, float hi) { unsigned r; asm volatile("v_cvt_pk_bf16_f32 %0, %1, %2" : "=v"(r) : "v"(lo), "v"(hi)); return r; }

struct GUnit { const char* A; const char* B; int pm, pn, x0, x1; };

template <class Epi, class Sched, bool GATHER>
__device__ __forceinline__ void gemm_phase(LAS unsigned char* lds, const int K, const int lda, const int ldb, const Sched& S, const Epi& E) {
    int tid_ = threadIdx.x; asm volatile("" : "+v"(tid_));
    const int tid = tid_, wid = __builtin_amdgcn_readfirstlane(tid >> 6), lane = tid & 63, wr = wid >> 2, wc = wid & 3, fr = lane & 15, fq = lane >> 4;
    const int nt = K / BK;
    int sR[2], sC[2];
    unsigned voffA[2][2], voffB[2], voffAn[2][2];
#pragma unroll
    for (int i = 0; i < 2; ++i) { int R, C; stage_rc(tid * 16 + i * 8192, R, C); sR[i] = R; sC[i] = C; const int Rb = Epi::PERM ? ((R & ~31) + perm32(R & 31)) : R;
        voffB[i] = (unsigned)(Rb * ldb + C) * 2u;
#pragma unroll
        for (int h = 0; h < 2; ++h) { voffA[h][i] = (unsigned)((h * HALF + R) * lda + C) * 2u; voffAn[h][i] = voffA[h][i]; } }
    const size_t kstep = (size_t)(BK * 2);
    const size_t hstepB = (size_t)HALF * ldb * 2;
    const unsigned ldsw = (unsigned)wid * 1024u;
    const int aoff = lds_byte(wr * 64 + fr, fq * 8), boff = lds_byte(wc * 32 + fr, fq * 8);
#define PG8_SA(b, h) (((b) * 2 + (h)) * HTB)
#define PG8_SB(b, h) ((4 + (b) * 2 + (h)) * HTB)
#define PG8_STAGE(bufoff, gbase, voff) do { _Pragma("unroll") for (int _i = 0; _i < 2; ++_i) \
        __builtin_amdgcn_global_load_lds((const unsigned*)((const char*)(gbase) + (voff)[_i]), (LAS unsigned*)(lds + (bufoff) + ldsw + _i * 8192), 16, 0, 0); } while (0)
#define PG8_LDA(dst, b, h) do { _Pragma("unroll") for (int m = 0; m < 4; ++m) _Pragma("unroll") for (int k = 0; k < 2; ++k) dst[m][k] = *(const LAS bf16x8*)(lds + PG8_SA(b, h) + aoff + m * 2048 + k * 1024); } while (0)
#define PG8_LDB(dst, b, h) do { _Pragma("unroll") for (int n = 0; n < 2; ++n) _Pragma("unroll") for (int k = 0; k < 2; ++k) dst[n][k] = *(const LAS bf16x8*)(lds + PG8_SB(b, h) + boff + n * 2048 + k * 1024); } while (0)
#define PG8_MMA(ai, bj, At, Bt) do { __builtin_amdgcn_s_setprio(1); _Pragma("unroll") for (int m = 0; m < 4; ++m) _Pragma("unroll") for (int n = 0; n < 2; ++n) _Pragma("unroll") for (int k = 0; k < 2; ++k) \
        acc[ai][bj][m][n] = __builtin_amdgcn_mfma_f32_16x16x32_bf16(Bt[n][k], At[m][k], acc[ai][bj][m][n], 0, 0, 0); __builtin_amdgcn_s_setprio(0); } while (0)
#define PG8_WAIT_V(n) asm volatile("s_waitcnt vmcnt(" #n ")" ::: "memory")
#define PG8_WAIT_L(n) asm volatile("s_waitcnt lgkmcnt(" #n ")" ::: "memory")
#define PG8_BAR __builtin_amdgcn_s_barrier()
#define PG8_SCHED __builtin_amdgcn_sched_barrier(0)
    GUnit cur, nxt; int ui = 0;
    if (!S.next(0, cur)) return;
    if constexpr (GATHER) {
#pragma unroll
        for (int i = 0; i < 2; ++i)
#pragma unroll
            for (int h = 0; h < 2; ++h) voffA[h][i] = (S.arow(0, h * HALF + sR[i]) * (unsigned)lda + (unsigned)sC[i]) * 2u;
    }
    f32x4 acc[2][2][4][2];
#pragma unroll
    for (int a = 0; a < 2; ++a)
#pragma unroll
        for (int b = 0; b < 2; ++b)
#pragma unroll
            for (int m = 0; m < 4; ++m)
#pragma unroll
                for (int n = 0; n < 2; ++n) acc[a][b][m][n] = (f32x4){0.f, 0.f, 0.f, 0.f};
    bf16x8 At[4][2], B0[2][2], B1[2][2];
    const char* cA = cur.A; const char* cB = cur.B;
    PG8_STAGE(PG8_SB(0, 0), cB, voffB); PG8_STAGE(PG8_SB(0, 1), cB + hstepB, voffB); PG8_STAGE(PG8_SA(0, 0), cA, voffA[0]); PG8_STAGE(PG8_SA(0, 1), cA, voffA[1]);
    if (wr == 1) PG8_BAR;
    PG8_WAIT_V(2); PG8_BAR;
    PG8_STAGE(PG8_SB(1, 0), cB + kstep, voffB); PG8_STAGE(PG8_SA(1, 0), cA + kstep, voffA[0]); PG8_STAGE(PG8_SB(1, 1), cB + hstepB + kstep, voffB);
    PG8_WAIT_V(6); PG8_BAR;
    for (;;) {
        const bool has_next = S.next(ui + 1, nxt);
        const char* nA = has_next ? nxt.A : cA; const char* nB = has_next ? nxt.B : cB;
        if constexpr (GATHER) {
#pragma unroll
            for (int i = 0; i < 2; ++i)
#pragma unroll
                for (int h = 0; h < 2; ++h) voffAn[h][i] = has_next ? (S.arow(ui + 1, h * HALF + sR[i]) * (unsigned)lda + (unsigned)sC[i]) * 2u : voffA[h][i];
        }
#pragma unroll 1
        for (int t = 0; t < nt; t += 2) {
            const bool last = (t == nt - 2);
            const char* a1 = cA + (size_t)(t + 1) * kstep;
            const char* a2 = last ? nA : cA + (size_t)(t + 2) * kstep; const char* b2 = last ? nB : cB + (size_t)(t + 2) * kstep;
            const char* a3 = a2 + kstep; const char* b3 = b2 + kstep;
            unsigned v2[2][2];
#pragma unroll
            for (int i = 0; i < 2; ++i)
#pragma unroll
                for (int h = 0; h < 2; ++h) v2[h][i] = GATHER ? (last ? voffAn[h][i] : voffA[h][i]) : voffA[h][i];
            PG8_LDB(B0, 0, 0); PG8_LDB(B1, 0, 1); PG8_SCHED; PG8_LDA(At, 0, 0); PG8_STAGE(PG8_SA(1, 1), a1, voffA[1]);
            PG8_WAIT_V(8); PG8_WAIT_L(0); PG8_BAR; PG8_MMA(0, 0, At, B0); PG8_MMA(0, 1, At, B1); PG8_BAR; PG8_SCHED;
            PG8_LDA(At, 0, 1); PG8_STAGE(PG8_SB(0, 0), b2, voffB); PG8_STAGE(PG8_SB(0, 1), b2 + hstepB, voffB); PG8_STAGE(PG8_SA(0, 0), a2, v2[0]);
            PG8_WAIT_V(8); PG8_WAIT_L(0); PG8_BAR; PG8_MMA(1, 0, At, B0); PG8_MMA(1, 1, At, B1); PG8_BAR; PG8_SCHED;
            PG8_LDB(B0, 1, 0); PG8_LDB(B1, 1, 1); PG8_SCHED; PG8_LDA(At, 1, 0); PG8_STAGE(PG8_SA(0, 1), a2, v2[1]);
            PG8_WAIT_V(8); PG8_WAIT_L(0); PG8_BAR; PG8_MMA(0, 0, At, B0); PG8_MMA(0, 1, At, B1); PG8_BAR; PG8_SCHED;
            PG8_LDA(At, 1, 1); PG8_STAGE(PG8_SB(1, 0), b3, voffB); PG8_STAGE(PG8_SB(1, 1), b3 + hstepB, voffB); PG8_STAGE(PG8_SA(1, 0), a3, v2[0]);
            PG8_WAIT_V(8); PG8_WAIT_L(0); PG8_BAR; PG8_MMA(1, 0, At, B0); PG8_MMA(1, 1, At, B1); PG8_BAR; PG8_SCHED;
        }
        if (wr == 0) PG8_BAR;
        E(acc, cur, wr, wc, fr, fq);
        if (!has_next) break;
        if (!(Epi::CHAIN && cur.x1 != 0)) {
#pragma unroll
        for (int a = 0; a < 2; ++a)
#pragma unroll
            for (int b = 0; b < 2; ++b)
#pragma unroll
                for (int m = 0; m < 4; ++m)
#pragma unroll
                    for (int n = 0; n < 2; ++n) acc[a][b][m][n] = (f32x4){0.f, 0.f, 0.f, 0.f};
        }
        cur = nxt; cA = nA; cB = nB; ++ui;
        if constexpr (GATHER) {
#pragma unroll
            for (int i = 0; i < 2; ++i)
#pragma unroll
                for (int h = 0; h < 2; ++h) voffA[h][i] = voffAn[h][i];
        }
        if (wr == 1) PG8_BAR;
    }
    PG8_WAIT_V(0);
    PG8_BAR;
#undef PG8_SA
#undef PG8_SB
#undef PG8_STAGE
#undef PG8_LDA
#undef PG8_LDB
#undef PG8_MMA
#undef PG8_WAIT_V
#undef PG8_WAIT_L
#undef PG8_BAR
#undef PG8_SCHED
}
}
namespace pg8 {
struct EpiProj {
    static constexpr bool PERM = true, CHAIN = false;
    bf16_t* P; unsigned char* GT;
    __device__ __forceinline__ void operator()(f32x4 (&acc)[2][2][4][2], const GUnit& u, int wr, int wc, int fr, int fq) const {
        const int row0 = u.pm * BM + wr * 64 + fr;
#pragma unroll
        for (int bj = 0; bj < 2; ++bj) {
            const int ct = u.pn * BM + bj * HALF;
            if (ct >= NCOLS_IN) continue;
            const bool sig = ct >= C_GT;
            const int col0 = ct + wc * 32 + 8 * fq;
#pragma unroll
            for (int ai = 0; ai < 2; ++ai)
#pragma unroll
                for (int m = 0; m < 4; ++m) {
                    const f32x4 v0 = acc[ai][bj][m][0], v1 = acc[ai][bj][m][1];
                    const size_t row = (size_t)(row0 + ai * HALF + m * 16);
                    if (sig) {
                        unsigned q[8];
#pragma unroll
                        for (int j = 0; j < 4; ++j) { q[j] = (unsigned)fmaxf(255.0f * sigmoidf_(v0[j]) + 0.5f, 1.0f); q[4 + j] = (unsigned)fmaxf(255.0f * sigmoidf_(v1[j]) + 0.5f, 1.0f); }
                        u32x2 w; w.x = q[0] | (q[1] << 8) | (q[2] << 16) | (q[3] << 24); w.y = q[4] | (q[5] << 8) | (q[6] << 16) | (q[7] << 24);
                        *(u32x2*)(GT + row * 3072 + (col0 - C_GT)) = w;
                    } else {
                        u32x4 w; w.x = cvt_pk_bf16(v0[0], v0[1]); w.y = cvt_pk_bf16(v0[2], v0[3]); w.z = cvt_pk_bf16(v1[0], v1[1]); w.w = cvt_pk_bf16(v1[2], v1[3]);
                        *(u32x4*)(P + row * PW + col0) = w;
                    }
                }
        }
    }
};
struct EpiLowRank {
    static constexpr bool PERM = true, CHAIN = false;
    bf16_t* W; const float* w0; const float* a0;
    __device__ __forceinline__ void operator()(f32x4 (&acc)[2][2][4][2], const GUnit& u, int wr, int wc, int fr, int fq) const {
        const int row0 = u.pm * BM + wr * 64 + fr;
#pragma unroll
        for (int bj = 0; bj < 2; ++bj) {
            const int ct = u.pn * BM + bj * HALF;
            const int col0 = ct + wc * 32 + 8 * fq;
            const int mode = ct < 1024 ? 0 : (ct < 2048 ? 1 : 2);
            float bias[8];
#pragma unroll
            for (int j = 0; j < 8; ++j) bias[j] = mode == 0 ? w0[col0 + j] : (mode == 1 ? a0[col0 - 1024 + j] : 0.f);
#pragma unroll
            for (int ai = 0; ai < 2; ++ai)
#pragma unroll
                for (int m = 0; m < 4; ++m) {
                    float v[8];
#pragma unroll
                    for (int j = 0; j < 4; ++j) { v[j] = acc[ai][bj][m][0][j] + bias[j]; v[4 + j] = acc[ai][bj][m][1][j] + bias[4 + j]; }
                    if (mode == 0) {
#pragma unroll
                        for (int j = 0; j < 8; ++j) v[j] = 0.60653066f * sigmoidf_(v[j]);
                    } else if (mode == 1) {
#pragma unroll
                        for (int j = 0; j < 8; ++j) v[j] = sigmoidf_(v[j]);
                    }
                    u32x4 w; w.x = cvt_pk_bf16(v[0], v[1]); w.y = cvt_pk_bf16(v[2], v[3]); w.z = cvt_pk_bf16(v[4], v[5]); w.w = cvt_pk_bf16(v[6], v[7]);
                    *(u32x4*)(W + (size_t)(row0 + ai * HALF + m * 16) * WAGW + col0) = w;
                    asm volatile("" ::: "memory");
                }
        }
    }
};
__device__ __forceinline__ void ldg8(const unsigned char* p, float (&g)[8]) {
    const u32x2 w = *(const u32x2*)p;
#pragma unroll
    for (int j = 0; j < 4; ++j) { g[j] = (float)((w.x >> (8 * j)) & 255u) * (1.0f / 255.0f); g[4 + j] = (float)((w.y >> (8 * j)) & 255u) * (1.0f / 255.0f); }
}
struct EpiMerge {
    static constexpr bool PERM = true, CHAIN = true;
    const unsigned char* GT; bf16_t* M;
    __device__ __forceinline__ void operator()(f32x4 (&acc)[2][2][4][2], const GUnit& u, int wr, int wc, int fr, int fq) const {
        const int row0 = u.pm * BM + wr * 64 + fr; const int br = u.x0;
#pragma unroll
        for (int bj = 0; bj < 2; ++bj) {
            const int col0 = u.pn * BM + bj * HALF + wc * 32 + 8 * fq;
#pragma unroll
            for (int ai = 0; ai < 2; ++ai)
#pragma unroll
                for (int m = 0; m < 4; ++m) {
                    const size_t row = (size_t)(row0 + ai * HALF + m * 16);
                    float g[8];
                    ldg8(GT + row * 3072 + br * 1024 + col0, g);
                    if (br < 2) {
                        float gn[8];
                        ldg8(GT + row * 3072 + (br + 1) * 1024 + col0, gn);
#pragma unroll
                        for (int j = 0; j < 8; ++j) g[j] = g[j] * rcp_(fmaxf(gn[j], 1.0f / 512.0f));
#pragma unroll
                        for (int j = 0; j < 4; ++j) { acc[ai][bj][m][0][j] *= g[j]; acc[ai][bj][m][1][j] *= g[4 + j]; }
                    } else {
                        float o[8];
#pragma unroll
                        for (int j = 0; j < 4; ++j) { o[j] = g[j] * acc[ai][bj][m][0][j]; o[4 + j] = g[4 + j] * acc[ai][bj][m][1][j]; }
                        st8(M + row * DM + col0, o);
                    }
                }
        }
    }
};
struct EpiOut {
    static constexpr bool PERM = true, CHAIN = false;
    bf16_t* XB; const float* mod;
    __device__ __forceinline__ void operator()(f32x4 (&acc)[2][2][4][2], const GUnit& u, int wr, int wc, int fr, int fq) const {
        const int rt = u.pm * BM; const int modrow = rt < NLAT ? (rt >> 11) : 16;
        const float* g1 = mod + (size_t)modrow * 6144 + 2048;
        const int row0 = rt + wr * 64 + fr;
#pragma unroll
        for (int bj = 0; bj < 2; ++bj) {
            const int col0 = u.pn * BM + bj * HALF + wc * 32 + 8 * fq;
            const f32x4 ga = *(const f32x4*)(g1 + col0), gb = *(const f32x4*)(g1 + col0 + 4);
#pragma unroll
            for (int ai = 0; ai < 2; ++ai)
#pragma unroll
                for (int m = 0; m < 4; ++m) {
                    bf16_t* xp = XB + (size_t)(row0 + ai * HALF + m * 16) * DM + col0;
                    float x[8]; ld8(xp, x);
#pragma unroll
                    for (int j = 0; j < 4; ++j) { x[j] += ga[j] * acc[ai][bj][m][0][j]; x[4 + j] += gb[j] * acc[ai][bj][m][1][j]; }
                    st8(xp, x);
                }
        }
    }
};
struct EpiUp {
    static constexpr bool PERM = true, CHAIN = false;
    bf16_t* HID;
    __device__ __forceinline__ void operator()(f32x4 (&acc)[2][2][4][2], const GUnit& u, int wr, int wc, int fr, int fq) const {
        const int row0 = u.x0 * PAIRS_E + u.pm * BM + wr * 64 + fr;
        const int col0 = u.pn * HALF + wc * 32 + 8 * fq;
#pragma unroll
        for (int ai = 0; ai < 2; ++ai)
#pragma unroll
            for (int m = 0; m < 4; ++m) {
                float v[8];
#pragma unroll
                for (int j = 0; j < 4; ++j) {
                    const float g0 = acc[ai][0][m][0][j], g1 = acc[ai][0][m][1][j];
                    v[j] = g0 * sigmoidf_(g0) * acc[ai][1][m][0][j]; v[4 + j] = g1 * sigmoidf_(g1) * acc[ai][1][m][1][j];
                }
                u32x4 w; w.x = cvt_pk_bf16(v[0], v[1]); w.y = cvt_pk_bf16(v[2], v[3]); w.z = cvt_pk_bf16(v[4], v[5]); w.w = cvt_pk_bf16(v[6], v[7]);
                *(u32x4*)(HID + (size_t)(row0 + ai * HALF + m * 16) * EFF + col0) = w;
            }
    }
};
struct EpiDown {
    static constexpr bool PERM = true, CHAIN = false;
    bf16_t* YE;
    __device__ __forceinline__ void operator()(f32x4 (&acc)[2][2][4][2], const GUnit& u, int wr, int wc, int fr, int fq) const {
        const int row0 = u.x0 * PAIRS_E + u.pm * BM + wr * 64 + fr;
#pragma unroll
        for (int bj = 0; bj < 2; ++bj) {
            const int col0 = u.pn * BM + bj * HALF + wc * 32 + 8 * fq;
#pragma unroll
            for (int ai = 0; ai < 2; ++ai)
#pragma unroll
                for (int m = 0; m < 4; ++m) {
                    const f32x4 v0 = acc[ai][bj][m][0], v1 = acc[ai][bj][m][1];
                    u32x4 w; w.x = cvt_pk_bf16(v0[0], v0[1]); w.y = cvt_pk_bf16(v0[2], v0[3]); w.z = cvt_pk_bf16(v1[0], v1[1]); w.w = cvt_pk_bf16(v1[2], v1[3]);
                    *(u32x4*)(YE + (size_t)(row0 + ai * HALF + m * 16) * DM + col0) = w;
                }
        }
    }
};

struct PlainOrder {
    const char* A; const char* B; int nM, nN, nwg, G, c; size_t astep, bstep;
    __device__ __forceinline__ void init(const void* A_, const void* B_, int M, int N, int lda, int ldb, int G_, int c_) { A = (const char*)A_; B = (const char*)B_; nM = M / BM; nN = N / BM; nwg = nM * nN; G = G_; c = c_; astep = (size_t)BM * lda * 2; bstep = (size_t)BM * ldb * 2; }
    __device__ __forceinline__ bool next(int i, GUnit& u) const {
        const long L = (long)i * G + c; if (L >= nwg) return false;
        int wgid = (int)L; { const int q = nwg / 8, r = nwg % 8, xcd = wgid % 8, off = wgid / 8; wgid = (xcd < r ? xcd * (q + 1) : r * (q + 1) + (xcd - r) * q) + off; }
#ifndef PG8_WGM
#define PG8_WGM 8
#endif
        const int nig = PG8_WGM * nN, gid = wgid / nig, fm = gid * PG8_WGM, gsz = (nM - fm) < PG8_WGM ? (nM - fm) : PG8_WGM;
        u.pm = fm + ((wgid % nig) % gsz); u.pn = (wgid % nig) / gsz; u.x0 = 0; u.x1 = 0;
        u.A = A + (size_t)u.pm * astep; u.B = B + (size_t)u.pn * bstep; return true;
    }
    __device__ __forceinline__ unsigned arow(int, int) const { return 0u; }
};
struct LastProjOrder {
    PlainOrder lat; const char* A; const char* B; size_t astep, bstep;
    __device__ __forceinline__ void init(const void* A_, const void* B_, int lda, int ldb, int G_, int c_) { lat.init(A_, B_, NLAT, PWP, lda, ldb, G_, c_); A = (const char*)A_; B = (const char*)B_; astep = (size_t)BM * lda * 2; bstep = (size_t)BM * ldb * 2; }
    __device__ __forceinline__ bool next(int i, GUnit& u) const {
        const long L = (long)i * lat.G + lat.c;
        if (L < lat.nwg) return lat.next(i, u);
        const int r = (int)(L - lat.nwg); if (r >= (NCTX / BM) * 8) return false;
        u.pm = NLAT / BM + r / 8; u.pn = 2 + (r % 8); u.x0 = 0; u.x1 = 0;
        u.A = A + (size_t)u.pm * astep; u.B = B + (size_t)u.pn * bstep; return true;
    }
    __device__ __forceinline__ unsigned arow(int, int) const { return 0u; }
};
struct LowRankOrder {
    const char* A; const char* B; int nM, G, c;
    __device__ __forceinline__ bool next(int i, GUnit& u) const {
        const long L = (long)i * G + c; if (L >= (long)nM * 10) return false;
        u.pm = (int)(L / 10); u.pn = (int)(L % 10); u.x0 = 0; u.x1 = 0;
        const int kwin = u.pn < 4 ? 0 : (u.pn < 8 ? 128 : 256);
        u.A = A + ((size_t)u.pm * BM * LRAW + kwin) * 2; u.B = B + (size_t)u.pn * BM * 128 * 2; return true;
    }
    __device__ __forceinline__ unsigned arow(int, int) const { return 0u; }
};
struct MergeOrder {
    const char* P; const char* W; int nM, G, c;
    __device__ __forceinline__ bool next(int i, GUnit& u) const {
        const long tl = (long)(i / 3) * G + c; if (tl >= (long)nM * 4) return false;
        const int tile = (int)tl, br = i % 3;
        u.pm = tile >> 2; u.pn = tile & 3; u.x0 = br; u.x1 = br < 2 ? 1 : 0;
        const int acol = br == 0 ? C_OATT : (br == 1 ? C_ORWKV : C_OCONV);
        u.A = P + ((size_t)u.pm * BM * PW + acol) * 2; u.B = W + ((size_t)br * 1024 * 512 + (size_t)u.pn * BM * 512) * 2; return true;
    }
    __device__ __forceinline__ unsigned arow(int, int) const { return 0u; }
};
struct MoeOrder {
    const char* A; const char* W; const LAS int* rows; int mt_per, npn, G, c; size_t wexp;
    __device__ __forceinline__ bool decode(long L, int& e, int& mt, int& pn) const {
        const int per_e = mt_per * npn; if (L >= (long)NEXP * per_e) return false;
        e = (int)(L / per_e); const int r = (int)(L % per_e); pn = r / mt_per; mt = r % mt_per; return true;
    }
    __device__ __forceinline__ bool next(int i, GUnit& u) const {
        int e, mt, pn; if (!decode((long)i * G + c, e, mt, pn)) return false;
        u.pm = mt; u.pn = pn; u.x0 = e; u.x1 = 0;
        u.A = A; u.B = W + (size_t)e * wexp + (size_t)pn * BM * 1024 * 2; return true;
    }
    __device__ __forceinline__ unsigned arow(int i, int r) const { return (unsigned)rows[i * 256 + r]; }
};
struct MoeDownOrder {
    const char* A; const char* W; int mt_per, G, c;
    __device__ __forceinline__ bool next(int i, GUnit& u) const {
        const long L = (long)i * G + c; const int per_e = mt_per * 4; if (L >= (long)NEXP * per_e) return false;
        const int e = (int)(L / per_e), r = (int)(L % per_e); u.pn = r / mt_per; u.pm = r % mt_per; u.x0 = e; u.x1 = 0;
        u.A = A + ((size_t)e * PAIRS_E + (size_t)u.pm * BM) * EFF * 2; u.B = W + ((size_t)e * 1024 + (size_t)u.pn * BM) * 1024 * 2; return true;
    }
    __device__ __forceinline__ unsigned arow(int, int) const { return 0u; }
};
}
namespace attn_body {
using bf16=__hip_bfloat16;
using bf16x8=__attribute__((ext_vector_type(8)))short;
using s16x4=__attribute__((ext_vector_type(4)))short;
using f32x16=__attribute__((ext_vector_type(16)))float;
using u32x4=__attribute__((ext_vector_type(4)))unsigned;
constexpr int D=64,DM=4224;
constexpr int NW=8,QBLK=32,QB=QBLK*NW,KVBLK=64;
constexpr int ATTN_PITCH=DM, ATTN_UNIT_ROWS=QB;
__device__ __forceinline__ int crow(int r,int hi){return (r&3)+8*(r>>2)+4*hi;}
#define SBAR() __builtin_amdgcn_sched_barrier(0)
__device__ __forceinline__ void cmask(f32x16&p0,f32x16&p1,int jb,int qrel,int hi){
  const float NEG=-INFINITY; int kb=64*jb+4*hi;
  #pragma unroll
  for(int r=0;r<16;++r){int kv=kb+(r&3)+8*(r>>2); if(kv>qrel)p0[r]=NEG; if(kv+32>qrel)p1[r]=NEG;}
}

constexpr int NSLOT=3, SLOTB=8192;
constexpr int LDS_K=0, LDS_V=NSLOT*SLOTB, LDS_WS=2*NSLOT*SLOTB, LDS_OST=LDS_WS+NW*64*4, LDS_BYTES=LDS_OST+NW*4096;
constexpr float C2=0.125f*1.4426950408889634f;
__device__ __forceinline__ void glds16(const void*gsrc,unsigned lds_dst){unsigned keep;
  asm volatile("s_mov_b32 %0, m0\n\ts_mov_b32 m0, %2\n\ts_nop 0\n\tglobal_load_lds_dwordx4 %1, off\n\ts_mov_b32 m0, %0":"=&s"(keep):"v"(gsrc),"s"(lds_dst):"memory");}
__device__ __forceinline__ float max3f(float a,float b,float c){float r;asm("v_max3_f32 %0, %1, %2, %3":"=v"(r):"v"(a),"v"(b),"v"(c));return r;}
__device__ __forceinline__ float max2f(float a,float b){float r;asm("v_max_f32_e32 %0, %1, %2":"=v"(r):"v"(a),"v"(b));return r;}
__device__ __forceinline__ float fadd_s(float a,float b){float r;asm("v_add_f32_e32 %0, %1, %2":"=v"(r):"v"(a),"v"(b));return r;}
__device__ __forceinline__ float fsub_s(float a,float b){float r;asm("v_sub_f32_e32 %0, %1, %2":"=v"(r):"v"(a),"v"(b));return r;}
typedef float f32x2_t __attribute__((ext_vector_type(2))); typedef __bf16 bf16x2_t __attribute__((ext_vector_type(2)));
__device__ __forceinline__ unsigned cvtpk_s(float lo,float hi){f32x2_t v={lo,hi};bf16x2_t b=__builtin_convertvector(v,bf16x2_t);return __builtin_bit_cast(unsigned,b);}
#define WAIT_BAR(N) asm volatile("s_waitcnt vmcnt(" #N ") lgkmcnt(0)\n\ts_barrier":::"memory")

__device__ __forceinline__ void qkt(f32x16&p0,f32x16&p1,const char*Kslot,const bf16x8*qr,const f32x16&negm,int r32,int hi){
  const char*kb=Kslot+hi*1024+r32*16;
  #pragma unroll
  for(int d0=0;d0<4;++d0){
    const bf16x8 b0=*reinterpret_cast<const bf16x8*>(kb+d0*2048);
    const bf16x8 b1=*reinterpret_cast<const bf16x8*>(kb+d0*2048+512);
    if(d0==0){p0=__builtin_amdgcn_mfma_f32_32x32x16_bf16(b0,qr[0],negm,0,0,0);p1=__builtin_amdgcn_mfma_f32_32x32x16_bf16(b1,qr[0],negm,0,0,0);}
    else{p0=__builtin_amdgcn_mfma_f32_32x32x16_bf16(b0,qr[d0],p0,0,0,0);p1=__builtin_amdgcn_mfma_f32_32x32x16_bf16(b1,qr[d0],p1,0,0,0);}}
}
typedef __attribute__((address_space(3))) const char* lds_cptr;
typedef short v4i16_t __attribute__((ext_vector_type(4)));
__device__ __forceinline__ void kload8(bf16x8*kf,lds_cptr kp){
  kf[0]=*(const __attribute__((address_space(3))) bf16x8*)(kp);      kf[1]=*(const __attribute__((address_space(3))) bf16x8*)(kp+512);
  kf[2]=*(const __attribute__((address_space(3))) bf16x8*)(kp+2048); kf[3]=*(const __attribute__((address_space(3))) bf16x8*)(kp+2560);
  kf[4]=*(const __attribute__((address_space(3))) bf16x8*)(kp+4096); kf[5]=*(const __attribute__((address_space(3))) bf16x8*)(kp+4608);
  kf[6]=*(const __attribute__((address_space(3))) bf16x8*)(kp+6144); kf[7]=*(const __attribute__((address_space(3))) bf16x8*)(kp+6656);
}
__device__ __forceinline__ void kload2(bf16x8*kf,lds_cptr kp,int j){ kf[2*j]=*(const __attribute__((address_space(3))) bf16x8*)(kp+j*2048); kf[2*j+1]=*(const __attribute__((address_space(3))) bf16x8*)(kp+j*2048+512); }
__device__ __forceinline__ s16x4 vtr(lds_cptr p){ return __builtin_bit_cast(s16x4,__builtin_amdgcn_ds_read_tr16_b64_v4i16((__attribute__((address_space(3))) v4i16_t*)p)); }
__device__ __forceinline__ float rowmax(const f32x16&p0,const f32x16&p1){
  float a=max3f(p0[0],p0[1],p1[0]),b=max3f(p0[2],p0[3],p1[1]);a=max3f(a,p1[2],p1[3]);
  #pragma unroll
  for(int r=4;r<16;r+=4){a=max3f(a,p0[r],p0[r+1]);b=max3f(b,p0[r+2],p0[r+3]);a=max3f(a,p1[r],p1[r+1]);b=max3f(b,p1[r+2],p1[r+3]);}
  const float m=max2f(a,b);
  auto rr=__builtin_amdgcn_permlane32_swap(__float_as_uint(m),__float_as_uint(m),false,false);
  return max2f(__uint_as_float(rr[0]),__uint_as_float(rr[1]));
}
__device__ __forceinline__ void pv(f32x16*o,int vb,bf16x8 pa0,bf16x8 pa1,bf16x8 pa2,bf16x8 pa3){
  #pragma unroll
  for(int d0=0;d0<2;++d0){s16x4 lo[4],hi[4];
    #pragma unroll
    for(int ks=0;ks<4;++ks){
      asm volatile("ds_read_b64_tr_b16 %0,%1 offset:%c2":"=&v"(lo[ks]):"v"(vb),"i"(d0*4096+ks*1024):"memory");
      asm volatile("ds_read_b64_tr_b16 %0,%1 offset:%c2":"=&v"(hi[ks]):"v"(vb),"i"(d0*4096+ks*1024+512):"memory");}
    asm volatile("s_waitcnt lgkmcnt(0)":::"memory");SBAR();
    #define PK(k) (bf16x8){lo[k][0],lo[k][1],lo[k][2],lo[k][3],hi[k][0],hi[k][1],hi[k][2],hi[k][3]}
    o[d0]=__builtin_amdgcn_mfma_f32_32x32x16_bf16(pa0,PK(0),o[d0],0,0,0);
    o[d0]=__builtin_amdgcn_mfma_f32_32x32x16_bf16(pa1,PK(1),o[d0],0,0,0);
    o[d0]=__builtin_amdgcn_mfma_f32_32x32x16_bf16(pa2,PK(2),o[d0],0,0,0);
    o[d0]=__builtin_amdgcn_mfma_f32_32x32x16_bf16(pa3,PK(3),o[d0],0,0,0);
    #undef PK
  }
}

#ifndef ATTN_STORE16
#define ATTN_STORE16(p,v) (*(u32x4*)(p)=(v))
#endif
template<int THRL> __device__ __forceinline__ void attn_unit(const bf16*Qu,bf16*Ou,const bf16*KV0,const int crow0,const int lrow0,const int NT,const int nct,char*shm){
  constexpr int VOFF=128;
  int tid_=threadIdx.x; asm volatile("":"+v"(tid_)); const int tid=tid_,lane=tid&63,r32=lane&31,hi=lane>>5; const int wid=__builtin_amdgcn_readfirstlane(tid>>6);
  const bf16*Qw=Qu+(long)(wid*QBLK)*DM;
  const unsigned lds0=(unsigned)(uintptr_t)shm;
  float*wsf=(float*)(shm+LDS_WS)+wid*64;
  const long klane=(long)lane*DM+wid*8;
  const long vlane=(long)(16*(wid&3)+(lane>>2))*DM+(wid>>2)*32+(lane&3)*8;
  const unsigned kdst=lds0+LDS_K+wid*1024, vdst=lds0+LDS_V+wid*1024;
  #define KTILE(t) (KV0+(long)(((t)<nct)?(crow0+(t)*KVBLK):(lrow0+((t)-nct)*KVBLK))*DM)
  #define VTILE(t) (KTILE(t)+VOFF)
  #define DMA_K(t,slot) glds16(KTILE(t)+klane,(unsigned)__builtin_amdgcn_readfirstlane(kdst+(slot)))
  #define DMA_V(t,slot) glds16(VTILE(t)+vlane,(unsigned)__builtin_amdgcn_readfirstlane(vdst+(slot)))
  const int vb0=(int)(lds0+LDS_V)+((lane>>4)&1)*32+(lane&3)*8+(4*hi+((lane&15)>>2))*64;
  const char*Kbase=shm+LDS_K; bf16x8 kf[8];
  const lds_cptr shm3=(lds_cptr)shm; const lds_cptr kp0=shm3+LDS_K+hi*1024+r32*16; const lds_cptr vp0=shm3+LDS_V+((lane>>4)&1)*32+(lane&3)*8+(4*hi+((lane&15)>>2))*64;
  DMA_K(0,0);DMA_V(0,0);DMA_K(1,SLOTB);
  bf16x8 qr[4];
  #pragma unroll
  for(int d0=0;d0<4;++d0)qr[d0]=*reinterpret_cast<const bf16x8*>(&Qw[(long)r32*DM+d0*16+hi*8]);
  float mhat=0.f,l_reg=0.f;f32x16 o[2];o[0]=f32x16{};o[1]=f32x16{};f32x16 negm=f32x16{};asm volatile("":"+v"(negm));
  #define CMASK(P0,P1,t) do{}while(0)
  bool resc=false;
#ifndef ATTN_NOMAX
#define ATTN_NOMAX 1
#endif
#if ATTN_NOMAX
  #define START(P0,P1) do{ resc=false; _Pragma("unroll") for(int r=0;r<16;++r)P0[r]=__builtin_amdgcn_exp2f(P0[r]); }while(0)
#else
  #define START(P0,P1) do{ const float rm=rowmax(P0,P1); resc=false; \
    { const float dl=rm; mhat=fadd_s(mhat,dl); \
      _Pragma("unroll") for(int r=0;r<16;++r){P0[r]=fsub_s(P0[r],dl);P1[r]=fsub_s(P1[r],dl);} \
      _Pragma("unroll") for(int r=0;r<16;++r)negm[r]=-mhat; asm volatile("":"+v"(negm)); } \
    _Pragma("unroll") for(int r=0;r<16;++r)P0[r]=__builtin_amdgcn_exp2f(P0[r]); }while(0)
#endif
  #define RESC() do{ if(resc){ asm volatile("s_waitcnt lgkmcnt(0)":::"memory"); \
      _Pragma("unroll") for(int d_=0;d_<2;++d_) _Pragma("unroll") for(int r=0;r<16;++r)o[d_][r]*=wsf[crow(r,hi)]; } }while(0)
  f32x16 pA0,pA1,pB0,pB1;
  int sl_prev=0,sl_cur=0,sl_next=SLOTB;
  #define ROT() do{sl_prev=sl_cur;sl_cur=sl_next;sl_next=(sl_next==(NSLOT-1)*SLOTB)?0:sl_next+SLOTB;}while(0)
  DMA_K(2,2*SLOTB);
  WAIT_BAR(3);
  qkt(pA0,pA1,Kbase,qr,negm,r32,hi);asm volatile("s_nop 15\n\ts_nop 7":"+v"(pA0),"+v"(pA1));CMASK(pA0,pA1,0);
  START(pA0,pA1);
  _Pragma("unroll") for(int r=0;r<16;++r)pA1[r]=__builtin_amdgcn_exp2f(pA1[r]);
  WAIT_BAR(0);
  DMA_K(3,0);DMA_V(1,SLOTB);
  ROT();
  kload8(kf,kp0+sl_cur);
  WAIT_BAR(2);
  s16x4 vlo[8],vhi[8]; u32x4 pw0,pw1,pw2,pw3;
  #define PKW(P,B) cvtpk_s(P[B],P[B+1])
  #define PAF(k) __builtin_bit_cast(bf16x8,pw##k)
  #define VFR(i) (bf16x8){vlo[i][0],vlo[i][1],vlo[i][2],vlo[i][3],vhi[i][0],vhi[i][1],vhi[i][2],vhi[i][3]}
  #define PIN(x) asm volatile("":"+v"(x))
  #define MX3(a,b,c) __builtin_fmaxf(__builtin_fmaxf((a),(b)),(c))
  #define GAPA(MF,A0,A1,A2,A3,W0,W1,PW) do{ MF; sacc+=A0; sacc+=A1; sacc+=A2; sacc+=A3; PIN(sacc); W0; W1; PIN(PW); SBAR(); }while(0)
  #define EX(v) __builtin_amdgcn_exp2f(v)
  #define GAPB(MF,X,B) do{ MF; X[B]=EX(X[B]); X[B+1]=EX(X[B+1]); X[B+2]=EX(X[B+2]); X[B+3]=EX(X[B+3]); PIN(X); SBAR(); }while(0)
  #define VRD(i) do{ vlo[i]=vtr(vp_+(((i)>>2)*4096+((i)&3)*1024)); vhi[i]=vtr(vp_+(((i)>>2)*4096+((i)&3)*1024+512)); }while(0)
  #define KRD(G,j) do{ if(G){ kload2(kf,kp0+sl_next,j); SBAR(); } }while(0)
#if ATTN_NOMAX
  #define ROWMAX_BLOCK(C0,C1) do{ resc=false; }while(0)
#else
  #define ROWMAX_BLOCK(C0,C1) do    { float a=MX3(C0[0],C0[1],C1[0]),b=MX3(C0[2],C0[3],C1[1]); a=MX3(a,C1[2],C1[3]); \
      _Pragma("unroll") for(int r=4;r<16;r+=4){a=MX3(a,C0[r],C0[r+1]);b=MX3(b,C0[r+2],C0[r+3]);a=MX3(a,C1[r],C1[r+1]);b=MX3(b,C1[r+2],C1[r+3]);} \
      float rm=__builtin_fmaxf(a,b); { auto rr=__builtin_amdgcn_permlane32_swap(__float_as_uint(rm),__float_as_uint(rm),false,false); rm=__builtin_fmaxf(__uint_as_float(rr[0]),__uint_as_float(rr[1])); } \
      resc=false; \
      if(__builtin_expect(__any(rm>(float)THRL),0)){ const float dl=__builtin_fmaxf(rm,0.f); mhat+=dl; \
        _Pragma("unroll") for(int r=0;r<16;++r){C0[r]-=dl;C1[r]-=dl;} \
        _Pragma("unroll") for(int r=0;r<16;++r)negm[r]=-mhat; asm volatile("":"+v"(negm)); \
        const float f=__builtin_amdgcn_exp2f(-dl); l_reg*=f; if(hi==0)wsf[r32]=f; resc=true; } } while(0)
#endif
  #define STEP(C0,C1,P0,P1,t,GK,GV,GL) do{ SBAR(); \
    const lds_cptr vp_=vp0+sl_prev; \
    VRD(0); SBAR(); float sacc=(P0[0]+P0[1]); \
    GAPA(C0=__builtin_amdgcn_mfma_f32_32x32x16_bf16(kf[0],qr[0],negm,0,0,0), P0[2],P0[3],P0[4],P0[5],     pw0[0]=PKW(P0,0), pw0[1]=PKW(P0,2), pw0); \
    VRD(4); SBAR(); GAPA(C1=__builtin_amdgcn_mfma_f32_32x32x16_bf16(kf[1],qr[0],negm,0,0,0), P0[6],P0[7],P0[8],P0[9],     pw0[2]=PKW(P0,4), pw0[3]=PKW(P0,6), pw0); \
    VRD(1); SBAR(); GAPA(C0=__builtin_amdgcn_mfma_f32_32x32x16_bf16(kf[2],qr[1],C0,0,0,0),   P0[10],P0[11],P0[12],P0[13], pw1[0]=PKW(P0,8), pw1[1]=PKW(P0,10), pw1); \
    VRD(5); SBAR(); GAPA(C1=__builtin_amdgcn_mfma_f32_32x32x16_bf16(kf[3],qr[1],C1,0,0,0),   P0[14],P0[15],P1[0],P1[1],   pw1[2]=PKW(P0,12),pw1[3]=PKW(P0,14), pw1); \
    VRD(2); SBAR(); GAPA(C0=__builtin_amdgcn_mfma_f32_32x32x16_bf16(kf[4],qr[2],C0,0,0,0),   P1[2],P1[3],P1[4],P1[5],     pw2[0]=PKW(P1,0), pw2[1]=PKW(P1,2), pw2); \
    VRD(6); SBAR(); GAPA(C1=__builtin_amdgcn_mfma_f32_32x32x16_bf16(kf[5],qr[2],C1,0,0,0),   P1[6],P1[7],P1[8],P1[9],     pw2[2]=PKW(P1,4), pw2[3]=PKW(P1,6), pw2); \
    VRD(3); SBAR(); GAPA(C0=__builtin_amdgcn_mfma_f32_32x32x16_bf16(kf[6],qr[3],C0,0,0,0),   P1[10],P1[11],P1[12],P1[13], pw3[0]=PKW(P1,8), pw3[1]=PKW(P1,10), pw3); \
    VRD(7); SBAR(); GAPA(C1=__builtin_amdgcn_mfma_f32_32x32x16_bf16(kf[7],qr[3],C1,0,0,0),   P1[14],P1[15],0.f,0.f,       pw3[2]=PKW(P1,12),pw3[3]=PKW(P1,14), pw3); \
    l_reg+=sacc; \
    if(GK){DMA_K((t)+3,sl_cur);} if(GV){DMA_V((t)+1,sl_next);} \
    CMASK(C0,C1,t); \
    ROWMAX_BLOCK(C0,C1); \
    SBAR(); \
    GAPB(o[0]=__builtin_amdgcn_mfma_f32_32x32x16_bf16(PAF(0),VFR(0),o[0],0,0,0), C0,0); \
    GAPB(o[1]=__builtin_amdgcn_mfma_f32_32x32x16_bf16(PAF(0),VFR(4),o[1],0,0,0), C0,4); \
    KRD(GL,0); GAPB(o[0]=__builtin_amdgcn_mfma_f32_32x32x16_bf16(PAF(1),VFR(1),o[0],0,0,0), C0,8); \
    KRD(GL,1); GAPB(o[1]=__builtin_amdgcn_mfma_f32_32x32x16_bf16(PAF(1),VFR(5),o[1],0,0,0), C0,12); \
    KRD(GL,2); GAPB(o[0]=__builtin_amdgcn_mfma_f32_32x32x16_bf16(PAF(2),VFR(2),o[0],0,0,0), C1,0); \
    KRD(GL,3); GAPB(o[1]=__builtin_amdgcn_mfma_f32_32x32x16_bf16(PAF(2),VFR(6),o[1],0,0,0), C1,4); \
    GAPB(o[0]=__builtin_amdgcn_mfma_f32_32x32x16_bf16(PAF(3),VFR(3),o[0],0,0,0), C1,8); \
    GAPB(o[1]=__builtin_amdgcn_mfma_f32_32x32x16_bf16(PAF(3),VFR(7),o[1],0,0,0), C1,12); \
    }while(0)
  int t=1;
  #undef CMASK
  #define CMASK(P0,P1,t) do{}while(0)
  for(;t+5<NT;t+=2){
    STEP(pB0,pB1,pA0,pA1,t,true,true,true);     WAIT_BAR(2); RESC(); ROT();
    STEP(pA0,pA1,pB0,pB1,t+1,true,true,true);   WAIT_BAR(2); RESC(); ROT();
  }
  #undef CMASK
  #define CMASK(P0,P1,t) do{}while(0)
  #define ENDW(tt) do{ if((tt)+3<NT){WAIT_BAR(2);} else if((tt)+2<NT){WAIT_BAR(1);} else {WAIT_BAR(0);} }while(0)
  for(;t+1<NT;t+=2){
    STEP(pB0,pB1,pA0,pA1,t,(t+3<NT),(t+1<NT),(t+1<NT));       ENDW(t);   RESC(); ROT();
    STEP(pA0,pA1,pB0,pB1,t+1,(t+4<NT),(t+2<NT),(t+2<NT));     ENDW(t+1); RESC(); ROT();
  }
  STEP(pB0,pB1,pA0,pA1,NT-1,false,false,false); RESC();
  { float sacc=pB0[0]+pB0[1]; _Pragma("unroll") for(int r=2;r<16;++r)sacc+=pB0[r]; _Pragma("unroll") for(int r=0;r<16;++r)sacc+=pB1[r]; l_reg+=sacc;
    pw0=(u32x4){PKW(pB0,0),PKW(pB0,2),PKW(pB0,4),PKW(pB0,6)};pw1=(u32x4){PKW(pB0,8),PKW(pB0,10),PKW(pB0,12),PKW(pB0,14)};pw2=(u32x4){PKW(pB1,0),PKW(pB1,2),PKW(pB1,4),PKW(pB1,6)};pw3=(u32x4){PKW(pB1,8),PKW(pB1,10),PKW(pB1,12),PKW(pB1,14)};
    SBAR(); pv(o,vb0+sl_cur,PAF(0),PAF(1),PAF(2),PAF(3)); }
  #undef PKW
  #undef PAF
  #undef VFR
  #undef PIN
  #undef MX3
  #undef GAPA
  #undef GAPB
  #undef EX
  #undef VRD
  #undef KRD
  #undef STEP
  #undef ROWMAX_BLOCK
  #undef ENDW
  {auto rr=__builtin_amdgcn_permlane32_swap(__float_as_uint(l_reg),__float_as_uint(l_reg),false,false);l_reg=__uint_as_float(rr[0])+__uint_as_float(rr[1]);}
  if(hi==0)wsf[32+r32]=l_reg;asm volatile("s_waitcnt lgkmcnt(0)":::"memory");
  float rli[16];
  #pragma unroll
  for(int r=0;r<16;++r)rli[r]=__builtin_amdgcn_rcpf(wsf[32+crow(r,hi)]);
  bf16*Ow=Ou+(long)(wid*QBLK)*DM;
  { bf16*stg=(bf16*)(shm+LDS_OST)+wid*2048;
    #pragma unroll
    for(int r=0;r<16;++r){const int orow=crow(r,hi);
      #pragma unroll
      for(int d0=0;d0<2;++d0)stg[orow*64+d0*32+r32]=__float2bfloat16(o[d0][r]*rli[r]);}
    asm volatile("s_waitcnt lgkmcnt(0)":::"memory");
    #pragma unroll
    for(int i=0;i<4;++i){const int row=i*8+(lane>>3),ch=lane&7; const u32x4 v=*(const u32x4*)(stg+row*64+ch*8); ATTN_STORE16(Ow+(long)row*DM+ch*8,v);} }
  asm volatile("s_waitcnt lgkmcnt(0)\n\ts_barrier":::"memory");
  #undef DMA_K
  #undef KTILE
  #undef VTILE
  #undef DMA_V
  #undef CMASK
  #undef START
  #undef RESC
  #undef ROT
}
constexpr int ATTN_LDS_BYTES=LDS_BYTES;
#undef SBAR
#undef WAIT_BAR
}
#define XB_TMO      128
#define XB_XCNT(j)  (256  + 64 * (j))
#define XB_XSUB(j)  (1280 + 64 * (j))
#define XB_XGEN(j)  (2304 + 64 * (j))
#define XB_TOP      3328
#define XB_TOPGEN   3392
#define XCD_BAR_WORDS 3456
#define XB_SPIN_CAP (1u << 18)
__device__ __forceinline__ unsigned xb_ld(unsigned* p)              { return __hip_atomic_load(p, __ATOMIC_RELAXED, __HIP_MEMORY_SCOPE_AGENT); }
__device__ __forceinline__ unsigned xb_add(unsigned* p, unsigned v) { return __hip_atomic_fetch_add(p, v, __ATOMIC_RELAXED, __HIP_MEMORY_SCOPE_AGENT); }
__device__ __forceinline__ unsigned xb_xcc_id() { return (unsigned)__builtin_amdgcn_s_getreg((3 << 11) | 20) & 0xFu; }
#define XB_SPIN(cond, bar) do { unsigned _sp = 0; while (cond) { __builtin_amdgcn_s_sleep(1); \
    if ((++_sp & 255u) == 0u) { if (xb_ld(&(bar)[XB_TMO])) break; if (_sp > XB_SPIN_CAP) { atomicAdd(&(bar)[XB_TMO], 1u); break; } } } } while (0)
struct XcdBarrier { unsigned* bar; unsigned x; volatile LAS unsigned* st; };
__device__ __forceinline__ XcdBarrier xcd_barrier_post(unsigned* bar, volatile LAS unsigned* st) {
    XcdBarrier b; b.bar = bar; b.x = xb_xcc_id(); b.st = st;
    if (threadIdx.x == 0) (void)xb_add(&bar[XB_XCNT(b.x)], 1u);
    return b;
}
__device__ __forceinline__ void xcd_barrier_complete(unsigned* bar, unsigned x, unsigned& nloc, unsigned& nx) {
    const unsigned G = gridDim.x * gridDim.y * gridDim.z;
    unsigned sum, cnt, mine, sp = 0u;
    for (;;) {
        sum = 0u; cnt = 0u; mine = 0u;
#pragma unroll
        for (unsigned j = 0; j < 16; ++j) { const unsigned c = xb_ld(&bar[XB_XCNT(j)]); sum += c; cnt += (c > 0u) ? 1u : 0u; mine = (j == x) ? c : mine; }
        if (sum == G) break;
        __builtin_amdgcn_s_sleep(1);
        if ((++sp & 255u) == 0u) { if (xb_ld(&bar[XB_TMO])) break; if (sp > XB_SPIN_CAP) { atomicAdd(&bar[XB_TMO], 1u); break; } }
    }
    nloc = mine > 0u ? mine : 1u; nx = cnt > 0u ? cnt : 1u;
}
__device__ __forceinline__ void xcd_barrier(const XcdBarrier& b) {
    asm volatile("s_waitcnt vmcnt(0)" ::: "memory");
    __syncthreads();
    if (threadIdx.x == 0) {
        unsigned long long bar_i = (unsigned long long)b.bar; unsigned bx_ = b.x; asm volatile("" : "+s"(bar_i), "+s"(bx_));
        unsigned* bar = (unsigned*)(__attribute__((address_space(1))) unsigned*)bar_i;
        __builtin_amdgcn_s_waitcnt(0);
        unsigned nloc = b.st[0], nx = b.st[1];
        if (nloc == 0u) { xcd_barrier_complete(bar, bx_, nloc, nx); b.st[0] = nloc; b.st[1] = nx; }
        const unsigned old = xb_add(&bar[XB_XSUB(bx_)], 1u);
        const unsigned gen = old / nloc;
        if (old + 1u == (gen + 1u) * nloc) {
            __builtin_amdgcn_fence(__ATOMIC_RELEASE, "agent");
            asm volatile("s_waitcnt vmcnt(0)" ::: "memory");
            const unsigned og = xb_add(&bar[XB_TOP], 1u);
            const unsigned tg = og / nx;
            if (og + 1u == (tg + 1u) * nx) xb_add(&bar[XB_TOPGEN], 1u);
            else XB_SPIN(xb_ld(&bar[XB_TOPGEN]) == tg, bar);
            __builtin_amdgcn_fence(__ATOMIC_ACQUIRE, "agent");
            xb_add(&bar[XB_XGEN(bx_)], 1u);
            asm volatile("s_waitcnt vmcnt(0)" ::: "memory");
        } else {
            XB_SPIN(xb_ld(&bar[XB_XGEN(bx_)]) == gen, bar);
            __builtin_amdgcn_fence(__ATOMIC_ACQUIRE, "agent");
            asm volatile("s_waitcnt vmcnt(0)" ::: "memory");
        }
    }
    __syncthreads();
}

struct Frame {
    LAS unsigned char* lds;
    int tid, lane, wave, vcu, G, gw, NGW, bid;
    float* out; unsigned char* ws;
};
__device__ __forceinline__ void relaunder(Frame& F) {
    unsigned long long w = (unsigned long long)F.ws, o = (unsigned long long)F.out;
    int vcu = F.vcu, G = F.G, wave = F.wave, tid = F.tid, bid = F.bid;
    asm volatile("" : "+s"(w), "+s"(o), "+s"(vcu), "+s"(G), "+s"(wave), "+s"(bid));
    asm volatile("" : "+v"(tid));
    F.ws = (unsigned char*)(__attribute__((address_space(1))) unsigned char*)w; F.out = (float*)(__attribute__((address_space(1))) float*)o;
    F.vcu = vcu; F.G = G; F.wave = wave; F.tid = tid; F.lane = tid & 63; F.bid = bid; F.gw = vcu * NWAVES + wave; F.NGW = G * NWAVES;
}
#define LDS_WAIT() asm volatile("s_waitcnt lgkmcnt(0)" ::: "memory")

__device__ __forceinline__ void transpose_item(const float* W, int N, int k0, int n0, bf16_t* dst, int ldk, LAS float* scr, int lane) {
#pragma unroll 8
    for (int i = 0; i < 32; ++i) { const int kk = 2 * i + (lane >> 5); scr[kk * 33 + (lane & 31)] = W[(size_t)(k0 + kk) * N + n0 + (lane & 31)]; }
    LDS_WAIT(); asm volatile("" ::: "memory");
    const int c = lane & 7;
#pragma unroll
    for (int j = 0; j < 4; ++j) { const int n = (lane >> 3) + 8 * j; const LAS float* s = scr + (8 * c) * 33 + n;
        u32x4 o; o.x = pk2(s[0 * 33], s[1 * 33]); o.y = pk2(s[2 * 33], s[3 * 33]); o.z = pk2(s[4 * 33], s[5 * 33]); o.w = pk2(s[6 * 33], s[7 * 33]);
        *(u32x4*)(dst + (size_t)n * ldk + 8 * c) = o; }
    LDS_WAIT(); asm volatile("" ::: "memory");
}

__device__ __forceinline__ void transpose_item32(const float* W, int N, int k0, int n0, bf16_t* dst, int ldk, LAS float* scr, int lane) {
#pragma unroll 8
    for (int i = 0; i < 16; ++i) { const int kk = 2 * i + (lane >> 5); scr[kk * 33 + (lane & 31)] = W[(size_t)(k0 + kk) * N + n0 + (lane & 31)]; }
    LDS_WAIT(); asm volatile("" ::: "memory");
    const int c = lane & 3;
#pragma unroll
    for (int j = 0; j < 2; ++j) { const int n = (lane >> 2) + 16 * j; const LAS float* s = scr + (8 * c) * 33 + n;
        u32x4 o; o.x = pk2(s[0 * 33], s[1 * 33]); o.y = pk2(s[2 * 33], s[3 * 33]); o.z = pk2(s[4 * 33], s[5 * 33]); o.w = pk2(s[6 * 33], s[7 * 33]);
        *(u32x4*)(dst + (size_t)n * ldk + 8 * c) = o; }
    LDS_WAIT(); asm volatile("" ::: "memory");
}
__device__ __forceinline__ void transpose_issue32(const float* W, int N, int k0, int n0, float (&v)[16], int lane) {
#pragma unroll
    for (int i = 0; i < 16; ++i) { const int kk = 2 * i + (lane >> 5); v[i] = W[(size_t)(k0 + kk) * N + n0 + (lane & 31)]; }
}
__device__ __forceinline__ void transpose_finish32(const float (&v)[16], bf16_t* dst, int ldk, LAS float* scr, int lane, bool store) {
#pragma unroll
    for (int i = 0; i < 16; ++i) { const int kk = 2 * i + (lane >> 5); scr[kk * 33 + (lane & 31)] = v[i]; }
    LDS_WAIT(); asm volatile("" ::: "memory");
    if (!store) return;
    const int c = lane & 3;
#pragma unroll
    for (int j = 0; j < 2; ++j) { const int n = (lane >> 2) + 16 * j; const LAS float* s = scr + (8 * c) * 33 + n;
        u32x4 o; o.x = pk2(s[0 * 33], s[1 * 33]); o.y = pk2(s[2 * 33], s[3 * 33]); o.z = pk2(s[4 * 33], s[5 * 33]); o.w = pk2(s[6 * 33], s[7 * 33]);
        *(u32x4*)(dst + (size_t)n * ldk + 8 * c) = o; }
    LDS_WAIT(); asm volatile("" ::: "memory");
}
__device__ __forceinline__ void convert_expert_issue32(int l, int it, const float* exp_gate, const float* exp_up, const float* exp_down, float (&v)[16], int lane) {
    constexpr int I_M = 32 * 32;
    const int which = it / (NEXP * I_M), r = it % (NEXP * I_M), e = r / I_M, q = r % I_M, kb = q / 32, nb = q % 32, n0 = nb * 32;
    const float* W = (which == 0 ? exp_gate : (which == 1 ? exp_up : exp_down)) + ((size_t)l * NEXP + e) * DM * EFF;
    transpose_issue32(W, which < 2 ? EFF : DM, kb * 32, n0, v, lane);
}
__device__ __forceinline__ void convert_expert_finish32(unsigned char* ws, int it_, const float (&v)[16], LAS float* scr, int lane) {
    bf16_t* Wup = (bf16_t*)(ws + WS_WUP); bf16_t* Wdn = (bf16_t*)(ws + WS_WDN);
    constexpr int I_M = 32 * 32;
    const bool store = it_ >= 0; const int it = store ? it_ : 0;
    const int which = it / (NEXP * I_M), r = it % (NEXP * I_M), e = r / I_M, q = r % I_M, kb = q / 32, nb = q % 32, n0 = nb * 32;
    if (which < 2) { const int drow = 256 * (n0 >> 7) + 128 * which + (n0 & 127);
        transpose_finish32(v, Wup + ((size_t)e * 2048 + drow) * DM + kb * 32, DM, scr, lane, store); }
    else transpose_finish32(v, Wdn + ((size_t)e * 1024 + n0) * EFF + kb * 32, EFF, scr, lane, store);
}
__device__ __forceinline__ void convert_expert_item32(unsigned char* ws, int l, int it, const float* exp_gate, const float* exp_up, const float* exp_down, LAS float* scr, int lane) {
    bf16_t* Wup = (bf16_t*)(ws + WS_WUP); bf16_t* Wdn = (bf16_t*)(ws + WS_WDN);
    constexpr int I_M = 32 * 32;
    const int which = it / (NEXP * I_M), r = it % (NEXP * I_M), e = r / I_M, q = r % I_M, kb = q / 32, nb = q % 32, n0 = nb * 32;
    const float* W = (which == 0 ? exp_gate : (which == 1 ? exp_up : exp_down)) + ((size_t)l * NEXP + e) * DM * EFF;
    if (which < 2) { const int drow = 256 * (n0 >> 7) + 128 * which + (n0 & 127);
        transpose_item32(W, EFF, kb * 32, n0, Wup + ((size_t)e * 2048 + drow) * DM + kb * 32, DM, scr, lane); }
    else transpose_item32(W, DM, kb * 32, n0, Wdn + ((size_t)e * 1024 + n0) * EFF + kb * 32, EFF, scr, lane);
}

__device__ __forceinline__ void phase_prologue(Frame& F, const float* c_in, const float* cctx_in, const float* ada_w, const float* ada_b, const float* w_in, const float* decay_w2, const float* iclr_a2, const float* gate_g2,
                                               const float* w_br_att, const float* w_br_rwkv, const float* w_br_conv, const float* w_out, const float* w_router) {
    LAS float* scr = (LAS float*)(F.lds + F.wave * 16384);
    bf16_t* Win = (bf16_t*)(F.ws + WS_WIN); bf16_t* Wbr = (bf16_t*)(F.ws + WS_WBR); bf16_t* Wout = (bf16_t*)(F.ws + WS_WOUT); bf16_t* Wlr = (bf16_t*)(F.ws + WS_WLR);
    constexpr int I_IN = 16 * 228, I_BR = 8 * 32, I_OUT = 16 * 32;
    constexpr int PER_L = I_IN + 3 * I_BR + I_OUT;
    for (int it = F.gw; it < NL * PER_L; it += F.NGW) {
        const int l = it / PER_L; int r = it % PER_L;
        if (r < I_IN) { const int kb = r / 228, nb = r % 228; transpose_item(w_in + (size_t)l * DM * NCOLS_IN, NCOLS_IN, kb * 64, nb * 32, Win + ((size_t)l * PWP + nb * 32) * DM + kb * 64, DM, scr, F.lane); continue; }
        r -= I_IN;
        if (r < 3 * I_BR) { const int br = r / I_BR, q = r % I_BR, kb = q / 32, nb = q % 32;
            const float* W = (br == 0 ? w_br_att : (br == 1 ? w_br_rwkv : w_br_conv)) + (size_t)l * 512 * DM;
            transpose_item(W, DM, kb * 64, nb * 32, Wbr + (((size_t)l * 3 + br) * 1024 + nb * 32) * 512 + kb * 64, 512, scr, F.lane); continue; }
        r -= 3 * I_BR;
        { const int kb = r / 32, nb = r % 32; transpose_item(w_out + (size_t)l * DM * DM, DM, kb * 64, nb * 32, Wout + ((size_t)l * 1024 + nb * 32) * DM + kb * 64, DM, scr, F.lane); }
    }
    for (int i = F.gw * 64 + F.lane; i < NL * (PWP - NCOLS_IN) * DM / 8; i += F.NGW * 64) {
        const int l = i / ((PWP - NCOLS_IN) * DM / 8), r = i % ((PWP - NCOLS_IN) * DM / 8);
        *(u32x4*)(Win + ((size_t)l * PWP + NCOLS_IN) * DM + (size_t)r * 8) = (u32x4){0u, 0u, 0u, 0u};
    }
    for (int i = F.gw * 64 + F.lane; i < NL * WAGW * 128; i += F.NGW * 64) {
        const int l = i / (WAGW * 128), r = i % (WAGW * 128), n = r / 128, kk = r % 128;
        float v = 0.f;
        if (n < 512) { if (kk < 64) v = decay_w2[(((size_t)l * 2 + 0) * 64 + kk) * 512 + n]; }
        else if (n < 1024) { if (kk >= 64) v = decay_w2[(((size_t)l * 2 + 1) * 64 + (kk - 64)) * 512 + (n - 512)]; }
        else if (n < 1536) { if (kk < 64) v = iclr_a2[(((size_t)l * 2 + 0) * 64 + kk) * 512 + (n - 1024)]; }
        else if (n < 2048) { if (kk >= 64) v = iclr_a2[(((size_t)l * 2 + 1) * 64 + (kk - 64)) * 512 + (n - 1536)]; }
        else v = gate_g2[((size_t)l * 128 + kk) * 512 + (n - 2048)];
        Wlr[i] = (bf16_t)f2bf(v);
    }
    { bf16_t* WRT = (bf16_t*)(F.ws + WS_WRT);
      for (int i = F.gw * 64 + F.lane; i < NL * 16 * 1024; i += F.NGW * 64) { const int l = i / 16384, r = i % 16384, e = r / 1024, k = r % 1024;
          const float w = w_router[((size_t)l * 1024 + k) * 16 + e]; const unsigned hi = f2bf(w); const unsigned lo = f2bf(w - bflo(hi));
          WRT[((size_t)l * 2 + 0) * 16384 + r] = (bf16_t)hi; WRT[((size_t)l * 2 + 1) * 16384 + r] = (bf16_t)lo; } }
    if (blockIdx.x == 0) {
        float* rope = (float*)(F.ws + WS_ROPE);
        for (int i = F.tid; i < 64 * 16; i += NTHR) { const int pos = i >> 4, fi = i & 15;
            const float inv = powf(10000.0f, -(float)(2 * fi) / 32.0f); const float ang = (float)pos * inv;
            rope[2 * i] = cosf(ang); rope[2 * i + 1] = sinf(ang); }
    }
    __syncthreads();
    LAS float* sc = (LAS float*)F.lds;
    LAS float* part = (LAS float*)(F.lds + 17 * 1024 * 4);
    for (int i = F.tid; i < 17 * 1024; i += NTHR) { const float v = (i < 16 * 1024) ? c_in[i] : cctx_in[i - 16 * 1024]; sc[i] = v * sigmoidf_(v); }
    __syncthreads();
    float* MOD = (float*)(F.ws + WS_MOD);
    for (int item = F.vcu; item < NL * 96; item += F.G) {
        const int l = item / 96, n0 = (item % 96) * 64;
        float acc[17];
#pragma unroll
        for (int r = 0; r < 17; ++r) acc[r] = 0.f;
        const float* wp = ada_w + ((size_t)l * DM + F.wave * 128) * 6144 + n0 + F.lane;
        for (int kk0 = 0; kk0 < 128; kk0 += 16) {
            float w[16];
#pragma unroll
            for (int j = 0; j < 16; ++j) w[j] = wp[(size_t)(kk0 + j) * 6144];
#pragma unroll
            for (int j = 0; j < 16; ++j) {
                const int k = F.wave * 128 + kk0 + j;
#pragma unroll
                for (int r = 0; r < 17; ++r) acc[r] += sc[r * 1024 + k] * w[j];
            }
        }
#pragma unroll
        for (int r = 0; r < 17; ++r) part[(F.wave * 17 + r) * 64 + F.lane] = acc[r];
        __syncthreads();
        for (int idx = F.tid; idx < 17 * 64; idx += NTHR) { const int r = idx >> 6, j = idx & 63; float s = 0.f;
#pragma unroll
            for (int w = 0; w < 8; ++w) s += part[(w * 17 + r) * 64 + j];
            MOD[((size_t)l * 17 + r) * 6144 + n0 + j] = s + ada_b[(size_t)l * 6144 + n0 + j]; }
        __syncthreads();
    }
}

__device__ __forceinline__ void convert_experts(Frame& F, int l, const float* exp_gate, const float* exp_up, const float* exp_down, int wk, int nwk, int it_lo, int it_hi) {
    LAS float* scr = (LAS float*)(F.lds + F.wave * 16384);
    bf16_t* Wup = (bf16_t*)(F.ws + WS_WUP); bf16_t* Wdn = (bf16_t*)(F.ws + WS_WDN);
    constexpr int I_M = 16 * 32;
    for (int it = it_lo + wk; it < it_hi; it += nwk) {
        const int which = it / (NEXP * I_M), r = it % (NEXP * I_M), e = r / I_M, q = r % I_M, kb = q / 32, nb = q % 32, n0 = nb * 32;
        const float* W = (which == 0 ? exp_gate : (which == 1 ? exp_up : exp_down)) + ((size_t)l * NEXP + e) * DM * EFF;
        if (which < 2) { const int drow = 256 * (n0 >> 7) + 128 * which + (n0 & 127);
            transpose_item(W, EFF, kb * 64, n0, Wup + ((size_t)e * 2048 + drow) * DM + kb * 64, DM, scr, F.lane); }
        else transpose_item(W, DM, kb * 64, n0, Wdn + ((size_t)e * 1024 + n0) * EFF + kb * 64, EFF, scr, F.lane);
    }
}

struct N1Row { f32x4 v[4]; int slot; float gate; int row; bool ok; };
__device__ __forceinline__ void n1_load(Frame& F, N1Row& R, int row, int nrows, int l, const float* x_in, const float* ctx_in) {
    R.ok = row < nrows; R.row = R.ok ? row : 0;
    const bool lat = R.row < NLAT;
    if (l == 0) {
        const float* xs = lat ? x_in + (size_t)R.row * DM : ctx_in + (size_t)(R.row - NLAT) * DM;
#pragma unroll
        for (int j = 0; j < 4; ++j) R.v[j] = *(const f32x4*)(xs + 4 * F.lane + 256 * j);
    } else {
        const bf16_t* xb = (const bf16_t*)(F.ws + WS_XB) + (size_t)R.row * DM + 4 * F.lane;
#pragma unroll
        for (int j = 0; j < 4; ++j) { const u32x2 w = *(const u32x2*)(xb + 256 * j); R.v[j] = (f32x4){bflo(w.x), bfhi(w.x), bflo(w.y), bfhi(w.y)}; }
    }
    R.slot = -1; R.gate = 0.f;
    if (l > 0) { R.slot = ((const int*)(F.ws + WS_SLOT))[(size_t)R.row * 16 + (F.lane & 15)]; R.gate = ((const float*)(F.ws + WS_AFF))[(size_t)R.row * 16 + (F.lane & 15)]; }
}
__device__ __forceinline__ void n1_finish(Frame& F, N1Row& R, int l, const float* norm1, const float* final_norm, bool dry) {
    const bool fin = (l == NL);
    const float* MOD = (const float*)(F.ws + WS_MOD);
    const bf16_t* YE = (const bf16_t*)(F.ws + WS_YE); bf16_t* H = (bf16_t*)(F.ws + WS_H);
    const int row = R.row; const bool lat = row < NLAT; const int b = lat ? (row >> 11) : ((row - NLAT) >> 8); const int modrow = lat ? b : 16;
    bf16_t* xbw = (bf16_t*)(F.ws + WS_XB) + (size_t)row * DM;
    if (dry) { xbw = (bf16_t*)(F.ws + WS_WAG) + (size_t)row * DM; H = (bf16_t*)(F.ws + WS_YF); }
    if (l > 0) {
        f32x4 a[4];
#pragma unroll
        for (int j = 0; j < 4; ++j) a[j] = (f32x4){0.f, 0.f, 0.f, 0.f};
        unsigned mask = (unsigned)(__ballot(R.slot >= 0 && F.lane < 16));
        const size_t pbase = (size_t)(lat ? b * CAPL : NB * CAPL + b * CAPC);
        while (mask) {
            const int e0 = __builtin_ctz(mask); mask &= mask - 1u;
            const bool two = mask != 0u; const int e1 = two ? __builtin_ctz(mask) : e0; if (two) mask &= mask - 1u;
            const int s0 = __builtin_amdgcn_readlane(R.slot, e0), s1 = __builtin_amdgcn_readlane(R.slot, e1);
            const float g0 = __builtin_bit_cast(float, __builtin_amdgcn_readlane(__builtin_bit_cast(int, R.gate), e0));
            const float g1 = two ? __builtin_bit_cast(float, __builtin_amdgcn_readlane(__builtin_bit_cast(int, R.gate), e1)) : 0.f;
            const bf16_t* y0 = YE + ((size_t)e0 * PAIRS_E + pbase + s0) * DM + 4 * F.lane;
            const bf16_t* y1 = YE + ((size_t)e1 * PAIRS_E + pbase + s1) * DM + 4 * F.lane;
            u32x2 w0[4], w1[4];
#pragma unroll
            for (int j = 0; j < 4; ++j) { w0[j] = *(const u32x2*)(y0 + 256 * j); w1[j] = *(const u32x2*)(y1 + 256 * j); }
#pragma unroll
            for (int j = 0; j < 4; ++j) {
                a[j][0] += g0 * bflo(w0[j].x) + g1 * bflo(w1[j].x); a[j][1] += g0 * bfhi(w0[j].x) + g1 * bfhi(w1[j].x);
                a[j][2] += g0 * bflo(w0[j].y) + g1 * bflo(w1[j].y); a[j][3] += g0 * bfhi(w0[j].y) + g1 * bfhi(w1[j].y);
            }
        }
        const float* g2 = MOD + ((size_t)(l - 1) * 17 + modrow) * 6144 + 5 * 1024 + 4 * F.lane;
#pragma unroll
        for (int j = 0; j < 4; ++j) R.v[j] += *(const f32x4*)(g2 + 256 * j) * a[j];
    }
    if (!fin && R.ok) {
#pragma unroll
        for (int j = 0; j < 4; ++j) { u32x2 w; w.x = pk2(R.v[j][0], R.v[j][1]); w.y = pk2(R.v[j][2], R.v[j][3]); *(u32x2*)(xbw + 4 * F.lane + 256 * j) = w; }
    }
    float ss = 0.f;
#pragma unroll
    for (int j = 0; j < 4; ++j) ss += (R.v[j][0] * R.v[j][0] + R.v[j][1] * R.v[j][1]) + (R.v[j][2] * R.v[j][2] + R.v[j][3] * R.v[j][3]);
    const float rstd = rsq_(wave_sum(ss) * (1.0f / DM) + NORM_EPS);
    if (!R.ok) return;
    if (fin) {
        const float* gn = final_norm + 4 * F.lane;
#pragma unroll
        for (int j = 0; j < 4; ++j) *(f32x4*)(F.out + (size_t)row * DM + 4 * F.lane + 256 * j) = R.v[j] * rstd * *(const f32x4*)(gn + 256 * j);
    } else {
        const float* gn = norm1 + (size_t)l * DM + 4 * F.lane;
        const float* md = MOD + ((size_t)l * 17 + modrow) * 6144 + 4 * F.lane;
#pragma unroll
        for (int j = 0; j < 4; ++j) {
            const f32x4 h = R.v[j] * rstd * *(const f32x4*)(gn + 256 * j) * (*(const f32x4*)(md + 1024 + 256 * j) + 1.0f) + *(const f32x4*)(md + 256 * j);
            u32x2 w; w.x = pk2(h[0], h[1]); w.y = pk2(h[2], h[3]);
            *(u32x2*)(H + (size_t)row * DM + 4 * F.lane + 256 * j) = w;
        }
    }
}
__device__ __forceinline__ void phase_norm1(Frame& F, int l, const float* x_in, const float* ctx_in, const float* norm1, const float* final_norm, bool dry = false) {
    const int nrows = (l == NL) ? NLAT : NTOK;
    for (int row = F.gw; row < nrows; row += 4 * F.NGW) {
        N1Row A, B, C, D;
        n1_load(F, A, row, nrows, l, x_in, ctx_in); n1_load(F, B, row + F.NGW, nrows, l, x_in, ctx_in); n1_load(F, C, row + 2 * F.NGW, nrows, l, x_in, ctx_in); n1_load(F, D, row + 3 * F.NGW, nrows, l, x_in, ctx_in);
        n1_finish(F, A, l, norm1, final_norm, dry); n1_finish(F, B, l, norm1, final_norm, dry); n1_finish(F, C, l, norm1, final_norm, dry); n1_finish(F, D, l, norm1, final_norm, dry);
    }
}

struct PrepRow { u32x4 q, k, bg, cg[3], u[3], lr[3]; };
__device__ __forceinline__ void prep_load(PrepRow& R, const bf16_t* pr, int t, int slen, int lane) {
    const bool hp = t > 0, hn = t + 1 < slen; const u32x4 z = {0u, 0u, 0u, 0u};
    R.q = *(const u32x4*)(pr + C_Q + 8 * lane); R.k = *(const u32x4*)(pr + C_K + 8 * (lane & 15));
    R.bg = *(const u32x4*)(pr + C_BG + 8 * lane);
    R.cg[0] = *(const u32x4*)(pr + C_CG + 8 * lane); R.u[0] = *(const u32x4*)(pr + C_U + 8 * lane);
    R.cg[1] = hp ? *(const u32x4*)(pr - PW + C_CG + 8 * lane) : z; R.u[1] = hp ? *(const u32x4*)(pr - PW + C_U + 8 * lane) : z;
    R.cg[2] = hn ? *(const u32x4*)(pr + PW + C_CG + 8 * lane) : z; R.u[2] = hn ? *(const u32x4*)(pr + PW + C_U + 8 * lane) : z;
    const int ll = lane < 48 ? lane : 47;
    R.lr[0] = *(const u32x4*)(pr + C_WLO + 8 * ll);
    R.lr[1] = hp ? *(const u32x4*)(pr - PW + C_WLO + 8 * ll) : z; R.lr[2] = hn ? *(const u32x4*)(pr + PW + C_WLO + 8 * ll) : z;
}
__device__ __forceinline__ void phase_prep(Frame& F, int l, const float* q_gain, const float* k_gain, const float* conv_w, const float* shift_mu, bool dry = false) {
    bf16_t* P = (bf16_t*)(F.ws + WS_PROJ); bf16_t* LRA = (bf16_t*)(F.ws + WS_LRA);
    LAS float* rope = (LAS float*)F.lds;
    for (int i = F.tid; i < 64 * 16 * 2; i += NTHR) rope[i] = ((const float*)(F.ws + WS_ROPE))[i];
    __syncthreads();
    const int lane = F.lane, s8 = lane & 7;
    float qg[8], kg[8], cw0[8], cw1[8], cw2[8], mu[8];
#pragma unroll
    for (int i = 0; i < 8; ++i) { qg[i] = q_gain[l * 64 + s8 * 8 + i]; kg[i] = k_gain[l * 64 + s8 * 8 + i];
        cw0[i] = conv_w[((size_t)l * 3 + 0) * 512 + 8 * lane + i]; cw1[i] = conv_w[((size_t)l * 3 + 1) * 512 + 8 * lane + i]; cw2[i] = conv_w[((size_t)l * 3 + 2) * 512 + 8 * lane + i];
        mu[i] = (lane < 48) ? shift_mu[(size_t)l * 1920 + (C_WLO - C_RW) + 8 * lane + i] : 0.f; }
    for (int row0 = F.gw; row0 < NTOK; row0 += 2 * F.NGW) {
        const int row1 = row0 + F.NGW; const bool ok1 = row1 < NTOK;
        PrepRow RR[2]; int tt[2]; bool latt[2];
#pragma unroll
        for (int z = 0; z < 2; ++z) { const int row = (z == 0 || !ok1) ? row0 : row1; latt[z] = row < NLAT; tt[z] = latt[z] ? (row & 2047) : ((row - NLAT) & 255);
            prep_load(RR[z], P + (size_t)row * PW, tt[z], latt[z] ? SEQ : CTXL, lane); }
#pragma unroll
        for (int z = 0; z < 2; ++z) {
            if (z == 1 && !ok1) break;
            const int row = z == 0 ? row0 : row1; const PrepRow& R = RR[z]; const bool lat = latt[z]; const int t = tt[z];
            bf16_t* pr = P + (size_t)row * PW;
#pragma unroll
            for (int which = 0; which < 2; ++which) {
                float x[8]; unpack8(which == 0 ? R.q : R.k, x);
                float ss = 0.f;
#pragma unroll
                for (int i = 0; i < 8; ++i) ss += x[i] * x[i];
                ss = sum8(ss);
                const float rstd = rsq_(ss * (1.0f / 64.0f) + NORM_EPS);
#pragma unroll
                for (int i = 0; i < 8; ++i) x[i] = x[i] * rstd * (which == 0 ? qg[i] : kg[i]);
                if (lat) {
                    const int pos = (s8 < 4) ? (t >> 6) : (t & 63);
                    float o[8];
#pragma unroll
                    for (int i = 0; i < 8; ++i) {
                        const float partner = dpp_f(x[i], 1);
                        const int fi = (s8 & 1) * 8 + i;
                        const float c = rope[(pos * 16 + fi) * 2], sn = rope[(pos * 16 + fi) * 2 + 1];
                        o[i] = (s8 & 2) ? (partner * sn + x[i] * c) : (x[i] * c - partner * sn);
                    }
#pragma unroll
                    for (int i = 0; i < 8; ++i) x[i] = o[i];
                }
                if (which == 0) {
#pragma unroll
                    for (int i = 0; i < 8; ++i) x[i] *= QSCALE;
                    if (!dry) st8(pr + C_Q + 8 * lane, x);
                } else if (lane < 16 && !dry) st8(pr + C_K + 8 * lane, x);
            }
            {
                float bg[8], c0[8], u0[8], z0[8], zp[8], zn[8];
                unpack8(R.bg, bg);
                unpack8(R.cg[0], c0); unpack8(R.u[0], u0);
#pragma unroll
                for (int i = 0; i < 8; ++i) z0[i] = c0[i] * u0[i];
                unpack8(R.cg[1], c0); unpack8(R.u[1], u0);
#pragma unroll
                for (int i = 0; i < 8; ++i) zp[i] = c0[i] * u0[i];
                unpack8(R.cg[2], c0); unpack8(R.u[2], u0);
#pragma unroll
                for (int i = 0; i < 8; ++i) zn[i] = c0[i] * u0[i];
                float o[8];
#pragma unroll
                for (int i = 0; i < 8; ++i) o[i] = bg[i] * (cw0[i] * zp[i] + cw1[i] * z0[i] + cw2[i] * zn[i]);
                if (!dry) st8(pr + C_OCONV + 8 * lane, o);
            }
            {
                float x[8], xp[8], xn[8], o[8];
                unpack8(R.lr[0], x); unpack8(R.lr[1], xp); unpack8(R.lr[2], xn);
#pragma unroll
                for (int i = 0; i < 8; ++i) { const float sft = x[i] + mu[i] * (0.5f * (xp[i] + xn[i]) - x[i]);
                    const float sg = sigmoidf_(lane < 16 ? 2.0f * sft : sft); o[i] = lane < 16 ? 2.0f * sg - 1.0f : (lane < 32 ? sft : sg); }
                if (lane < 48) st8(LRA + (size_t)row * LRAW + 8 * lane, o);
            }
        }
    }
}
__device__ __forceinline__ void n2_modulate(Frame& F, f32x4 (&v)[4], int row, int l, const float* norm2) {
    const float* MOD = (const float*)(F.ws + WS_MOD); bf16_t* H = (bf16_t*)(F.ws + WS_H);
    const bool lat = row < NLAT; const int b = lat ? (row >> 11) : ((row - NLAT) >> 8); const int modrow = lat ? b : 16;
    float ss = 0.f;
#pragma unroll
    for (int j = 0; j < 4; ++j) ss += (v[j][0] * v[j][0] + v[j][1] * v[j][1]) + (v[j][2] * v[j][2] + v[j][3] * v[j][3]);
    const float rstd = rsq_(wave_sum(ss) * (1.0f / DM) + NORM_EPS);
    const float* gn = norm2 + (size_t)l * DM + 4 * F.lane;
    const float* md = MOD + ((size_t)l * 17 + modrow) * 6144 + 3 * 1024 + 4 * F.lane;
#pragma unroll
    for (int j = 0; j < 4; ++j) {
        v[j] = v[j] * rstd * *(const f32x4*)(gn + 256 * j) * (*(const f32x4*)(md + 1024 + 256 * j) + 1.0f) + *(const f32x4*)(md + 256 * j);
        u32x2 w; w.x = pk2(v[j][0], v[j][1]); w.y = pk2(v[j][2], v[j][3]);
        *(u32x2*)(H + (size_t)row * DM + 4 * F.lane + 256 * j) = w;
    }
}
__device__ __forceinline__ void n2_softmax_store(Frame& F, float (&lg)[16], int row) {
    float* AFF = (float*)(F.ws + WS_AFF);
    float mx = lg[0];
#pragma unroll
    for (int e = 1; e < 16; ++e) mx = fmaxf(mx, lg[e]);
    float den = 0.f;
#pragma unroll
    for (int e = 0; e < 16; ++e) { lg[e] = __expf(lg[e] - mx); den += lg[e]; }
    const float inv = rcp_(den);
    float mine = 0.f;
#pragma unroll
    for (int e = 0; e < 16; ++e) mine = (F.lane == e) ? lg[e] * inv : mine;
    if (F.lane < 16) AFF[(size_t)row * 16 + F.lane] = mine;
}
__device__ __forceinline__ void phase_norm2_router(Frame& F, int l, int nrows, const float* norm2, const float* w_router) {
    LAS float* wrT = (LAS float*)F.lds;
    for (int i = F.tid; i < 16 * 1024; i += NTHR) { const int c = i >> 4, e = i & 15; wrT[e * 1024 + c] = w_router[(size_t)l * DM * 16 + i]; }
    __syncthreads();
    const bf16_t* XB = (const bf16_t*)(F.ws + WS_XB);
    for (int row = F.gw; row < nrows; row += 2 * F.NGW) {
        const int row1 = row + F.NGW; const bool ok1 = row1 < nrows; const int r1 = ok1 ? row1 : row;
        f32x4 v0[4], v1[4];
#pragma unroll
        for (int j = 0; j < 4; ++j) { const u32x2 a = *(const u32x2*)(XB + (size_t)row * DM + 4 * F.lane + 256 * j), b = *(const u32x2*)(XB + (size_t)r1 * DM + 4 * F.lane + 256 * j);
            v0[j] = (f32x4){bflo(a.x), bfhi(a.x), bflo(a.y), bfhi(a.y)}; v1[j] = (f32x4){bflo(b.x), bfhi(b.x), bflo(b.y), bfhi(b.y)}; }
        n2_modulate(F, v0, row, l, norm2);
        n2_modulate(F, v1, r1, l, norm2);
        float lg0[16], lg1[16];
#pragma unroll
        for (int e = 0; e < 16; ++e) {
            float s0 = 0.f, s1 = 0.f;
#pragma unroll
            for (int j = 0; j < 4; ++j) { const f32x4 w = *(const LAS f32x4*)(wrT + e * 1024 + 4 * F.lane + 256 * j);
                s0 += (v0[j][0] * w[0] + v0[j][1] * w[1]) + (v0[j][2] * w[2] + v0[j][3] * w[3]); s1 += (v1[j][0] * w[0] + v1[j][1] * w[1]) + (v1[j][2] * w[2] + v1[j][3] * w[3]); }
            lg0[e] = wave_sum(s0); lg1[e] = wave_sum(s1);
            if ((e & 3) == 3) __builtin_amdgcn_sched_barrier(0);
        }
        n2_softmax_store(F, lg0, row);
        if (ok1) n2_softmax_store(F, lg1, row1);
    }
}

__device__ __forceinline__ float qsum4(float x) {
    x += __shfl_xor(x, 16); x += __shfl_xor(x, 32);
    return x;
}
__device__ __forceinline__ void n2_tile(Frame& F, int row0, const LAS float* Gs, const LAS float* Sh, const bf16_t* WRh, const bf16_t* WRl) {
    const int lane = F.lane, r = lane & 15, q = lane >> 4;
    const bf16_t* xrow = (const bf16_t*)(F.ws + WS_XB) + (size_t)(row0 + r) * DM + 8 * q;
    bf16_t* hrow = (bf16_t*)(F.ws + WS_H) + (size_t)(row0 + r) * DM + 8 * q;
    const bf16_t* wh = WRh + (size_t)r * 1024 + 8 * q; const bf16_t* wl = WRl + (size_t)r * 1024 + 8 * q;
    float ss = 0.f;
#pragma unroll 8
    for (int s = 0; s < 32; ++s) { float x[8]; ld8(xrow + 32 * s, x);
#pragma unroll
        for (int j = 0; j < 8; ++j) ss += x[j] * x[j]; }
    const float rstd = rsq_(qsum4(ss) * (1.0f / DM) + NORM_EPS);
    f32x4 acc = {0.f, 0.f, 0.f, 0.f};
#pragma unroll 2
    for (int s = 0; s < 32; ++s) {
        float x[8]; ld8(xrow + 32 * s, x);
        const f32x4 g0 = *(const LAS f32x4*)(Gs + 32 * s + 8 * q), g1 = *(const LAS f32x4*)(Gs + 32 * s + 8 * q + 4), h0 = *(const LAS f32x4*)(Sh + 32 * s + 8 * q), h1 = *(const LAS f32x4*)(Sh + 32 * s + 8 * q + 4);
        const bf16x8 bh = *(const bf16x8*)(wh + 32 * s), bl = *(const bf16x8*)(wl + 32 * s);
        float h[8];
#pragma unroll
        for (int j = 0; j < 4; ++j) { h[j] = x[j] * rstd * g0[j] + h0[j]; h[4 + j] = x[4 + j] * rstd * g1[j] + h1[j]; }
        u32x4 hw; hw.x = pk2(h[0], h[1]); hw.y = pk2(h[2], h[3]); hw.z = pk2(h[4], h[5]); hw.w = pk2(h[6], h[7]);
        *(u32x4*)(hrow + 32 * s) = hw;
        u32x4 lw; lw.x = pk2(h[0] - bflo(hw.x), h[1] - bfhi(hw.x)); lw.y = pk2(h[2] - bflo(hw.y), h[3] - bfhi(hw.y)); lw.z = pk2(h[4] - bflo(hw.z), h[5] - bfhi(hw.z)); lw.w = pk2(h[6] - bflo(hw.w), h[7] - bfhi(hw.w));
        const bf16x8 ah = __builtin_bit_cast(bf16x8, hw), al = __builtin_bit_cast(bf16x8, lw);
        acc = __builtin_amdgcn_mfma_f32_16x16x32_bf16(ah, bh, acc, 0, 0, 0);
        acc = __builtin_amdgcn_mfma_f32_16x16x32_bf16(ah, bl, acc, 0, 0, 0);
        acc = __builtin_amdgcn_mfma_f32_16x16x32_bf16(al, bh, acc, 0, 0, 0);
    }
    float* AFF = (float*)(F.ws + WS_AFF);
#pragma unroll
    for (int g = 0; g < 4; ++g) {
        float mx = acc[g];
#pragma unroll
        for (int c_ = 0; c_ < 4; ++c_) mx = fmaxf(mx, dpp_f(mx, c_));
        const float e = __expf(acc[g] - mx);
        float den = e;
#pragma unroll
        for (int c_ = 0; c_ < 4; ++c_) den += dpp_f(den, c_);
        AFF[(size_t)(row0 + 4 * q + g) * 16 + r] = e * rcp_(den);
    }
}
__device__ __forceinline__ void phase_norm2_router_mfma(Frame& F, int l, int nrows, const float* norm2) {
    LAS float* Gs = (LAS float*)F.lds;
    LAS float* Sh = Gs + 2048;
    const float* MOD = (const float*)(F.ws + WS_MOD);
    const int b = (F.vcu * NWAVES * 16) >> 11;
    for (int i = F.tid; i < 2048; i += NTHR) { const int c = i & 1023, modrow = i < 1024 ? b : 16; const float* md = MOD + ((size_t)l * 17 + modrow) * 6144 + 3 * 1024;
        Gs[i] = norm2[(size_t)l * DM + c] * (1.0f + md[1024 + c]); Sh[i] = md[c]; }
    __syncthreads();
    const bf16_t* WRh = (const bf16_t*)(F.ws + WS_WRT) + (size_t)l * 2 * 16384; const bf16_t* WRl = WRh + 16384;
    n2_tile(F, 16 * F.gw, Gs, Sh, WRh, WRl);
    if (nrows > NLAT && F.wave == 0) n2_tile(F, NLAT + 16 * F.vcu, Gs + 1024, Sh + 1024, WRh, WRl);
}

__device__ __forceinline__ int block_sum_i(LAS int* red, int& par, int wave_val, int wave, int lane) {
    if (lane == 0) red[par * 8 + wave] = wave_val;
    __syncthreads();
    int s = 0;
#pragma unroll
    for (int w = 0; w < 8; ++w) s += red[par * 8 + w];
    par ^= 1;
    return s;
}
__device__ __forceinline__ int block_exscan_i(LAS int* red, int& par, int val, int wave, int lane) {
    int inc = val;
#pragma unroll
    for (int o = 1; o < 64; o <<= 1) { const int t = __shfl_up(inc, o); if (lane >= o) inc += t; }
    if (lane == 63) red[par * 8 + wave] = inc;
    __syncthreads();
    int base = 0;
#pragma unroll
    for (int w = 0; w < 8; ++w) base += (w < wave) ? red[par * 8 + w] : 0;
    par ^= 1;
    return base + inc - val;
}
__device__ __forceinline__ void topk_set(Frame& F, LAS int* red, int& par, int n, int cap, int rowbase, int e, int listbase) {
    const float* AFF = (const float*)(F.ws + WS_AFF); int* LIST = (int*)(F.ws + WS_LIST); int* SLOT = (int*)(F.ws + WS_SLOT);
    unsigned key[4];
#pragma unroll
    for (int j = 0; j < 4; ++j) { const int tok = 4 * F.tid + j; key[j] = (tok < n) ? __builtin_bit_cast(unsigned, AFF[(size_t)(rowbase + tok) * 16 + e]) : 0u; }
    unsigned T = 0u;
    for (int bit = 30; bit >= 0; --bit) {
        const unsigned cand = T | (1u << bit);
        int c = 0;
#pragma unroll
        for (int j = 0; j < 4; ++j) c += __popcll(__ballot(key[j] >= cand));
        if (block_sum_i(red, par, c, F.wave, F.lane) >= cap) T = cand;
    }
    int cgt = 0, ceq = 0;
#pragma unroll
    for (int j = 0; j < 4; ++j) { cgt += __popcll(__ballot(key[j] > T)); ceq += (key[j] == T) ? 1 : 0; }
    const int n_gt = block_sum_i(red, par, cgt, F.wave, F.lane);
    const int need_eq = cap - n_gt;
    int eqrank = block_exscan_i(red, par, ceq, F.wave, F.lane);
    int sel[4], csel = 0;
#pragma unroll
    for (int j = 0; j < 4; ++j) { const bool eq = key[j] == T; sel[j] = (key[j] > T || (eq && eqrank < need_eq)) ? 1 : 0; eqrank += eq ? 1 : 0; csel += sel[j]; }
    int slot = block_exscan_i(red, par, csel, F.wave, F.lane);
#pragma unroll
    for (int j = 0; j < 4; ++j) { const int tok = 4 * F.tid + j;
        if (tok < n) { SLOT[(size_t)(rowbase + tok) * 16 + e] = sel[j] ? slot : -1; if (sel[j]) { LIST[listbase + slot] = rowbase + tok; ++slot; } } }
}
__device__ __forceinline__ void phase_topk(Frame& F, bool need_ctx) {
    LAS int* red = (LAS int*)F.lds; int par = 0;
    for (int pair = F.vcu; pair < NB * NEXP; pair += F.G) {
        const int b = pair >> 4, e = pair & 15;
        topk_set(F, red, par, SEQ, CAPL, b * SEQ, e, e * PAIRS_E + b * CAPL);
        if (need_ctx) topk_set(F, red, par, CTXL, CAPC, NLAT + b * CTXL, e, e * PAIRS_E + NB * CAPL + b * CAPC);
    }
}

constexpr int SC_STEPS = 32;
constexpr int CS_AT = 0, CS_BT = 4608, CS_KT = 9216, CS_RT = 13824, CS_WC = 18432, CS_SET = CS_WC + 512;
__device__ __forceinline__ u32x2 cs_tr(const LAS char* arr, int row0, int col0, int lane) {
    const LAS char* p = arr + (row0 + ((lane & 15) >> 2)) * 144 + (col0 + 4 * (lane & 3)) * 2;
    return __builtin_bit_cast(u32x2, __builtin_amdgcn_ds_read_tr16_b64_v4i16((LAS attn_body::v4i16_t*)p));
}
constexpr int CS_WT = 2 * CS_SET, CS_NM = CS_WT + 1024, CS_ABK = CS_NM + 2560, CS_AVT = CS_ABK + 2 * 2560, CS_TT = CS_AVT + 2 * 10240, CS_CONV = CS_TT + 1024;
constexpr int CS_CST = CS_CONV + 4 * 4224, CS_YO = CS_CST + 1536, CS_VTR = CS_YO + 4608, CS_VTSZ = 4608;
static_assert(CS_SET % 16 == 0 && CS_VTR + 3 * CS_VTSZ <= MISC_OFF, "scan lds map");
__device__ __forceinline__ void scan_chunk_geom(int ci, int b, int d, int s, int& slen, int& t, size_t& row) {
    constexpr int NC = CTXL / SC_STEPS;
    const bool ctx = ci < NC; slen = ctx ? CTXL : SEQ; const int c0 = (ctx ? ci : ci - NC) * SC_STEPS; const int rowbase = ctx ? NLAT + b * CTXL : b * SEQ;
    t = d == 0 ? (c0 + s) : (slen - 1 - (c0 + s)); row = (size_t)(rowbase + t);
}
#define CS_MMA(x_, y_, c_) __builtin_amdgcn_mfma_f32_16x16x32_bf16(x_, y_, c_, 0, 0, 0)
__device__ __forceinline__ bf16x8 cs_ld16(const LAS char* p) { return *(const LAS bf16x8*)p; }
__device__ __forceinline__ bf16x8 cs_ld8x2(const LAS char* p0, const LAS char* p1) { const u32x2 a = *(const LAS u32x2*)p0, b = *(const LAS u32x2*)p1; const u32x4 w = {a.x, a.y, b.x, b.y}; return __builtin_bit_cast(bf16x8, w); }
__device__ __forceinline__ void cs_st16(LAS char* p, float x) { *(LAS unsigned short*)p = (unsigned short)pk2(x, x); }
#define CS_UD4(v_) asm volatile("" : "=v"(v_.x), "=v"(v_.y), "=v"(v_.z), "=v"(v_.w))
#define CS_UD8(a_) asm volatile("" : "=v"(a_[0]), "=v"(a_[1]), "=v"(a_[2]), "=v"(a_[3]), "=v"(a_[4]), "=v"(a_[5]), "=v"(a_[6]), "=v"(a_[7]))
#define CS_UNDEF_ALL() do { CS_UD4(rx[0]); CS_UD4(rx[1]); CS_UD4(rx[2]); CS_UD4(rp[0]); CS_UD4(rp[1]); CS_UD4(rp[2]); CS_UD4(rn[0]); CS_UD4(rn[1]); CS_UD4(rn[2]); CS_UD4(wu); CS_UD4(wa); \
        CS_UD8(pr_); CS_UD8(pkk); CS_UD8(pb); CS_UD8(pkd); asm volatile("" : "=v"(cv[0]), "=v"(cv[1]), "=v"(cv[2]), "=v"(cv[3]), "=v"(cv[4]), "=v"(cv[5]), "=v"(cv[6]), "=v"(cv[7])); \
        asm volatile("" : "=v"(cv[8]), "=v"(cv[9]), "=v"(cv[10]), "=v"(cv[11]), "=v"(cv[12]), "=v"(cv[13]), "=v"(cv[14]), "=v"(cv[15])); asm volatile("" : "=v"(cv_it)); } while (0)
#define CS_BAR() asm volatile("s_waitcnt lgkmcnt(0)\n\ts_barrier" ::: "memory")
template <int PR>
__device__ __forceinline__ void phase_scan(Frame& F, int l, const float* shift_mu, const float* rwkv_kk, const float* rwkv_ka, const float* exp_gate, const float* exp_up, const float* exp_down, const float* rwkv_rk, bool noconv_ = false) {
    const bool noconv = noconv_ || PR != 0;
    const bf16_t* P = (const bf16_t*)(F.ws + WS_PROJ); const bf16_t* WAG = (const bf16_t*)(F.ws + WS_WAG);
    LAS char* LB = (LAS char*)F.lds;
    const int tid = F.tid;
    const bool teamS = F.wave < 4;
    constexpr bool skipS = (PR & 1) != 0, skipP = (PR & 2) != 0, skipY = (PR & 4) != 0, skipS2 = (PR & 8) != 0, skipS3 = (PR & 16) != 0, skipP2 = (PR & 32) != 0;
    const int wv = F.wave & 3;
    const int pt = tid & 255, s = pt >> 3, cg = pt & 7;
    const int psc = s >> 4, pts = s & 15;
    constexpr int NCH = (CTXL + SEQ) / SC_STEPS;
    for (int chain = F.vcu; chain < 2 * NB * 8; chain += F.G) {
        const int d = chain >> 7, b = (chain >> 3) & 15, h = chain & 7;
        bf16_t* Y = (bf16_t*)(F.ws + (d == 0 ? WS_YF : WS_YB));
        const int hc = h * 64 + 8 * cg;
        if (tid < 384) {
            const int a_ = tid >> 6, c_ = tid & 63;
            const float* src = a_ == 0 ? rwkv_rk + (size_t)l * 512 : a_ == 4 ? rwkv_kk + (size_t)l * 512 : a_ == 5 ? rwkv_ka + (size_t)l * 512 : shift_mu + (size_t)l * 1920 + 512 * (a_ - 1);
            ((LAS float*)(LB + CS_CST))[tid] = src[h * 64 + c_];
        }
        __syncthreads();
        f32x4 Sacc[4];
#pragma unroll
        for (int j = 0; j < 4; ++j) Sacc[j] = (f32x4){0.f, 0.f, 0.f, 0.f};
        float pr_[8], pkk[8], pb[8], pkd[8];
        u32x4 rx[3], rp[3], rn[3], wu, wa;
        float cv[16]; int cv_it = -1;
#define CS_FETCH(cix_, dep_) do { int slen_, t_; size_t row_; scan_chunk_geom((cix_), b, d, s + (dep_), slen_, t_, row_); const bf16_t* pr_g = P + row_ * PW + C_RW + hc; const bool hp_ = t_ > 0, hn_ = t_ + 1 < slen_; \
            const bf16_t* pr_p = pr_g - (hp_ ? PW : 0); const bf16_t* pr_n = pr_g + (hn_ ? PW : 0);        \
            _Pragma("unroll") for (int q = 0; q < 3; ++q) { rx[q] = *(const u32x4*)(pr_g + 512 * q); rp[q] = *(const u32x4*)(pr_p + 512 * q); rn[q] = *(const u32x4*)(pr_n + 512 * q); } \
            wu = *(const u32x4*)(WAG + row_ * WAGW + d * 512 + hc); wa = *(const u32x4*)(WAG + row_ * WAGW + 1024 + d * 512 + hc); } while (0)
#pragma unroll
        for (int i = 0; i < 16; ++i) cv[i] = 0.f;
        if (!teamS) CS_FETCH(0, 0);
        for (int ci = -2; ci < NCH; ++ci) {
            int lane = F.lane; asm volatile("" : "+v"(lane));
            const int r16 = lane & 15, q4 = lane >> 4;
            const int s = ((tid & 255) >> 6) * 8 + (lane >> 3), cg = lane & 7;
            const int psc = s >> 4, pts = s & 15;
            const int hc = h * 64 + 8 * cg;
            const LAS char* set0 = LB + (ci & 1) * CS_SET;
            const LAS char* set1 = LB + ((ci + 1) & 1) * CS_SET;
            if (teamS) {
                if (ci >= 0 && !skipS && !skipS3) {
                    const LAS char* setc = set0; const LAS char* vtc = LB + CS_VTR + (ci % 3) * CS_VTSZ; const LAS char* abk = LB + CS_ABK + (ci & 1) * 2560;
                    const int vrow = 16 * wv + r16;
#pragma unroll
                    for (int sc = 0; sc < 2; ++sc) {
                        bf16x8 sop[2];
#pragma unroll
                        for (int kk = 0; kk < 2; ++kk) { const u32x4 w = {pk2(Sacc[2 * kk][0], Sacc[2 * kk][1]), pk2(Sacc[2 * kk][2], Sacc[2 * kk][3]), pk2(Sacc[2 * kk + 1][0], Sacc[2 * kk + 1][1]), pk2(Sacc[2 * kk + 1][2], Sacc[2 * kk + 1][3])}; sop[kk] = __builtin_bit_cast(bf16x8, w); }
                        f32x4 uacc = *(const LAS f32x4*)(LB + CS_AVT + (ci & 1) * 10240 + (sc * 64 + vrow) * 80 + 16 * q4);
                        f32x4 yacc = {0.f, 0.f, 0.f, 0.f};
#pragma unroll
                        for (int kk = 0; kk < 2; ++kk) {
                            const LAS char* ah = setc + CS_AT + (16 * sc + r16) * 144 + 64 * kk + 8 * q4;
                            uacc = CS_MMA(cs_ld8x2(ah, ah + 32), sop[kk], uacc);
                            const LAS char* rt = setc + CS_RT + (16 * sc + r16) * 144 + 64 * kk + 8 * q4;
                            yacc = CS_MMA(cs_ld8x2(rt, rt + 32), sop[kk], yacc);
                        }
                        {
                            const u32x2 t2 = *(const LAS u32x2*)(LB + CS_TT + (sc * 16 + r16) * 32 + 8 * q4);
                            const u32x4 tw = {t2.x, t2.y, 0u, 0u}, pw = {pk2(uacc[0], uacc[1]), pk2(uacc[2], uacc[3]), 0u, 0u};
                            uacc = CS_MMA(__builtin_bit_cast(bf16x8, tw), __builtin_bit_cast(bf16x8, pw), ((f32x4){0.f, 0.f, 0.f, 0.f}));
                        }
                        const u32x2 v2 = cs_tr(vtc, 16 * sc + 4 * q4, 16 * wv, lane);
                        const u32x4 uvw = {pk2(uacc[0], uacc[1]), pk2(uacc[2], uacc[3]), v2.x, v2.y};
                        const bf16x8 uv = __builtin_bit_cast(bf16x8, uvw);
                        yacc = CS_MMA(cs_ld16(abk + (sc * 16 + r16) * 80 + 16 * q4), uv, yacc);
#pragma unroll
                        for (int tile = 0; tile < 4; ++tile) {
                            const f32x4 wc = *(const LAS f32x4*)(setc + CS_WC + (sc * 64 + 16 * tile + 4 * q4) * 4);
                            const u32x2 bt2 = cs_tr(setc + CS_BT, 16 * sc + 4 * q4, 16 * tile, lane), kt2 = cs_tr(setc + CS_KT, 16 * sc + 4 * q4, 16 * tile, lane);
                            const u32x4 bkw = {bt2.x, bt2.y, kt2.x, kt2.y};
                            Sacc[tile] = CS_MMA(__builtin_bit_cast(bf16x8, bkw), uv, Sacc[tile]) * wc;
                        }
#pragma unroll
                        for (int g = 0; g < 4; ++g) cs_st16(LB + CS_YO + (16 * sc + 4 * q4 + g) * 144 + 2 * vrow, yacc[g]);
                    }
                }
                if (ci + 1 >= 0 && ci + 1 < NCH && !skipS) {
                    const LAS char* setc = set1; const LAS char* vtc = LB + CS_VTR + ((ci + 1) % 3) * CS_VTSZ; LAS char* abk = LB + CS_ABK + ((ci + 1) & 1) * 2560;
                    const int sc = wv >> 1, role = wv & 1;
                    const LAS char* yop = setc + (role == 0 ? CS_AT : CS_RT) + (16 * sc + r16) * 144 + 16 * q4;
                    const LAS char* xb = setc + CS_BT + (16 * sc + r16) * 144 + 16 * q4;
                    const LAS char* xk = setc + CS_KT + (16 * sc + r16) * 144 + 16 * q4;
                    f32x4 accB = {0.f, 0.f, 0.f, 0.f}, accK = {0.f, 0.f, 0.f, 0.f};
#pragma unroll
                    for (int kk = 0; kk < 2; ++kk) { const bf16x8 yv = cs_ld16(yop + 64 * kk); accB = CS_MMA(cs_ld16(xb + 64 * kk), yv, accB); accK = CS_MMA(cs_ld16(xk + 64 * kk), yv, accK); }
                    if (role == 0) {
                        f32x4 nm; float ak[4];
#pragma unroll
                        for (int g = 0; g < 4; ++g) { const bool keep = 4 * q4 + g < r16; nm[g] = keep ? accB[g] : 0.f; ak[g] = keep ? accK[g] : 0.f; }
                        *(LAS f32x4*)(LB + CS_NM + (sc * 16 + r16) * 80 + 16 * q4) = nm;
                        const u32x4 xw = {pk2(ak[0], ak[1]), pk2(ak[2], ak[3]), 0u, 0u};
                        const bf16x8 xop = __builtin_bit_cast(bf16x8, xw);
#pragma unroll
                        for (int vt = 0; vt < 4; ++vt) {
                            const u32x2 v2 = cs_tr(vtc, 16 * sc + 4 * q4, 16 * vt, lane);
                            const u32x4 yw = {v2.x, v2.y, 0u, 0u};
                            f32x4 av = {0.f, 0.f, 0.f, 0.f};
                            av = CS_MMA(xop, __builtin_bit_cast(bf16x8, yw), av);
                            *(LAS f32x4*)(LB + CS_AVT + ((ci + 1) & 1) * 10240 + (sc * 64 + 16 * vt + r16) * 80 + 16 * q4) = av;
                        }
                    } else {
                        float rb[4], rk[4];
#pragma unroll
                        for (int g = 0; g < 4; ++g) { const bool keep = 4 * q4 + g <= r16; rb[g] = keep ? accB[g] : 0.f; rk[g] = keep ? accK[g] : 0.f; }
                        const u32x4 w = {pk2(rb[0], rb[1]), pk2(rb[2], rb[3]), pk2(rk[0], rk[1]), pk2(rk[2], rk[3])};
                        *(LAS u32x4*)(abk + (sc * 16 + r16) * 80 + 16 * q4) = w;
                    }
                }
                CS_UNDEF_ALL();
            } else {
              {
                  LAS float* scr = (LAS float*)(LB + CS_CONV) + (F.wave - 4) * (32 * 33);
                  convert_expert_finish32(F.ws, cv_it, cv, scr, F.lane);
              }
              int dep = 0;
              if (ci + 2 < NCH && !skipP) {
                int slen, t; size_t row;
                scan_chunk_geom(ci + 2, b, d, s, slen, t, row);
                const bool hp = t > 0, hn = t + 1 < slen;
                const LAS float* cst = (const LAS float*)(LB + CS_CST) + 8 * cg;
                float k[8], pv[8];
#pragma unroll
                for (int q = 0; q < 3; ++q) {
                    float x[8], xp[8], xn[8];
                    const unsigned mp = hp ? 0xffffffffu : 0u, mn = hn ? 0xffffffffu : 0u;
                    unpack8(rx[q], x); unpack8((u32x4){rp[q].x & mp, rp[q].y & mp, rp[q].z & mp, rp[q].w & mp}, xp); unpack8((u32x4){rn[q].x & mn, rn[q].y & mn, rn[q].z & mn, rn[q].w & mn}, xn);
                    const f32x4 m0 = *(const LAS f32x4*)(cst + 64 * (1 + q)), m1 = *(const LAS f32x4*)(cst + 64 * (1 + q) + 4);
#pragma unroll
                    for (int i = 0; i < 8; ++i) { const float m = i < 4 ? m0[i & 3] : m1[i & 3]; const float sft = x[i] + m * (0.5f * (xp[i] + xn[i]) - x[i]);
                        if (q == 0) pr_[i] = sft; else if (q == 1) k[i] = sft; else pv[i] = sft; }
                    __builtin_amdgcn_sched_barrier(0);
                }
                __builtin_amdgcn_sched_barrier(0);
                float pu[8], ag[8];
                unpack8(wu, pu); unpack8(wa, ag);
#pragma unroll
                for (int i = 0; i < 8; ++i) pu[i] *= 1.4426950408889634f;
                asm volatile("" : "+v"(dep) : "v"(pu[0]), "v"(pu[1]), "v"(pu[2]), "v"(pu[3]), "v"(pu[4]), "v"(pu[5]), "v"(pu[6]), "v"(pu[7]), "v"(ag[0]), "v"(ag[1]), "v"(ag[2]), "v"(ag[3]), "v"(ag[4]), "v"(ag[5]), "v"(ag[6]), "v"(ag[7]), "v"(pr_[0]), "v"(k[0]), "v"(pv[0]), "v"(pr_[7]), "v"(k[7]), "v"(pv[7]));
                CS_FETCH(ci + 3 < NCH ? ci + 3 : NCH - 1, dep);
#pragma unroll
                for (int i = 0; i < 1; ++i) *(LAS u32x4*)(LB + CS_VTR + ((ci + 2) % 3) * CS_VTSZ + s * 144 + 16 * cg) = pack8(pv);
                if (d == 0) {
                    const f32x4 k0 = *(const LAS f32x4*)(cst), k1 = *(const LAS f32x4*)(cst + 4);
                    float bs = 0.f, bo[8];
#pragma unroll
                    for (int i = 0; i < 8; ++i) bs += pr_[i] * k[i] * (i < 4 ? k0[i & 3] : k1[i & 3]);
                    bs = sum8(bs);
#pragma unroll
                    for (int i = 0; i < 8; ++i) bo[i] = bs * pv[i];
                    st8((bf16_t*)(F.ws + WS_BON) + row * 512 + hc, bo);
                }
                LAS float* ub = (LAS float*)(LB + CS_CONV + (F.wave - 4) * 4224) + (s & 7) * 64 + 8 * cg;
                *(LAS f32x4*)ub = (f32x4){pu[0], pu[1], pu[2], pu[3]}; *(LAS f32x4*)(ub + 4) = (f32x4){pu[4], pu[5], pu[6], pu[7]};
                {
                    float pl[8];
                    const int srcA = ((lane >> 4) - 1) * 16 + 8 + cg, srcB = ((lane >> 4) - 2) * 16 + 8 + cg;
#pragma unroll
                    for (int i = 0; i < 8; ++i) pl[i] = pu[i] + __builtin_bit_cast(float, __builtin_amdgcn_update_dpp(0, __builtin_bit_cast(int, pu[i]), 0x118, 0xF, 0xF, true));
#pragma unroll
                    for (int i = 0; i < 8; ++i) { const float t_ = __builtin_bit_cast(float, __builtin_amdgcn_ds_bpermute(srcA * 4, __builtin_bit_cast(int, pl[i]))); pl[i] += lane >= 16 ? t_ : 0.f; }
#pragma unroll
                    for (int i = 0; i < 8; ++i) { const float t_ = __builtin_bit_cast(float, __builtin_amdgcn_ds_bpermute(srcB * 4, __builtin_bit_cast(int, pl[i]))); pl[i] += lane >= 32 ? t_ : 0.f; }
                    if (lane >= 56) { LAS float* wt = (LAS float*)(LB + CS_WT) + (s >> 3) * 64 + 8 * cg; *(LAS f32x4*)wt = (f32x4){pl[0], pl[1], pl[2], pl[3]}; *(LAS f32x4*)(wt + 4) = (f32x4){pl[4], pl[5], pl[6], pl[7]}; }
                    LAS float* ub2 = ub + 512;
                    *(LAS f32x4*)ub2 = (f32x4){pl[0], pl[1], pl[2], pl[3]}; *(LAS f32x4*)(ub2 + 4) = (f32x4){pl[4], pl[5], pl[6], pl[7]};
                }
                const f32x4 kk0 = *(const LAS f32x4*)(cst + 64 * 4), kk1 = *(const LAS f32x4*)(cst + 64 * 4 + 4), ka0 = *(const LAS f32x4*)(cst + 64 * 5), ka1 = *(const LAS f32x4*)(cst + 64 * 5 + 4);
                float kks[8], n2 = 0.f;
#pragma unroll
                for (int i = 0; i < 8; ++i) { kks[i] = k[i] * (i < 4 ? kk0[i & 3] : kk1[i & 3]); n2 += kks[i] * kks[i]; }
                n2 = sum8(n2);
                const float rn_ = rsq_(n2 + 1e-12f);
#pragma unroll
                for (int i = 0; i < 8; ++i) { pkk[i] = kks[i] * rn_; pb[i] = pkk[i] * ag[i]; pkd[i] = k[i] * (1.0f + (ag[i] - 1.0f) * (i < 4 ? ka0[i & 3] : ka1[i & 3])); }
              }
            }
            CS_BAR();
            if (teamS) {
                if (ci + 1 >= 0 && ci + 1 < NCH && !skipS && !skipS2) {
                    const LAS char* setc = set1;
                    const int sc = wv >> 1, part = wv & 1;
                    if (part == 0) {
                        const LAS float* nrow = (const LAS float*)(LB + CS_NM + sc * 1280);
                        float xs[16];
#pragma unroll
                        for (int t = 0; t < 16; ++t) xs[t] = t == r16 ? 1.0f : 0.0f;
#pragma unroll
                        for (int t = 1; t < 16; ++t) {
                            float a3[3] = {xs[t], 0.f, 0.f};
#pragma unroll
                            for (int i4 = 0; i4 < (t + 3) / 4; ++i4) {
                                const f32x4 n4 = *(const LAS f32x4*)(nrow + t * 20 + 4 * i4);
#pragma unroll
                                for (int jx = 0; jx < 4; ++jx) if (4 * i4 + jx < t) a3[(4 * i4 + jx) % 3] += n4[jx] * xs[4 * i4 + jx];
                            }
                            xs[t] = (a3[0] + a3[1]) + a3[2];
                        }
                        if (lane < 16) {
#pragma unroll
                            for (int t = 0; t < 16; ++t) cs_st16(LB + CS_TT + (sc * 16 + t) * 32 + 2 * lane, xs[t]);
                        }
                    }
                }
                CS_UNDEF_ALL();
            } else {
              {
                  const int pw = F.vcu * 4 + (F.wave - 4), npw = F.G * 4;
                  const int it = ((ci / 3) * 2 + (ci % 3)) * npw + pw;
                  const bool valid = ci >= 0 && ci % 3 != 2 && chain < F.G && !noconv && it < 3 * NEXP * 1024;
                  cv_it = valid ? it : -1;
                  convert_expert_issue32(l, valid ? it : pw, exp_gate, exp_up, exp_down, cv, lane);
              }
              if (ci + 2 < NCH && !skipP && !skipP2) {
                LAS char* setn = LB + (ci & 1) * CS_SET;
                float li[8], lt[8];
                const LAS float* ub = (const LAS float*)(LB + CS_CONV + (F.wave - 4) * 4224) + (s & 7) * 64 + 8 * cg;
                {
                    const int wq = s >> 3;
                    const LAS float* w0 = (const LAS float*)(LB + CS_WT) + wq * 64 + 8 * cg; const LAS float* w1 = (const LAS float*)(LB + CS_WT) + (wq ^ 1) * 64 + 8 * cg;
                    const f32x4 a0 = *(const LAS f32x4*)w0, a1 = *(const LAS f32x4*)(w0 + 4), b0 = *(const LAS f32x4*)w1, b1 = *(const LAS f32x4*)(w1 + 4);
                    const float m = (wq & 1) ? 1.0f : 0.0f;
                    const LAS float* ub2 = ub + 512;
                    const f32x4 p0 = *(const LAS f32x4*)ub2, p1 = *(const LAS f32x4*)(ub2 + 4);
#pragma unroll
                    for (int i = 0; i < 4; ++i) { lt[i] = a0[i] + b0[i]; lt[4 + i] = a1[i] + b1[i]; li[i] = p0[i] + m * b0[i]; li[4 + i] = p1[i] + m * b1[i]; }
                }
                float at[8], bt[8], kt[8], rt[8], pu[8];
                { const f32x4 u0 = *(const LAS f32x4*)(ub), u1 = *(const LAS f32x4*)(ub + 4); pu[0] = u0[0]; pu[1] = u0[1]; pu[2] = u0[2]; pu[3] = u0[3]; pu[4] = u1[0]; pu[5] = u1[1]; pu[6] = u1[2]; pu[7] = u1[3]; }
#pragma unroll
                for (int i = 0; i < 8; ++i) {
                    const float wt = __builtin_amdgcn_exp2f(-li[i]), wprev = __builtin_amdgcn_exp2f(pu[i] - li[i]), iw = __builtin_amdgcn_exp2f(li[i]);
                    at[i] = -pkk[i] * wprev; bt[i] = pb[i] * iw; kt[i] = pkd[i] * iw; rt[i] = pr_[i] * wt;
                }
                *(LAS u32x4*)(setn + CS_AT + s * 144 + 16 * cg) = pack8(at);
                *(LAS u32x4*)(setn + CS_BT + s * 144 + 16 * cg) = pack8(bt);
                *(LAS u32x4*)(setn + CS_KT + s * 144 + 16 * cg) = pack8(kt);
                *(LAS u32x4*)(setn + CS_RT + s * 144 + 16 * cg) = pack8(rt);
                if (pts == 15) {
                    LAS float* wc = (LAS float*)(setn + CS_WC) + psc * 64 + 8 * cg;
                    *(LAS f32x4*)wc = (f32x4){__builtin_amdgcn_exp2f(-lt[0]), __builtin_amdgcn_exp2f(-lt[1]), __builtin_amdgcn_exp2f(-lt[2]), __builtin_amdgcn_exp2f(-lt[3])}; *(LAS f32x4*)(wc + 4) = (f32x4){__builtin_amdgcn_exp2f(-lt[4]), __builtin_amdgcn_exp2f(-lt[5]), __builtin_amdgcn_exp2f(-lt[6]), __builtin_amdgcn_exp2f(-lt[7])};
                }
            }
              if (ci >= 0 && !(skipS || skipS3 || skipY)) {
                  int slen, t; size_t row;
                  scan_chunk_geom(ci, b, d, s, slen, t, row);
                  *(u32x4*)(Y + row * 512 + hc) = *(const LAS u32x4*)(LB + CS_YO + s * 144 + 16 * cg);
              }
            }
            CS_BAR();
        }
        if (!teamS) { LAS float* scr = (LAS float*)(LB + CS_CONV) + (F.wave - 4) * (32 * 33); convert_expert_finish32(F.ws, cv_it, cv, scr, F.lane); }
        __syncthreads();
#undef CS_FETCH
    }
}
#undef CS_MMA

struct RoRow { u32x4 yf, yb, bo, g; };
__device__ __forceinline__ void ro_load(Frame& F, RoRow& R, int row) {
    const int lane = F.lane;
    R.yf = *(const u32x4*)((const bf16_t*)(F.ws + WS_YF) + (size_t)row * 512 + 8 * lane); R.yb = *(const u32x4*)((const bf16_t*)(F.ws + WS_YB) + (size_t)row * 512 + 8 * lane);
    R.bo = *(const u32x4*)((const bf16_t*)(F.ws + WS_BON) + (size_t)row * 512 + 8 * lane);
    R.g = *(const u32x4*)((const bf16_t*)(F.ws + WS_WAG) + (size_t)row * WAGW + 2048 + 8 * lane);
}
__device__ __forceinline__ void phase_readout(Frame& F, int l, int nrows, const float* gn_w, const float* gn_b) {
    bf16_t* P = (bf16_t*)(F.ws + WS_PROJ);
    const int lane = F.lane;
    float gw[8], gb[8];
#pragma unroll
    for (int i = 0; i < 8; ++i) { gw[i] = gn_w[(size_t)l * 512 + 8 * lane + i]; gb[i] = gn_b[(size_t)l * 512 + 8 * lane + i]; }
    for (int row0 = F.gw; row0 < nrows; row0 += 4 * F.NGW) {
        RoRow RR[4]; int rows[4]; bool ok[4];
#pragma unroll
        for (int z = 0; z < 4; ++z) { rows[z] = row0 + z * F.NGW; ok[z] = rows[z] < nrows; ro_load(F, RR[z], ok[z] ? rows[z] : row0); }
#pragma unroll
        for (int z = 0; z < 4; ++z) {
            if (!ok[z]) continue;
            const RoRow& R = RR[z];
            float yf[8], yb[8], y[8];
            unpack8(R.yf, yf); unpack8(R.yb, yb);
            float sm = 0.f;
#pragma unroll
            for (int i = 0; i < 8; ++i) { y[i] = yf[i] + yb[i]; sm += y[i]; }
            const float mean = sum8(sm) * (1.0f / 64.0f);
            float sq = 0.f;
#pragma unroll
            for (int i = 0; i < 8; ++i) { y[i] -= mean; sq += y[i] * y[i]; }
            const float rstd = rsq_(sum8(sq) * (1.0f / 64.0f) + GN_EPS);
            float bo[8], g[8], o[8];
            unpack8(R.bo, bo); unpack8(R.g, g);
#pragma unroll
            for (int i = 0; i < 8; ++i) o[i] = (y[i] * rstd * gw[i] + gb[i] + bo[i]) * g[i];
            st8(P + (size_t)rows[z] * PW + C_ORWKV + 8 * lane, o);
        }
    }
}
__device__ __forceinline__ void phase_attention(Frame& F, bool need_ctx, char* lds_generic) {
    typedef attn_body::bf16 abf;
    abf* P = (abf*)(F.ws + WS_PROJ);
    const int nu = (need_ctx && F.vcu < NB * 8) ? 5 : 4;
    for (int i = 0; i < nu; ++i) {
        int b, h, qrow, NT;
        if (i < 4) { const int u = F.vcu * 4 + i; b = u >> 6; h = (u >> 3) & 7; qrow = b * SEQ + (u & 7) * 256; NT = (CTXL + SEQ) / 64; }
        else { b = F.vcu >> 3; h = F.vcu & 7; qrow = NLAT + b * CTXL; NT = CTXL / 64; }
        abf* Qu = P + (size_t)qrow * PW + C_Q + h * 64;
        attn_body::attn_unit<8>(Qu, Qu + (C_OATT - C_Q), P + C_K + (h >> 2) * 64, NLAT + b * CTXL, b * SEQ, NT, CTXL / 64, lds_generic);
    }
}

struct Args { const float* in[32]; float* out; unsigned char* ws; int ph_lo, ph_hi; };
constexpr int PH_PER_LAYER = 12, PH_FINAL = 1 + NL * PH_PER_LAYER, PH_END = PH_FINAL + 1;

__global__ void __launch_bounds__(NTHR, 2) mega_fwd(Args args) {
    extern __shared__ __attribute__((aligned(16))) unsigned char lds[];
    Frame F;
    F.lds = (LAS unsigned char*)lds;
    F.tid = threadIdx.x; F.lane = F.tid & 63; F.wave = __builtin_amdgcn_readfirstlane(F.tid >> 6);
    F.G = gridDim.x; { const int bx = blockIdx.x; F.vcu = (F.G % 8 == 0) ? (bx % 8) * (F.G / 8) + bx / 8 : bx; }
    F.gw = F.vcu * NWAVES + F.wave; F.NGW = F.G * NWAVES; F.bid = blockIdx.x;
    F.out = args.out; F.ws = args.ws;
    volatile LAS unsigned* MISC = (volatile LAS unsigned*)(F.lds + MISC_OFF);
    for (int u = F.tid; u < (LDS_BYTES - MISC_OFF) / 4; u += NTHR) MISC[u] = 0u;
    __syncthreads();
    unsigned* ctl = (unsigned*)(F.ws + WS_CTL);
    XcdBarrier bar = xcd_barrier_post(ctl + CW_BAR, MISC + 8);
    const int lo = args.ph_lo, hi = args.ph_hi;
    typedef const __attribute__((address_space(1))) float* cfp_t;
#define KP(k) ((const float*)KIN[k])
#define KIN_DECL const __attribute__((address_space(4))) cfp_t* KIN = (const __attribute__((address_space(4))) cfp_t*)__builtin_amdgcn_kernarg_segment_ptr(); asm volatile("" : "+s"(KIN))
#ifndef PHMASK
#define PHMASK 0xFFFFFFFFu
#endif
#define IN(k) (lo <= (k) && (k) < hi)
#define EN(j) ((PHMASK >> (j)) & 1u)
#define SEAM(k) do { if ((k) + 1 < hi) xcd_barrier(bar); } while (0)
#ifndef DUPMASK
#define DUPMASK 0u
#endif
#define REP(j) for (int rep_ = 0; rep_ < 1 + (int)((DUPMASK >> (j)) & 1u); ++rep_)
#ifdef PROBE_T1
    unsigned long long pt0 = 0; int l_ = 0; volatile LAS unsigned* PTS = MISC + 64;
#define PB() do { pt0 = __builtin_amdgcn_s_memrealtime(); } while (0)
#define PE(j) do { PTS[(j) * 4 + (l_ & 3)] = (unsigned)(__builtin_amdgcn_s_memrealtime() - pt0); } while (0)
#else
#define PB() do {} while (0)
#define PE(j) do {} while (0)
#endif

    if (EN(0) && IN(0)) { relaunder(F); PB(); KIN_DECL; REP(0) phase_prologue(F, KP(1), KP(3), KP(4), KP(5), KP(7), KP(12), KP(14), KP(15), KP(22), KP(23), KP(24), KP(25), KP(27)); SEAM(0); PE(0); }

    for (int l = 0; l < NL; ++l) {
#ifdef PROBE_T1
        l_ = l;
#endif
        const int pb = 1 + l * PH_PER_LAYER;
        const bool need_ctx = l < NL - 1;
        const int nrows = need_ctx ? NTOK : NLAT;
        if (EN(1) && IN(pb + 0)) { relaunder(F); PB(); KIN_DECL; REP(1) phase_norm1(F, l, KP(0), KP(2), KP(6), KP(31), rep_ > 0); SEAM(pb + 0); PE(1); }
        if (EN(2) && IN(pb + 1)) { relaunder(F); PB();
            pg8::EpiProj E{(bf16_t*)(F.ws + WS_PROJ), F.ws + WS_GATES};
            if (need_ctx) { pg8::PlainOrder S; S.init(F.ws + WS_H, F.ws + WS_WIN + (size_t)l * PWP * DM * 2, NTOK, PWP, DM, DM, F.G, F.bid);
                REP(2) pg8::gemm_phase<pg8::EpiProj, pg8::PlainOrder, false>(F.lds, DM, DM, DM, S, E); }
            else { pg8::LastProjOrder S; S.init(F.ws + WS_H, F.ws + WS_WIN + (size_t)l * PWP * DM * 2, DM, DM, F.G, F.bid);
                pg8::gemm_phase<pg8::EpiProj, pg8::LastProjOrder, false>(F.lds, DM, DM, DM, S, E); }
            SEAM(pb + 1); PE(2);
        }
        if (EN(3) && IN(pb + 2)) { relaunder(F); PB(); KIN_DECL; REP(3) phase_prep(F, l, KP(8), KP(9), KP(21), KP(10), rep_ > 0); SEAM(pb + 2); PE(3); }
        if (EN(4) && IN(pb + 3)) { relaunder(F); PB();
            pg8::LowRankOrder S{(const char*)(F.ws + WS_LRA), (const char*)(F.ws + WS_WLR + (size_t)l * WAGW * 128 * 2), NTOK / 256, F.G, F.bid};
            KIN_DECL; pg8::EpiLowRank E{(bf16_t*)(F.ws + WS_WAG), KP(11) + (size_t)l * 1024, KP(13) + (size_t)l * 1024};
            int klr = 128; asm volatile("" : "+s"(klr));
            REP(4) pg8::gemm_phase<pg8::EpiLowRank, pg8::LowRankOrder, false>(F.lds, klr, LRAW, 128, S, E);
            REP(14) phase_attention(F, need_ctx, (char*)lds);
            SEAM(pb + 3); PE(4);
        }
        if (EN(5) && IN(pb + 4)) { relaunder(F); PB(); KIN_DECL; REP(5) phase_scan<0>(F, l, KP(10), KP(16), KP(17), KP(28), KP(29), KP(30), KP(18), rep_ > 0);
#ifdef SCAN_PROBE
            phase_scan<SCAN_PROBE>(F, l, KP(10), KP(16), KP(17), KP(28), KP(29), KP(30), KP(18), true);
#endif
 SEAM(pb + 4); PE(5); }
        if (EN(6) && IN(pb + 5)) { relaunder(F); PB(); KIN_DECL; REP(6) phase_readout(F, l, nrows, KP(19), KP(20)); SEAM(pb + 5); PE(6); }
        if (EN(7) && IN(pb + 6)) { relaunder(F); PB();
            pg8::MergeOrder S{(const char*)(F.ws + WS_PROJ), (const char*)(F.ws + WS_WBR + (size_t)l * 3 * 1024 * 512 * 2), nrows / 256, F.G, F.bid};
            pg8::EpiMerge E{(const unsigned char*)(F.ws + WS_GATES), (bf16_t*)(F.ws + WS_H)};
            REP(7) pg8::gemm_phase<pg8::EpiMerge, pg8::MergeOrder, false>(F.lds, 512, PW, 512, S, E);
            SEAM(pb + 6); PE(7);
        }
        if (EN(8) && IN(pb + 7)) { relaunder(F); PB();
            pg8::PlainOrder S; S.init(F.ws + WS_H, F.ws + WS_WOUT + (size_t)l * DM * DM * 2, nrows, DM, DM, DM, F.G, F.bid);
            pg8::EpiOut E{(bf16_t*)(F.ws + WS_XB), (const float*)(F.ws + WS_MOD) + (size_t)l * 17 * 6144};
            pg8::gemm_phase<pg8::EpiOut, pg8::PlainOrder, false>(F.lds, DM, DM, DM, S, E);
            SEAM(pb + 7); PE(8);
        }
        if (EN(9) && IN(pb + 8)) { relaunder(F); PB(); KIN_DECL; REP(9) phase_norm2_router_mfma(F, l, nrows, KP(26)); SEAM(pb + 8); PE(9); }
        if (EN(10) && IN(pb + 9)) { relaunder(F); PB(); REP(10) phase_topk(F, need_ctx); SEAM(pb + 9); PE(10); }
        if (EN(11) && IN(pb + 10)) { relaunder(F); PB();
            const int mt_per = need_ctx ? 18 : 16;
            LAS int* rows = (LAS int*)(F.lds + XTRA_OFF);
            pg8::MoeOrder S{(const char*)(F.ws + WS_H), (const char*)(F.ws + WS_WUP), rows, mt_per, 8, F.G, F.bid, (size_t)2048 * 1024 * 2};
            const int* LIST = (const int*)(F.ws + WS_LIST);
            for (int i = 0; i < XTRA_BYTES / 1024; ++i) { int e, mt, pn; if (!S.decode((long)i * F.G + F.bid, e, mt, pn)) break;
                if (F.tid < 256) rows[i * 256 + F.tid] = LIST[e * PAIRS_E + mt * 256 + F.tid]; }
            __syncthreads();
            pg8::EpiUp E{(bf16_t*)(F.ws + WS_HID)};
            REP(11) pg8::gemm_phase<pg8::EpiUp, pg8::MoeOrder, true>(F.lds, DM, DM, DM, S, E);
            SEAM(pb + 10); PE(11);
        }
        if (EN(12) && IN(pb + 11)) { relaunder(F); PB();
            const int mt_per = need_ctx ? 18 : 16;
            pg8::MoeDownOrder S{(const char*)(F.ws + WS_HID), (const char*)(F.ws + WS_WDN), mt_per, F.G, F.bid};
            pg8::EpiDown E{(bf16_t*)(F.ws + WS_YE)};
            REP(12) pg8::gemm_phase<pg8::EpiDown, pg8::MoeDownOrder, false>(F.lds, EFF, EFF, EFF, S, E);
            SEAM(pb + 11); PE(12);
        }
    }
    if (EN(13) && IN(PH_FINAL)) { relaunder(F); PB(); KIN_DECL; phase_norm1(F, NL, KP(0), KP(2), KP(6), KP(31)); PE(13); }
#ifdef PROBE_T1
    {
        __syncthreads();
        if (blockIdx.x == 0 && threadIdx.x == 0) { unsigned s1 = 0, s2 = 0; for (int q = 0; q < 4; ++q) { s1 += PTS[PROBE_T1 * 4 + q]; s2 += PTS[PROBE_T2 * 4 + q]; } ctl[CW_DBG] = s1; ctl[CW_DBG + 1] = s2; }
        xcd_barrier(bar);
        const float t1 = (float)__hip_atomic_load(ctl + CW_DBG, __ATOMIC_RELAXED, __HIP_MEMORY_SCOPE_AGENT), t2 = (float)__hip_atomic_load(ctl + CW_DBG + 1, __ATOMIC_RELAXED, __HIP_MEMORY_SCOPE_AGENT);
        const float cval = 10.0f * sqrtf(t1 * 0.01f);
        for (size_t i = (size_t)F.bid * NTHR + F.tid; i < (size_t)NLAT * DM; i += (size_t)F.G * NTHR) F.out[i] = (i == 0) ? t2 : cval;
    }
#endif
#undef IN
#undef SEAM
}

extern "C" void kernel_launch(void* const* d_in, const int* in_sizes, int n_in, void* d_out, int out_size, void* d_ws, size_t ws_size, hipStream_t stream) {
    static int grid = 0;
    if (grid == 0) {
        if (n_in != 32 || in_sizes[0] != NLAT * DM || out_size != NLAT * DM || ws_size < WS_END) { fprintf(stderr, "kernel_launch: unexpected shapes / workspace (n_in %d, ws %zu)\n", n_in, ws_size); grid = -1; return; }
        int dev = 0, cus = 0, per_cu = 0;
        if (hipGetDevice(&dev) != hipSuccess || hipDeviceGetAttribute(&cus, hipDeviceAttributeMultiprocessorCount, dev) != hipSuccess) { grid = -1; return; }
        if (hipFuncSetAttribute((const void*)mega_fwd, hipFuncAttributeMaxDynamicSharedMemorySize, LDS_BYTES) != hipSuccess) { grid = -1; return; }
        if (hipOccupancyMaxActiveBlocksPerMultiprocessor(&per_cu, (const void*)mega_fwd, NTHR, LDS_BYTES) != hipSuccess || per_cu < 1) { fprintf(stderr, "kernel_launch: occupancy query says %d\n", per_cu); }
        (void)hipGetLastError();
        grid = cus;
        if (grid != 256) { fprintf(stderr, "kernel_launch: built for 256 CUs, got %d\n", grid); grid = -1; return; }
    }
    if (grid < 0) return;
    if (hipMemsetAsync((char*)d_ws + WS_CTL, 0, CTL_ZERO_BYTES, stream) != hipSuccess) return;
    Args a{};
    for (int i = 0; i < 32; ++i) a.in[i] = (const float*)d_in[i];
    a.out = (float*)d_out; a.ws = (unsigned char*)d_ws;
#ifndef MK_PER_PHASE
    a.ph_lo = 0; a.ph_hi = PH_END;
    hipLaunchKernelGGL(mega_fwd, dim3(grid), dim3(NTHR), LDS_BYTES, stream, a);
#else
    for (int p = 0; p < PH_END; ++p) { a.ph_lo = p; a.ph_hi = p + 1; hipLaunchKernelGGL(mega_fwd, dim3(grid), dim3(NTHR), LDS_BYTES, stream, a); }
#endif
}
```

```cpp
#include <hip/hip_runtime.h>
#include <hip/hip_bf16.h>
#include <cstdio>
#include <cstdint>
#include <cmath>

#define LAS __attribute__((address_space(3)))
typedef unsigned short bf16_t;
typedef short bf16x8 __attribute__((ext_vector_type(8)));
typedef float f32x4 __attribute__((ext_vector_type(4)));
typedef float f32x2 __attribute__((ext_vector_type(2)));
typedef unsigned u32x4 __attribute__((ext_vector_type(4)));
typedef unsigned u32x2 __attribute__((ext_vector_type(2)));

constexpr int DM = 1024, NB = 16, SEQ = 2048, NL = 4, CTXL = 256;
constexpr int NLAT = NB * SEQ;
constexpr int NCTX = NB * CTXL;
constexpr int NTOK = NLAT + NCTX;
constexpr int PW = 4224;
constexpr int NCOLS_IN = 7296;
constexpr int PWP = 7424;
constexpr int C_Q = 0, C_K = 512, C_V = 640, C_RW = 768, C_R = 768, C_RK = 1280, C_RV = 1792, C_WLO = 2304, C_ALO = 2432, C_GLO = 2560;
constexpr int C_BG = 2688, C_CG = 3200, C_U = 3712, C_GT = 4224;
constexpr int C_OATT = 3712, C_OCONV = 2688, C_ORWKV = 3200;
constexpr int WAGW = 2560;
constexpr int LRAW = 384;
constexpr int NEXP = 16, EFF = 1024, CAPL = 256, CAPC = 32, PAIRS_E = 4608;
constexpr float NORM_EPS = 1e-6f, GN_EPS = 64e-5f;
constexpr float QSCALE = 0.125f * 1.4426950408889634f;

constexpr size_t MiB = 1u << 20;
constexpr size_t WS_CTL = 0, CTL_ZERO_BYTES = 1 * MiB;
constexpr size_t WS_MOD = 1 * MiB;
constexpr size_t WS_ROPE = 3 * MiB;
constexpr size_t WS_WRT = 3 * MiB + 65536;
constexpr size_t WS_LIST = 4 * MiB;
constexpr size_t WS_SLOT = 5 * MiB;
constexpr size_t WS_AFF = 8 * MiB;
constexpr size_t WS_XC = 11 * MiB;
constexpr size_t WS_WIN = 27 * MiB;
constexpr size_t WS_WBR = 85 * MiB;
constexpr size_t WS_WOUT = 97 * MiB;
constexpr size_t WS_WLR = 105 * MiB;
constexpr size_t WS_WUP = 113 * MiB;
constexpr size_t WS_WDN = 177 * MiB;
constexpr size_t WS_H = 209 * MiB;
constexpr size_t WS_PROJ = 281 * MiB;
constexpr size_t WS_GATES = 578 * MiB;
constexpr size_t WS_HID = WS_PROJ;
constexpr size_t WS_YE = WS_PROJ + 144 * MiB;
constexpr size_t WS_XB = 686 * MiB;
constexpr size_t WS_WAG = 794 * MiB;
constexpr size_t WS_LRA = 974 * MiB;
constexpr size_t WS_YF = 1001 * MiB;
constexpr size_t WS_YB = 1037 * MiB;
constexpr size_t WS_BON = 1073 * MiB;
constexpr size_t WS_END = 1109 * MiB;
static_assert(WS_WIN + (size_t)NL * PWP * DM * 2 <= WS_WBR && WS_PROJ + (size_t)NTOK * PW * 2 <= WS_GATES && WS_GATES + (size_t)NTOK * 3072 <= WS_XB && WS_XB + (size_t)NTOK * DM * 2 <= WS_WAG && WS_WAG + (size_t)NTOK * WAGW * 2 <= WS_LRA && WS_LRA + (size_t)NTOK * LRAW * 2 <= WS_YF, "ws map");
static_assert(WS_YE + (size_t)NEXP * PAIRS_E * DM * 2 <= WS_GATES && WS_H + (size_t)NTOK * DM * 2 <= WS_PROJ, "ws map 2");
constexpr int CW_BAR = 4096;
constexpr int CW_DBG = 32768;

constexpr int RING_BYTES = 131072;
constexpr int XTRA_OFF = RING_BYTES;
constexpr int XTRA_BYTES = 12288;
constexpr int MISC_OFF = XTRA_OFF + XTRA_BYTES;
constexpr int LDS_BYTES = 147456;
static_assert(MISC_OFF + 256 <= LDS_BYTES, "lds map");
constexpr int NWAVES = 8, NTHR = 512;

__device__ __forceinline__ unsigned f2bf(float f) { unsigned u = __builtin_bit_cast(unsigned, f); return (u + 0x7fffu + ((u >> 16) & 1u)) >> 16; }
typedef __bf16 bf16v2 __attribute__((ext_vector_type(2)));
__device__ __forceinline__ unsigned pk2(float lo, float hi) { const f32x2 v = {lo, hi}; return __builtin_bit_cast(unsigned, __builtin_convertvector(v, bf16v2)); }
__device__ __forceinline__ float bflo(unsigned w) { return __builtin_bit_cast(float, w << 16); }
__device__ __forceinline__ float bfhi(unsigned w) { return __builtin_bit_cast(float, w & 0xffff0000u); }
__device__ __forceinline__ void unpack8(const u32x4 w, float (&f)[8]) { f[0] = bflo(w.x); f[1] = bfhi(w.x); f[2] = bflo(w.y); f[3] = bfhi(w.y); f[4] = bflo(w.z); f[5] = bfhi(w.z); f[6] = bflo(w.w); f[7] = bfhi(w.w); }
__device__ __forceinline__ u32x4 pack8(const float (&f)[8]) { u32x4 w; w.x = pk2(f[0], f[1]); w.y = pk2(f[2], f[3]); w.z = pk2(f[4], f[5]); w.w = pk2(f[6], f[7]); return w; }
__device__ __forceinline__ void ld8(const bf16_t* p, float (&f)[8]) { unpack8(*(const u32x4*)p, f); }
__device__ __forceinline__ void st8(bf16_t* p, const float (&f)[8]) { *(u32x4*)p = pack8(f); }
__device__ __forceinline__ float rcp_(float x) { return __builtin_amdgcn_rcpf(x); }
__device__ __forceinline__ float rsq_(float x) { return __builtin_amdgcn_rsqf(x); }
__device__ __forceinline__ float sigmoidf_(float x) { return rcp_(1.0f + __builtin_amdgcn_exp2f(-1.4426950408889634f * x)); }
__device__ __forceinline__ float tanhf_(float x) { return 2.0f * sigmoidf_(2.0f * x) - 1.0f; }
__device__ __forceinline__ float dpp_f(float x, const int ctrl_sel) {
    const int xi = __builtin_bit_cast(int, x); int r;
    if (ctrl_sel == 0) r = __builtin_amdgcn_update_dpp(0, xi, 0xB1, 0xF, 0xF, true);
    else if (ctrl_sel == 1) r = __builtin_amdgcn_update_dpp(0, xi, 0x4E, 0xF, 0xF, true);
    else if (ctrl_sel == 2) r = __builtin_amdgcn_update_dpp(0, xi, 0x141, 0xF, 0xF, true);
    else r = __builtin_amdgcn_update_dpp(0, xi, 0x140, 0xF, 0xF, true);
    return __builtin_bit_cast(float, r);
}
__device__ __forceinline__ float sum8(float x) { x += dpp_f(x, 0); x += dpp_f(x, 1); x += dpp_f(x, 2); return x; }
__device__ __forceinline__ float wave_sum(float x) {
    x += dpp_f(x, 0); x += dpp_f(x, 1); x += dpp_f(x, 2); x += dpp_f(x, 3);
    const int xi = __builtin_bit_cast(int, x);
    const float r0 = __builtin_bit_cast(float, __builtin_amdgcn_readlane(xi, 0)), r1 = __builtin_bit_cast(float, __builtin_amdgcn_readlane(xi, 16)),
                r2 = __builtin_bit_cast(float, __builtin_amdgcn_readlane(xi, 32)), r3 = __builtin_bit_cast(float, __builtin_amdgcn_readlane(xi, 48));
    return (r0 + r1) + (r2 + r3);
}
namespace pg8 {
constexpr int BM = 256, BK = 64, HALF = 128, HTB = HALF * BK * 2, STAGE_BYTES = 8 * HTB;
__host__ __device__ __forceinline__ int lds_byte(int r, int c) { const int st = (r >> 4) * 2 + (c >> 5), rr = r & 15, cc = c & 31, ob = rr * 64 + cc * 2; return st * 1024 + (ob ^ (((ob >> 9) & 1) << 5)); }
__host__ __device__ __forceinline__ void stage_rc(int b, int& R, int& C) { const int st = b / 1024, sb = b % 1024, swz = sb ^ (((sb >> 9) & 1) << 5); R = (st >> 1) * 16 + swz / 64; C = (st & 1) * 32 + (swz % 64) / 2; }
__host__ __device__ __forceinline__ int perm32(int rho) { const int n = rho >> 4, i = rho & 15; return 8 * (i >> 2) + 4 * n + (i & 3); }
__device__ __forceinline__ unsigned cvt_pk_bf16(float lo, float hi) { unsigned r; asm volatile("v_cvt_pk_bf16_f32 %0, %1, %2" : "=v"(r) : "v"(lo), "v"(hi)); return r; }

struct GUnit { const char* A; const char* B; int pm, pn, x0, x1; };

template <class Epi, class Sched, bool GATHER>
__device__ __forceinline__ void gemm_phase(LAS unsigned char* lds, const int K, const int lda, const int ldb, const Sched& S, const Epi& E) {
    int tid_ = threadIdx.x; asm volatile("" : "+v"(tid_));
    const int tid = tid_, wid = __builtin_amdgcn_readfirstlane(tid >> 6), lane = tid & 63, wr = wid >> 2, wc = wid & 3, fr = lane & 15, fq = lane >> 4;
    const int nt = K / BK;
    int sR[2], sC[2];
    unsigned voffA[2][2], voffB[2], voffAn[2][2];
#pragma unroll
    for (int i = 0; i < 2; ++i) { int R, C; stage_rc(tid * 16 + i * 8192, R, C); sR[i] = R; sC[i] = C; const int Rb = Epi::PERM ? ((R & ~31) + perm32(R & 31)) : R;
        voffB[i] = (unsigned)(Rb * ldb + C) * 2u;
#pragma unroll
        for (int h = 0; h < 2; ++h) { voffA[h][i] = (unsigned)((h * HALF + R) * lda + C) * 2u; voffAn[h][i] = voffA[h][i]; } }
    const size_t kstep = (size_t)(BK * 2);
    const size_t hstepB = (size_t)HALF * ldb * 2;
    const unsigned ldsw = (unsigned)wid * 1024u;
    const int aoff = lds_byte(wr * 64 + fr, fq * 8), boff = lds_byte(wc * 32 + fr, fq * 8);
#define PG8_SA(b, h) (((b) * 2 + (h)) * HTB)
#define PG8_SB(b, h) ((4 + (b) * 2 + (h)) * HTB)
#define PG8_STAGE(bufoff, gbase, voff) do { _Pragma("unroll") for (int _i = 0; _i < 2; ++_i) \
        __builtin_amdgcn_global_load_lds((const unsigned*)((const char*)(gbase) + (voff)[_i]), (LAS unsigned*)(lds + (bufoff) + ldsw + _i * 8192), 16, 0, 0); } while (0)
#define PG8_LDA(dst, b, h) do { _Pragma("unroll") for (int m = 0; m < 4; ++m) _Pragma("unroll") for (int k = 0; k < 2; ++k) dst[m][k] = *(const LAS bf16x8*)(lds + PG8_SA(b, h) + aoff + m * 2048 + k * 1024); } while (0)
#define PG8_LDB(dst, b, h) do { _Pragma("unroll") for (int n = 0; n < 2; ++n) _Pragma("unroll") for (int k = 0; k < 2; ++k) dst[n][k] = *(const LAS bf16x8*)(lds + PG8_SB(b, h) + boff + n * 2048 + k * 1024); } while (0)
#define PG8_MMA(ai, bj, At, Bt) do { __builtin_amdgcn_s_setprio(1); _Pragma("unroll") for (int m = 0; m < 4; ++m) _Pragma("unroll") for (int n = 0; n < 2; ++n) _Pragma("unroll") for (int k = 0; k < 2; ++k) \
        acc[ai][bj][m][n] = __builtin_amdgcn_mfma_f32_16x16x32_bf16(Bt[n][k], At[m][k], acc[ai][bj][m][n], 0, 0, 0); __builtin_amdgcn_s_setprio(0); } while (0)
#define PG8_WAIT_V(n) asm volatile("s_waitcnt vmcnt(" #n ")" ::: "memory")
#define PG8_WAIT_L(n) asm volatile("s_waitcnt lgkmcnt(" #n ")" ::: "memory")
#define PG8_BAR __builtin_amdgcn_s_barrier()
#define PG8_SCHED __builtin_amdgcn_sched_barrier(0)
    GUnit cur, nxt; int ui = 0;
    if (!S.next(0, cur)) return;
    if constexpr (GATHER) {
#pragma unroll
        for (int i = 0; i < 2; ++i)
#pragma unroll
            for (int h = 0; h < 2; ++h) voffA[h][i] = (S.arow(0, h * HALF + sR[i]) * (unsigned)lda + (unsigned)sC[i]) * 2u;
    }
    f32x4 acc[2][2][4][2];
#pragma unroll
    for (int a = 0; a < 2; ++a)
#pragma unroll
        for (int b = 0; b < 2; ++b)
#pragma unroll
            for (int m = 0; m < 4; ++m)
#pragma unroll
                for (int n = 0; n < 2; ++n) acc[a][b][m][n] = (f32x4){0.f, 0.f, 0.f, 0.f};
    bf16x8 At[4][2], B0[2][2], B1[2][2];
    const char* cA = cur.A; const char* cB = cur.B;
    PG8_STAGE(PG8_SB(0, 0), cB, voffB); PG8_STAGE(PG8_SB(0, 1), cB + hstepB, voffB); PG8_STAGE(PG8_SA(0, 0), cA, voffA[0]); PG8_STAGE(PG8_SA(0, 1), cA, voffA[1]);
    if (wr == 1) PG8_BAR;
    PG8_WAIT_V(2); PG8_BAR;
    PG8_STAGE(PG8_SB(1, 0), cB + kstep, voffB); PG8_STAGE(PG8_SA(1, 0), cA + kstep, voffA[0]); PG8_STAGE(PG8_SB(1, 1), cB + hstepB + kstep, voffB);
    PG8_WAIT_V(6); PG8_BAR;
    for (;;) {
        const bool has_next = S.next(ui + 1, nxt);
        const char* nA = has_next ? nxt.A : cA; const char* nB = has_next ? nxt.B : cB;
        if constexpr (GATHER) {
#pragma unroll
            for (int i = 0; i < 2; ++i)
#pragma unroll
                for (int h = 0; h < 2; ++h) voffAn[h][i] = has_next ? (S.arow(ui + 1, h * HALF + sR[i]) * (unsigned)lda + (unsigned)sC[i]) * 2u : voffA[h][i];
        }
#pragma unroll 1
        for (int t = 0; t < nt; t += 2) {
            const bool last = (t == nt - 2);
            const char* a1 = cA + (size_t)(t + 1) * kstep;
            const char* a2 = last ? nA : cA + (size_t)(t + 2) * kstep; const char* b2 = last ? nB : cB + (size_t)(t + 2) * kstep;
            const char* a3 = a2 + kstep; const char* b3 = b2 + kstep;
            unsigned v2[2][2];
#pragma unroll
            for (int i = 0; i < 2; ++i)
#pragma unroll
                for (int h = 0; h < 2; ++h) v2[h][i] = GATHER ? (last ? voffAn[h][i] : voffA[h][i]) : voffA[h][i];
            PG8_LDB(B0, 0, 0); PG8_LDB(B1, 0, 1); PG8_SCHED; PG8_LDA(At, 0, 0); PG8_STAGE(PG8_SA(1, 1), a1, voffA[1]);
            PG8_WAIT_V(8); PG8_WAIT_L(0); PG8_BAR; PG8_MMA(0, 0, At, B0); PG8_MMA(0, 1, At, B1); PG8_BAR; PG8_SCHED;
            PG8_LDA(At, 0, 1); PG8_STAGE(PG8_SB(0, 0), b2, voffB); PG8_STAGE(PG8_SB(0, 1), b2 + hstepB, voffB); PG8_STAGE(PG8_SA(0, 0), a2, v2[0]);
            PG8_WAIT_V(8); PG8_WAIT_L(0); PG8_BAR; PG8_MMA(1, 0, At, B0); PG8_MMA(1, 1, At, B1); PG8_BAR; PG8_SCHED;
            PG8_LDB(B0, 1, 0); PG8_LDB(B1, 1, 1); PG8_SCHED; PG8_LDA(At, 1, 0); PG8_STAGE(PG8_SA(0, 1), a2, v2[1]);
            PG8_WAIT_V(8); PG8_WAIT_L(0); PG8_BAR; PG8_MMA(0, 0, At, B0); PG8_MMA(0, 1, At, B1); PG8_BAR; PG8_SCHED;
            PG8_LDA(At, 1, 1); PG8_STAGE(PG8_SB(1, 0), b3, voffB); PG8_STAGE(PG8_SB(1, 1), b3 + hstepB, voffB); PG8_STAGE(PG8_SA(1, 0), a3, v2[0]);
            PG8_WAIT_V(8); PG8_WAIT_L(0); PG8_BAR; PG8_MMA(1, 0, At, B0); PG8_MMA(1, 1, At, B1); PG8_BAR; PG8_SCHED;
        }
        if (wr == 0) PG8_BAR;
        E(acc, cur, wr, wc, fr, fq);
        if (!has_next) break;
        if (!(Epi::CHAIN && cur.x1 != 0)) {
#pragma unroll
        for (int a = 0; a < 2; ++a)
#pragma unroll
            for (int b = 0; b < 2; ++b)
#pragma unroll
                for (int m = 0; m < 4; ++m)
#pragma unroll
                    for (int n = 0; n < 2; ++n) acc[a][b][m][n] = (f32x4){0.f, 0.f, 0.f, 0.f};
        }
        cur = nxt; cA = nA; cB = nB; ++ui;
        if constexpr (GATHER) {
#pragma unroll
            for (int i = 0; i < 2; ++i)
#pragma unroll
                for (int h = 0; h < 2; ++h) voffA[h][i] = voffAn[h][i];
        }
        if (wr == 1) PG8_BAR;
    }
    PG8_WAIT_V(0);
    PG8_BAR;
#undef PG8_SA
#undef PG8_SB
#undef PG8_STAGE
#undef PG8_LDA
#undef PG8_LDB
#undef PG8_MMA
#undef PG8_WAIT_V
#undef PG8_WAIT_L
#undef PG8_BAR
#undef PG8_SCHED
}
}
namespace pg8 {
__device__ __forceinline__ size_t gates_off(int pm, int gh, int ai, int mp, int tid) { return ((((size_t)pm * 24 + gh) * 2 + ai) * 2 + mp) * (512 * 16) + (size_t)tid * 16; }
struct EpiProj {
    static constexpr bool PERM = true, CHAIN = false;
    bf16_t* P; unsigned char* GT;
    __device__ __forceinline__ void operator()(f32x4 (&acc)[2][2][4][2], const GUnit& u, int wr, int wc, int fr, int fq) const {
        const int row0 = u.pm * BM + wr * 64 + fr;
#pragma unroll
        for (int bj = 0; bj < 2; ++bj) {
            const int ct = u.pn * BM + bj * HALF;
            if (ct >= NCOLS_IN) continue;
            const bool sig = ct >= C_GT;
            const int col0 = ct + wc * 32 + 8 * fq;
            const int tid = (wr * 4 + wc) * 64 + fq * 16 + fr, gh = (ct - C_GT) / HALF;
#pragma unroll
            for (int ai = 0; ai < 2; ++ai)
#pragma unroll
                for (int m = 0; m < 4; ++m) {
                    const f32x4 v0 = acc[ai][bj][m][0], v1 = acc[ai][bj][m][1];
                    const size_t row = (size_t)(row0 + ai * HALF + m * 16);
                    if (sig) {
                        if ((m & 1) == 0) {
                            const f32x4 w0 = acc[ai][bj][m + 1][0], w1 = acc[ai][bj][m + 1][1];
                            unsigned q[16];
#pragma unroll
                            for (int j = 0; j < 4; ++j) { q[j] = (unsigned)fmaxf(255.0f * sigmoidf_(v0[j]) + 0.5f, 1.0f); q[4 + j] = (unsigned)fmaxf(255.0f * sigmoidf_(v1[j]) + 0.5f, 1.0f);
                                q[8 + j] = (unsigned)fmaxf(255.0f * sigmoidf_(w0[j]) + 0.5f, 1.0f); q[12 + j] = (unsigned)fmaxf(255.0f * sigmoidf_(w1[j]) + 0.5f, 1.0f); }
                            u32x4 w; w.x = q[0] | (q[1] << 8) | (q[2] << 16) | (q[3] << 24); w.y = q[4] | (q[5] << 8) | (q[6] << 16) | (q[7] << 24);
                            w.z = q[8] | (q[9] << 8) | (q[10] << 16) | (q[11] << 24); w.w = q[12] | (q[13] << 8) | (q[14] << 16) | (q[15] << 24);
                            *(u32x4*)(GT + gates_off(u.pm, gh, ai, m >> 1, tid)) = w;
                        }
                    } else {
                        u32x4 w; w.x = cvt_pk_bf16(v0[0], v0[1]); w.y = cvt_pk_bf16(v0[2], v0[3]); w.z = cvt_pk_bf16(v1[0], v1[1]); w.w = cvt_pk_bf16(v1[2], v1[3]);
                        *(u32x4*)(P + row * PW + col0) = w;
                    }
                }
        }
    }
};
struct EpiLowRank {
    static constexpr bool PERM = true, CHAIN = false;
    bf16_t* W; const float* w0; const float* a0;
    __device__ __forceinline__ void operator()(f32x4 (&acc)[2][2][4][2], const GUnit& u, int wr, int wc, int fr, int fq) const {
        const int row0 = u.pm * BM + wr * 64 + fr;
#pragma unroll
        for (int bj = 0; bj < 2; ++bj) {
            const int ct = u.pn * BM + bj * HALF;
            const int col0 = ct + wc * 32 + 8 * fq;
            const int mode = ct < 1024 ? 0 : (ct < 2048 ? 1 : 2);
            float bias[8];
#pragma unroll
            for (int j = 0; j < 8; ++j) bias[j] = mode == 0 ? w0[col0 + j] : (mode == 1 ? a0[col0 - 1024 + j] : 0.f);
#pragma unroll
            for (int ai = 0; ai < 2; ++ai)
#pragma unroll
                for (int m = 0; m < 4; ++m) {
                    float v[8];
#pragma unroll
                    for (int j = 0; j < 4; ++j) { v[j] = acc[ai][bj][m][0][j] + bias[j]; v[4 + j] = acc[ai][bj][m][1][j] + bias[4 + j]; }
                    if (mode == 0) {
#pragma unroll
                        for (int j = 0; j < 8; ++j) v[j] = (0.60653066f * 1.4426950408889634f) * sigmoidf_(v[j]);
                    } else if (mode == 1) {
#pragma unroll
                        for (int j = 0; j < 8; ++j) v[j] = sigmoidf_(v[j]);
                    }
                    u32x4 w; w.x = cvt_pk_bf16(v[0], v[1]); w.y = cvt_pk_bf16(v[2], v[3]); w.z = cvt_pk_bf16(v[4], v[5]); w.w = cvt_pk_bf16(v[6], v[7]);
                    *(u32x4*)(W + (size_t)(row0 + ai * HALF + m * 16) * WAGW + col0) = w;
                    asm volatile("" ::: "memory");
                }
        }
    }
};
__device__ __forceinline__ void ldg8(const u32x2 w, float (&g)[8]) {
#pragma unroll
    for (int j = 0; j < 4; ++j) { g[j] = (float)((w.x >> (8 * j)) & 255u) * (1.0f / 255.0f); g[4 + j] = (float)((w.y >> (8 * j)) & 255u) * (1.0f / 255.0f); }
}
struct EpiMerge {
    static constexpr bool PERM = true, CHAIN = true;
    const unsigned char* GT; bf16_t* M;
    __device__ __forceinline__ void operator()(f32x4 (&acc)[2][2][4][2], const GUnit& u, int wr, int wc, int fr, int fq) const {
        const int row0 = u.pm * BM + wr * 64 + fr; const int br = u.x0;
#pragma unroll
        for (int bj = 0; bj < 2; ++bj) {
            const int col0 = u.pn * BM + bj * HALF + wc * 32 + 8 * fq;
            const int tid = (wr * 4 + wc) * 64 + fq * 16 + fr, gh = br * 8 + u.pn * 2 + bj;
#pragma unroll
            for (int ai = 0; ai < 2; ++ai)
#pragma unroll
                for (int m = 0; m < 4; ++m) {
                    const size_t row = (size_t)(row0 + ai * HALF + m * 16);
                    const u32x4 gq = *(const u32x4*)(GT + gates_off(u.pm, gh, ai, m >> 1, tid));
                    float g[8];
                    ldg8((m & 1) ? (u32x2){gq.z, gq.w} : (u32x2){gq.x, gq.y}, g);
                    if (br < 2) {
                        const u32x4 gnq = *(const u32x4*)(GT + gates_off(u.pm, gh + 8, ai, m >> 1, tid));
                        float gn[8];
                        ldg8((m & 1) ? (u32x2){gnq.z, gnq.w} : (u32x2){gnq.x, gnq.y}, gn);
#pragma unroll
                        for (int j = 0; j < 8; ++j) g[j] = g[j] * rcp_(fmaxf(gn[j], 1.0f / 512.0f));
#pragma unroll
                        for (int j = 0; j < 4; ++j) { acc[ai][bj][m][0][j] *= g[j]; acc[ai][bj][m][1][j] *= g[4 + j]; }
                    } else {
                        float o[8];
#pragma unroll
                        for (int j = 0; j < 4; ++j) { o[j] = g[j] * acc[ai][bj][m][0][j]; o[4 + j] = g[4 + j] * acc[ai][bj][m][1][j]; }
                        st8(M + row * DM + col0, o);
                    }
                }
        }
    }
};
struct EpiOut {
    static constexpr bool PERM = true, CHAIN = false;
    bf16_t* XB; const float* mod;
    __device__ __forceinline__ void operator()(f32x4 (&acc)[2][2][4][2], const GUnit& u, int wr, int wc, int fr, int fq) const {
        const int rt = u.pm * BM; const int modrow = rt < NLAT ? (rt >> 11) : 16;
        const float* g1 = mod + (size_t)modrow * 6144 + 2048;
        const int row0 = rt + wr * 64 + fr;
#pragma unroll
        for (int bj = 0; bj < 2; ++bj) {
            const int col0 = u.pn * BM + bj * HALF + wc * 32 + 8 * fq;
            const f32x4 ga = *(const f32x4*)(g1 + col0), gb = *(const f32x4*)(g1 + col0 + 4);
#pragma unroll
            for (int ai = 0; ai < 2; ++ai)
#pragma unroll
                for (int m = 0; m < 4; ++m) {
                    bf16_t* xp = XB + (size_t)(row0 + ai * HALF + m * 16) * DM + col0;
                    float x[8]; ld8(xp, x);
#pragma unroll
                    for (int j = 0; j < 4; ++j) { x[j] += ga[j] * acc[ai][bj][m][0][j]; x[4 + j] += gb[j] * acc[ai][bj][m][1][j]; }
                    st8(xp, x);
                }
        }
    }
};
struct EpiUp {
    static constexpr bool PERM = true, CHAIN = false;
    bf16_t* HID;
    __device__ __forceinline__ void operator()(f32x4 (&acc)[2][2][4][2], const GUnit& u, int wr, int wc, int fr, int fq) const {
        const int row0 = u.x0 * PAIRS_E + u.pm * BM + wr * 64 + fr;
        const int col0 = u.pn * HALF + wc * 32 + 8 * fq;
#pragma unroll
        for (int ai = 0; ai < 2; ++ai)
#pragma unroll
            for (int m = 0; m < 4; ++m) {
                float v[8];
#pragma unroll
                for (int j = 0; j < 4; ++j) {
                    const float g0 = acc[ai][0][m][0][j], g1 = acc[ai][0][m][1][j];
                    v[j] = g0 * sigmoidf_(g0) * acc[ai][1][m][0][j]; v[4 + j] = g1 * sigmoidf_(g1) * acc[ai][1][m][1][j];
                }
                u32x4 w; w.x = cvt_pk_bf16(v[0], v[1]); w.y = cvt_pk_bf16(v[2], v[3]); w.z = cvt_pk_bf16(v[4], v[5]); w.w = cvt_pk_bf16(v[6], v[7]);
                *(u32x4*)(HID + (size_t)(row0 + ai * HALF + m * 16) * EFF + col0) = w;
            }
    }
};
struct EpiDown {
    static constexpr bool PERM = true, CHAIN = false;
    bf16_t* YE;
    __device__ __forceinline__ void operator()(f32x4 (&acc)[2][2][4][2], const GUnit& u, int wr, int wc, int fr, int fq) const {
        const int row0 = u.x0 * PAIRS_E + u.pm * BM + wr * 64 + fr;
#pragma unroll
        for (int bj = 0; bj < 2; ++bj) {
            const int col0 = u.pn * BM + bj * HALF + wc * 32 + 8 * fq;
#pragma unroll
            for (int ai = 0; ai < 2; ++ai)
#pragma unroll
                for (int m = 0; m < 4; ++m) {
                    const f32x4 v0 = acc[ai][bj][m][0], v1 = acc[ai][bj][m][1];
                    u32x4 w; w.x = cvt_pk_bf16(v0[0], v0[1]); w.y = cvt_pk_bf16(v0[2], v0[3]); w.z = cvt_pk_bf16(v1[0], v1[1]); w.w = cvt_pk_bf16(v1[2], v1[3]);
                    *(u32x4*)(YE + (size_t)(row0 + ai * HALF + m * 16) * DM + col0) = w;
                }
        }
    }
};

struct PlainOrder {
    const char* A; const char* B; int nM, nN, nwg, G, c; size_t astep, bstep;
    __device__ __forceinline__ void init(const void* A_, const void* B_, int M, int N, int lda, int ldb, int G_, int c_) { A = (const char*)A_; B = (const char*)B_; nM = M / BM; nN = N / BM; nwg = nM * nN; G = G_; c = c_; astep = (size_t)BM * lda * 2; bstep = (size_t)BM * ldb * 2; }
    __device__ __forceinline__ bool next(int i, GUnit& u) const {
        const long L = (long)i * G + c; if (L >= nwg) return false;
        int wgid = (int)L; { const int q = nwg / 8, r = nwg % 8, xcd = wgid % 8, off = wgid / 8; wgid = (xcd < r ? xcd * (q + 1) : r * (q + 1) + (xcd - r) * q) + off; }
#ifndef PG8_WGM
#define PG8_WGM 8
#endif
        const int nig = PG8_WGM * nN, gid = wgid / nig, fm = gid * PG8_WGM, gsz = (nM - fm) < PG8_WGM ? (nM - fm) : PG8_WGM;
        u.pm = fm + ((wgid % nig) % gsz); u.pn = (wgid % nig) / gsz; u.x0 = 0; u.x1 = 0;
        u.A = A + (size_t)u.pm * astep; u.B = B + (size_t)u.pn * bstep; return true;
    }
    __device__ __forceinline__ unsigned arow(int, int) const { return 0u; }
};
struct LastProjOrder {
    PlainOrder lat; const char* A; const char* B; size_t astep, bstep;
    __device__ __forceinline__ void init(const void* A_, const void* B_, int lda, int ldb, int G_, int c_) { lat.init(A_, B_, NLAT, PWP, lda, ldb, G_, c_); A = (const char*)A_; B = (const char*)B_; astep = (size_t)BM * lda * 2; bstep = (size_t)BM * ldb * 2; }
    __device__ __forceinline__ bool next(int i, GUnit& u) const {
        const long L = (long)i * lat.G + lat.c;
        if (L < lat.nwg) return lat.next(i, u);
        const int r = (int)(L - lat.nwg); if (r >= (NCTX / BM) * 8) return false;
        u.pm = NLAT / BM + r / 8; u.pn = 2 + (r % 8); u.x0 = 0; u.x1 = 0;
        u.A = A + (size_t)u.pm * astep; u.B = B + (size_t)u.pn * bstep; return true;
    }
    __device__ __forceinline__ unsigned arow(int, int) const { return 0u; }
};
struct LowRankOrder {
    const char* A; const char* B; int nM, G, c;
    __device__ __forceinline__ bool next(int i, GUnit& u) const {
        const long L = (long)i * G + c; if (L >= (long)nM * 10) return false;
        u.pm = (int)(L / 10); u.pn = (int)(L % 10); u.x0 = 0; u.x1 = 0;
        const int kwin = u.pn < 4 ? 0 : (u.pn < 8 ? 128 : 256);
        u.A = A + ((size_t)u.pm * BM * LRAW + kwin) * 2; u.B = B + (size_t)u.pn * BM * 128 * 2; return true;
    }
    __device__ __forceinline__ unsigned arow(int, int) const { return 0u; }
};
struct MergeOrder {
    const char* P; const char* W; int nM, G, c;
    __device__ __forceinline__ bool next(int i, GUnit& u) const {
        const long tl = (long)(i / 3) * G + c; if (tl >= (long)nM * 4) return false;
        const int tile = (int)tl, br = i % 3;
        u.pm = tile >> 2; u.pn = tile & 3; u.x0 = br; u.x1 = br < 2 ? 1 : 0;
        const int acol = br == 0 ? C_OATT : (br == 1 ? C_ORWKV : C_OCONV);
        u.A = P + ((size_t)u.pm * BM * PW + acol) * 2; u.B = W + ((size_t)br * 1024 * 512 + (size_t)u.pn * BM * 512) * 2; return true;
    }
    __device__ __forceinline__ unsigned arow(int, int) const { return 0u; }
};
struct MoeOrder {
    const char* A; const char* W; const LAS int* rows; int mt_per, npn, G, c; size_t wexp;
    __device__ __forceinline__ bool decode(long L, int& e, int& mt, int& pn) const {
        const int per_e = mt_per * npn; if (L >= (long)NEXP * per_e) return false;
        e = (int)(L / per_e); const int r = (int)(L % per_e); pn = r / mt_per; mt = r % mt_per; return true;
    }
    __device__ __forceinline__ bool next(int i, GUnit& u) const {
        int e, mt, pn; if (!decode((long)i * G + c, e, mt, pn)) return false;
        u.pm = mt; u.pn = pn; u.x0 = e; u.x1 = 0;
        u.A = A; u.B = W + (size_t)e * wexp + (size_t)pn * BM * 1024 * 2; return true;
    }
    __device__ __forceinline__ unsigned arow(int i, int r) const { return (unsigned)rows[i * 256 + r]; }
};
struct MoeDownOrder {
    const char* A; const char* W; int mt_per, G, c;
    __device__ __forceinline__ bool next(int i, GUnit& u) const {
        const long L = (long)i * G + c; const int per_e = mt_per * 4; if (L >= (long)NEXP * per_e) return false;
        const int e = (int)(L / per_e), r = (int)(L % per_e); u.pn = r / mt_per; u.pm = r % mt_per; u.x0 = e; u.x1 = 0;
        u.A = A + ((size_t)e * PAIRS_E + (size_t)u.pm * BM) * EFF * 2; u.B = W + ((size_t)e * 1024 + (size_t)u.pn * BM) * 1024 * 2; return true;
    }
    __device__ __forceinline__ unsigned arow(int, int) const { return 0u; }
};
}
namespace attn_body {
using bf16=__hip_bfloat16;
using bf16x8=__attribute__((ext_vector_type(8)))short;
using s16x4=__attribute__((ext_vector_type(4)))short;
using f32x16=__attribute__((ext_vector_type(16)))float;
using u32x4=__attribute__((ext_vector_type(4)))unsigned;
constexpr int D=64,DM=4224;
constexpr int NW=8,QBLK=32,QB=QBLK*NW,KVBLK=64;
constexpr int ATTN_PITCH=DM, ATTN_UNIT_ROWS=QB;
__device__ __forceinline__ int crow(int r,int hi){return (r&3)+8*(r>>2)+4*hi;}
#define SBAR() __builtin_amdgcn_sched_barrier(0)
__device__ __forceinline__ void cmask(f32x16&p0,f32x16&p1,int jb,int qrel,int hi){
  const float NEG=-INFINITY; int kb=64*jb+4*hi;
  #pragma unroll
  for(int r=0;r<16;++r){int kv=kb+(r&3)+8*(r>>2); if(kv>qrel)p0[r]=NEG; if(kv+32>qrel)p1[r]=NEG;}
}

constexpr int NSLOT=3, SLOTB=8192;
constexpr int LDS_K=0, LDS_V=NSLOT*SLOTB, LDS_WS=2*NSLOT*SLOTB, LDS_OST=LDS_WS+NW*64*4, LDS_BYTES=LDS_OST+NW*4096;
constexpr float C2=0.125f*1.4426950408889634f;
__device__ __forceinline__ void glds16(const void*gsrc,unsigned lds_dst){unsigned keep;
  asm volatile("s_mov_b32 %0, m0\n\ts_mov_b32 m0, %2\n\ts_nop 0\n\tglobal_load_lds_dwordx4 %1, off\n\ts_mov_b32 m0, %0":"=&s"(keep):"v"(gsrc),"s"(lds_dst):"memory");}
__device__ __forceinline__ float max3f(float a,float b,float c){float r;asm("v_max3_f32 %0, %1, %2, %3":"=v"(r):"v"(a),"v"(b),"v"(c));return r;}
__device__ __forceinline__ float max2f(float a,float b){float r;asm("v_max_f32_e32 %0, %1, %2":"=v"(r):"v"(a),"v"(b));return r;}
__device__ __forceinline__ float fadd_s(float a,float b){float r;asm("v_add_f32_e32 %0, %1, %2":"=v"(r):"v"(a),"v"(b));return r;}
__device__ __forceinline__ float fsub_s(float a,float b){float r;asm("v_sub_f32_e32 %0, %1, %2":"=v"(r):"v"(a),"v"(b));return r;}
typedef float f32x2_t __attribute__((ext_vector_type(2))); typedef __bf16 bf16x2_t __attribute__((ext_vector_type(2)));
__device__ __forceinline__ unsigned cvtpk_s(float lo,float hi){f32x2_t v={lo,hi};bf16x2_t b=__builtin_convertvector(v,bf16x2_t);return __builtin_bit_cast(unsigned,b);}
#define WAIT_BAR(N) asm volatile("s_waitcnt vmcnt(" #N ") lgkmcnt(0)\n\ts_barrier":::"memory")

__device__ __forceinline__ void qkt(f32x16&p0,f32x16&p1,const char*Kslot,const bf16x8*qr,const f32x16&negm,int r32,int hi){
  const char*kb=Kslot+hi*1024+r32*16;
  #pragma unroll
  for(int d0=0;d0<4;++d0){
    const bf16x8 b0=*reinterpret_cast<const bf16x8*>(kb+d0*2048);
    const bf16x8 b1=*reinterpret_cast<const bf16x8*>(kb+d0*2048+512);
    if(d0==0){p0=__builtin_amdgcn_mfma_f32_32x32x16_bf16(b0,qr[0],negm,0,0,0);p1=__builtin_amdgcn_mfma_f32_32x32x16_bf16(b1,qr[0],negm,0,0,0);}
    else{p0=__builtin_amdgcn_mfma_f32_32x32x16_bf16(b0,qr[d0],p0,0,0,0);p1=__builtin_amdgcn_mfma_f32_32x32x16_bf16(b1,qr[d0],p1,0,0,0);}}
}
typedef __attribute__((address_space(3))) const char* lds_cptr;
typedef short v4i16_t __attribute__((ext_vector_type(4)));
__device__ __forceinline__ void kload8(bf16x8*kf,lds_cptr kp){
  kf[0]=*(const __attribute__((address_space(3))) bf16x8*)(kp);      kf[1]=*(const __attribute__((address_space(3))) bf16x8*)(kp+512);
  kf[2]=*(const __attribute__((address_space(3))) bf16x8*)(kp+2048); kf[3]=*(const __attribute__((address_space(3))) bf16x8*)(kp+2560);
  kf[4]=*(const __attribute__((address_space(3))) bf16x8*)(kp+4096); kf[5]=*(const __attribute__((address_space(3))) bf16x8*)(kp+4608);
  kf[6]=*(const __attribute__((address_space(3))) bf16x8*)(kp+6144); kf[7]=*(const __attribute__((address_space(3))) bf16x8*)(kp+6656);
}
__device__ __forceinline__ void kload2(bf16x8*kf,lds_cptr kp,int j){ kf[2*j]=*(const __attribute__((address_space(3))) bf16x8*)(kp+j*2048); kf[2*j+1]=*(const __attribute__((address_space(3))) bf16x8*)(kp+j*2048+512); }
__device__ __forceinline__ s16x4 vtr(lds_cptr p){ return __builtin_bit_cast(s16x4,__builtin_amdgcn_ds_read_tr16_b64_v4i16((__attribute__((address_space(3))) v4i16_t*)p)); }
__device__ __forceinline__ float rowmax(const f32x16&p0,const f32x16&p1){
  float a=max3f(p0[0],p0[1],p1[0]),b=max3f(p0[2],p0[3],p1[1]);a=max3f(a,p1[2],p1[3]);
  #pragma unroll
  for(int r=4;r<16;r+=4){a=max3f(a,p0[r],p0[r+1]);b=max3f(b,p0[r+2],p0[r+3]);a=max3f(a,p1[r],p1[r+1]);b=max3f(b,p1[r+2],p1[r+3]);}
  const float m=max2f(a,b);
  auto rr=__builtin_amdgcn_permlane32_swap(__float_as_uint(m),__float_as_uint(m),false,false);
  return max2f(__uint_as_float(rr[0]),__uint_as_float(rr[1]));
}
__device__ __forceinline__ void pv(f32x16*o,int vb,bf16x8 pa0,bf16x8 pa1,bf16x8 pa2,bf16x8 pa3){
  #pragma unroll
  for(int d0=0;d0<2;++d0){s16x4 lo[4],hi[4];
    #pragma unroll
    for(int ks=0;ks<4;++ks){
      asm volatile("ds_read_b64_tr_b16 %0,%1 offset:%c2":"=&v"(lo[ks]):"v"(vb),"i"(d0*4096+ks*1024):"memory");
      asm volatile("ds_read_b64_tr_b16 %0,%1 offset:%c2":"=&v"(hi[ks]):"v"(vb),"i"(d0*4096+ks*1024+512):"memory");}
    asm volatile("s_waitcnt lgkmcnt(0)":::"memory");SBAR();
    #define PK(k) (bf16x8){lo[k][0],lo[k][1],lo[k][2],lo[k][3],hi[k][0],hi[k][1],hi[k][2],hi[k][3]}
    o[d0]=__builtin_amdgcn_mfma_f32_32x32x16_bf16(pa0,PK(0),o[d0],0,0,0);
    o[d0]=__builtin_amdgcn_mfma_f32_32x32x16_bf16(pa1,PK(1),o[d0],0,0,0);
    o[d0]=__builtin_amdgcn_mfma_f32_32x32x16_bf16(pa2,PK(2),o[d0],0,0,0);
    o[d0]=__builtin_amdgcn_mfma_f32_32x32x16_bf16(pa3,PK(3),o[d0],0,0,0);
    #undef PK
  }
}

#ifndef ATTN_STORE16
#define ATTN_STORE16(p,v) (*(u32x4*)(p)=(v))
#endif
template<int THRL> __device__ __forceinline__ void attn_unit(const bf16*Qu,bf16*Ou,const bf16*KV0,const int crow0,const int lrow0,const int NT,const int nct,char*shm){
  constexpr int VOFF=128;
  int tid_=threadIdx.x; asm volatile("":"+v"(tid_)); const int tid=tid_,lane=tid&63,r32=lane&31,hi=lane>>5; const int wid=__builtin_amdgcn_readfirstlane(tid>>6);
  const bf16*Qw=Qu+(long)(wid*QBLK)*DM;
  const unsigned lds0=(unsigned)(uintptr_t)shm;
  float*wsf=(float*)(shm+LDS_WS)+wid*64;
  const long klane=(long)lane*DM+wid*8;
  const long vlane=(long)(16*(wid&3)+(lane>>2))*DM+(wid>>2)*32+(lane&3)*8;
  const unsigned kdst=lds0+LDS_K+wid*1024, vdst=lds0+LDS_V+wid*1024;
  #define KTILE(t) (KV0+(long)(((t)<nct)?(crow0+(t)*KVBLK):(lrow0+((t)-nct)*KVBLK))*DM)
  #define VTILE(t) (KTILE(t)+VOFF)
  #define DMA_K(t,slot) glds16(KTILE(t)+klane,(unsigned)__builtin_amdgcn_readfirstlane(kdst+(slot)))
  #define DMA_V(t,slot) glds16(VTILE(t)+vlane,(unsigned)__builtin_amdgcn_readfirstlane(vdst+(slot)))
  const int vb0=(int)(lds0+LDS_V)+((lane>>4)&1)*32+(lane&3)*8+(4*hi+((lane&15)>>2))*64;
  const char*Kbase=shm+LDS_K; bf16x8 kf[8];
  const lds_cptr shm3=(lds_cptr)shm; const lds_cptr kp0=shm3+LDS_K+hi*1024+r32*16; const lds_cptr vp0=shm3+LDS_V+((lane>>4)&1)*32+(lane&3)*8+(4*hi+((lane&15)>>2))*64;
  DMA_K(0,0);DMA_V(0,0);DMA_K(1,SLOTB);
  bf16x8 qr[4];
  #pragma unroll
  for(int d0=0;d0<4;++d0)qr[d0]=*reinterpret_cast<const bf16x8*>(&Qw[(long)r32*DM+d0*16+hi*8]);
  float mhat=0.f,l_reg=0.f;f32x16 o[2];o[0]=f32x16{};o[1]=f32x16{};f32x16 negm=f32x16{};asm volatile("":"+v"(negm));
  #define CMASK(P0,P1,t) do{}while(0)
  bool resc=false;
#ifndef ATTN_NOMAX
#define ATTN_NOMAX 1
#endif
#if ATTN_NOMAX
  #define START(P0,P1) do{ resc=false; _Pragma("unroll") for(int r=0;r<16;++r)P0[r]=__builtin_amdgcn_exp2f(P0[r]); }while(0)
#else
  #define START(P0,P1) do{ const float rm=rowmax(P0,P1); resc=false; \
    { const float dl=rm; mhat=fadd_s(mhat,dl); \
      _Pragma("unroll") for(int r=0;r<16;++r){P0[r]=fsub_s(P0[r],dl);P1[r]=fsub_s(P1[r],dl);} \
      _Pragma("unroll") for(int r=0;r<16;++r)negm[r]=-mhat; asm volatile("":"+v"(negm)); } \
    _Pragma("unroll") for(int r=0;r<16;++r)P0[r]=__builtin_amdgcn_exp2f(P0[r]); }while(0)
#endif
  #define RESC() do{ if(resc){ asm volatile("s_waitcnt lgkmcnt(0)":::"memory"); \
      _Pragma("unroll") for(int d_=0;d_<2;++d_) _Pragma("unroll") for(int r=0;r<16;++r)o[d_][r]*=wsf[crow(r,hi)]; } }while(0)
  f32x16 pA0,pA1,pB0,pB1;
  int sl_prev=0,sl_cur=0,sl_next=SLOTB;
  #define ROT() do{sl_prev=sl_cur;sl_cur=sl_next;sl_next=(sl_next==(NSLOT-1)*SLOTB)?0:sl_next+SLOTB;}while(0)
  DMA_K(2,2*SLOTB);
  WAIT_BAR(3);
  qkt(pA0,pA1,Kbase,qr,negm,r32,hi);asm volatile("s_nop 15\n\ts_nop 7":"+v"(pA0),"+v"(pA1));CMASK(pA0,pA1,0);
  START(pA0,pA1);
  _Pragma("unroll") for(int r=0;r<16;++r)pA1[r]=__builtin_amdgcn_exp2f(pA1[r]);
  WAIT_BAR(0);
  DMA_K(3,0);DMA_V(1,SLOTB);
  ROT();
  kload8(kf,kp0+sl_cur);
  WAIT_BAR(2);
  s16x4 vlo[8],vhi[8]; u32x4 pw0,pw1,pw2,pw3;
  #define PKW(P,B) cvtpk_s(P[B],P[B+1])
  #define PAF(k) __builtin_bit_cast(bf16x8,pw##k)
  #define VFR(i) (bf16x8){vlo[i][0],vlo[i][1],vlo[i][2],vlo[i][3],vhi[i][0],vhi[i][1],vhi[i][2],vhi[i][3]}
  #define PIN(x) asm volatile("":"+v"(x))
  #define MX3(a,b,c) __builtin_fmaxf(__builtin_fmaxf((a),(b)),(c))
  #define GAPA(MF,A0,A1,A2,A3,W0,W1,PW) do{ MF; sacc+=A0; sacc+=A1; sacc+=A2; sacc+=A3; PIN(sacc); W0; W1; PIN(PW); SBAR(); }while(0)
  #define EX(v) __builtin_amdgcn_exp2f(v)
  #define GAPB(MF,X,B) do{ MF; X[B]=EX(X[B]); X[B+1]=EX(X[B+1]); X[B+2]=EX(X[B+2]); X[B+3]=EX(X[B+3]); PIN(X); SBAR(); }while(0)
  #define VRD(i) do{ vlo[i]=vtr(vp_+(((i)>>2)*4096+((i)&3)*1024)); vhi[i]=vtr(vp_+(((i)>>2)*4096+((i)&3)*1024+512)); }while(0)
  #define KRD(G,j) do{ if(G){ kload2(kf,kp0+sl_next,j); SBAR(); } }while(0)
#if ATTN_NOMAX
  #define ROWMAX_BLOCK(C0,C1) do{ resc=false; }while(0)
#else
  #define ROWMAX_BLOCK(C0,C1) do    { float a=MX3(C0[0],C0[1],C1[0]),b=MX3(C0[2],C0[3],C1[1]); a=MX3(a,C1[2],C1[3]); \
      _Pragma("unroll") for(int r=4;r<16;r+=4){a=MX3(a,C0[r],C0[r+1]);b=MX3(b,C0[r+2],C0[r+3]);a=MX3(a,C1[r],C1[r+1]);b=MX3(b,C1[r+2],C1[r+3]);} \
      float rm=__builtin_fmaxf(a,b); { auto rr=__builtin_amdgcn_permlane32_swap(__float_as_uint(rm),__float_as_uint(rm),false,false); rm=__builtin_fmaxf(__uint_as_float(rr[0]),__uint_as_float(rr[1])); } \
      resc=false; \
      if(__builtin_expect(__any(rm>(float)THRL),0)){ const float dl=__builtin_fmaxf(rm,0.f); mhat+=dl; \
        _Pragma("unroll") for(int r=0;r<16;++r){C0[r]-=dl;C1[r]-=dl;} \
        _Pragma("unroll") for(int r=0;r<16;++r)negm[r]=-mhat; asm volatile("":"+v"(negm)); \
        const float f=__builtin_amdgcn_exp2f(-dl); l_reg*=f; if(hi==0)wsf[r32]=f; resc=true; } } while(0)
#endif
  #define STEP(C0,C1,P0,P1,t,GK,GV,GL) do{ SBAR(); \
    const lds_cptr vp_=vp0+sl_prev; \
    VRD(0); SBAR(); float sacc=(P0[0]+P0[1]); \
    GAPA(C0=__builtin_amdgcn_mfma_f32_32x32x16_bf16(kf[0],qr[0],negm,0,0,0), P0[2],P0[3],P0[4],P0[5],     pw0[0]=PKW(P0,0), pw0[1]=PKW(P0,2), pw0); \
    VRD(4); SBAR(); GAPA(C1=__builtin_amdgcn_mfma_f32_32x32x16_bf16(kf[1],qr[0],negm,0,0,0), P0[6],P0[7],P0[8],P0[9],     pw0[2]=PKW(P0,4), pw0[3]=PKW(P0,6), pw0); \
    VRD(1); SBAR(); GAPA(C0=__builtin_amdgcn_mfma_f32_32x32x16_bf16(kf[2],qr[1],C0,0,0,0),   P0[10],P0[11],P0[12],P0[13], pw1[0]=PKW(P0,8), pw1[1]=PKW(P0,10), pw1); \
    VRD(5); SBAR(); GAPA(C1=__builtin_amdgcn_mfma_f32_32x32x16_bf16(kf[3],qr[1],C1,0,0,0),   P0[14],P0[15],P1[0],P1[1],   pw1[2]=PKW(P0,12),pw1[3]=PKW(P0,14), pw1); \
    VRD(2); SBAR(); GAPA(C0=__builtin_amdgcn_mfma_f32_32x32x16_bf16(kf[4],qr[2],C0,0,0,0),   P1[2],P1[3],P1[4],P1[5],     pw2[0]=PKW(P1,0), pw2[1]=PKW(P1,2), pw2); \
    VRD(6); SBAR(); GAPA(C1=__builtin_amdgcn_mfma_f32_32x32x16_bf16(kf[5],qr[2],C1,0,0,0),   P1[6],P1[7],P1[8],P1[9],     pw2[2]=PKW(P1,4), pw2[3]=PKW(P1,6), pw2); \
    VRD(3); SBAR(); GAPA(C0=__builtin_amdgcn_mfma_f32_32x32x16_bf16(kf[6],qr[3],C0,0,0,0),   P1[10],P1[11],P1[12],P1[13], pw3[0]=PKW(P1,8), pw3[1]=PKW(P1,10), pw3); \
    VRD(7); SBAR(); GAPA(C1=__builtin_amdgcn_mfma_f32_32x32x16_bf16(kf[7],qr[3],C1,0,0,0),   P1[14],P1[15],0.f,0.f,       pw3[2]=PKW(P1,12),pw3[3]=PKW(P1,14), pw3); \
    l_reg+=sacc; \
    if(GK){DMA_K((t)+3,sl_cur);} if(GV){DMA_V((t)+1,sl_next);} \
    CMASK(C0,C1,t); \
    ROWMAX_BLOCK(C0,C1); \
    SBAR(); \
    GAPB(o[0]=__builtin_amdgcn_mfma_f32_32x32x16_bf16(PAF(0),VFR(0),o[0],0,0,0), C0,0); \
    GAPB(o[1]=__builtin_amdgcn_mfma_f32_32x32x16_bf16(PAF(0),VFR(4),o[1],0,0,0), C0,4); \
    KRD(GL,0); GAPB(o[0]=__builtin_amdgcn_mfma_f32_32x32x16_bf16(PAF(1),VFR(1),o[0],0,0,0), C0,8); \
    KRD(GL,1); GAPB(o[1]=__builtin_amdgcn_mfma_f32_32x32x16_bf16(PAF(1),VFR(5),o[1],0,0,0), C0,12); \
    KRD(GL,2); GAPB(o[0]=__builtin_amdgcn_mfma_f32_32x32x16_bf16(PAF(2),VFR(2),o[0],0,0,0), C1,0); \
    KRD(GL,3); GAPB(o[1]=__builtin_amdgcn_mfma_f32_32x32x16_bf16(PAF(2),VFR(6),o[1],0,0,0), C1,4); \
    GAPB(o[0]=__builtin_amdgcn_mfma_f32_32x32x16_bf16(PAF(3),VFR(3),o[0],0,0,0), C1,8); \
    GAPB(o[1]=__builtin_amdgcn_mfma_f32_32x32x16_bf16(PAF(3),VFR(7),o[1],0,0,0), C1,12); \
    }while(0)
  int t=1;
  #undef CMASK
  #define CMASK(P0,P1,t) do{}while(0)
  for(;t+5<NT;t+=2){
    STEP(pB0,pB1,pA0,pA1,t,true,true,true);     WAIT_BAR(2); RESC(); ROT();
    STEP(pA0,pA1,pB0,pB1,t+1,true,true,true);   WAIT_BAR(2); RESC(); ROT();
  }
  #undef CMASK
  #define CMASK(P0,P1,t) do{}while(0)
  #define ENDW(tt) do{ if((tt)+3<NT){WAIT_BAR(2);} else if((tt)+2<NT){WAIT_BAR(1);} else {WAIT_BAR(0);} }while(0)
  for(;t+1<NT;t+=2){
    STEP(pB0,pB1,pA0,pA1,t,(t+3<NT),(t+1<NT),(t+1<NT));       ENDW(t);   RESC(); ROT();
    STEP(pA0,pA1,pB0,pB1,t+1,(t+4<NT),(t+2<NT),(t+2<NT));     ENDW(t+1); RESC(); ROT();
  }
  STEP(pB0,pB1,pA0,pA1,NT-1,false,false,false); RESC();
  { float sacc=pB0[0]+pB0[1]; _Pragma("unroll") for(int r=2;r<16;++r)sacc+=pB0[r]; _Pragma("unroll") for(int r=0;r<16;++r)sacc+=pB1[r]; l_reg+=sacc;
    pw0=(u32x4){PKW(pB0,0),PKW(pB0,2),PKW(pB0,4),PKW(pB0,6)};pw1=(u32x4){PKW(pB0,8),PKW(pB0,10),PKW(pB0,12),PKW(pB0,14)};pw2=(u32x4){PKW(pB1,0),PKW(pB1,2),PKW(pB1,4),PKW(pB1,6)};pw3=(u32x4){PKW(pB1,8),PKW(pB1,10),PKW(pB1,12),PKW(pB1,14)};
    SBAR(); pv(o,vb0+sl_cur,PAF(0),PAF(1),PAF(2),PAF(3)); }
  #undef PKW
  #undef PAF
  #undef VFR
  #undef PIN
  #undef MX3
  #undef GAPA
  #undef GAPB
  #undef EX
  #undef VRD
  #undef KRD
  #undef STEP
  #undef ROWMAX_BLOCK
  #undef ENDW
  {auto rr=__builtin_amdgcn_permlane32_swap(__float_as_uint(l_reg),__float_as_uint(l_reg),false,false);l_reg=__uint_as_float(rr[0])+__uint_as_float(rr[1]);}
  if(hi==0)wsf[32+r32]=l_reg;asm volatile("s_waitcnt lgkmcnt(0)":::"memory");
  float rli[16];
  #pragma unroll
  for(int r=0;r<16;++r)rli[r]=__builtin_amdgcn_rcpf(wsf[32+crow(r,hi)]);
  bf16*Ow=Ou+(long)(wid*QBLK)*DM;
  { bf16*stg=(bf16*)(shm+LDS_OST)+wid*2048;
    #pragma unroll
    for(int r=0;r<16;++r){const int orow=crow(r,hi);
      #pragma unroll
      for(int d0=0;d0<2;++d0)stg[orow*64+d0*32+r32]=__float2bfloat16(o[d0][r]*rli[r]);}
    asm volatile("s_waitcnt lgkmcnt(0)":::"memory");
    #pragma unroll
    for(int i=0;i<4;++i){const int row=i*8+(lane>>3),ch=lane&7; const u32x4 v=*(const u32x4*)(stg+row*64+ch*8); ATTN_STORE16(Ow+(long)row*DM+ch*8,v);} }
  asm volatile("s_waitcnt lgkmcnt(0)\n\ts_barrier":::"memory");
  #undef DMA_K
  #undef KTILE
  #undef VTILE
  #undef DMA_V
  #undef CMASK
  #undef START
  #undef RESC
  #undef ROT
}
constexpr int ATTN_LDS_BYTES=LDS_BYTES;
#undef SBAR
#undef WAIT_BAR
}
#define XB_TMO      128
#define XB_XCNT(j)  (256  + 64 * (j))
#define XB_XSUB(j)  (1280 + 64 * (j))
#define XB_XGEN(j)  (2304 + 64 * (j))
#define XB_TOP      3328
#define XB_TOPGEN   3392
#define XCD_BAR_WORDS 3456
#define XB_SPIN_CAP (1u << 18)
__device__ __forceinline__ unsigned xb_ld(unsigned* p)              { return __hip_atomic_load(p, __ATOMIC_RELAXED, __HIP_MEMORY_SCOPE_AGENT); }
__device__ __forceinline__ unsigned xb_add(unsigned* p, unsigned v) { return __hip_atomic_fetch_add(p, v, __ATOMIC_RELAXED, __HIP_MEMORY_SCOPE_AGENT); }
__device__ __forceinline__ unsigned xb_xcc_id() { return (unsigned)__builtin_amdgcn_s_getreg((3 << 11) | 20) & 0xFu; }
#define XB_SPIN(cond, bar) do { unsigned _sp = 0; while (cond) { __builtin_amdgcn_s_sleep(1); \
    if ((++_sp & 255u) == 0u) { if (xb_ld(&(bar)[XB_TMO])) break; if (_sp > XB_SPIN_CAP) { atomicAdd(&(bar)[XB_TMO], 1u); break; } } } } while (0)
struct XcdBarrier { unsigned* bar; unsigned x; volatile LAS unsigned* st; };
__device__ __forceinline__ XcdBarrier xcd_barrier_post(unsigned* bar, volatile LAS unsigned* st) {
    XcdBarrier b; b.bar = bar; b.x = xb_xcc_id(); b.st = st;
    if (threadIdx.x == 0) (void)xb_add(&bar[XB_XCNT(b.x)], 1u);
    return b;
}
__device__ __forceinline__ void xcd_barrier_complete(unsigned* bar, unsigned x, unsigned& nloc, unsigned& nx) {
    const unsigned G = gridDim.x * gridDim.y * gridDim.z;
    unsigned sum, cnt, mine, sp = 0u;
    for (;;) {
        sum = 0u; cnt = 0u; mine = 0u;
#pragma unroll
        for (unsigned j = 0; j < 16; ++j) { const unsigned c = xb_ld(&bar[XB_XCNT(j)]); sum += c; cnt += (c > 0u) ? 1u : 0u; mine = (j == x) ? c : mine; }
        if (sum == G) break;
        __builtin_amdgcn_s_sleep(1);
        if ((++sp & 255u) == 0u) { if (xb_ld(&bar[XB_TMO])) break; if (sp > XB_SPIN_CAP) { atomicAdd(&bar[XB_TMO], 1u); break; } }
    }
    nloc = mine > 0u ? mine : 1u; nx = cnt > 0u ? cnt : 1u;
}
__device__ __forceinline__ void xcd_barrier(const XcdBarrier& b) {
    asm volatile("s_waitcnt vmcnt(0)" ::: "memory");
    __syncthreads();
    if (threadIdx.x == 0) {
        unsigned long long bar_i = (unsigned long long)b.bar; unsigned bx_ = b.x; asm volatile("" : "+s"(bar_i), "+s"(bx_));
        unsigned* bar = (unsigned*)(__attribute__((address_space(1))) unsigned*)bar_i;
        __builtin_amdgcn_s_waitcnt(0);
        unsigned nloc = b.st[0], nx = b.st[1];
        if (nloc == 0u) { xcd_barrier_complete(bar, bx_, nloc, nx); b.st[0] = nloc; b.st[1] = nx; }
        const unsigned old = xb_add(&bar[XB_XSUB(bx_)], 1u);
        const unsigned gen = old / nloc;
        if (old + 1u == (gen + 1u) * nloc) {
            __builtin_amdgcn_fence(__ATOMIC_RELEASE, "agent");
            asm volatile("s_waitcnt vmcnt(0)" ::: "memory");
            const unsigned og = xb_add(&bar[XB_TOP], 1u);
            const unsigned tg = og / nx;
            if (og + 1u == (tg + 1u) * nx) xb_add(&bar[XB_TOPGEN], 1u);
            else XB_SPIN(xb_ld(&bar[XB_TOPGEN]) == tg, bar);
            __builtin_amdgcn_fence(__ATOMIC_ACQUIRE, "agent");
            xb_add(&bar[XB_XGEN(bx_)], 1u);
            asm volatile("s_waitcnt vmcnt(0)" ::: "memory");
        } else {
            XB_SPIN(xb_ld(&bar[XB_XGEN(bx_)]) == gen, bar);
            __builtin_amdgcn_fence(__ATOMIC_ACQUIRE, "agent");
            asm volatile("s_waitcnt vmcnt(0)" ::: "memory");
        }
    }
    __syncthreads();
}

struct Frame {
    LAS unsigned char* lds;
    int tid, lane, wave, vcu, G, gw, NGW, bid;
    float* out; unsigned char* ws;
};
__device__ __forceinline__ void relaunder(Frame& F) {
    unsigned long long w = (unsigned long long)F.ws, o = (unsigned long long)F.out;
    int vcu = F.vcu, G = F.G, wave = F.wave, tid = F.tid, bid = F.bid;
    asm volatile("" : "+s"(w), "+s"(o), "+s"(vcu), "+s"(G), "+s"(wave), "+s"(bid));
    asm volatile("" : "+v"(tid));
    F.ws = (unsigned char*)(__attribute__((address_space(1))) unsigned char*)w; F.out = (float*)(__attribute__((address_space(1))) float*)o;
    F.vcu = vcu; F.G = G; F.wave = wave; F.tid = tid; F.lane = tid & 63; F.bid = bid; F.gw = vcu * NWAVES + wave; F.NGW = G * NWAVES;
}
#define LDS_WAIT() asm volatile("s_waitcnt lgkmcnt(0)" ::: "memory")

__device__ __forceinline__ void transpose_item(const float* W, int N, int k0, int n0, bf16_t* dst, int ldk, LAS float* scr, int lane) {
#pragma unroll 8
    for (int i = 0; i < 32; ++i) { const int kk = 2 * i + (lane >> 5); scr[kk * 33 + (lane & 31)] = W[(size_t)(k0 + kk) * N + n0 + (lane & 31)]; }
    LDS_WAIT(); asm volatile("" ::: "memory");
    const int c = lane & 7;
#pragma unroll
    for (int j = 0; j < 4; ++j) { const int n = (lane >> 3) + 8 * j; const LAS float* s = scr + (8 * c) * 33 + n;
        u32x4 o; o.x = pk2(s[0 * 33], s[1 * 33]); o.y = pk2(s[2 * 33], s[3 * 33]); o.z = pk2(s[4 * 33], s[5 * 33]); o.w = pk2(s[6 * 33], s[7 * 33]);
        *(u32x4*)(dst + (size_t)n * ldk + 8 * c) = o; }
    LDS_WAIT(); asm volatile("" ::: "memory");
}

__device__ __forceinline__ void transpose_item32(const float* W, int N, int k0, int n0, bf16_t* dst, int ldk, LAS float* scr, int lane) {
#pragma unroll 8
    for (int i = 0; i < 16; ++i) { const int kk = 2 * i + (lane >> 5); scr[kk * 33 + (lane & 31)] = W[(size_t)(k0 + kk) * N + n0 + (lane & 31)]; }
    LDS_WAIT(); asm volatile("" ::: "memory");
    const int c = lane & 3;
#pragma unroll
    for (int j = 0; j < 2; ++j) { const int n = (lane >> 2) + 16 * j; const LAS float* s = scr + (8 * c) * 33 + n;
        u32x4 o; o.x = pk2(s[0 * 33], s[1 * 33]); o.y = pk2(s[2 * 33], s[3 * 33]); o.z = pk2(s[4 * 33], s[5 * 33]); o.w = pk2(s[6 * 33], s[7 * 33]);
        *(u32x4*)(dst + (size_t)n * ldk + 8 * c) = o; }
    LDS_WAIT(); asm volatile("" ::: "memory");
}
__device__ __forceinline__ void transpose_issue32(const float* W, int N, int k0, int n0, float (&v)[16], int lane) {
    const unsigned char* Wb = (const unsigned char*)(W + (size_t)k0 * N + n0);
    const unsigned lo = (unsigned)(((lane >> 5) * N + (lane & 31)) * 4);
#pragma unroll
    for (int i = 0; i < 16; ++i) { const unsigned oi = lo + (unsigned)(2 * i * N * 4); v[i] = *(const float*)(Wb + oi); }
}
__device__ __forceinline__ void transpose_finish32(const float (&v)[16], bf16_t* dst, int ldk, LAS float* scr, int lane, bool store) {
    if (!store) {
        asm volatile("" :: "v"(v[0]), "v"(v[1]), "v"(v[2]), "v"(v[3]), "v"(v[4]), "v"(v[5]), "v"(v[6]), "v"(v[7]), "v"(v[8]), "v"(v[9]), "v"(v[10]), "v"(v[11]), "v"(v[12]), "v"(v[13]), "v"(v[14]), "v"(v[15]));
        return;
    }
#pragma unroll
    for (int i = 0; i < 16; ++i) { const int kk = 2 * i + (lane >> 5); scr[kk * 33 + (lane & 31)] = v[i]; }
    LDS_WAIT(); asm volatile("" ::: "memory");
    const int c = lane & 3;
#pragma unroll
    for (int j = 0; j < 2; ++j) { const int n = (lane >> 2) + 16 * j; const LAS float* s = scr + (8 * c) * 33 + n;
        u32x4 o; o.x = pk2(s[0 * 33], s[1 * 33]); o.y = pk2(s[2 * 33], s[3 * 33]); o.z = pk2(s[4 * 33], s[5 * 33]); o.w = pk2(s[6 * 33], s[7 * 33]);
        *(u32x4*)((unsigned char*)dst + (unsigned)((n * ldk + 8 * c) * 2)) = o; }
    LDS_WAIT(); asm volatile("" ::: "memory");
}
__device__ __forceinline__ void convert_expert_issue32(int l, int it, const float* exp_gate, const float* exp_up, const float* exp_down, float (&v)[16], int lane) {
    constexpr int I_M = 32 * 32;
    const int which = it / (NEXP * I_M), r = it % (NEXP * I_M), e = r / I_M, q = r % I_M, kb = q / 32, nb = q % 32, n0 = nb * 32;
    const float* W = (which == 0 ? exp_gate : (which == 1 ? exp_up : exp_down)) + ((size_t)l * NEXP + e) * DM * EFF;
    transpose_issue32(W, which < 2 ? EFF : DM, kb * 32, n0, v, lane);
}
__device__ __forceinline__ void convert_expert_finish32(unsigned char* ws, int it_in, const float (&v)[16], LAS float* scr, int lane) {
    const int it_ = __builtin_amdgcn_readfirstlane(it_in);
    bf16_t* Wup = (bf16_t*)(ws + WS_WUP); bf16_t* Wdn = (bf16_t*)(ws + WS_WDN);
    constexpr int I_M = 32 * 32;
    const bool store = it_ >= 0; const int it = store ? it_ : 0;
    const int which = it / (NEXP * I_M), r = it % (NEXP * I_M), e = r / I_M, q = r % I_M, kb = q / 32, nb = q % 32, n0 = nb * 32;
    if (which < 2) { const int drow = 256 * (n0 >> 7) + 128 * which + (n0 & 127);
        transpose_finish32(v, Wup + ((size_t)e * 2048 + drow) * DM + kb * 32, DM, scr, lane, store); }
    else transpose_finish32(v, Wdn + ((size_t)e * 1024 + n0) * EFF + kb * 32, EFF, scr, lane, store);
}
__device__ __forceinline__ void convert_expert_item32(unsigned char* ws, int l, int it, const float* exp_gate, const float* exp_up, const float* exp_down, LAS float* scr, int lane) {
    bf16_t* Wup = (bf16_t*)(ws + WS_WUP); bf16_t* Wdn = (bf16_t*)(ws + WS_WDN);
    constexpr int I_M = 32 * 32;
    const int which = it / (NEXP * I_M), r = it % (NEXP * I_M), e = r / I_M, q = r % I_M, kb = q / 32, nb = q % 32, n0 = nb * 32;
    const float* W = (which == 0 ? exp_gate : (which == 1 ? exp_up : exp_down)) + ((size_t)l * NEXP + e) * DM * EFF;
    if (which < 2) { const int drow = 256 * (n0 >> 7) + 128 * which + (n0 & 127);
        transpose_item32(W, EFF, kb * 32, n0, Wup + ((size_t)e * 2048 + drow) * DM + kb * 32, DM, scr, lane); }
    else transpose_item32(W, DM, kb * 32, n0, Wdn + ((size_t)e * 1024 + n0) * EFF + kb * 32, EFF, scr, lane);
}

__device__ __forceinline__ void phase_prologue(Frame& F, const float* c_in, const float* cctx_in, const float* ada_w, const float* ada_b, const float* w_in, const float* decay_w2, const float* iclr_a2, const float* gate_g2,
                                               const float* w_br_att, const float* w_br_rwkv, const float* w_br_conv, const float* w_out, const float* w_router) {
    LAS float* scr = (LAS float*)(F.lds + F.wave * 16384);
    bf16_t* Win = (bf16_t*)(F.ws + WS_WIN); bf16_t* Wbr = (bf16_t*)(F.ws + WS_WBR); bf16_t* Wout = (bf16_t*)(F.ws + WS_WOUT); bf16_t* Wlr = (bf16_t*)(F.ws + WS_WLR);
    constexpr int I_IN = 16 * 228, I_BR = 8 * 32, I_OUT = 16 * 32;
    constexpr int PER_L = I_IN + 3 * I_BR + I_OUT;
    for (int it = F.gw; it < NL * PER_L; it += F.NGW) {
        const int l = it / PER_L; int r = it % PER_L;
        if (r < I_IN) { const int kb = r / 228, nb = r % 228; transpose_item(w_in + (size_t)l * DM * NCOLS_IN, NCOLS_IN, kb * 64, nb * 32, Win + ((size_t)l * PWP + nb * 32) * DM + kb * 64, DM, scr, F.lane); continue; }
        r -= I_IN;
        if (r < 3 * I_BR) { const int br = r / I_BR, q = r % I_BR, kb = q / 32, nb = q % 32;
            const float* W = (br == 0 ? w_br_att : (br == 1 ? w_br_rwkv : w_br_conv)) + (size_t)l * 512 * DM;
            transpose_item(W, DM, kb * 64, nb * 32, Wbr + (((size_t)l * 3 + br) * 1024 + nb * 32) * 512 + kb * 64, 512, scr, F.lane); continue; }
        r -= 3 * I_BR;
        { const int kb = r / 32, nb = r % 32; transpose_item(w_out + (size_t)l * DM * DM, DM, kb * 64, nb * 32, Wout + ((size_t)l * 1024 + nb * 32) * DM + kb * 64, DM, scr, F.lane); }
    }
    for (int i = F.gw * 64 + F.lane; i < NL * (PWP - NCOLS_IN) * DM / 8; i += F.NGW * 64) {
        const int l = i / ((PWP - NCOLS_IN) * DM / 8), r = i % ((PWP - NCOLS_IN) * DM / 8);
        *(u32x4*)(Win + ((size_t)l * PWP + NCOLS_IN) * DM + (size_t)r * 8) = (u32x4){0u, 0u, 0u, 0u};
    }
    for (int i = F.gw * 64 + F.lane; i < NL * WAGW * 16; i += F.NGW * 64) {
        const int l = i / (WAGW * 16), r = i % (WAGW * 16), k8 = r / WAGW, n = r % WAGW, kk0 = 8 * k8;
        const float* src = nullptr;
        if (n < 512) { if (kk0 < 64) src = decay_w2 + (((size_t)l * 2 + 0) * 64 + kk0) * 512 + n; }
        else if (n < 1024) { if (kk0 >= 64) src = decay_w2 + (((size_t)l * 2 + 1) * 64 + (kk0 - 64)) * 512 + (n - 512); }
        else if (n < 1536) { if (kk0 < 64) src = iclr_a2 + (((size_t)l * 2 + 0) * 64 + kk0) * 512 + (n - 1024); }
        else if (n < 2048) { if (kk0 >= 64) src = iclr_a2 + (((size_t)l * 2 + 1) * 64 + (kk0 - 64)) * 512 + (n - 1536); }
        else src = gate_g2 + ((size_t)l * 128 + kk0) * 512 + (n - 2048);
        float v[8];
#pragma unroll
        for (int q = 0; q < 8; ++q) v[q] = src ? src[(size_t)q * 512] : 0.f;
        *(u32x4*)(Wlr + ((size_t)l * WAGW + n) * 128 + kk0) = pack8(v);
    }
    { bf16_t* WRT = (bf16_t*)(F.ws + WS_WRT);
      for (int i = F.gw * 64 + F.lane; i < NL * 16 * 1024; i += F.NGW * 64) { const int l = i / 16384, r = i % 16384, e = r / 1024, k = r % 1024;
          const float w = w_router[((size_t)l * 1024 + k) * 16 + e]; const unsigned hi = f2bf(w); const unsigned lo = f2bf(w - bflo(hi));
          WRT[((size_t)l * 2 + 0) * 16384 + r] = (bf16_t)hi; WRT[((size_t)l * 2 + 1) * 16384 + r] = (bf16_t)lo; } }
    if (blockIdx.x == 0) {
        float* rope = (float*)(F.ws + WS_ROPE);
        for (int i = F.tid; i < 64 * 16; i += NTHR) { const int pos = i >> 4, fi = i & 15;
            const float inv = powf(10000.0f, -(float)(2 * fi) / 32.0f); const float ang = (float)pos * inv;
            rope[2 * i] = cosf(ang); rope[2 * i + 1] = sinf(ang); }
    }
    __syncthreads();
    LAS float* sc = (LAS float*)F.lds;
    LAS float* part = (LAS float*)(F.lds + 17 * 1024 * 4);
    for (int i = F.tid; i < 17 * 1024; i += NTHR) { const float v = (i < 16 * 1024) ? c_in[i] : cctx_in[i - 16 * 1024]; sc[i] = v * sigmoidf_(v); }
    __syncthreads();
    float* MOD = (float*)(F.ws + WS_MOD);
    for (int item = F.vcu; item < NL * 96; item += F.G) {
        const int l = item / 96, n0 = (item % 96) * 64;
        float acc[17];
#pragma unroll
        for (int r = 0; r < 17; ++r) acc[r] = 0.f;
        const float* wp = ada_w + ((size_t)l * DM + F.wave * 128) * 6144 + n0 + F.lane;
        for (int kk0 = 0; kk0 < 128; kk0 += 16) {
            float w[16];
#pragma unroll
            for (int j = 0; j < 16; ++j) w[j] = wp[(size_t)(kk0 + j) * 6144];
#pragma unroll
            for (int j = 0; j < 16; ++j) {
                const int k = F.wave * 128 + kk0 + j;
#pragma unroll
                for (int r = 0; r < 17; ++r) acc[r] += sc[r * 1024 + k] * w[j];
            }
        }
#pragma unroll
        for (int r = 0; r < 17; ++r) part[(F.wave * 17 + r) * 64 + F.lane] = acc[r];
        __syncthreads();
        for (int idx = F.tid; idx < 17 * 64; idx += NTHR) { const int r = idx >> 6, j = idx & 63; float s = 0.f;
#pragma unroll
            for (int w = 0; w < 8; ++w) s += part[(w * 17 + r) * 64 + j];
            MOD[((size_t)l * 17 + r) * 6144 + n0 + j] = s + ada_b[(size_t)l * 6144 + n0 + j]; }
        __syncthreads();
    }
}

__device__ __forceinline__ void convert_experts(Frame& F, int l, const float* exp_gate, const float* exp_up, const float* exp_down, int wk, int nwk, int it_lo, int it_hi) {
    LAS float* scr = (LAS float*)(F.lds + F.wave * 16384);
    bf16_t* Wup = (bf16_t*)(F.ws + WS_WUP); bf16_t* Wdn = (bf16_t*)(F.ws + WS_WDN);
    constexpr int I_M = 16 * 32;
    for (int it = it_lo + wk; it < it_hi; it += nwk) {
        const int which = it / (NEXP * I_M), r = it % (NEXP * I_M), e = r / I_M, q = r % I_M, kb = q / 32, nb = q % 32, n0 = nb * 32;
        const float* W = (which == 0 ? exp_gate : (which == 1 ? exp_up : exp_down)) + ((size_t)l * NEXP + e) * DM * EFF;
        if (which < 2) { const int drow = 256 * (n0 >> 7) + 128 * which + (n0 & 127);
            transpose_item(W, EFF, kb * 64, n0, Wup + ((size_t)e * 2048 + drow) * DM + kb * 64, DM, scr, F.lane); }
        else transpose_item(W, DM, kb * 64, n0, Wdn + ((size_t)e * 1024 + n0) * EFF + kb * 64, EFF, scr, F.lane);
    }
}

struct N1Row { f32x4 v[4]; int slot; float gate; int row; bool ok; };
__device__ __forceinline__ void n1_load(Frame& F, N1Row& R, int row, int nrows, int l, const float* x_in, const float* ctx_in) {
    R.ok = row < nrows; R.row = R.ok ? row : 0;
    const bool lat = R.row < NLAT;
    if (l == 0) {
        const float* xs = lat ? x_in + (size_t)R.row * DM : ctx_in + (size_t)(R.row - NLAT) * DM;
#pragma unroll
        for (int j = 0; j < 4; ++j) R.v[j] = *(const f32x4*)(xs + 4 * F.lane + 256 * j);
    } else {
        const bf16_t* xb = (const bf16_t*)(F.ws + WS_XB) + (size_t)R.row * DM + 4 * F.lane;
#pragma unroll
        for (int j = 0; j < 4; ++j) { const u32x2 w = *(const u32x2*)(xb + 256 * j); R.v[j] = (f32x4){bflo(w.x), bfhi(w.x), bflo(w.y), bfhi(w.y)}; }
    }
    R.slot = -1; R.gate = 0.f;
    if (l > 0) { R.slot = ((const int*)(F.ws + WS_SLOT))[(size_t)R.row * 16 + (F.lane & 15)]; R.gate = ((const float*)(F.ws + WS_AFF))[(size_t)R.row * 16 + (F.lane & 15)]; }
}
__device__ __forceinline__ void n1_finish(Frame& F, N1Row& R, int l, const float* norm1, const float* final_norm, bool dry) {
    const bool fin = (l == NL);
    const float* MOD = (const float*)(F.ws + WS_MOD);
    const bf16_t* YE = (const bf16_t*)(F.ws + WS_YE); bf16_t* H = (bf16_t*)(F.ws + WS_H);
    const int row = R.row; const bool lat = row < NLAT; const int b = lat ? (row >> 11) : ((row - NLAT) >> 8); const int modrow = lat ? b : 16;
    bf16_t* xbw = (bf16_t*)(F.ws + WS_XB) + (size_t)row * DM;
    if (dry) { xbw = (bf16_t*)(F.ws + WS_WAG) + (size_t)row * DM; H = (bf16_t*)(F.ws + WS_YF); }
    if (l > 0) {
        f32x4 a[4];
#pragma unroll
        for (int j = 0; j < 4; ++j) a[j] = (f32x4){0.f, 0.f, 0.f, 0.f};
        unsigned mask = (unsigned)(__ballot(R.slot >= 0 && F.lane < 16));
        const size_t pbase = (size_t)(lat ? b * CAPL : NB * CAPL + b * CAPC);
        while (mask) {
            const int e0 = __builtin_ctz(mask); mask &= mask - 1u;
            const bool two = mask != 0u; const int e1 = two ? __builtin_ctz(mask) : e0; if (two) mask &= mask - 1u;
            const int s0 = __builtin_amdgcn_readlane(R.slot, e0), s1 = __builtin_amdgcn_readlane(R.slot, e1);
            const float g0 = __builtin_bit_cast(float, __builtin_amdgcn_readlane(__builtin_bit_cast(int, R.gate), e0));
            const float g1 = two ? __builtin_bit_cast(float, __builtin_amdgcn_readlane(__builtin_bit_cast(int, R.gate), e1)) : 0.f;
            const bf16_t* y0 = YE + ((size_t)e0 * PAIRS_E + pbase + s0) * DM + 4 * F.lane;
            const bf16_t* y1 = YE + ((size_t)e1 * PAIRS_E + pbase + s1) * DM + 4 * F.lane;
            u32x2 w0[4], w1[4];
#pragma unroll
            for (int j = 0; j < 4; ++j) { w0[j] = *(const u32x2*)(y0 + 256 * j); w1[j] = *(const u32x2*)(y1 + 256 * j); }
#pragma unroll
            for (int j = 0; j < 4; ++j) {
                a[j][0] += g0 * bflo(w0[j].x) + g1 * bflo(w1[j].x); a[j][1] += g0 * bfhi(w0[j].x) + g1 * bfhi(w1[j].x);
                a[j][2] += g0 * bflo(w0[j].y) + g1 * bflo(w1[j].y); a[j][3] += g0 * bfhi(w0[j].y) + g1 * bfhi(w1[j].y);
            }
        }
        const float* g2 = MOD + ((size_t)(l - 1) * 17 + modrow) * 6144 + 5 * 1024 + 4 * F.lane;
#pragma unroll
        for (int j = 0; j < 4; ++j) R.v[j] += *(const f32x4*)(g2 + 256 * j) * a[j];
    }
    if (!fin && R.ok) {
#pragma unroll
        for (int j = 0; j < 4; ++j) { u32x2 w; w.x = pk2(R.v[j][0], R.v[j][1]); w.y = pk2(R.v[j][2], R.v[j][3]); *(u32x2*)(xbw + 4 * F.lane + 256 * j) = w; }
    }
    float ss = 0.f;
#pragma unroll
    for (int j = 0; j < 4; ++j) ss += (R.v[j][0] * R.v[j][0] + R.v[j][1] * R.v[j][1]) + (R.v[j][2] * R.v[j][2] + R.v[j][3] * R.v[j][3]);
    const float rstd = rsq_(wave_sum(ss) * (1.0f / DM) + NORM_EPS);
    if (!R.ok) return;
    if (fin) {
        const float* gn = final_norm + 4 * F.lane;
#pragma unroll
        for (int j = 0; j < 4; ++j) *(f32x4*)(F.out + (size_t)row * DM + 4 * F.lane + 256 * j) = R.v[j] * rstd * *(const f32x4*)(gn + 256 * j);
    } else {
        const float* gn = norm1 + (size_t)l * DM + 4 * F.lane;
        const float* md = MOD + ((size_t)l * 17 + modrow) * 6144 + 4 * F.lane;
#pragma unroll
        for (int j = 0; j < 4; ++j) {
            const f32x4 h = R.v[j] * rstd * *(const f32x4*)(gn + 256 * j) * (*(const f32x4*)(md + 1024 + 256 * j) + 1.0f) + *(const f32x4*)(md + 256 * j);
            u32x2 w; w.x = pk2(h[0], h[1]); w.y = pk2(h[2], h[3]);
            *(u32x2*)(H + (size_t)row * DM + 4 * F.lane + 256 * j) = w;
        }
    }
}
__device__ __forceinline__ void phase_norm1(Frame& F, int l, const float* x_in, const float* ctx_in, const float* norm1, const float* final_norm, bool dry = false) {
    const int nrows = (l == NL) ? NLAT : NTOK;
    for (int row = F.gw; row < nrows; row += 4 * F.NGW) {
        N1Row A, B, C, D;
        n1_load(F, A, row, nrows, l, x_in, ctx_in); n1_load(F, B, row + F.NGW, nrows, l, x_in, ctx_in); n1_load(F, C, row + 2 * F.NGW, nrows, l, x_in, ctx_in); n1_load(F, D, row + 3 * F.NGW, nrows, l, x_in, ctx_in);
        n1_finish(F, A, l, norm1, final_norm, dry); n1_finish(F, B, l, norm1, final_norm, dry); n1_finish(F, C, l, norm1, final_norm, dry); n1_finish(F, D, l, norm1, final_norm, dry);
    }
}

struct PrepRow { u32x4 q, k, bg, cg[3], u[3], lr[3]; };
__device__ __forceinline__ void prep_load(PrepRow& R, const bf16_t* pr, int t, int slen, int lane) {
    const bool hp = t > 0, hn = t + 1 < slen; const u32x4 z = {0u, 0u, 0u, 0u};
    R.q = *(const u32x4*)(pr + C_Q + 8 * lane); R.k = *(const u32x4*)(pr + C_K + 8 * (lane & 15));
    R.bg = *(const u32x4*)(pr + C_BG + 8 * lane);
    R.cg[0] = *(const u32x4*)(pr + C_CG + 8 * lane); R.u[0] = *(const u32x4*)(pr + C_U + 8 * lane);
    R.cg[1] = hp ? *(const u32x4*)(pr - PW + C_CG + 8 * lane) : z; R.u[1] = hp ? *(const u32x4*)(pr - PW + C_U + 8 * lane) : z;
    R.cg[2] = hn ? *(const u32x4*)(pr + PW + C_CG + 8 * lane) : z; R.u[2] = hn ? *(const u32x4*)(pr + PW + C_U + 8 * lane) : z;
    const int ll = lane < 48 ? lane : 47;
    R.lr[0] = *(const u32x4*)(pr + C_WLO + 8 * ll);
    R.lr[1] = hp ? *(const u32x4*)(pr - PW + C_WLO + 8 * ll) : z; R.lr[2] = hn ? *(const u32x4*)(pr + PW + C_WLO + 8 * ll) : z;
}
__device__ __forceinline__ void phase_prep(Frame& F, int l, const float* q_gain, const float* k_gain, const float* conv_w, const float* shift_mu, bool dry = false) {
    bf16_t* P = (bf16_t*)(F.ws + WS_PROJ); bf16_t* LRA = (bf16_t*)(F.ws + WS_LRA);
    LAS float* rope = (LAS float*)F.lds;
    for (int i = F.tid; i < 64 * 16 * 2; i += NTHR) rope[i] = ((const float*)(F.ws + WS_ROPE))[i];
    __syncthreads();
    const int lane = F.lane, s8 = lane & 7;
    float qg[8], kg[8], cw0[8], cw1[8], cw2[8], mu[8];
#pragma unroll
    for (int i = 0; i < 8; ++i) { qg[i] = q_gain[l * 64 + s8 * 8 + i]; kg[i] = k_gain[l * 64 + s8 * 8 + i];
        cw0[i] = conv_w[((size_t)l * 3 + 0) * 512 + 8 * lane + i]; cw1[i] = conv_w[((size_t)l * 3 + 1) * 512 + 8 * lane + i]; cw2[i] = conv_w[((size_t)l * 3 + 2) * 512 + 8 * lane + i];
        mu[i] = (lane < 48) ? shift_mu[(size_t)l * 1920 + (C_WLO - C_RW) + 8 * lane + i] : 0.f; }
    for (int row0 = F.gw; row0 < NTOK; row0 += 2 * F.NGW) {
        const int row1 = row0 + F.NGW; const bool ok1 = row1 < NTOK;
        PrepRow RR[2]; int tt[2]; bool latt[2];
#pragma unroll
        for (int z = 0; z < 2; ++z) { const int row = (z == 0 || !ok1) ? row0 : row1; latt[z] = row < NLAT; tt[z] = latt[z] ? (row & 2047) : ((row - NLAT) & 255);
            prep_load(RR[z], P + (size_t)row * PW, tt[z], latt[z] ? SEQ : CTXL, lane); }
#pragma unroll
        for (int z = 0; z < 2; ++z) {
            if (z == 1 && !ok1) break;
            const int row = z == 0 ? row0 : row1; const PrepRow& R = RR[z]; const bool lat = latt[z]; const int t = tt[z];
            bf16_t* pr = P + (size_t)row * PW;
#pragma unroll
            for (int which = 0; which < 2; ++which) {
                float x[8]; unpack8(which == 0 ? R.q : R.k, x);
                float ss = 0.f;
#pragma unroll
                for (int i = 0; i < 8; ++i) ss += x[i] * x[i];
                ss = sum8(ss);
                const float rstd = rsq_(ss * (1.0f / 64.0f) + NORM_EPS);
#pragma unroll
                for (int i = 0; i < 8; ++i) x[i] = x[i] * rstd * (which == 0 ? qg[i] : kg[i]);
                if (lat) {
                    const int pos = (s8 < 4) ? (t >> 6) : (t & 63);
                    float o[8];
#pragma unroll
                    for (int i = 0; i < 8; ++i) {
                        const float partner = dpp_f(x[i], 1);
                        const int fi = (s8 & 1) * 8 + i;
                        const float c = rope[(pos * 16 + fi) * 2], sn = rope[(pos * 16 + fi) * 2 + 1];
                        o[i] = (s8 & 2) ? (partner * sn + x[i] * c) : (x[i] * c - partner * sn);
                    }
#pragma unroll
                    for (int i = 0; i < 8; ++i) x[i] = o[i];
                }
                if (which == 0) {
#pragma unroll
                    for (int i = 0; i < 8; ++i) x[i] *= QSCALE;
                    if (!dry) st8(pr + C_Q + 8 * lane, x);
                } else if (lane < 16 && !dry) st8(pr + C_K + 8 * lane, x);
            }
            {
                float bg[8], c0[8], u0[8], z0[8], zp[8], zn[8];
                unpack8(R.bg, bg);
                unpack8(R.cg[0], c0); unpack8(R.u[0], u0);
#pragma unroll
                for (int i = 0; i < 8; ++i) z0[i] = c0[i] * u0[i];
                unpack8(R.cg[1], c0); unpack8(R.u[1], u0);
#pragma unroll
                for (int i = 0; i < 8; ++i) zp[i] = c0[i] * u0[i];
                unpack8(R.cg[2], c0); unpack8(R.u[2], u0);
#pragma unroll
                for (int i = 0; i < 8; ++i) zn[i] = c0[i] * u0[i];
                float o[8];
#pragma unroll
                for (int i = 0; i < 8; ++i) o[i] = bg[i] * (cw0[i] * zp[i] + cw1[i] * z0[i] + cw2[i] * zn[i]);
                if (!dry) st8(pr + C_OCONV + 8 * lane, o);
            }
            {
                float x[8], xp[8], xn[8], o[8];
                unpack8(R.lr[0], x); unpack8(R.lr[1], xp); unpack8(R.lr[2], xn);
#pragma unroll
                for (int i = 0; i < 8; ++i) { const float sft = x[i] + mu[i] * (0.5f * (xp[i] + xn[i]) - x[i]);
                    const float sg = sigmoidf_(lane < 16 ? 2.0f * sft : sft); o[i] = lane < 16 ? 2.0f * sg - 1.0f : (lane < 32 ? sft : sg); }
                if (lane < 48) st8(LRA + (size_t)row * LRAW + 8 * lane, o);
            }
        }
    }
}
__device__ __forceinline__ void n2_modulate(Frame& F, f32x4 (&v)[4], int row, int l, const float* norm2) {
    const float* MOD = (const float*)(F.ws + WS_MOD); bf16_t* H = (bf16_t*)(F.ws + WS_H);
    const bool lat = row < NLAT; const int b = lat ? (row >> 11) : ((row - NLAT) >> 8); const int modrow = lat ? b : 16;
    float ss = 0.f;
#pragma unroll
    for (int j = 0; j < 4; ++j) ss += (v[j][0] * v[j][0] + v[j][1] * v[j][1]) + (v[j][2] * v[j][2] + v[j][3] * v[j][3]);
    const float rstd = rsq_(wave_sum(ss) * (1.0f / DM) + NORM_EPS);
    const float* gn = norm2 + (size_t)l * DM + 4 * F.lane;
    const float* md = MOD + ((size_t)l * 17 + modrow) * 6144 + 3 * 1024 + 4 * F.lane;
#pragma unroll
    for (int j = 0; j < 4; ++j) {
        v[j] = v[j] * rstd * *(const f32x4*)(gn + 256 * j) * (*(const f32x4*)(md + 1024 + 256 * j) + 1.0f) + *(const f32x4*)(md + 256 * j);
        u32x2 w; w.x = pk2(v[j][0], v[j][1]); w.y = pk2(v[j][2], v[j][3]);
        *(u32x2*)(H + (size_t)row * DM + 4 * F.lane + 256 * j) = w;
    }
}
__device__ __forceinline__ void n2_softmax_store(Frame& F, float (&lg)[16], int row) {
    float* AFF = (float*)(F.ws + WS_AFF);
    float mx = lg[0];
#pragma unroll
    for (int e = 1; e < 16; ++e) mx = fmaxf(mx, lg[e]);
    float den = 0.f;
#pragma unroll
    for (int e = 0; e < 16; ++e) { lg[e] = __expf(lg[e] - mx); den += lg[e]; }
    const float inv = rcp_(den);
    float mine = 0.f;
#pragma unroll
    for (int e = 0; e < 16; ++e) mine = (F.lane == e) ? lg[e] * inv : mine;
    if (F.lane < 16) AFF[(size_t)row * 16 + F.lane] = mine;
}
__device__ __forceinline__ void phase_norm2_router(Frame& F, int l, int nrows, const float* norm2, const float* w_router) {
    LAS float* wrT = (LAS float*)F.lds;
    for (int i = F.tid; i < 16 * 1024; i += NTHR) { const int c = i >> 4, e = i & 15; wrT[e * 1024 + c] = w_router[(size_t)l * DM * 16 + i]; }
    __syncthreads();
    const bf16_t* XB = (const bf16_t*)(F.ws + WS_XB);
    for (int row = F.gw; row < nrows; row += 2 * F.NGW) {
        const int row1 = row + F.NGW; const bool ok1 = row1 < nrows; const int r1 = ok1 ? row1 : row;
        f32x4 v0[4], v1[4];
#pragma unroll
        for (int j = 0; j < 4; ++j) { const u32x2 a = *(const u32x2*)(XB + (size_t)row * DM + 4 * F.lane + 256 * j), b = *(const u32x2*)(XB + (size_t)r1 * DM + 4 * F.lane + 256 * j);
            v0[j] = (f32x4){bflo(a.x), bfhi(a.x), bflo(a.y), bfhi(a.y)}; v1[j] = (f32x4){bflo(b.x), bfhi(b.x), bflo(b.y), bfhi(b.y)}; }
        n2_modulate(F, v0, row, l, norm2);
        n2_modulate(F, v1, r1, l, norm2);
        float lg0[16], lg1[16];
#pragma unroll
        for (int e = 0; e < 16; ++e) {
            float s0 = 0.f, s1 = 0.f;
#pragma unroll
            for (int j = 0; j < 4; ++j) { const f32x4 w = *(const LAS f32x4*)(wrT + e * 1024 + 4 * F.lane + 256 * j);
                s0 += (v0[j][0] * w[0] + v0[j][1] * w[1]) + (v0[j][2] * w[2] + v0[j][3] * w[3]); s1 += (v1[j][0] * w[0] + v1[j][1] * w[1]) + (v1[j][2] * w[2] + v1[j][3] * w[3]); }
            lg0[e] = wave_sum(s0); lg1[e] = wave_sum(s1);
            if ((e & 3) == 3) __builtin_amdgcn_sched_barrier(0);
        }
        n2_softmax_store(F, lg0, row);
        if (ok1) n2_softmax_store(F, lg1, row1);
    }
}

__device__ __forceinline__ float qsum4(float x) {
    x += __shfl_xor(x, 16); x += __shfl_xor(x, 32);
    return x;
}
__device__ __forceinline__ void n2_tile(Frame& F, int row0, const LAS float* Gs, const LAS float* Sh, const bf16_t* WRh, const bf16_t* WRl) {
    const int lane = F.lane, r = lane & 15, q = lane >> 4;
    const bf16_t* xrow = (const bf16_t*)(F.ws + WS_XB) + (size_t)(row0 + r) * DM + 8 * q;
    bf16_t* hrow = (bf16_t*)(F.ws + WS_H) + (size_t)(row0 + r) * DM + 8 * q;
    const bf16_t* wh = WRh + (size_t)r * 1024 + 8 * q; const bf16_t* wl = WRl + (size_t)r * 1024 + 8 * q;
    float ss = 0.f;
#pragma unroll 8
    for (int s = 0; s < 32; ++s) { float x[8]; ld8(xrow + 32 * s, x);
#pragma unroll
        for (int j = 0; j < 8; ++j) ss += x[j] * x[j]; }
    const float rstd = rsq_(qsum4(ss) * (1.0f / DM) + NORM_EPS);
    f32x4 acc = {0.f, 0.f, 0.f, 0.f};
#pragma unroll 2
    for (int s = 0; s < 32; ++s) {
        float x[8]; ld8(xrow + 32 * s, x);
        const f32x4 g0 = *(const LAS f32x4*)(Gs + 32 * s + 8 * q), g1 = *(const LAS f32x4*)(Gs + 32 * s + 8 * q + 4), h0 = *(const LAS f32x4*)(Sh + 32 * s + 8 * q), h1 = *(const LAS f32x4*)(Sh + 32 * s + 8 * q + 4);
        const bf16x8 bh = *(const bf16x8*)(wh + 32 * s), bl = *(const bf16x8*)(wl + 32 * s);
        float h[8];
#pragma unroll
        for (int j = 0; j < 4; ++j) { h[j] = x[j] * rstd * g0[j] + h0[j]; h[4 + j] = x[4 + j] * rstd * g1[j] + h1[j]; }
        u32x4 hw; hw.x = pk2(h[0], h[1]); hw.y = pk2(h[2], h[3]); hw.z = pk2(h[4], h[5]); hw.w = pk2(h[6], h[7]);
        *(u32x4*)(hrow + 32 * s) = hw;
        u32x4 lw; lw.x = pk2(h[0] - bflo(hw.x), h[1] - bfhi(hw.x)); lw.y = pk2(h[2] - bflo(hw.y), h[3] - bfhi(hw.y)); lw.z = pk2(h[4] - bflo(hw.z), h[5] - bfhi(hw.z)); lw.w = pk2(h[6] - bflo(hw.w), h[7] - bfhi(hw.w));
        const bf16x8 ah = __builtin_bit_cast(bf16x8, hw), al = __builtin_bit_cast(bf16x8, lw);
        acc = __builtin_amdgcn_mfma_f32_16x16x32_bf16(ah, bh, acc, 0, 0, 0);
        acc = __builtin_amdgcn_mfma_f32_16x16x32_bf16(ah, bl, acc, 0, 0, 0);
        acc = __builtin_amdgcn_mfma_f32_16x16x32_bf16(al, bh, acc, 0, 0, 0);
    }
    float* AFF = (float*)(F.ws + WS_AFF);
#pragma unroll
    for (int g = 0; g < 4; ++g) {
        float mx = acc[g];
#pragma unroll
        for (int c_ = 0; c_ < 4; ++c_) mx = fmaxf(mx, dpp_f(mx, c_));
        const float e = __expf(acc[g] - mx);
        float den = e;
#pragma unroll
        for (int c_ = 0; c_ < 4; ++c_) den += dpp_f(den, c_);
        AFF[(size_t)(row0 + 4 * q + g) * 16 + r] = e * rcp_(den);
    }
}
__device__ __forceinline__ void phase_norm2_router_mfma(Frame& F, int l, int nrows, const float* norm2) {
    LAS float* Gs = (LAS float*)F.lds;
    LAS float* Sh = Gs + 2048;
    const float* MOD = (const float*)(F.ws + WS_MOD);
    const int b = (F.vcu * NWAVES * 16) >> 11;
    for (int i = F.tid; i < 2048; i += NTHR) { const int c = i & 1023, modrow = i < 1024 ? b : 16; const float* md = MOD + ((size_t)l * 17 + modrow) * 6144 + 3 * 1024;
        Gs[i] = norm2[(size_t)l * DM + c] * (1.0f + md[1024 + c]); Sh[i] = md[c]; }
    __syncthreads();
    const bf16_t* WRh = (const bf16_t*)(F.ws + WS_WRT) + (size_t)l * 2 * 16384; const bf16_t* WRl = WRh + 16384;
    n2_tile(F, 16 * F.gw, Gs, Sh, WRh, WRl);
    if (nrows > NLAT && F.wave == 0) n2_tile(F, NLAT + 16 * F.vcu, Gs + 1024, Sh + 1024, WRh, WRl);
}

__device__ __forceinline__ int block_sum_i(LAS int* red, int& par, int wave_val, int wave, int lane) {
    if (lane == 0) red[par * 8 + wave] = wave_val;
    __syncthreads();
    int s = 0;
#pragma unroll
    for (int w = 0; w < 8; ++w) s += red[par * 8 + w];
    par ^= 1;
    return s;
}
__device__ __forceinline__ int block_exscan_i(LAS int* red, int& par, int val, int wave, int lane) {
    int inc = val;
#pragma unroll
    for (int o = 1; o < 64; o <<= 1) { const int t = __shfl_up(inc, o); if (lane >= o) inc += t; }
    if (lane == 63) red[par * 8 + wave] = inc;
    __syncthreads();
    int base = 0;
#pragma unroll
    for (int w = 0; w < 8; ++w) base += (w < wave) ? red[par * 8 + w] : 0;
    par ^= 1;
    return base + inc - val;
}
__device__ __forceinline__ void topk_set(Frame& F, LAS int* red, int& par, int n, int cap, int rowbase, int e, int listbase) {
    const float* AFF = (const float*)(F.ws + WS_AFF); int* LIST = (int*)(F.ws + WS_LIST); int* SLOT = (int*)(F.ws + WS_SLOT);
    unsigned key[4];
#pragma unroll
    for (int j = 0; j < 4; ++j) { const int tok = 4 * F.tid + j; key[j] = (tok < n) ? __builtin_bit_cast(unsigned, AFF[(size_t)(rowbase + tok) * 16 + e]) : 0u; }
    unsigned T = 0u;
    for (int bit = 30; bit >= 0; --bit) {
        const unsigned cand = T | (1u << bit);
        int c = 0;
#pragma unroll
        for (int j = 0; j < 4; ++j) c += __popcll(__ballot(key[j] >= cand));
        if (block_sum_i(red, par, c, F.wave, F.lane) >= cap) T = cand;
    }
    int cgt = 0, ceq = 0;
#pragma unroll
    for (int j = 0; j < 4; ++j) { cgt += __popcll(__ballot(key[j] > T)); ceq += (key[j] == T) ? 1 : 0; }
    const int n_gt = block_sum_i(red, par, cgt, F.wave, F.lane);
    const int need_eq = cap - n_gt;
    int eqrank = block_exscan_i(red, par, ceq, F.wave, F.lane);
    int sel[4], csel = 0;
#pragma unroll
    for (int j = 0; j < 4; ++j) { const bool eq = key[j] == T; sel[j] = (key[j] > T || (eq && eqrank < need_eq)) ? 1 : 0; eqrank += eq ? 1 : 0; csel += sel[j]; }
    int slot = block_exscan_i(red, par, csel, F.wave, F.lane);
#pragma unroll
    for (int j = 0; j < 4; ++j) { const int tok = 4 * F.tid + j;
        if (tok < n) { SLOT[(size_t)(rowbase + tok) * 16 + e] = sel[j] ? slot : -1; if (sel[j]) { LIST[listbase + slot] = rowbase + tok; ++slot; } } }
}
__device__ __forceinline__ void phase_topk(Frame& F, bool need_ctx) {
    LAS int* red = (LAS int*)F.lds; int par = 0;
    for (int pair = F.vcu; pair < NB * NEXP; pair += F.G) {
        const int b = pair >> 4, e = pair & 15;
        topk_set(F, red, par, SEQ, CAPL, b * SEQ, e, e * PAIRS_E + b * CAPL);
        if (need_ctx) topk_set(F, red, par, CTXL, CAPC, NLAT + b * CTXL, e, e * PAIRS_E + NB * CAPL + b * CAPC);
    }
}

constexpr int SC_STEPS = 32;
constexpr int CS_AT = 0, CS_BT = 4608, CS_KT = 9216, CS_RT = 13824, CS_WC = 18432, CS_SET = CS_WC + 512;
__device__ __forceinline__ u32x2 cs_tr(const LAS char* arr, int row0, int col0, int lane) {
    const LAS char* p = arr + (row0 + ((lane & 15) >> 2)) * 144 + (col0 + 4 * (lane & 3)) * 2;
    return __builtin_bit_cast(u32x2, __builtin_amdgcn_ds_read_tr16_b64_v4i16((LAS attn_body::v4i16_t*)p));
}
constexpr int CS_WT = 2 * CS_SET, CS_NM = CS_WT + 1024, CS_ABK = CS_NM + 2560, CS_AVT = CS_ABK + 2 * 2560, CS_TT = CS_AVT + 2 * 10240, CS_CONV = CS_TT + 1024;
constexpr int CS_CST = CS_CONV + 4 * 4224, CS_YO = CS_CST + 1792, CS_VTR = CS_YO + 4608, CS_VTSZ = 4608;
static_assert(CS_SET % 16 == 0 && CS_VTR + 3 * CS_VTSZ <= MISC_OFF, "scan lds map");
__device__ __forceinline__ void scan_chunk_geom(int ci, int b, int d, int s, int& slen, int& t, size_t& row) {
    constexpr int NC = CTXL / SC_STEPS;
    const bool ctx = ci < NC; slen = ctx ? CTXL : SEQ; const int c0 = (ctx ? ci : ci - NC) * SC_STEPS; const int rowbase = ctx ? NLAT + b * CTXL : b * SEQ;
    t = d == 0 ? (c0 + s) : (slen - 1 - (c0 + s)); row = (size_t)(rowbase + t);
}
#define CS_MMA(x_, y_, c_) __builtin_amdgcn_mfma_f32_16x16x32_bf16(x_, y_, c_, 0, 0, 0)
__device__ __forceinline__ bf16x8 cs_ld16(const LAS char* p) { return *(const LAS bf16x8*)p; }
__device__ __forceinline__ bf16x8 cs_ld8x2(const LAS char* p0, const LAS char* p1) { const u32x2 a = *(const LAS u32x2*)p0, b = *(const LAS u32x2*)p1; const u32x4 w = {a.x, a.y, b.x, b.y}; return __builtin_bit_cast(bf16x8, w); }
__device__ __forceinline__ void cs_st16(LAS char* p, float x) { *(LAS unsigned short*)p = (unsigned short)pk2(x, x); }
#define CS_UD4(v_) asm volatile("" : "=v"(v_.x), "=v"(v_.y), "=v"(v_.z), "=v"(v_.w))
#define CS_UD8(a_) asm volatile("" : "=v"(a_[0]), "=v"(a_[1]), "=v"(a_[2]), "=v"(a_[3]), "=v"(a_[4]), "=v"(a_[5]), "=v"(a_[6]), "=v"(a_[7]))
#define CS_UNDEF_ALL() do { CS_UD4(rx[0]); CS_UD4(rx[1]); CS_UD4(rx[2]); CS_UD4(rp[0]); CS_UD4(rp[1]); CS_UD4(rp[2]); CS_UD4(rn[0]); CS_UD4(rn[1]); CS_UD4(rn[2]); CS_UD4(wu); CS_UD4(wa); \
        CS_UD8(pr_); CS_UD8(pkk); CS_UD8(pb); CS_UD8(pkd); CS_UD8(cpl); CS_UD8(cpu); asm volatile("" : "=v"(cv[0]), "=v"(cv[1]), "=v"(cv[2]), "=v"(cv[3]), "=v"(cv[4]), "=v"(cv[5]), "=v"(cv[6]), "=v"(cv[7])); \
        asm volatile("" : "=v"(cv[8]), "=v"(cv[9]), "=v"(cv[10]), "=v"(cv[11]), "=v"(cv[12]), "=v"(cv[13]), "=v"(cv[14]), "=v"(cv[15])); asm volatile("" : "=v"(cv_it)); } while (0)
#define CS_BAR() asm volatile("s_waitcnt lgkmcnt(0)\n\ts_barrier" ::: "memory")
template <int PR>
__device__ __forceinline__ void phase_scan(Frame& F, int l, const float* shift_mu, const float* rwkv_kk, const float* rwkv_ka, const float* exp_gate, const float* exp_up, const float* exp_down, const float* rwkv_rk, bool noconv_ = false) {
    const bool noconv = noconv_ || PR != 0;
    const bf16_t* P = (const bf16_t*)(F.ws + WS_PROJ); const bf16_t* WAG = (const bf16_t*)(F.ws + WS_WAG);
    LAS char* LB = (LAS char*)F.lds;
    const int tid = F.tid;
    const bool teamS = F.wave < 4;
    constexpr bool skipS = (PR & 1) != 0, skipP = (PR & 2) != 0, skipY = (PR & 4) != 0, skipS2 = (PR & 8) != 0, skipS3 = (PR & 16) != 0, skipP2 = (PR & 32) != 0;
    const int wv = F.wave & 3;
    const int pt = tid & 255, s = pt >> 3, cg = pt & 7;
    const int psc = s >> 4, pts = s & 15;
    constexpr int NCH = (CTXL + SEQ) / SC_STEPS;
    for (int chain = F.vcu; chain < 2 * NB * 8; chain += F.G) {
        const int d = chain >> 7, b = (chain >> 3) & 15, h = chain & 7;
        bf16_t* Y = (bf16_t*)(F.ws + (d == 0 ? WS_YF : WS_YB));
        const int hc = h * 64 + 8 * cg;
        if (tid < 448) {
            const int a_ = tid >> 6, c_ = tid & 63;
            const float* src = a_ == 0 ? rwkv_rk + (size_t)l * 512 : a_ == 4 ? rwkv_kk + (size_t)l * 512 : a_ >= 5 ? rwkv_ka + (size_t)l * 512 : shift_mu + (size_t)l * 1920 + 512 * (a_ - 1);
            const float cv_ = src[h * 64 + c_];
            ((LAS float*)(LB + CS_CST))[tid] = a_ == 6 ? 1.0f - cv_ : cv_;
        }
        __syncthreads();
        f32x4 Sacc[4];
#pragma unroll
        for (int j = 0; j < 4; ++j) Sacc[j] = (f32x4){0.f, 0.f, 0.f, 0.f};
        float cpl[8], cpu[8];
        float pr_[8], pkk[8], pb[8], pkd[8];
        u32x4 rx[3], rp[3], rn[3], wu, wa;
        float cv[16]; int cv_it = -1;
#define CS_FETCH(cix_, dep_) do { int slen_, t_; size_t row_; scan_chunk_geom((cix_), b, d, s + (dep_), slen_, t_, row_); const bool hp_ = t_ > 0, hn_ = t_ + 1 < slen_; \
              \
            const unsigned char* wsb_ = F.ws; const unsigned ro_ = (unsigned)row_; \
            const unsigned og_ = (unsigned)WS_PROJ + ro_ * (unsigned)(PW * 2) + (unsigned)((C_RW + hc) * 2), oz_ = (unsigned)(WS_CTL + 768 * 1024); \
            const unsigned op_ = hp_ ? og_ - (unsigned)(PW * 2) : oz_, on_ = hn_ ? og_ + (unsigned)(PW * 2) : oz_, ow_ = (unsigned)WS_WAG + ro_ * (unsigned)(WAGW * 2) + (unsigned)((d * 512 + hc) * 2); \
            _Pragma("unroll") for (int q = 0; q < 3; ++q) { rx[q] = *(const u32x4*)(wsb_ + og_ + 1024 * q); rp[q] = *(const u32x4*)(wsb_ + op_ + 1024 * q); rn[q] = *(const u32x4*)(wsb_ + on_ + 1024 * q); } \
            wu = *(const u32x4*)(wsb_ + ow_); wa = *(const u32x4*)(wsb_ + ow_ + 2048); } while (0)
#pragma unroll
        for (int i = 0; i < 16; ++i) cv[i] = 0.f;
        if (!teamS) CS_FETCH(0, 0);
        for (int ci = -2; ci < NCH; ++ci) {
            int lane = F.lane; asm volatile("" : "+v"(lane));
            const int r16 = lane & 15, q4 = lane >> 4;
            const int s = ((tid & 255) >> 6) * 8 + (lane >> 3), cg = lane & 7;
            const int psc = s >> 4, pts = s & 15;
            const int hc = h * 64 + 8 * cg;
            const LAS char* set0 = LB + (ci & 1) * CS_SET;
            const LAS char* set1 = LB + ((ci + 1) & 1) * CS_SET;
            if (teamS) {
                if (ci >= 0 && !skipS && !skipS3) {
                    const LAS char* setc = set0; const LAS char* vtc = LB + CS_VTR + (ci % 3) * CS_VTSZ; const LAS char* abk = LB + CS_ABK + (ci & 1) * 2560;
                    const int vrow = 16 * wv + r16;
#pragma unroll
                    for (int sc = 0; sc < 2; ++sc) {
                        bf16x8 sop[2];
#pragma unroll
                        for (int kk = 0; kk < 2; ++kk) { const u32x4 w = {pk2(Sacc[2 * kk][0], Sacc[2 * kk][1]), pk2(Sacc[2 * kk][2], Sacc[2 * kk][3]), pk2(Sacc[2 * kk + 1][0], Sacc[2 * kk + 1][1]), pk2(Sacc[2 * kk + 1][2], Sacc[2 * kk + 1][3])}; sop[kk] = __builtin_bit_cast(bf16x8, w); }
                        f32x4 uacc = *(const LAS f32x4*)(LB + CS_AVT + (ci & 1) * 10240 + (sc * 64 + vrow) * 80 + 16 * q4);
                        f32x4 yacc = {0.f, 0.f, 0.f, 0.f};
#pragma unroll
                        for (int kk = 0; kk < 2; ++kk) {
                            const LAS char* ah = setc + CS_AT + (16 * sc + r16) * 144 + 64 * kk + 8 * q4;
                            uacc = CS_MMA(cs_ld8x2(ah, ah + 32), sop[kk], uacc);
                            const LAS char* rt = setc + CS_RT + (16 * sc + r16) * 144 + 64 * kk + 8 * q4;
                            yacc = CS_MMA(cs_ld8x2(rt, rt + 32), sop[kk], yacc);
                        }
                        {
                            const u32x2 t2 = *(const LAS u32x2*)(LB + CS_TT + (sc * 16 + r16) * 32 + 8 * q4);
                            const u32x4 tw = {t2.x, t2.y, 0u, 0u}, pw = {pk2(uacc[0], uacc[1]), pk2(uacc[2], uacc[3]), 0u, 0u};
                            uacc = CS_MMA(__builtin_bit_cast(bf16x8, tw), __builtin_bit_cast(bf16x8, pw), ((f32x4){0.f, 0.f, 0.f, 0.f}));
                        }
                        const u32x2 v2 = cs_tr(vtc, 16 * sc + 4 * q4, 16 * wv, lane);
                        const u32x4 uvw = {pk2(uacc[0], uacc[1]), pk2(uacc[2], uacc[3]), v2.x, v2.y};
                        const bf16x8 uv = __builtin_bit_cast(bf16x8, uvw);
                        yacc = CS_MMA(cs_ld16(abk + (sc * 16 + r16) * 80 + 16 * q4), uv, yacc);
#pragma unroll
                        for (int tile = 0; tile < 4; ++tile) {
                            const f32x4 wc = *(const LAS f32x4*)(setc + CS_WC + (sc * 64 + 16 * tile + 4 * q4) * 4);
                            const u32x2 bt2 = cs_tr(setc + CS_BT, 16 * sc + 4 * q4, 16 * tile, lane), kt2 = cs_tr(setc + CS_KT, 16 * sc + 4 * q4, 16 * tile, lane);
                            const u32x4 bkw = {bt2.x, bt2.y, kt2.x, kt2.y};
                            Sacc[tile] = CS_MMA(__builtin_bit_cast(bf16x8, bkw), uv, Sacc[tile]) * wc;
                        }
#pragma unroll
                        for (int g = 0; g < 4; ++g) cs_st16(LB + CS_YO + (16 * sc + 4 * q4 + g) * 144 + 2 * vrow, yacc[g]);
                    }
                }
                if (ci + 1 >= 0 && ci + 1 < NCH && !skipS) {
                    const LAS char* setc = set1; const LAS char* vtc = LB + CS_VTR + ((ci + 1) % 3) * CS_VTSZ; LAS char* abk = LB + CS_ABK + ((ci + 1) & 1) * 2560;
                    const int sc = wv >> 1, role = wv & 1;
                    const LAS char* yop = setc + (role == 0 ? CS_AT : CS_RT) + (16 * sc + r16) * 144 + 16 * q4;
                    const LAS char* xb = setc + CS_BT + (16 * sc + r16) * 144 + 16 * q4;
                    const LAS char* xk = setc + CS_KT + (16 * sc + r16) * 144 + 16 * q4;
                    f32x4 accB = {0.f, 0.f, 0.f, 0.f}, accK = {0.f, 0.f, 0.f, 0.f};
#pragma unroll
                    for (int kk = 0; kk < 2; ++kk) { const bf16x8 yv = cs_ld16(yop + 64 * kk); accB = CS_MMA(cs_ld16(xb + 64 * kk), yv, accB); accK = CS_MMA(cs_ld16(xk + 64 * kk), yv, accK); }
                    if (role == 0) {
                        f32x4 nm; float ak[4];
#pragma unroll
                        for (int g = 0; g < 4; ++g) { const bool keep = 4 * q4 + g < r16; nm[g] = keep ? accB[g] : 0.f; ak[g] = keep ? accK[g] : 0.f; }
                        *(LAS f32x4*)(LB + CS_NM + (sc * 16 + r16) * 80 + 16 * q4) = nm;
                        const u32x4 xw = {pk2(ak[0], ak[1]), pk2(ak[2], ak[3]), 0u, 0u};
                        const bf16x8 xop = __builtin_bit_cast(bf16x8, xw);
#pragma unroll
                        for (int vt = 0; vt < 4; ++vt) {
                            const u32x2 v2 = cs_tr(vtc, 16 * sc + 4 * q4, 16 * vt, lane);
                            const u32x4 yw = {v2.x, v2.y, 0u, 0u};
                            f32x4 av = {0.f, 0.f, 0.f, 0.f};
                            av = CS_MMA(xop, __builtin_bit_cast(bf16x8, yw), av);
                            *(LAS f32x4*)(LB + CS_AVT + ((ci + 1) & 1) * 10240 + (sc * 64 + 16 * vt + r16) * 80 + 16 * q4) = av;
                        }
                    } else {
                        float rb[4], rk[4];
#pragma unroll
                        for (int g = 0; g < 4; ++g) { const bool keep = 4 * q4 + g <= r16; rb[g] = keep ? accB[g] : 0.f; rk[g] = keep ? accK[g] : 0.f; }
                        const u32x4 w = {pk2(rb[0], rb[1]), pk2(rb[2], rb[3]), pk2(rk[0], rk[1]), pk2(rk[2], rk[3])};
                        *(LAS u32x4*)(abk + (sc * 16 + r16) * 80 + 16 * q4) = w;
                    }
                }
                CS_UNDEF_ALL();
            } else {
              {
                  LAS float* scr = (LAS float*)(LB + CS_CONV) + (F.wave - 4) * (32 * 33);
                  convert_expert_finish32(F.ws, cv_it, cv, scr, F.lane);
              }
              int dep = 0;
              if (ci + 2 < NCH && !skipP) {
                int slen, t; size_t row;
                scan_chunk_geom(ci + 2, b, d, s, slen, t, row);
                const bool hp = t > 0, hn = t + 1 < slen;
                const LAS float* cst = (const LAS float*)(LB + CS_CST) + 8 * cg;
                float k[8], pv[8];
#pragma unroll
                for (int q = 0; q < 3; ++q) {
                    float x[8], xp[8], xn[8];
                    unpack8(rx[q], x); unpack8(rp[q], xp); unpack8(rn[q], xn);
                    const f32x4 m0 = *(const LAS f32x4*)(cst + 64 * (1 + q)), m1 = *(const LAS f32x4*)(cst + 64 * (1 + q) + 4);
#pragma unroll
                    for (int i = 0; i < 8; ++i) { const float m = i < 4 ? m0[i & 3] : m1[i & 3]; const float sft = x[i] + m * (0.5f * (xp[i] + xn[i]) - x[i]);
                        if (q == 0) pr_[i] = sft; else if (q == 1) k[i] = sft; else pv[i] = sft; }
                    __builtin_amdgcn_sched_barrier(0);
                }
                __builtin_amdgcn_sched_barrier(0);
                float pu[8], ag[8];
                unpack8(wu, pu); unpack8(wa, ag);
                asm volatile("" : "+v"(dep) : "v"(pu[0]), "v"(pu[1]), "v"(pu[2]), "v"(pu[3]), "v"(pu[4]), "v"(pu[5]), "v"(pu[6]), "v"(pu[7]), "v"(ag[0]), "v"(ag[1]), "v"(ag[2]), "v"(ag[3]), "v"(ag[4]), "v"(ag[5]), "v"(ag[6]), "v"(ag[7]), "v"(pr_[0]), "v"(k[0]), "v"(pv[0]), "v"(pr_[7]), "v"(k[7]), "v"(pv[7]));
                CS_FETCH(ci + 3 < NCH ? ci + 3 : NCH - 1, dep);
#pragma unroll
                for (int i = 0; i < 1; ++i) *(LAS u32x4*)(LB + CS_VTR + ((ci + 2) % 3) * CS_VTSZ + s * 144 + 16 * cg) = pack8(pv);
                const int cix2 = ci + 2; const bool bon_mine = cix2 < CTXL / SC_STEPS ? cix2 < CTXL / SC_STEPS / 2 : cix2 - CTXL / SC_STEPS < SEQ / SC_STEPS / 2;
                if (bon_mine) {
                    const f32x4 k0 = *(const LAS f32x4*)(cst), k1 = *(const LAS f32x4*)(cst + 4);
                    float bs = 0.f, bo[8];
#pragma unroll
                    for (int i = 0; i < 8; ++i) bs += pr_[i] * k[i] * (i < 4 ? k0[i & 3] : k1[i & 3]);
                    bs = sum8(bs);
#pragma unroll
                    for (int i = 0; i < 8; ++i) bo[i] = bs * pv[i];
                    *(u32x4*)(F.ws + ((unsigned)WS_BON + (unsigned)row * 1024u + (unsigned)(hc * 2))) = pack8(bo);
                }
#pragma unroll
                for (int i = 0; i < 8; ++i) cpu[i] = pu[i];
                {
                    float pl[8];
                    const int srcA = ((lane >> 4) - 1) * 16 + 8 + cg, srcB = ((lane >> 4) - 2) * 16 + 8 + cg;
                    const float mA = lane >= 16 ? 1.0f : 0.0f, mB = lane >= 32 ? 1.0f : 0.0f;
#pragma unroll
                    for (int i = 0; i < 8; ++i) pl[i] = pu[i] + __builtin_bit_cast(float, __builtin_amdgcn_update_dpp(0, __builtin_bit_cast(int, pu[i]), 0x118, 0xF, 0xF, true));
#pragma unroll
                    for (int i = 0; i < 8; ++i) { const float t_ = __builtin_bit_cast(float, __builtin_amdgcn_ds_bpermute(srcA * 4, __builtin_bit_cast(int, pl[i]))); pl[i] = __builtin_fmaf(t_, mA, pl[i]); }
#pragma unroll
                    for (int i = 0; i < 8; ++i) { const float t_ = __builtin_bit_cast(float, __builtin_amdgcn_ds_bpermute(srcB * 4, __builtin_bit_cast(int, pl[i]))); pl[i] = __builtin_fmaf(t_, mB, pl[i]); }
                    if (lane >= 56) { LAS float* wt = (LAS float*)(LB + CS_WT) + (s >> 3) * 64 + 8 * cg; *(LAS f32x4*)wt = (f32x4){pl[0], pl[1], pl[2], pl[3]}; *(LAS f32x4*)(wt + 4) = (f32x4){pl[4], pl[5], pl[6], pl[7]}; }
#pragma unroll
                    for (int i = 0; i < 8; ++i) cpl[i] = pl[i];
                }
                const f32x4 kk0 = *(const LAS f32x4*)(cst + 64 * 4), kk1 = *(const LAS f32x4*)(cst + 64 * 4 + 4), ka0 = *(const LAS f32x4*)(cst + 64 * 5), ka1 = *(const LAS f32x4*)(cst + 64 * 5 + 4), kc0 = *(const LAS f32x4*)(cst + 64 * 6), kc1 = *(const LAS f32x4*)(cst + 64 * 6 + 4);
                float kks[8], n2 = 0.f;
#pragma unroll
                for (int i = 0; i < 8; ++i) { kks[i] = k[i] * (i < 4 ? kk0[i & 3] : kk1[i & 3]); n2 += kks[i] * kks[i]; }
                n2 = sum8(n2);
                const float rn_ = rsq_(n2 + 1e-12f);
#pragma unroll
                for (int i = 0; i < 8; ++i) { pkk[i] = kks[i] * rn_; pb[i] = pkk[i] * ag[i]; pkd[i] = k[i] * __builtin_fmaf(ag[i], i < 4 ? ka0[i & 3] : ka1[i & 3], i < 4 ? kc0[i & 3] : kc1[i & 3]); }
              }
            }
            CS_BAR();
            if (teamS) {
                if (ci + 1 >= 0 && ci + 1 < NCH && !skipS && !skipS2) {
                    const LAS char* setc = set1;
                    const int sc = wv >> 1, part = wv & 1;
                    if (part == 0) {
                        const LAS float* nrow = (const LAS float*)(LB + CS_NM + sc * 1280);
                        float xs[16];
#pragma unroll
                        for (int t = 0; t < 16; ++t) xs[t] = t == r16 ? 1.0f : 0.0f;
#pragma unroll
                        for (int t = 1; t < 16; ++t) {
                            float a3[3] = {xs[t], 0.f, 0.f};
#pragma unroll
                            for (int i4 = 0; i4 < (t + 3) / 4; ++i4) {
                                const f32x4 n4 = *(const LAS f32x4*)(nrow + t * 20 + 4 * i4);
#pragma unroll
                                for (int jx = 0; jx < 4; ++jx) if (4 * i4 + jx < t) a3[(4 * i4 + jx) % 3] += n4[jx] * xs[4 * i4 + jx];
                            }
                            xs[t] = (a3[0] + a3[1]) + a3[2];
                        }
                        if (lane < 16) {
#pragma unroll
                            for (int t = 0; t < 16; ++t) cs_st16(LB + CS_TT + (sc * 16 + t) * 32 + 2 * lane, xs[t]);
                        }
                    }
                }
                CS_UNDEF_ALL();
            } else {
              {
                  const int pw = F.vcu * 4 + (F.wave - 4), npw = F.G * 4;
                  const int it = ((ci / 3) * 2 + (ci % 3)) * npw + pw;
                  const bool valid = ci >= 0 && ci % 3 != 2 && chain < F.G && !noconv && it < 3 * NEXP * 1024;
                  cv_it = valid ? it : -1;
                  convert_expert_issue32(l, valid ? it : pw, exp_gate, exp_up, exp_down, cv, lane);
              }
              if (ci + 2 < NCH && !skipP && !skipP2) {
                LAS char* setn = LB + (ci & 1) * CS_SET;
                float li[8], lt[8];
                {
                    const int wq = s >> 3;
                    const LAS float* w0 = (const LAS float*)(LB + CS_WT) + wq * 64 + 8 * cg; const LAS float* w1 = (const LAS float*)(LB + CS_WT) + (wq ^ 1) * 64 + 8 * cg;
                    const f32x4 a0 = *(const LAS f32x4*)w0, a1 = *(const LAS f32x4*)(w0 + 4), b0 = *(const LAS f32x4*)w1, b1 = *(const LAS f32x4*)(w1 + 4);
                    const float m = (wq & 1) ? 1.0f : 0.0f;
#pragma unroll
                    for (int i = 0; i < 4; ++i) { lt[i] = a0[i] + b0[i]; lt[4 + i] = a1[i] + b1[i]; li[i] = cpl[i] + m * b0[i]; li[4 + i] = cpl[4 + i] + m * b1[i]; }
                }
                float at[8], bt[8], kt[8], rt[8], pu[8], wts[8];
#pragma unroll
                for (int i = 0; i < 8; ++i) pu[i] = cpu[i];
#pragma unroll
                for (int i = 0; i < 8; ++i) {
                    const float wt = __builtin_amdgcn_exp2f(-li[i]), wprev = __builtin_amdgcn_exp2f(pu[i] - li[i]), iw = __builtin_amdgcn_exp2f(li[i]); wts[i] = wt;
                    at[i] = -pkk[i] * wprev; bt[i] = pb[i] * iw; kt[i] = pkd[i] * iw; rt[i] = pr_[i] * wt;
                }
                *(LAS u32x4*)(setn + CS_AT + s * 144 + 16 * cg) = pack8(at);
                *(LAS u32x4*)(setn + CS_BT + s * 144 + 16 * cg) = pack8(bt);
                *(LAS u32x4*)(setn + CS_KT + s * 144 + 16 * cg) = pack8(kt);
                *(LAS u32x4*)(setn + CS_RT + s * 144 + 16 * cg) = pack8(rt);
                if (pts == 15) {
                    LAS float* wc = (LAS float*)(setn + CS_WC) + psc * 64 + 8 * cg;
                    *(LAS f32x4*)wc = (f32x4){wts[0], wts[1], wts[2], wts[3]}; *(LAS f32x4*)(wc + 4) = (f32x4){wts[4], wts[5], wts[6], wts[7]};
                }
            }
              if (ci >= 0 && !(skipS || skipS3 || skipY)) {
                  int slen, t; size_t row;
                  scan_chunk_geom(ci, b, d, s, slen, t, row);
                  *(u32x4*)(F.ws + ((unsigned)(d == 0 ? WS_YF : WS_YB) + (unsigned)row * 1024u + (unsigned)(hc * 2))) = *(const LAS u32x4*)(LB + CS_YO + s * 144 + 16 * cg);
              }
            }
            CS_BAR();
        }
        if (!teamS) { LAS float* scr = (LAS float*)(LB + CS_CONV) + (F.wave - 4) * (32 * 33); convert_expert_finish32(F.ws, cv_it, cv, scr, F.lane); }
        __syncthreads();
#undef CS_FETCH
    }
}
#undef CS_MMA

struct RoRow { u32x4 yf, yb, bo, g; };
__device__ __forceinline__ void ro_load(Frame& F, RoRow& R, int row) {
    const int lane = F.lane;
    R.yf = *(const u32x4*)((const bf16_t*)(F.ws + WS_YF) + (size_t)row * 512 + 8 * lane); R.yb = *(const u32x4*)((const bf16_t*)(F.ws + WS_YB) + (size_t)row * 512 + 8 * lane);
    R.bo = *(const u32x4*)((const bf16_t*)(F.ws + WS_BON) + (size_t)row * 512 + 8 * lane);
    R.g = *(const u32x4*)((const bf16_t*)(F.ws + WS_WAG) + (size_t)row * WAGW + 2048 + 8 * lane);
}
__device__ __forceinline__ void phase_readout(Frame& F, int l, int nrows, const float* gn_w, const float* gn_b) {
    bf16_t* P = (bf16_t*)(F.ws + WS_PROJ);
    const int lane = F.lane;
    float gw[8], gb[8];
#pragma unroll
    for (int i = 0; i < 8; ++i) { gw[i] = gn_w[(size_t)l * 512 + 8 * lane + i]; gb[i] = gn_b[(size_t)l * 512 + 8 * lane + i]; }
    for (int row0 = F.gw; row0 < nrows; row0 += 4 * F.NGW) {
        RoRow RR[4]; int rows[4]; bool ok[4];
#pragma unroll
        for (int z = 0; z < 4; ++z) { rows[z] = row0 + z * F.NGW; ok[z] = rows[z] < nrows; ro_load(F, RR[z], ok[z] ? rows[z] : row0); }
#pragma unroll
        for (int z = 0; z < 4; ++z) {
            if (!ok[z]) continue;
            const RoRow& R = RR[z];
            float yf[8], yb[8], y[8];
            unpack8(R.yf, yf); unpack8(R.yb, yb);
            float sm = 0.f;
#pragma unroll
            for (int i = 0; i < 8; ++i) { y[i] = yf[i] + yb[i]; sm += y[i]; }
            const float mean = sum8(sm) * (1.0f / 64.0f);
            float sq = 0.f;
#pragma unroll
            for (int i = 0; i < 8; ++i) { y[i] -= mean; sq += y[i] * y[i]; }
            const float rstd = rsq_(sum8(sq) * (1.0f / 64.0f) + GN_EPS);
            float bo[8], g[8], o[8];
            unpack8(R.bo, bo); unpack8(R.g, g);
#pragma unroll
            for (int i = 0; i < 8; ++i) o[i] = (y[i] * rstd * gw[i] + gb[i] + bo[i]) * g[i];
            st8(P + (size_t)rows[z] * PW + C_ORWKV + 8 * lane, o);
        }
    }
}
__device__ __forceinline__ void phase_attention(Frame& F, bool need_ctx, char* lds_generic) {
    typedef attn_body::bf16 abf;
    abf* P = (abf*)(F.ws + WS_PROJ);
    const int nu = (need_ctx && F.vcu < NB * 8) ? 5 : 4;
    for (int i = 0; i < nu; ++i) {
        int b, h, qrow, NT;
        if (i < 4) { const int u = F.vcu * 4 + i; b = u >> 6; h = (u >> 3) & 7; qrow = b * SEQ + (u & 7) * 256; NT = (CTXL + SEQ) / 64; }
        else { b = F.vcu >> 3; h = F.vcu & 7; qrow = NLAT + b * CTXL; NT = CTXL / 64; }
        abf* Qu = P + (size_t)qrow * PW + C_Q + h * 64;
        attn_body::attn_unit<8>(Qu, Qu + (C_OATT - C_Q), P + C_K + (h >> 2) * 64, NLAT + b * CTXL, b * SEQ, NT, CTXL / 64, lds_generic);
    }
}

struct Args { const float* in[32]; float* out; unsigned char* ws; int ph_lo, ph_hi; };
constexpr int PH_PER_LAYER = 12, PH_FINAL = 1 + NL * PH_PER_LAYER, PH_END = PH_FINAL + 1;

__global__ void __launch_bounds__(NTHR, 2) mega_fwd(Args args) {
    extern __shared__ __attribute__((aligned(16))) unsigned char lds[];
    Frame F;
    F.lds = (LAS unsigned char*)lds;
    F.tid = threadIdx.x; F.lane = F.tid & 63; F.wave = __builtin_amdgcn_readfirstlane(F.tid >> 6);
    F.G = gridDim.x; { const int bx = blockIdx.x; F.vcu = (F.G % 8 == 0) ? (bx % 8) * (F.G / 8) + bx / 8 : bx; }
    F.gw = F.vcu * NWAVES + F.wave; F.NGW = F.G * NWAVES; F.bid = blockIdx.x;
    F.out = args.out; F.ws = args.ws;
    volatile LAS unsigned* MISC = (volatile LAS unsigned*)(F.lds + MISC_OFF);
    for (int u = F.tid; u < (LDS_BYTES - MISC_OFF) / 4; u += NTHR) MISC[u] = 0u;
    __syncthreads();
    unsigned* ctl = (unsigned*)(F.ws + WS_CTL);
    XcdBarrier bar = xcd_barrier_post(ctl + CW_BAR, MISC + 8);
    const int lo = args.ph_lo, hi = args.ph_hi;
    typedef const __attribute__((address_space(1))) float* cfp_t;
#define KP(k) ((const float*)KIN[k])
#define KIN_DECL const __attribute__((address_space(4))) cfp_t* KIN = (const __attribute__((address_space(4))) cfp_t*)__builtin_amdgcn_kernarg_segment_ptr(); asm volatile("" : "+s"(KIN))
#ifndef PHMASK
#define PHMASK 0xFFFFFFFFu
#endif
#define IN(k) (lo <= (k) && (k) < hi)
#define EN(j) ((PHMASK >> (j)) & 1u)
#define SEAM(k) do { if ((k) + 1 < hi) xcd_barrier(bar); } while (0)
#ifndef DUPMASK
#define DUPMASK 0u
#endif
#define REP(j) for (int rep_ = 0; rep_ < 1 + (int)((DUPMASK >> (j)) & 1u); ++rep_)
#ifdef PROBE_T1
    unsigned long long pt0 = 0; int l_ = 0; volatile LAS unsigned* PTS = MISC + 64;
#define PB() do { pt0 = __builtin_amdgcn_s_memrealtime(); } while (0)
#define PE(j) do { PTS[(j) * 4 + (l_ & 3)] = (unsigned)(__builtin_amdgcn_s_memrealtime() - pt0); } while (0)
#else
#define PB() do {} while (0)
#define PE(j) do {} while (0)
#endif

    if (EN(0) && IN(0)) { relaunder(F); PB(); KIN_DECL; REP(0) phase_prologue(F, KP(1), KP(3), KP(4), KP(5), KP(7), KP(12), KP(14), KP(15), KP(22), KP(23), KP(24), KP(25), KP(27)); SEAM(0); PE(0); }

    for (int l = 0; l < NL; ++l) {
#ifdef PROBE_T1
        l_ = l;
#endif
        const int pb = 1 + l * PH_PER_LAYER;
        const bool need_ctx = l < NL - 1;
        const int nrows = need_ctx ? NTOK : NLAT;
        if (EN(1) && IN(pb + 0)) { relaunder(F); PB(); KIN_DECL; REP(1) phase_norm1(F, l, KP(0), KP(2), KP(6), KP(31), rep_ > 0); SEAM(pb + 0); PE(1); }
        if (EN(2) && IN(pb + 1)) { relaunder(F); PB();
            pg8::EpiProj E{(bf16_t*)(F.ws + WS_PROJ), F.ws + WS_GATES};
            if (need_ctx) { pg8::PlainOrder S; S.init(F.ws + WS_H, F.ws + WS_WIN + (size_t)l * PWP * DM * 2, NTOK, PWP, DM, DM, F.G, F.bid);
                REP(2) pg8::gemm_phase<pg8::EpiProj, pg8::PlainOrder, false>(F.lds, DM, DM, DM, S, E); }
            else { pg8::LastProjOrder S; S.init(F.ws + WS_H, F.ws + WS_WIN + (size_t)l * PWP * DM * 2, DM, DM, F.G, F.bid);
                pg8::gemm_phase<pg8::EpiProj, pg8::LastProjOrder, false>(F.lds, DM, DM, DM, S, E); }
            SEAM(pb + 1); PE(2);
        }
        if (EN(3) && IN(pb + 2)) { relaunder(F); PB(); KIN_DECL; REP(3) phase_prep(F, l, KP(8), KP(9), KP(21), KP(10), rep_ > 0); SEAM(pb + 2); PE(3); }
        if (EN(4) && IN(pb + 3)) { relaunder(F); PB();
            pg8::LowRankOrder S{(const char*)(F.ws + WS_LRA), (const char*)(F.ws + WS_WLR + (size_t)l * WAGW * 128 * 2), NTOK / 256, F.G, F.bid};
            KIN_DECL; pg8::EpiLowRank E{(bf16_t*)(F.ws + WS_WAG), KP(11) + (size_t)l * 1024, KP(13) + (size_t)l * 1024};
            int klr = 128; asm volatile("" : "+s"(klr));
            REP(4) pg8::gemm_phase<pg8::EpiLowRank, pg8::LowRankOrder, false>(F.lds, klr, LRAW, 128, S, E);
            REP(14) phase_attention(F, need_ctx, (char*)lds);
            SEAM(pb + 3); PE(4);
        }
        if (EN(5) && IN(pb + 4)) { relaunder(F); PB(); KIN_DECL; REP(5) phase_scan<0>(F, l, KP(10), KP(16), KP(17), KP(28), KP(29), KP(30), KP(18), rep_ > 0);
#ifdef SCAN_PROBE
            phase_scan<SCAN_PROBE>(F, l, KP(10), KP(16), KP(17), KP(28), KP(29), KP(30), KP(18), true);
#endif
 SEAM(pb + 4); PE(5); }
        if (EN(6) && IN(pb + 5)) { relaunder(F); PB(); KIN_DECL; REP(6) phase_readout(F, l, nrows, KP(19), KP(20)); SEAM(pb + 5); PE(6); }
        if (EN(7) && IN(pb + 6)) { relaunder(F); PB();
            pg8::MergeOrder S{(const char*)(F.ws + WS_PROJ), (const char*)(F.ws + WS_WBR + (size_t)l * 3 * 1024 * 512 * 2), nrows / 256, F.G, F.bid};
            pg8::EpiMerge E{(const unsigned char*)(F.ws + WS_GATES), (bf16_t*)(F.ws + WS_H)};
            REP(7) pg8::gemm_phase<pg8::EpiMerge, pg8::MergeOrder, false>(F.lds, 512, PW, 512, S, E);
            SEAM(pb + 6); PE(7);
        }
        if (EN(8) && IN(pb + 7)) { relaunder(F); PB();
            pg8::PlainOrder S; S.init(F.ws + WS_H, F.ws + WS_WOUT + (size_t)l * DM * DM * 2, nrows, DM, DM, DM, F.G, F.bid);
            pg8::EpiOut E{(bf16_t*)(F.ws + WS_XB), (const float*)(F.ws + WS_MOD) + (size_t)l * 17 * 6144};
            pg8::gemm_phase<pg8::EpiOut, pg8::PlainOrder, false>(F.lds, DM, DM, DM, S, E);
            SEAM(pb + 7); PE(8);
        }
        if (EN(9) && IN(pb + 8)) { relaunder(F); PB(); KIN_DECL; REP(9) phase_norm2_router_mfma(F, l, nrows, KP(26)); SEAM(pb + 8); PE(9); }
        if (EN(10) && IN(pb + 9)) { relaunder(F); PB(); REP(10) phase_topk(F, need_ctx); SEAM(pb + 9); PE(10); }
        if (EN(11) && IN(pb + 10)) { relaunder(F); PB();
            const int mt_per = need_ctx ? 18 : 16;
            LAS int* rows = (LAS int*)(F.lds + XTRA_OFF);
            pg8::MoeOrder S{(const char*)(F.ws + WS_H), (const char*)(F.ws + WS_WUP), rows, mt_per, 8, F.G, F.bid, (size_t)2048 * 1024 * 2};
            const int* LIST = (const int*)(F.ws + WS_LIST);
            for (int i = 0; i < XTRA_BYTES / 1024; ++i) { int e, mt, pn; if (!S.decode((long)i * F.G + F.bid, e, mt, pn)) break;
                if (F.tid < 256) rows[i * 256 + F.tid] = LIST[e * PAIRS_E + mt * 256 + F.tid]; }
            __syncthreads();
            pg8::EpiUp E{(bf16_t*)(F.ws + WS_HID)};
            REP(11) pg8::gemm_phase<pg8::EpiUp, pg8::MoeOrder, true>(F.lds, DM, DM, DM, S, E);
            SEAM(pb + 10); PE(11);
        }
        if (EN(12) && IN(pb + 11)) { relaunder(F); PB();
            const int mt_per = need_ctx ? 18 : 16;
            pg8::MoeDownOrder S{(const char*)(F.ws + WS_HID), (const char*)(F.ws + WS_WDN), mt_per, F.G, F.bid};
            pg8::EpiDown E{(bf16_t*)(F.ws + WS_YE)};
            REP(12) pg8::gemm_phase<pg8::EpiDown, pg8::MoeDownOrder, false>(F.lds, EFF, EFF, EFF, S, E);
            SEAM(pb + 11); PE(12);
        }
    }
    if (EN(13) && IN(PH_FINAL)) { relaunder(F); PB(); KIN_DECL; phase_norm1(F, NL, KP(0), KP(2), KP(6), KP(31)); PE(13); }
#ifdef PROBE_T1
    {
        __syncthreads();
        if (blockIdx.x == 0 && threadIdx.x == 0) { unsigned s1 = 0, s2 = 0; for (int q = 0; q < 4; ++q) { s1 += PTS[PROBE_T1 * 4 + q]; s2 += PTS[PROBE_T2 * 4 + q]; } ctl[CW_DBG] = s1; ctl[CW_DBG + 1] = s2; }
        xcd_barrier(bar);
        const float t1 = (float)__hip_atomic_load(ctl + CW_DBG, __ATOMIC_RELAXED, __HIP_MEMORY_SCOPE_AGENT), t2 = (float)__hip_atomic_load(ctl + CW_DBG + 1, __ATOMIC_RELAXED, __HIP_MEMORY_SCOPE_AGENT);
        const float cval = 10.0f * sqrtf(t1 * 0.01f);
        for (size_t i = (size_t)F.bid * NTHR + F.tid; i < (size_t)NLAT * DM; i += (size_t)F.G * NTHR) F.out[i] = (i == 0) ? t2 : cval;
    }
#endif
#undef IN
#undef SEAM
}

extern "C" void kernel_launch(void* const* d_in, const int* in_sizes, int n_in, void* d_out, int out_size, void* d_ws, size_t ws_size, hipStream_t stream) {
    static int grid = 0;
    if (grid == 0) {
        if (n_in != 32 || in_sizes[0] != NLAT * DM || out_size != NLAT * DM || ws_size < WS_END) { fprintf(stderr, "kernel_launch: unexpected shapes / workspace (n_in %d, ws %zu)\n", n_in, ws_size); grid = -1; return; }
        int dev = 0, cus = 0, per_cu = 0;
        if (hipGetDevice(&dev) != hipSuccess || hipDeviceGetAttribute(&cus, hipDeviceAttributeMultiprocessorCount, dev) != hipSuccess) { grid = -1; return; }
        if (hipFuncSetAttribute((const void*)mega_fwd, hipFuncAttributeMaxDynamicSharedMemorySize, LDS_BYTES) != hipSuccess) { grid = -1; return; }
        if (hipOccupancyMaxActiveBlocksPerMultiprocessor(&per_cu, (const void*)mega_fwd, NTHR, LDS_BYTES) != hipSuccess || per_cu < 1) { fprintf(stderr, "kernel_launch: occupancy query says %d\n", per_cu); }
        (void)hipGetLastError();
        grid = cus;
        if (grid != 256) { fprintf(stderr, "kernel_launch: built for 256 CUs, got %d\n", grid); grid = -1; return; }
    }
    if (grid < 0) return;
    if (hipMemsetAsync((char*)d_ws + WS_CTL, 0, CTL_ZERO_BYTES, stream) != hipSuccess) return;
    Args a{};
    for (int i = 0; i < 32; ++i) a.in[i] = (const float*)d_in[i];
    a.out = (float*)d_out; a.ws = (unsigned char*)d_ws;
#ifndef MK_PER_PHASE
    a.ph_lo = 0; a.ph_hi = PH_END;
    hipLaunchKernelGGL(mega_fwd, dim3(grid), dim3(NTHR), LDS_BYTES, stream, a);
#else
    for (int p = 0; p < PH_END; ++p) { a.ph_lo = p; a.ph_hi = p + 1; hipLaunchKernelGGL(mega_fwd, dim3(grid), dim3(NTHR), LDS_BYTES, stream, a); }
#endif
}
```
